# Optimizing an MI355X kernel written in HIP

```python
import math
import jax, jax.numpy as jnp
from jax import lax
import numpy as np

D_MODEL = 4096
BATCH = 16
SEQ = 256
DEPTH = 2
DEC_BATCH = 2
DEC_SEQ = 4096
PAST_LEN = 512

GRID_W = 64
POS_BASE = 10000.0
EPS = 1e-6
F32 = jnp.float32
N_EVEN = (DEPTH + 1) // 2
N_ODD = DEPTH // 2
BRANCH_W = D_MODEL // 2
SHORT_CONV = 3
GDN_DK = 128
GDN_DV = 128
GDN_HEADS = BRANCH_W // GDN_DV
GDN_KW = GDN_HEADS * GDN_DK
GDN_W = GDN_HEADS * GDN_DV
GDN_CHUNK = 64
SSD_HEAD_DIM = 64
SSD_HEADS = BRANCH_W // SSD_HEAD_DIM
SSD_W = SSD_HEADS * SSD_HEAD_DIM
SSD_GROUPS = 8
SSD_STATE = 128
SSD_CHUNK = 128
HY_ORDER = 2
HY_W = BRANCH_W
HY_BANDS = 16
HY_EMB = 2 * HY_BANDS + 1
HY_FFN = 64
HY_TARGET = 1e-2
HY_MIN_DECAY = math.log(HY_TARGET) / 1.5
HY_MAX_DECAY = math.log(HY_TARGET) / 0.3
HG_DK = 128
HG_DV = 128
HG_HEADS = BRANCH_W // HG_DV
HG_KW = HG_HEADS * HG_DK
HG_W = HG_HEADS * HG_DV
HG_CHUNK = 32
EVEN_SPLIT = (2 * GDN_KW + GDN_W, 2 * GDN_HEADS, 2 * GDN_HEADS, GDN_W, SSD_W + 2 * SSD_GROUPS * SSD_STATE, 2 * SSD_HEADS, SSD_W)
ODD_SPLIT = (3 * HY_W, HY_W, HG_KW, 2 * HG_KW, HG_W, HG_W)
IN_EVEN = sum(EVEN_SPLIT)
IN_ODD = sum(ODD_SPLIT)
MIX_W = GDN_W + SSD_W

kernel_name = 'bidir_hybrid_gdn_ssd_hyena_hgrn2_prefix_ctx_step'


def _split(u, sizes):
    return jnp.split(u, np.cumsum(sizes)[:-1].tolist(), axis=-1)


def _rmsnorm(x, g):
    xf = x.astype(F32)
    y = xf * lax.rsqrt(jnp.mean(xf * xf, axis=-1, keepdims=True) + EPS)
    return y * g.astype(F32)


def _l2norm(x):
    xf = x.astype(F32)
    return xf * lax.rsqrt(jnp.sum(xf * xf, axis=-1, keepdims=True) + EPS)


def _flip(t):
    return jnp.flip(t, axis=1)


def _short_conv(x, w):
    k = w.shape[0]
    l = x.shape[1]
    pad = k // 2
    xp = jnp.pad(x, ((0, 0), (pad, k - 1 - pad), (0, 0)))
    return sum(xp[:, i:i + l] * w[i] for i in range(k))


def _grid_pos_embed(n_tokens, dim):
    rows = n_tokens // GRID_W
    r, col = jnp.meshgrid(jnp.arange(rows, dtype=F32), jnp.arange(GRID_W, dtype=F32), indexing='ij')
    r, col = r.reshape(-1), col.reshape(-1)
    quarter = dim // 4
    omega = 1.0 / (POS_BASE ** (jnp.arange(quarter, dtype=F32) / quarter))
    ar = r[:, None] * omega
    ac = col[:, None] * omega
    return jnp.concatenate([jnp.sin(ar), jnp.cos(ar), jnp.sin(ac), jnp.cos(ac)], axis=-1)


def _gdn_chunked(q, k, v, beta, g, s0):
    b, l, h, dk = q.shape
    dv = v.shape[-1]
    c = GDN_CHUNK
    nc = l // c
    rs = lambda t: t.astype(F32).reshape(b, nc, c, *t.shape[2:])
    q, k, v, beta, g = rs(q), rs(k), rs(v), rs(beta), rs(g)
    gc = jnp.cumsum(g, axis=2)
    gct = jnp.swapaxes(gc, 2, 3)
    causal = jnp.tril(jnp.ones((c, c), bool))
    strict = jnp.tril(jnp.ones((c, c), bool), -1)
    decay = jnp.exp(jnp.where(causal, gct[..., :, None] - gct[..., None, :], -jnp.inf))
    kb = k * beta[..., None]
    kk = jnp.einsum('bcihd,bcjhd->bchij', kb, k) * decay
    eye = jnp.eye(c, dtype=F32)
    m = eye + jnp.where(strict, kk, 0.0)
    t_inv = lax.linalg.triangular_solve(m, jnp.broadcast_to(eye, m.shape), left_side=True, lower=True, unit_diagonal=True)
    u = jnp.einsum('bchij,bcjhd->bcihd', t_inv, v * beta[..., None])
    w = jnp.einsum('bchij,bcjhd->bcihd', t_inv, kb * jnp.exp(gc)[..., None])
    qk = jnp.einsum('bcihd,bcjhd->bchij', q, k) * decay
    qg = q * jnp.exp(gc)[..., None]
    kg = k * jnp.exp(gc[:, :, -1:] - gc)[..., None]
    glast = jnp.exp(gc[:, :, -1])

    def step(s, inp):
        u_c, w_c, qk_c, qg_c, kg_c, gl_c = inp
        v_new = u_c - jnp.einsum('bihk,bhkv->bihv', w_c, s)
        o = jnp.einsum('bihk,bhkv->bihv', qg_c, s) + jnp.einsum('bhij,bjhv->bihv', qk_c, v_new)
        s = s * gl_c[..., None, None] + jnp.einsum('bjhk,bjhv->bhkv', kg_c, v_new)
        return s, o

    xs = tuple(jnp.moveaxis(t, 1, 0) for t in (u, w, qk, qg, kg, glast))
    s_fin, o = lax.scan(step, s0.astype(F32), xs)
    return jnp.moveaxis(o, 0, 1).reshape(b, l, h, dv), s_fin


def _ssd_chunked(x, dt, a, bm, cm, s0):
    b, l, nh, p = x.shape
    ng, n = bm.shape[2], bm.shape[3]
    r = nh // ng
    c = SSD_CHUNK
    nc = l // c
    x = x.astype(F32).reshape(b, nc, c, ng, r, p)
    dt = dt.astype(F32).reshape(b, nc, c, ng, r)
    bm = bm.astype(F32).reshape(b, nc, c, ng, n)
    cm = cm.astype(F32).reshape(b, nc, c, ng, n)
    acum = jnp.cumsum(dt * a.astype(F32).reshape(ng, r), axis=2)
    at = jnp.moveaxis(acum, 2, -1)
    causal = jnp.tril(jnp.ones((c, c), bool))
    lmat = jnp.exp(jnp.where(causal, at[..., :, None] - at[..., None, :], -jnp.inf))
    cb = jnp.einsum('bcign,bcjgn->bcgij', cm, bm)
    xdt = x * dt[..., None]
    y_diag = jnp.einsum('bcgij,bcgrij,bcjgrp->bcigrp', cb, lmat, xdt)
    decay_end = jnp.exp(acum[:, :, -1:] - acum)
    chunk_states = jnp.einsum('bcjgn,bcjgr,bcjgrp->bcgrpn', bm, decay_end, xdt)
    chunk_decay = jnp.exp(acum[:, :, -1])

    def step(s, inp):
        cs, cd = inp
        return s * cd[..., None, None] + cs, s

    s_fin, s_in = lax.scan(step, s0.astype(F32).reshape(b, ng, r, p, n),
                           (jnp.moveaxis(chunk_states, 1, 0), jnp.moveaxis(chunk_decay, 1, 0)))
    s_in = jnp.moveaxis(s_in, 0, 1)
    y_off = jnp.einsum('bcign,bcgrpn,bcigr->bcigrp', cm, s_in, jnp.exp(acum))
    return (y_diag + y_off).reshape(b, l, nh, p), s_fin.reshape(b, nh, p, n)


def _gla_chunked(q, k, v, logf, s0):
    b, l, h, dk = q.shape
    dv = v.shape[-1]
    c = HG_CHUNK
    nc = l // c
    to_chunks = lambda t: jnp.moveaxis(t.astype(F32).reshape(b, nc, c, h, t.shape[-1]), 1, 0)
    qc, kc, vc, gc = to_chunks(q), to_chunks(k), to_chunks(v), to_chunks(logf)
    gc = jnp.cumsum(gc, axis=2)
    causal = jnp.tril(jnp.ones((c, c), bool))[None, :, :, None, None]

    def step(s, inp):
        q_i, k_i, v_i, g_i = inp
        g_last = g_i[:, -1]
        pair = jnp.exp(jnp.where(causal, g_i[:, :, None] - g_i[:, None, :], -jnp.inf))
        att = jnp.einsum('bihk,bjhk,bijhk->bhij', q_i, k_i, pair)
        o = jnp.einsum('bihk,bhkv->bihv', q_i * jnp.exp(g_i), s) + jnp.einsum('bhij,bjhv->bihv', att, v_i)
        s = s * jnp.exp(g_last)[..., None] + jnp.einsum('bjhk,bjhv->bhkv', k_i * jnp.exp(g_last[:, None] - g_i), v_i)
        return s, o

    s_fin, o = lax.scan(step, s0.astype(F32), (qc, kc, vc, gc))
    return jnp.moveaxis(o, 0, 1).reshape(b, l, h, dv), s_fin


def _hyena_filter_spectra(l, w1, b1, freq, w2, b2, w3):
    pos = jnp.arange(l, dtype=F32)
    t = pos / (l - 1)
    bands = jnp.linspace(1e-4, HY_BANDS - 1, HY_BANDS, dtype=F32)
    ang = (2.0 * math.pi / l) * pos[:, None] * bands[None]
    z = jnp.concatenate([t[:, None], jnp.cos(ang), -jnp.sin(ang)], axis=-1)
    hdn = jnp.sin(freq[0] * (z @ w1 + b1))
    hdn = jnp.sin(freq[1] * (hdn @ w2 + b2))
    filt = (hdn @ w3).astype(F32).reshape(l, 2, HY_ORDER, HY_W)
    deltas = jnp.abs(jnp.linspace(HY_MIN_DECAY, HY_MAX_DECAY, HY_W, dtype=F32))
    filt = filt * jnp.exp(-t[:, None] * deltas)[:, None, None, :]
    h_fwd, h_bwd = filt[:, 0], filt[:, 1]
    two_sided = jnp.concatenate([h_fwd, jnp.zeros_like(h_fwd[:1]), jnp.flip(h_bwd[1:], axis=0)], axis=0)
    two_sided = two_sided / jnp.sum(jnp.abs(two_sided), axis=0, keepdims=True)
    return jnp.fft.rfft(two_sided, axis=0)


def _fftconv(u, h_spec, bias):
    l = u.shape[1]
    uf = u.astype(F32)
    spec = jnp.fft.rfft(uf, n=2 * l, axis=1)
    y = jnp.fft.irfft(spec * h_spec[None], n=2 * l, axis=1)[:, :l]
    return y + uf * bias.astype(F32)


def _even_mixer(u, j, p, s_gdn, s_ssd):
    b, l, _ = u.shape
    qkv, beta_raw, a_raw, z_a, xbc, dt_raw, z_b = _split(u, EVEN_SPLIT)
    qkv = jax.nn.silu(_short_conv(qkv, p['conv_gdn'][j]))
    q, k, v = _split(qkv, (GDN_KW, GDN_KW, GDN_W))
    q = _l2norm(q.reshape(b, l, GDN_HEADS, GDN_DK)) * GDN_DK ** -0.5
    k = _l2norm(k.reshape(b, l, GDN_HEADS, GDN_DK))
    v = v.reshape(b, l, GDN_HEADS, GDN_DV)
    beta = jax.nn.sigmoid(beta_raw.astype(F32)).reshape(b, l, 2, GDN_HEADS)
    g = -jnp.exp(p['gdn_a_log'][j].astype(F32)) * jax.nn.softplus(a_raw.astype(F32).reshape(b, l, 2, GDN_HEADS) + p['gdn_dt_bias'][j])
    o_f, sg_f = _gdn_chunked(q, k, v, beta[:, :, 0], g[:, :, 0], s_gdn[:, 0])
    o_b, sg_b = _gdn_chunked(_flip(q), _flip(k), _flip(v), _flip(beta[:, :, 1]), _flip(g[:, :, 1]), s_gdn[:, 1])
    o = _rmsnorm(o_f + _flip(o_b), p['gdn_norm_g'][j]) * jax.nn.silu(z_a.astype(F32).reshape(b, l, GDN_HEADS, GDN_DV))
    o = o.reshape(b, l, GDN_W)
    xbc = jax.nn.silu(_short_conv(xbc, p['conv_ssd'][j]))
    xs, bm, cm = _split(xbc, (SSD_W, SSD_GROUPS * SSD_STATE, SSD_GROUPS * SSD_STATE))
    xs = xs.astype(F32).reshape(b, l, SSD_HEADS, SSD_HEAD_DIM)
    bm = bm.reshape(b, l, SSD_GROUPS, SSD_STATE)
    cm = cm.reshape(b, l, SSD_GROUPS, SSD_STATE)
    dt = jax.nn.softplus(dt_raw.astype(F32).reshape(b, l, 2, SSD_HEADS) + p['ssd_dt_bias'][j])
    a = -jnp.exp(p['ssd_a_log'][j].astype(F32))
    y_f, ss_f = _ssd_chunked(xs, dt[:, :, 0], a[0], bm, cm, s_ssd[:, 0])
    y_b, ss_b = _ssd_chunked(_flip(xs), _flip(dt[:, :, 1]), a[1], _flip(bm), _flip(cm), s_ssd[:, 1])
    y = y_f + _flip(y_b) + p['ssd_d'][j].astype(F32)[:, None] * xs
    y = y.reshape(b, l, SSD_W) * jax.nn.silu(z_b.astype(F32))
    y = _rmsnorm(y.reshape(b, l, SSD_GROUPS, SSD_W // SSD_GROUPS), p['ssd_norm_g'][j].reshape(SSD_GROUPS, -1)).reshape(b, l, SSD_W)
    mix = jnp.concatenate([o, y], axis=-1).astype(u.dtype)
    return mix, jnp.stack([sg_f, sg_b], axis=1), jnp.stack([ss_f, ss_b], axis=1)


def _odd_mixer(u, j, p, lb, s_hgrn):
    b, l, _ = u.shape
    vx, z_c, q, f_raw, i_in, z_d = _split(u, ODD_SPLIT)
    v, x1, x2 = jnp.split(_short_conv(vx, p['conv_hyena'][j]), 3, axis=-1)
    spec = _hyena_filter_spectra(l, p['hy_w1'][j], p['hy_b1'][j], p['hy_freq'][j], p['hy_w2'][j], p['hy_b2'][j], p['hy_w3'][j])
    zc = x1.astype(F32) * _fftconv(v, spec[:, 0], p['hy_bias'][j, 0])
    zc = x2.astype(F32) * _fftconv(zc, spec[:, 1], p['hy_bias'][j, 1])
    y_c = zc * jax.nn.silu(z_c.astype(F32))
    q = jax.nn.silu(q.astype(F32)).reshape(b, l, HG_HEADS, HG_DK) * HG_DK ** -0.5
    f = lb + (1.0 - lb) * jax.nn.sigmoid(f_raw.astype(F32).reshape(b, l, 2, HG_KW))
    logf = jnp.log(f).reshape(b, l, 2, HG_HEADS, HG_DK)
    kf = (1.0 - f).reshape(b, l, 2, HG_HEADS, HG_DK)
    iv = i_in.reshape(b, l, HG_HEADS, HG_DV)
    o_f, sh_f = _gla_chunked(q, kf[:, :, 0], iv, logf[:, :, 0], s_hgrn[:, 0])
    o_b, sh_b = _gla_chunked(_flip(q), _flip(kf[:, :, 1]), _flip(iv), _flip(logf[:, :, 1]), s_hgrn[:, 1])
    o = _rmsnorm(o_f + _flip(o_b), p['hgrn_norm_g'][j]) * jax.nn.silu(z_d.astype(F32).reshape(b, l, HG_HEADS, HG_DV))
    mix = jnp.concatenate([y_c, o.reshape(b, l, HG_W)], axis=-1).astype(u.dtype)
    return mix, jnp.stack([sh_f, sh_b], axis=1)


def _run_trunk(x, cond, init_gdn, init_ssd, init_hgrn, p):
    lb_all = jnp.cumsum(jax.nn.softmax(p['hgrn_lb_logits'].astype(F32), axis=0), axis=0)
    fin_gdn, fin_ssd, fin_hgrn = [], [], []
    for li in range(DEPTH):
        j = li // 2
        mod = jax.nn.silu(cond) @ p['w_ada'][li] + p['b_ada'][li]
        shift, scale, gate = jnp.split(mod[:, None, :], 3, axis=-1)
        h = _rmsnorm(x, p['norm_g'][li]).astype(x.dtype) * (1.0 + scale) + shift
        if li % 2 == 0:
            mix, sg, ss = _even_mixer(h @ p['w_in_even'][j], j, p, init_gdn[:, j], init_ssd[:, j])
            fin_gdn.append(sg)
            fin_ssd.append(ss)
        else:
            mix, sh = _odd_mixer(h @ p['w_in_odd'][j], j, p, lb_all[j], init_hgrn[:, j])
            fin_hgrn.append(sh)
        x = x + (gate * (mix @ p['w_out'][li])).astype(x.dtype)
    y = _rmsnorm(x, p['final_g']).astype(x.dtype)
    return y, jnp.stack(fin_gdn, axis=1), jnp.stack(fin_ssd, axis=1), jnp.stack(fin_hgrn, axis=1)


def setup_inputs(seed: int = 0) -> dict:
    k = jax.random.split(jax.random.key(seed), 33)

    def nrm(i, shape, scale):
        return scale * jax.random.normal(k[i], shape, F32)

    def gain(i, shape):
        return 1.0 + nrm(i, shape, 0.01)

    def dt_bias(i, shape):
        dt = jnp.exp(jax.random.uniform(k[i], shape, F32, math.log(1e-3), math.log(1e-1)))
        return dt + jnp.log(-jnp.expm1(-dt))

    def a_log(i, shape):
        return jnp.log(jax.random.uniform(k[i], shape, F32, 1.0, 16.0))

    conv_scale = SHORT_CONV ** -0.5
    return {
        'x_prompt': nrm(0, (BATCH, SEQ, D_MODEL), 1.0),
        'x_sample': nrm(1, (DEC_BATCH, DEC_SEQ, D_MODEL), 1.0),
        'state_gdn': nrm(2, (DEC_BATCH, N_EVEN, 2, GDN_HEADS, GDN_DK, GDN_DV), 0.1),
        'state_ssd': nrm(3, (DEC_BATCH, N_EVEN, 2, SSD_HEADS, SSD_HEAD_DIM, SSD_STATE), 0.1),
        'state_hgrn': nrm(4, (DEC_BATCH, N_ODD, 2, HG_HEADS, HG_DK, HG_DV), 0.1),
        'c': nrm(5, (DEC_BATCH, D_MODEL), 1.0),
        'c_ctx': nrm(6, (D_MODEL,), 1.0),
        'norm_g': gain(7, (DEPTH, D_MODEL)),
        'w_ada': nrm(8, (DEPTH, D_MODEL, 3 * D_MODEL), D_MODEL ** -0.5),
        'b_ada': nrm(9, (DEPTH, 3 * D_MODEL), 0.01),
        'w_out': nrm(10, (DEPTH, MIX_W, D_MODEL), MIX_W ** -0.5),
        'final_g': gain(11, (D_MODEL,)),
        'w_in_even': nrm(12, (N_EVEN, D_MODEL, IN_EVEN), D_MODEL ** -0.5),
        'conv_gdn': nrm(13, (N_EVEN, SHORT_CONV, EVEN_SPLIT[0]), conv_scale),
        'gdn_a_log': a_log(14, (N_EVEN, 2, GDN_HEADS)),
        'gdn_dt_bias': dt_bias(15, (N_EVEN, 2, GDN_HEADS)),
        'gdn_norm_g': gain(16, (N_EVEN, GDN_DV)),
        'conv_ssd': nrm(17, (N_EVEN, SHORT_CONV, EVEN_SPLIT[4]), conv_scale),
        'ssd_a_log': a_log(18, (N_EVEN, 2, SSD_HEADS)),
        'ssd_dt_bias': dt_bias(19, (N_EVEN, 2, SSD_HEADS)),
        'ssd_d': gain(20, (N_EVEN, SSD_HEADS)),
        'ssd_norm_g': gain(21, (N_EVEN, SSD_W)),
        'w_in_odd': nrm(22, (N_ODD, D_MODEL, IN_ODD), D_MODEL ** -0.5),
        'conv_hyena': nrm(23, (N_ODD, SHORT_CONV, 3 * HY_W), conv_scale),
        'hy_w1': nrm(24, (N_ODD, HY_EMB, HY_FFN), HY_EMB ** -0.5),
        'hy_b1': nrm(25, (N_ODD, HY_FFN), 0.01),
        'hy_freq': gain(26, (N_ODD, 2, HY_FFN)),
        'hy_w2': nrm(27, (N_ODD, HY_FFN, HY_FFN), HY_FFN ** -0.5),
        'hy_b2': nrm(28, (N_ODD, HY_FFN), 0.01),
        'hy_w3': nrm(29, (N_ODD, HY_FFN, 2 * HY_ORDER * HY_W), HY_FFN ** -0.5),
        'hy_bias': nrm(30, (N_ODD, HY_ORDER, HY_W), 1.0),
        'hgrn_lb_logits': nrm(31, (N_ODD + 1, 2, HG_KW), 0.1),
        'hgrn_norm_g': gain(32, (N_ODD, HG_DV)),
    }


def reference(x_prompt, x_sample, state_gdn, state_ssd, state_hgrn, c, c_ctx, norm_g, w_ada, b_ada, w_out, final_g,
              w_in_even, conv_gdn, gdn_a_log, gdn_dt_bias, gdn_norm_g, conv_ssd, ssd_a_log, ssd_dt_bias, ssd_d, ssd_norm_g,
              w_in_odd, conv_hyena, hy_w1, hy_b1, hy_freq, hy_w2, hy_b2, hy_w3, hy_bias, hgrn_lb_logits, hgrn_norm_g):
    p = dict(norm_g=norm_g, w_ada=w_ada, b_ada=b_ada, w_out=w_out, final_g=final_g,
             w_in_even=w_in_even, conv_gdn=conv_gdn, gdn_a_log=gdn_a_log, gdn_dt_bias=gdn_dt_bias, gdn_norm_g=gdn_norm_g,
             conv_ssd=conv_ssd, ssd_a_log=ssd_a_log, ssd_dt_bias=ssd_dt_bias, ssd_d=ssd_d, ssd_norm_g=ssd_norm_g,
             w_in_odd=w_in_odd, conv_hyena=conv_hyena, hy_w1=hy_w1, hy_b1=hy_b1, hy_freq=hy_freq, hy_w2=hy_w2,
             hy_b2=hy_b2, hy_w3=hy_w3, hy_bias=hy_bias, hgrn_lb_logits=hgrn_lb_logits, hgrn_norm_g=hgrn_norm_g)
    b_ctx = x_prompt.shape[0]
    zero_gdn = jnp.zeros((b_ctx, N_EVEN, 2, GDN_HEADS, GDN_DK, GDN_DV), F32)
    zero_ssd = jnp.zeros((b_ctx, N_EVEN, 2, SSD_HEADS, SSD_HEAD_DIM, SSD_STATE), F32)
    zero_hgrn = jnp.zeros((b_ctx, N_ODD, 2, HG_HEADS, HG_DK, HG_DV), F32)
    y_prompt, new_state_gdn, new_state_ssd, new_state_hgrn = _run_trunk(x_prompt, c_ctx[None], zero_gdn, zero_ssd, zero_hgrn, p)
    n_lat = x_sample.shape[1]
    x_lat = x_sample + _grid_pos_embed(n_lat, D_MODEL).astype(x_sample.dtype)[None]
    y_sample = _run_trunk(x_lat, c, state_gdn, state_ssd, state_hgrn, p)[0]
    return (y_prompt, y_sample, new_state_gdn, new_state_ssd, new_state_hgrn)
```

```cpp
#include <hip/hip_runtime.h>
#include <cstdio>
#include <cstdint>
namespace pg8 {
#define PG8_LAS __attribute__((address_space(3)))
typedef unsigned short bf16_t;
typedef short bf16x8 __attribute__((ext_vector_type(8)));
typedef float f32x4 __attribute__((ext_vector_type(4)));
typedef unsigned u32x4 __attribute__((ext_vector_type(4)));
constexpr int BM = 256, BK = 64, HALF = 128, HTB = HALF * BK * 2  , STAGE_BYTES = 8 * HTB, NXCD = 8, WGM = 8;

__host__ __device__ __forceinline__ int lds_byte(int r, int c) { const int st = (r >> 4) * 2 + (c >> 5), rr = r & 15, cc = c & 31, ob = rr * 64 + cc * 2; return st * 1024 + (ob ^ (((ob >> 9) & 1) << 5)); }
__host__ __device__ __forceinline__ void stage_rc(int b, int& R, int& C) { const int st = b / 1024, sb = b % 1024, swz = sb ^ (((sb >> 9) & 1) << 5); R = (st >> 1) * 16 + swz / 64; C = (st & 1) * 32 + (swz % 64) / 2; }
__host__ __device__ __forceinline__ int perm32(int rho) { const int n = rho >> 4, i = rho & 15; return 8 * (i >> 2) + 4 * n + (i & 3); }

struct Unit { int pm, pn; };
struct Gemm { const bf16_t* A; const bf16_t* Bt; int M, N, K; };

struct StaticOrder {
    int nM, nN, nwg, G, c;
    __host__ __device__ void init(int M, int N, int G_, int c_) { nM = M / BM; nN = N / BM; nwg = nM * nN; G = G_; c = c_; }
    __host__ __device__ bool next(int i, Unit& u) const {
        const long L = (long)i * G + c; if (L >= nwg) return false;
        int wgid = (int)L; { const int q = nwg / NXCD, r = nwg % NXCD, xcd = wgid % NXCD, off = wgid / NXCD; wgid = (xcd < r ? xcd * (q + 1) : r * (q + 1) + (xcd - r) * q) + off; }
        const int nig = WGM * nN, gid = wgid / nig, fm = gid * WGM, gsz = (nM - fm) < WGM ? (nM - fm) : WGM;
        u.pm = fm + ((wgid % nig) % gsz); u.pn = (wgid % nig) / gsz; return true;
    }
    __device__ __forceinline__ void a_ready(const Unit&) const {}
    __device__ __forceinline__ void done(const Unit&) const {}
};
__device__ __forceinline__ unsigned cvt_pk_bf16(float lo, float hi) { unsigned r; asm volatile("v_cvt_pk_bf16_f32 %0, %1, %2" : "=v"(r) : "v"(lo), "v"(hi)); return r; }
typedef __bf16 bf16x2v __attribute__((ext_vector_type(2)));
typedef float f32x2v_ __attribute__((ext_vector_type(2)));
__device__ __forceinline__ unsigned pk_bf16(float lo, float hi) { f32x2v_ v = {lo, hi}; return __builtin_bit_cast(unsigned, __builtin_convertvector(v, bf16x2v)); }
struct EpiStoreBf16 {
    static constexpr bool PERM = true, AFTER_DRAIN = false;
    bf16_t* O; int ldc;
    __device__ __forceinline__ void operator()(const f32x4 (&acc)[2][2][4][2], const Unit& u, int wr, int wc, int fr, int fq) const {
        const int row0 = u.pm * BM + wr * 64 + fr, col0 = u.pn * BM + wc * 32 + 8 * fq;
#pragma unroll
        for (int ai = 0; ai < 2; ++ai)
#pragma unroll
            for (int m = 0; m < 4; ++m) { bf16_t* rowp = O + (size_t)(row0 + ai * HALF + m * 16) * ldc + col0;
#pragma unroll
                for (int bj = 0; bj < 2; ++bj) { const f32x4 v0 = acc[ai][bj][m][0], v1 = acc[ai][bj][m][1];
                    u32x4 w; w.x = pk_bf16(v0[0], v0[1]); w.y = pk_bf16(v0[2], v0[3]); w.z = pk_bf16(v1[0], v1[1]); w.w = pk_bf16(v1[2], v1[3]);
                    *(u32x4*)(rowp + bj * HALF) = w; } }
    }
};
struct EpiResGate {
    static constexpr bool PERM = false, AFTER_DRAIN = false;
    float* io; int ldc; const float* gate;
    __device__ __forceinline__ void operator()(const f32x4 (&acc)[2][2][4][2], const Unit& u, int wr, int wc, int fr, int fq) const {
        const int row0 = u.pm * BM + wr * 64 + fr, col0 = u.pn * BM + wc * 32 + 4 * fq;
        const int rb = u.pm * BM; const int r = rb < 4096 ? 0 : 1 + ((rb - 4096) >> 12);
        const float* g = gate + r * 4096 + col0;
        f32x4 gv[2][2];
#pragma unroll
        for (int bj = 0; bj < 2; ++bj)
#pragma unroll
            for (int n = 0; n < 2; ++n) gv[bj][n] = *(const f32x4*)(g + bj * HALF + n * 16);
#pragma unroll
        for (int ai = 0; ai < 2; ++ai)
#pragma unroll
            for (int m = 0; m < 4; ++m) { float* rowp = io + (size_t)(row0 + ai * HALF + m * 16) * ldc + col0;
#pragma unroll
                for (int bj = 0; bj < 2; ++bj)
#pragma unroll
                    for (int n = 0; n < 2; ++n) { f32x4* p = (f32x4*)(rowp + bj * HALF + n * 16); const f32x4 b = *p; *p = b + gv[bj][n] * acc[ai][bj][m][n]; }
                if (m == 3) asm volatile("" ::: "memory"); }
    }
};

struct EpiResGateBf16 {
    static constexpr bool PERM = true, AFTER_DRAIN = false;
    bf16_t* io; int ldc; const float* gate;
    __device__ __forceinline__ void operator()(const f32x4 (&acc)[2][2][4][2], const Unit& u, int wr, int wc, int fr, int fq) const {
        const int row0 = u.pm * BM + wr * 64 + fr, col0 = u.pn * BM + wc * 32 + 8 * fq;
        const int rb = u.pm * BM; const int r = rb < 4096 ? 0 : 1 + ((rb - 4096) >> 12);
        const float* g = gate + r * 4096 + col0;
        f32x4 gv[2][2];
#pragma unroll
        for (int bj = 0; bj < 2; ++bj)
#pragma unroll
            for (int n = 0; n < 2; ++n) gv[bj][n] = *(const f32x4*)(g + bj * HALF + 4 * n);
#pragma unroll
        for (int ai = 0; ai < 2; ++ai)
#pragma unroll
            for (int m = 0; m < 4; ++m) { bf16_t* rowp = io + (size_t)(row0 + ai * HALF + m * 16) * ldc + col0;
#pragma unroll
                for (int bj = 0; bj < 2; ++bj) { u32x4* p = (u32x4*)(rowp + bj * HALF); const u32x4 b = *p;
                    const f32x4 a0 = acc[ai][bj][m][0] * gv[bj][0], a1 = acc[ai][bj][m][1] * gv[bj][1];
                    u32x4 w;
                    w.x = pk_bf16(__uint_as_float(b.x << 16) + a0[0], __uint_as_float(b.x & 0xffff0000u) + a0[1]); w.y = pk_bf16(__uint_as_float(b.y << 16) + a0[2], __uint_as_float(b.y & 0xffff0000u) + a0[3]);
                    w.z = pk_bf16(__uint_as_float(b.z << 16) + a1[0], __uint_as_float(b.z & 0xffff0000u) + a1[1]); w.w = pk_bf16(__uint_as_float(b.w << 16) + a1[2], __uint_as_float(b.w & 0xffff0000u) + a1[3]);
                    *p = w; }
                if (m == 3) asm volatile("" ::: "memory"); }
    }
};
template <class Epi, class Sched, bool ALIGN_EPI = false, bool SP2 = false>
__device__ __forceinline__ void gemm_phase(PG8_LAS unsigned char* lds, const Gemm g, const Sched& S, const Epi& E) {
    const int tid = threadIdx.x, wid = __builtin_amdgcn_readfirstlane(tid >> 6), lane = tid & 63, wr = wid >> 2, wc = wid & 3, fr = lane & 15, fq = lane >> 4;
    const int K = g.K, nt = K / BK;
    unsigned voffA[2], voffB[2];
#pragma unroll
    for (int i = 0; i < 2; ++i) { int R, C; stage_rc(tid * 16 + i * 8192, R, C); const int Rb = Epi::PERM ? ((R & ~31) + perm32(R & 31)) : R;
        voffA[i] = (unsigned)(R * K + C) * 2u; voffB[i] = (unsigned)(Rb * K + C) * 2u; }
    const size_t kstep = (size_t)(BK * 2);
    const size_t hstep = (size_t)HALF * K * 2;
    const size_t tstep = 2 * hstep;
    const unsigned ldsw = (unsigned)wid * 1024u;
    const int aoff = lds_byte(wr * 64 + fr, fq * 8), boff = lds_byte(wc * 32 + fr, fq * 8);
#define PG8_SA(b, h) (((b) * 2 + (h)) * HTB)
#define PG8_SB(b, h) ((4 + (b) * 2 + (h)) * HTB)
#define PG8_STAGE(bufoff, gbase, voff) do { _Pragma("unroll") for (int _i = 0; _i < 2; ++_i) \
        __builtin_amdgcn_global_load_lds((const unsigned*)((const char*)(gbase) + (voff)[_i]), (PG8_LAS unsigned*)(lds + (bufoff) + ldsw + _i * 8192), 16, 0, 0); } while (0)
#define PG8_LDA(dst, b, h) do { _Pragma("unroll") for (int m = 0; m < 4; ++m) _Pragma("unroll") for (int k = 0; k < 2; ++k) dst[m][k] = *(const PG8_LAS bf16x8*)(lds + PG8_SA(b, h) + aoff + m * 2048 + k * 1024); } while (0)
#define PG8_LDB(dst, b, h) do { _Pragma("unroll") for (int n = 0; n < 2; ++n) _Pragma("unroll") for (int k = 0; k < 2; ++k) dst[n][k] = *(const PG8_LAS bf16x8*)(lds + PG8_SB(b, h) + boff + n * 2048 + k * 1024); } while (0)
#define PG8_MMA(ai, bj, At, Bt) do { __builtin_amdgcn_s_setprio(1); _Pragma("unroll") for (int m = 0; m < 4; ++m) _Pragma("unroll") for (int n = 0; n < 2; ++n) _Pragma("unroll") for (int k = 0; k < 2; ++k) \
        acc[ai][bj][m][n] = __builtin_amdgcn_mfma_f32_16x16x32_bf16(Bt[n][k], At[m][k], acc[ai][bj][m][n], 0, 0, 0); __builtin_amdgcn_s_setprio(0); } while (0)
#define PG8_WAIT_V(n) asm volatile("s_waitcnt vmcnt(" #n ")" ::: "memory")
#define PG8_WAIT_L(n) asm volatile("s_waitcnt lgkmcnt(" #n ")" ::: "memory")
#define PG8_BAR __builtin_amdgcn_s_barrier()
#define PG8_SCHED __builtin_amdgcn_sched_barrier(0)
    Unit cur, nxt; int ui = 0;
    if (!S.next(0, cur)) return;
    f32x4 acc[2][2][4][2];
#pragma unroll
    for (int a = 0; a < 2; ++a)
#pragma unroll
        for (int b = 0; b < 2; ++b)
#pragma unroll
            for (int m = 0; m < 4; ++m)
#pragma unroll
                for (int n = 0; n < 2; ++n) acc[a][b][m][n] = (f32x4){0.f, 0.f, 0.f, 0.f};
    bf16x8 At[4][2], B0[2][2], B1[2][2];
    const char* cA = (const char*)g.A + (size_t)cur.pm * tstep; const char* cB = (const char*)g.Bt + (size_t)cur.pn * tstep;
    S.a_ready(cur);
    if constexpr (SP2) {
        PG8_STAGE(PG8_SB(0, 0), cB, voffB); PG8_STAGE(PG8_SB(0, 1), cB + hstep, voffB); PG8_STAGE(PG8_SA(0, 0), cA, voffA); PG8_STAGE(PG8_SA(0, 1), cA + hstep, voffA);
        if (wr == 1) PG8_BAR;
        PG8_WAIT_V(2); PG8_BAR;
        PG8_STAGE(PG8_SB(1, 0), cB + kstep, voffB); PG8_STAGE(PG8_SA(1, 0), cA + kstep, voffA); PG8_STAGE(PG8_SB(1, 1), cB + hstep + kstep, voffB);
        PG8_WAIT_V(6); PG8_BAR;
    } else {
        PG8_STAGE(PG8_SB(0, 0), cB, voffB); PG8_STAGE(PG8_SA(0, 0), cA, voffA); PG8_STAGE(PG8_SB(0, 1), cB + hstep, voffB); PG8_STAGE(PG8_SA(0, 1), cA + hstep, voffA);
        if (wr == 1) PG8_BAR;
        PG8_WAIT_V(4); PG8_BAR;
        PG8_STAGE(PG8_SB(1, 0), cB + kstep, voffB); PG8_STAGE(PG8_SA(1, 0), cA + kstep, voffA); PG8_STAGE(PG8_SB(1, 1), cB + hstep + kstep, voffB);
        PG8_WAIT_V(6); PG8_BAR;
    }
    for (;;) {
        const bool has_next = S.next(ui + 1, nxt);
        const char* nA = has_next ? (const char*)g.A + (size_t)nxt.pm * tstep : cA; const char* nB = has_next ? (const char*)g.Bt + (size_t)nxt.pn * tstep : cB;
        for (int t = 0; t < nt; t += 2) {
            const bool last = (t == nt - 2);
            const char* a1 = cA + (size_t)(t + 1) * kstep;
            const char* a2 = last ? nA : cA + (size_t)(t + 2) * kstep; const char* b2 = last ? nB : cB + (size_t)(t + 2) * kstep;
            const char* a3 = a2 + kstep; const char* b3 = b2 + kstep;
            if (last && has_next) S.a_ready(nxt);
            if constexpr (SP2) {
            PG8_LDB(B0, 0, 0); PG8_LDB(B1, 0, 1); PG8_SCHED; PG8_LDA(At, 0, 0); PG8_STAGE(PG8_SA(1, 1), a1 + hstep, voffA);
            PG8_WAIT_V(8); PG8_WAIT_L(0); PG8_BAR; PG8_MMA(0, 0, At, B0); PG8_MMA(0, 1, At, B1); PG8_BAR; PG8_SCHED;
            PG8_LDA(At, 0, 1); PG8_STAGE(PG8_SB(0, 0), b2, voffB); PG8_STAGE(PG8_SB(0, 1), b2 + hstep, voffB); PG8_STAGE(PG8_SA(0, 0), a2, voffA);
            PG8_WAIT_V(8); PG8_WAIT_L(0); PG8_BAR; PG8_MMA(1, 0, At, B0); PG8_MMA(1, 1, At, B1); PG8_BAR; PG8_SCHED;
            PG8_LDB(B0, 1, 0); PG8_LDB(B1, 1, 1); PG8_SCHED; PG8_LDA(At, 1, 0); PG8_STAGE(PG8_SA(0, 1), a2 + hstep, voffA);
            PG8_WAIT_V(8); PG8_WAIT_L(0); PG8_BAR; PG8_MMA(0, 0, At, B0); PG8_MMA(0, 1, At, B1); PG8_BAR; PG8_SCHED;
            PG8_LDA(At, 1, 1); PG8_STAGE(PG8_SB(1, 0), b3, voffB); PG8_STAGE(PG8_SB(1, 1), b3 + hstep, voffB); PG8_STAGE(PG8_SA(1, 0), a3, voffA);
            PG8_WAIT_V(8); PG8_WAIT_L(0); PG8_BAR; PG8_MMA(1, 0, At, B0); PG8_MMA(1, 1, At, B1); PG8_BAR; PG8_SCHED;
            } else {
            PG8_LDB(B0, 0, 0); PG8_SCHED; PG8_LDA(At, 0, 0); PG8_STAGE(PG8_SA(1, 1), a1 + hstep, voffA);
            PG8_WAIT_L(8); PG8_BAR; PG8_WAIT_L(0); PG8_MMA(0, 0, At, B0); PG8_BAR; PG8_SCHED;
            PG8_LDB(B1, 0, 1); PG8_STAGE(PG8_SB(0, 0), b2, voffB);
            PG8_BAR; PG8_WAIT_L(0); PG8_MMA(0, 1, At, B1); PG8_BAR;
            PG8_LDA(At, 0, 1); PG8_STAGE(PG8_SA(0, 0), a2, voffA);
            PG8_BAR; PG8_WAIT_L(0); PG8_MMA(1, 0, At, B0); PG8_BAR; PG8_SCHED;
            PG8_STAGE(PG8_SB(0, 1), b2 + hstep, voffB);
            PG8_WAIT_V(6); PG8_BAR; PG8_MMA(1, 1, At, B1); PG8_BAR;
            PG8_LDB(B0, 1, 0); PG8_SCHED; PG8_LDA(At, 1, 0); PG8_STAGE(PG8_SA(0, 1), a2 + hstep, voffA);
            PG8_WAIT_L(8); PG8_BAR; PG8_WAIT_L(0); PG8_MMA(0, 0, At, B0); PG8_BAR; PG8_SCHED;
            PG8_LDB(B1, 1, 1); PG8_STAGE(PG8_SB(1, 0), b3, voffB);
            PG8_BAR; PG8_WAIT_L(0); PG8_MMA(0, 1, At, B1); PG8_BAR;
            PG8_LDA(At, 1, 1); PG8_STAGE(PG8_SA(1, 0), a3, voffA);
            PG8_BAR; PG8_WAIT_L(0); PG8_MMA(1, 0, At, B0); PG8_BAR; PG8_SCHED;
            PG8_STAGE(PG8_SB(1, 1), b3 + hstep, voffB);
            PG8_WAIT_V(6); PG8_BAR; PG8_MMA(1, 1, At, B1); PG8_BAR;
            }
        }
        if constexpr (ALIGN_EPI) { if (wr == 0) PG8_BAR; }
        if constexpr (!Epi::AFTER_DRAIN) { E(acc, cur, wr, wc, fr, fq); S.done(cur); }
        if (!has_next) break;
#pragma unroll
        for (int a = 0; a < 2; ++a)
#pragma unroll
            for (int b = 0; b < 2; ++b)
#pragma unroll
                for (int m = 0; m < 4; ++m)
#pragma unroll
                    for (int n = 0; n < 2; ++n) acc[a][b][m][n] = (f32x4){0.f, 0.f, 0.f, 0.f};
        cur = nxt; cA = nA; cB = nB; ++ui;
        if constexpr (ALIGN_EPI) { if (wr == 1) PG8_BAR; }
    }
    PG8_WAIT_V(0);
    if constexpr (!ALIGN_EPI) { if (wr == 0) PG8_BAR; }
    PG8_BAR;
    if constexpr (Epi::AFTER_DRAIN) { E.fused(acc, cur, wr, wc, fr, fq, lds, wid, lane); S.done(cur); }
#undef PG8_SA
#undef PG8_SB
#undef PG8_STAGE
#undef PG8_LDA
#undef PG8_LDB
#undef PG8_MMA
#undef PG8_WAIT_V
#undef PG8_WAIT_L
#undef PG8_BAR
#undef PG8_SCHED
}
}
#define XB_TMO      128
#define XB_XCNT(j)  (256  + 64 * (j))
#define XB_XSUB(j)  (1280 + 64 * (j))
#define XB_XGEN(j)  (2304 + 64 * (j))
#define XB_TOP      3328
#define XB_TOPGEN   3392
#define XCD_BAR_WORDS 3456
#define XB_SPIN_CAP (1u << 18)
#define LAS __attribute__((address_space(3)))

__device__ __forceinline__ unsigned xb_ld(unsigned* p)              { return __hip_atomic_load(p, __ATOMIC_RELAXED, __HIP_MEMORY_SCOPE_AGENT); }
__device__ __forceinline__ unsigned xb_add(unsigned* p, unsigned v) { return __hip_atomic_fetch_add(p, v, __ATOMIC_RELAXED, __HIP_MEMORY_SCOPE_AGENT); }
__device__ __forceinline__ unsigned xb_xcc_id() { return (unsigned)__builtin_amdgcn_s_getreg((3 << 11) | 20) & 0xFu; }
#define XB_SPIN(cond, bar) do { unsigned _sp = 0; while (cond) { __builtin_amdgcn_s_sleep(1); \
    if ((++_sp & 255u) == 0u) { if (xb_ld(&(bar)[XB_TMO])) break; if (_sp > XB_SPIN_CAP) { atomicAdd(&(bar)[XB_TMO], 1u); break; } } } } while (0)

struct XcdBarrier {
    unsigned* bar; unsigned x;
    volatile LAS unsigned* st;
};

__device__ __forceinline__ XcdBarrier xcd_barrier_post(unsigned* bar, volatile LAS unsigned* st) {
    XcdBarrier b; b.bar = bar; b.x = xb_xcc_id(); b.st = st;
    if (threadIdx.x == 0) (void)xb_add(&bar[XB_XCNT(b.x)], 1u);
    return b;
}
__device__ __forceinline__ void xcd_barrier_complete(unsigned* bar, unsigned x, unsigned& nloc, unsigned& nx) {
    const unsigned G = gridDim.x * gridDim.y * gridDim.z;
    unsigned sum, cnt, mine, sp = 0u;
    for (;;) {
        sum = 0u; cnt = 0u; mine = 0u;
#pragma unroll
        for (unsigned j = 0; j < 16; ++j) { const unsigned c = xb_ld(&bar[XB_XCNT(j)]); sum += c; cnt += (c > 0u) ? 1u : 0u; mine = (j == x) ? c : mine; }
        if (sum == G) break;
        __builtin_amdgcn_s_sleep(1);
        if ((++sp & 255u) == 0u) { if (xb_ld(&bar[XB_TMO])) break; if (sp > XB_SPIN_CAP) { atomicAdd(&bar[XB_TMO], 1u); break; } }
    }
    nloc = mine > 0u ? mine : 1u; nx = cnt > 0u ? cnt : 1u;
}

__device__ __forceinline__ void xcd_barrier(const XcdBarrier& b) {
    asm volatile("s_waitcnt vmcnt(0)" ::: "memory");
    __syncthreads();
    if (threadIdx.x == 0) {
        unsigned* bar = b.bar;
        __builtin_amdgcn_s_waitcnt(0);
        unsigned nloc = b.st[0], nx = b.st[1];
        if (nloc == 0u) { xcd_barrier_complete(bar, b.x, nloc, nx); b.st[0] = nloc; b.st[1] = nx; }
        const unsigned old = xb_add(&bar[XB_XSUB(b.x)], 1u);
        const unsigned gen = old / nloc;
        if (old + 1u == (gen + 1u) * nloc) {
            __builtin_amdgcn_fence(__ATOMIC_RELEASE, "agent");
            asm volatile("s_waitcnt vmcnt(0)" ::: "memory");
            const unsigned og = xb_add(&bar[XB_TOP], 1u);
            const unsigned tg = og / nx;
            if (og + 1u == (tg + 1u) * nx) xb_add(&bar[XB_TOPGEN], 1u);
            else XB_SPIN(xb_ld(&bar[XB_TOPGEN]) == tg, bar);
            __builtin_amdgcn_fence(__ATOMIC_ACQUIRE, "agent");
            xb_add(&bar[XB_XGEN(b.x)], 1u);
            asm volatile("s_waitcnt vmcnt(0)" ::: "memory");
        } else {
            XB_SPIN(xb_ld(&bar[XB_XGEN(b.x)]) == gen, bar);
            __builtin_amdgcn_fence(__ATOMIC_ACQUIRE, "agent");
            asm volatile("s_waitcnt vmcnt(0)" ::: "memory");
        }
    }
    __syncthreads();
}
#define DI __device__ __forceinline__
typedef unsigned short bf16;
typedef short bf16x8 __attribute__((ext_vector_type(8)));
typedef short bf16x4 __attribute__((ext_vector_type(4)));
typedef float f32x4 __attribute__((ext_vector_type(4)));
typedef float f32x2 __attribute__((ext_vector_type(2)));
typedef unsigned u32x4 __attribute__((ext_vector_type(4)));
typedef unsigned u32x2 __attribute__((ext_vector_type(2)));
typedef __bf16 bf16x2n __attribute__((ext_vector_type(2)));
#define MFMA16(a, b, c) __builtin_amdgcn_mfma_f32_16x16x32_bf16((a), (b), (c), 0, 0, 0)

constexpr int DM = 4096, NROWS = 12288;
constexpr int IN_EVEN = 14464, LD_EVEN = 14592, IN_ODD = 18432;
constexpr int E_QKV = 0, E_BETA = 6144, E_A = 6176, E_ZA = 6208, E_XBC = 8256, E_DT = 12352, E_ZB = 12416;
constexpr int O_VX = 0, O_ZC = 6144, O_Q = 8192, O_F = 10240, O_I = 14336, O_ZD = 16384;
constexpr float EPS = 1e-6f;
constexpr int NSEQ = 18;
DI int seq_row0(int s) { return s < 16 ? s * 256 : 4096 + (s - 16) * 4096; }
DI int seq_len(int s) { return s < 16 ? 256 : 4096; }
constexpr size_t OUT_SG = 50331648, OUT_SS = 58720256, OUT_SH = 67108864;

constexpr size_t MiB = 1u << 20;
constexpr size_t WS_CTL = 0, CTL_ZERO_BYTES = 1 * MiB;
constexpr size_t WS_MODP = 1 * MiB;
constexpr size_t WS_MODF = 4 * MiB;
constexpr size_t WS_PE = 5 * MiB;
constexpr size_t WS_HDN = 6 * MiB;
constexpr size_t WS_HNRM = 8 * MiB;
constexpr size_t WS_HF256 = 16 * MiB;
constexpr size_t WS_HF4096 = 32 * MiB;
constexpr size_t WS_WTE = 160 * MiB;
constexpr size_t WS_WTO = 274 * MiB;
constexpr size_t WS_WTOUT = 418 * MiB;
constexpr size_t WS_H = 482 * MiB;
constexpr size_t WS_U = 578 * MiB;
constexpr size_t WS_MIX = 1010 * MiB;
constexpr size_t WS_OFA = 1106 * MiB;
constexpr size_t WS_OBA = 1154 * MiB;
constexpr size_t WS_OFB = 1202 * MiB;
constexpr size_t WS_OBB = 1250 * MiB;
constexpr size_t WS_TB = 1298 * MiB;
constexpr size_t WS_END = 1490 * MiB;
constexpr size_t WS_YT = WS_WTE;
constexpr size_t WS_GWN = 1298 * MiB;
constexpr size_t WS_GUF = 1394 * MiB;
constexpr size_t WS_GPP = 920 * MiB;
constexpr size_t WS_GGC = 968 * MiB;
constexpr size_t WS_GQN = WS_WTE;
constexpr size_t WS_GKT = WS_WTE + 48 * MiB;
constexpr size_t WS_SSP = 32 * MiB;
constexpr size_t WS_SCN = 128 * MiB;
constexpr size_t WS_SSG = 152 * MiB;
constexpr size_t WS_SBT = 1490 * MiB;
constexpr size_t WS_SVT = WS_H;
constexpr size_t WS_END2 = 1514 * MiB;
constexpr size_t WS_LQS = WS_H;
constexpr size_t WS_LKS = WS_WTO;
constexpr size_t WS_LAT = WS_WTO + 96 * MiB;
constexpr size_t WS_LVT = WS_OFB;
constexpr size_t WS_LGL = WS_OBB;
constexpr int CW_Q0 = 8192, CW_Q1 = 8256, CW_Q2 = 8320, CW_Q3 = 8384, CW_Q4 = 8448;
constexpr int CW_BAR = 4096;

DI float bf2f(bf16 b) { return __uint_as_float(((unsigned)b) << 16); }
DI unsigned pk2(float lo, float hi) { f32x2 v = {lo, hi}; return __builtin_bit_cast(unsigned, __builtin_convertvector(v, bf16x2n)); }
DI bf16 f2bf(float f) { return (bf16)(pk2(f, 0.f) & 0xffffu); }
DI float wave_sum(float v) {
#pragma unroll
    for (int o = 1; o < 64; o <<= 1) v += __shfl_xor(v, o);
    return v;
}
DI float sigmoidf_(float x) { return __builtin_amdgcn_rcpf(1.0f + __expf(-x)); }
DI float siluf_(float x) { return x * __builtin_amdgcn_rcpf(1.0f + __expf(-x)); }
DI float softplusf_(float x) { return x > 20.f ? x : log1pf(__expf(x)); }
DI void unpack8(const u32x4 w, float* o) {
    o[0] = __uint_as_float(w.x << 16); o[1] = __uint_as_float(w.x & 0xffff0000u); o[2] = __uint_as_float(w.y << 16); o[3] = __uint_as_float(w.y & 0xffff0000u);
    o[4] = __uint_as_float(w.z << 16); o[5] = __uint_as_float(w.z & 0xffff0000u); o[6] = __uint_as_float(w.w << 16); o[7] = __uint_as_float(w.w & 0xffff0000u);
}
DI bf16x8 frag_nat(const LAS bf16* M, int ld, int r0, int k0, int lane) { return *(const LAS bf16x8*)(M + (r0 + (lane & 15)) * ld + k0 + 8 * (lane >> 4)); }
DI bf16x8 frag_perm(const LAS bf16* M, int ld, int r0, int k0, int lane) {
    const LAS bf16* p = M + (r0 + (lane & 15)) * ld + k0 + 4 * (lane >> 4);
    const bf16x4 lo = *(const LAS bf16x4*)p, hi = *(const LAS bf16x4*)(p + 16);
    return __builtin_shufflevector(lo, hi, 0, 1, 2, 3, 4, 5, 6, 7);
}
DI bf16x8 pack2(const f32x4 a, const f32x4 b) {
    u32x4 w; w.x = pk2(a[0], a[1]); w.y = pk2(a[2], a[3]); w.z = pk2(b[0], b[1]); w.w = pk2(b[2], b[3]);
    return __builtin_bit_cast(bf16x8, w);
}
DI void st_bf16x4(LAS bf16* p, float a, float b, float c, float d) { u32x2 w; w.x = pk2(a, b); w.y = pk2(c, d); *(LAS u32x2*)p = w; }
constexpr int LDQ = 136, LDT = 72;
DI int swz_idx(int row, int col) { return row * LDT + (((((col >> 3) ^ (row >> 4)) & 7) << 3) | (col & 7)); }
DI bf16x8 frag_nat_sw(const LAS bf16* M, int r0, int k0, int lane) { const int q = lane >> 4; return *(const LAS bf16x8*)(M + (r0 + (lane & 15)) * LDT + ((((k0 >> 3) + q) ^ (r0 >> 4)) & 7) * 8); }
DI bf16x8 frag_perm_sw(const LAS bf16* M, int r0, int k0, int lane) { const int q = lane >> 4, sw = r0 >> 4; const LAS bf16* p = M + (r0 + (lane & 15)) * LDT + 4 * (q & 1);
    const bf16x4 lo = *(const LAS bf16x4*)(p + ((((k0 >> 3) + (q >> 1)) ^ sw) & 7) * 8), hi = *(const LAS bf16x4*)(p + ((((k0 >> 3) + 2 + (q >> 1)) ^ sw) & 7) * 8);
    return __builtin_shufflevector(lo, hi, 0, 1, 2, 3, 4, 5, 6, 7); }
#define LDSBAR() do { asm volatile("s_waitcnt lgkmcnt(0)" ::: "memory"); __builtin_amdgcn_s_barrier(); asm volatile("" ::: "memory"); } while (0)
#ifndef WODD_KEEP
#define WODD_KEEP 288
#endif
constexpr int WODD_P0 = 64 * WODD_KEEP;
struct Ctx {
    LAS unsigned char* lds;
    const float* const* in;
    unsigned char* ws;
    float* out;
    int tid, lane, wave, bid, G;
};
DI void p0_transpose_pair(const float* W, int K, int N, bf16* WT, LAS float* scr, int item0, int item1, int lane) {
    const int nblk = N / 32;
    float va[32], vb[32];
    { const int kb = item0 / nblk, nb = item0 % nblk; const float* src = W + (size_t)(64 * kb + (lane >> 5)) * N + 32 * nb + (lane & 31);
#pragma unroll
      for (int i = 0; i < 32; ++i) va[i] = __builtin_nontemporal_load(src + (size_t)(2 * i) * N); }
    if (item1 >= 0) { const int kb = item1 / nblk, nb = item1 % nblk; const float* src = W + (size_t)(64 * kb + (lane >> 5)) * N + 32 * nb + (lane & 31);
#pragma unroll
      for (int i = 0; i < 32; ++i) vb[i] = __builtin_nontemporal_load(src + (size_t)(2 * i) * N); }
#pragma unroll
    for (int half = 0; half < 2; ++half) { const int item = half ? item1 : item0; if (item < 0) break;
        const int kb = item / nblk, nb = item % nblk, k0 = 64 * kb, n0 = 32 * nb;
#pragma unroll
        for (int i = 0; i < 32; ++i) scr[(2 * i + (lane >> 5)) * 33 + (lane & 31)] = half ? vb[i] : va[i];
        asm volatile("s_waitcnt lgkmcnt(0)" ::: "memory");
        const int c = lane & 7;
#pragma unroll
        for (int j = 0; j < 4; ++j) { const int n = (lane >> 3) + 8 * j; const LAS float* s = scr + (8 * c) * 33 + n;
            u32x4 o; o.x = pk2(s[0 * 33], s[1 * 33]); o.y = pk2(s[2 * 33], s[3 * 33]); o.z = pk2(s[4 * 33], s[5 * 33]); o.w = pk2(s[6 * 33], s[7 * 33]);
            *(u32x4*)(WT + (size_t)(n0 + n) * K + k0 + 8 * c) = o; }
        asm volatile("s_waitcnt lgkmcnt(0)" ::: "memory"); }
}
DI void p0_transpose_range(const float* W, int K, int N, bf16* WT, LAS float* scr, int first, int stride, int total, int lane) {
    for (int it = first; it < total; it += 2 * stride) p0_transpose_pair(W, K, N, WT, scr, it, it + stride < total ? it + stride : -1, lane);
}
DI void p0_adaln_item(const Ctx& F, const float* w_ada, const float* c, const float* c_ctx, int item) {
    const int li = item / 384, rem = item % 384, strip = rem >> 3, kseg = rem & 7;
    const float* W = w_ada + (size_t)li * 4096 * 12288 + strip * 256 + F.lane * 4;
    const int k0 = kseg * 512 + F.wave * 64;
    f32x4 a0 = {0.f, 0.f, 0.f, 0.f}, a1 = a0, a2 = a0;
#pragma unroll 8
    for (int kk = 0; kk < 64; ++kk) { const int k = k0 + kk;
        const float s0 = siluf_(c_ctx[k]), s1 = siluf_(c[k]), s2 = siluf_(c[4096 + k]);
        const f32x4 w = __builtin_nontemporal_load((const f32x4*)(W + (size_t)k * 12288));
        a0 += s0 * w; a1 += s1 * w; a2 += s2 * w; }
    LAS float* scr = (LAS float*)F.lds;
    *(LAS f32x4*)(scr + F.wave * 768 + 0 * 256 + F.lane * 4) = a0;
    *(LAS f32x4*)(scr + F.wave * 768 + 1 * 256 + F.lane * 4) = a1;
    *(LAS f32x4*)(scr + F.wave * 768 + 2 * 256 + F.lane * 4) = a2;
    __syncthreads();
    float* modp = (float*)(F.ws + WS_MODP);
    for (int o = F.tid; o < 768; o += 512) { float s = 0.f;
#pragma unroll
        for (int w = 0; w < 8; ++w) s += scr[w * 768 + o];
        const int r = o >> 8, ci = o & 255;
        modp[((size_t)(kseg * 2 + li) * 3 + r) * 12288 + strip * 256 + ci] = s; }
    __syncthreads();
}
DI void p0_hdn_item(const float* w1, const float* b1, const float* freq, const float* w2, const float* b2, int L, int p, float* out, int lane) {
    const float t = (float)p / (float)(L - 1);
    float zk = 0.f;
    if (lane == 0) zk = t;
    else if (lane <= 32) { const int b = (lane - 1) & 15; const float band = 1e-4f + (float)b * ((15.0f - 1e-4f) / 15.0f);
        const float ang = (6.283185307179586f / (float)L) * (float)p * band; zk = (lane <= 16) ? cosf(ang) : -sinf(ang); }
    float a = b1[lane];
#pragma unroll
    for (int k = 0; k < 33; ++k) a += __shfl(zk, k) * w1[k * 64 + lane];
    const float h1 = sinf(freq[lane] * a);
    float a2 = b2[lane];
#pragma unroll 16
    for (int k = 0; k < 64; ++k) a2 += __shfl(h1, k) * w2[k * 64 + lane];
    out[lane] = sinf(freq[64 + lane] * a2);
}
DI void p0_filter_item(const Ctx& F, const float* hdn, const float* w3, float* HF, float* HNRM, int L, int cg) {
    LAS float* wl = (LAS float*)F.lds;
    LAS float* red = wl + 2048;
    for (int e = F.tid; e < 2048; e += 512) { const int k = e >> 5, x = e & 31, dir = x >> 4, ord = (x >> 3) & 1, cc = x & 7;
        wl[e] = w3[(size_t)k * 8192 + dir * 4096 + ord * 2048 + cg * 8 + cc]; }
    __syncthreads();
    float asum[16];
#pragma unroll
    for (int i = 0; i < 16; ++i) asum[i] = 0.f;
    const float tinv = 1.0f / (float)(L - 1);
    float dl2[8];
#pragma unroll
    for (int cc = 0; cc < 8; ++cc) dl2[cc] = 1.4426950408889634f * fabsf(-3.0701134573253945f + (-15.350567286626972f + 3.0701134573253945f) * ((float)(cg * 8 + cc) * (1.0f / 2047.0f)));
    const int half = L > 512 ? L / 2 : L;
    for (int p = F.tid; p < half; p += 512) { const bool two = (L > 512); const int p1 = two ? p + half : p;
        float acc0[32], acc1[32];
#pragma unroll
        for (int i = 0; i < 32; ++i) { acc0[i] = 0.f; acc1[i] = 0.f; }
        const f32x4* hp0 = (const f32x4*)(hdn + (size_t)p * 64); const f32x4* hp1 = (const f32x4*)(hdn + (size_t)p1 * 64);
#pragma unroll 2
        for (int k4 = 0; k4 < 16; ++k4) { const f32x4 hv0 = hp0[k4], hv1 = hp1[k4];
#pragma unroll
            for (int kk = 0; kk < 4; ++kk) { const float h0 = hv0[kk], h1 = hv1[kk]; const LAS f32x4* wr = (const LAS f32x4*)(wl + (k4 * 4 + kk) * 32);
#pragma unroll
                for (int x4 = 0; x4 < 8; ++x4) { const f32x4 w = wr[x4];
                    acc0[x4 * 4 + 0] += h0 * w[0]; acc0[x4 * 4 + 1] += h0 * w[1]; acc0[x4 * 4 + 2] += h0 * w[2]; acc0[x4 * 4 + 3] += h0 * w[3];
                    acc1[x4 * 4 + 0] += h1 * w[0]; acc1[x4 * 4 + 1] += h1 * w[1]; acc1[x4 * 4 + 2] += h1 * w[2]; acc1[x4 * 4 + 3] += h1 * w[3]; } } }
#pragma unroll
        for (int pp = 0; pp < 2; ++pp) { if (pp == 1 && !two) break; const int q = pp ? p1 : p; const float t = (float)q * tinv;
            float win[8];
#pragma unroll
            for (int cc = 0; cc < 8; ++cc) win[cc] = __builtin_amdgcn_exp2f(-t * dl2[cc]);
#pragma unroll
            for (int x = 0; x < 32; ++x) { const int dir = x >> 4, ord = (x >> 3) & 1, cc = x & 7, c = cg * 8 + cc;
                const float val = (pp ? acc1[x] : acc0[x]) * win[cc];
                float* row = HF + ((size_t)ord * 2048 + c) * (size_t)(2 * L);
                if (dir == 0) { row[q] = val; asum[ord * 8 + cc] += fabsf(val); if (q == 0) row[L] = 0.f; }
                else if (q >= 1) { row[2 * L - q] = val; asum[ord * 8 + cc] += fabsf(val); } } }
    }
#pragma unroll
    for (int i = 0; i < 16; ++i) { const float s = wave_sum(asum[i]); if (F.lane == 0) red[F.wave * 16 + i] = s; }
    __syncthreads();
    if (F.tid < 16) { float s = 0.f;
#pragma unroll
        for (int w = 0; w < 8; ++w) s += red[w * 16 + F.tid];
        const int ord = F.tid >> 3, cc = F.tid & 7; HNRM[ord * 2048 + cg * 8 + cc] = 1.0f / s; }
    __syncthreads();
}
DI void phase_p0(const Ctx& F, const float* const* in) {
    const int gw = F.bid * 8 + F.wave, NGW = F.G * 8;
    for (int it = F.bid; it < 768; it += F.G) p0_adaln_item(F, in[8], in[5], in[6], it);
    LAS float* scr = (LAS float*)(F.lds + F.wave * 16384);
    constexpr int I_E = 64 * (IN_EVEN / 32);
    p0_transpose_range(in[12], 4096, IN_EVEN, (bf16*)(F.ws + WS_WTE), scr, gw, NGW, I_E, F.lane);
    p0_transpose_range(in[22], 4096, IN_ODD, (bf16*)(F.ws + WS_WTO), scr, gw, NGW, WODD_P0, F.lane);
    { u32x4* z = (u32x4*)((bf16*)(F.ws + WS_WTE) + (size_t)IN_EVEN * 4096); const u32x4 zero = {0u, 0u, 0u, 0u};
      for (int i = F.bid * 512 + F.tid; i < (LD_EVEN - IN_EVEN) * 4096 / 8; i += F.G * 512) z[i] = zero; }
    { float* pe = (float*)(F.ws + WS_PE);
      for (int i = F.bid * 512 + F.tid; i < 65536; i += F.G * 512) { const int v = i >> 10, j = i & 1023;
          const float omega = 1.0f / powf(10000.0f, (float)j / 1024.0f); const float ang = (float)v * omega;
          pe[2 * i] = sinf(ang); pe[2 * i + 1] = cosf(ang); } }
    { float* hdn = (float*)(F.ws + WS_HDN);
      for (int it = gw; it < 256 + 4096; it += NGW) { const int L = it < 256 ? 256 : 4096, p = it < 256 ? it : it - 256;
          p0_hdn_item(in[24], in[25], in[26], in[27], in[28], L, p, hdn + (size_t)it * 64, F.lane); } }
}
DI void phase_p0c(const Ctx& F, const float* const* in) {
    { const float* modp = (const float*)(F.ws + WS_MODP); float* modf = (float*)(F.ws + WS_MODF);
      for (int i = F.bid * 512 + F.tid; i < 2 * 3 * 4096; i += F.G * 512) { const int li = i / 12288, r = (i / 4096) % 3, cc = i & 4095;
          float sh = in[9][li * 12288 + cc], sc = in[9][li * 12288 + 4096 + cc], gt = in[9][li * 12288 + 8192 + cc];
#pragma unroll
          for (int ks = 0; ks < 8; ++ks) { const float* m = modp + ((size_t)(ks * 2 + li) * 3 + r) * 12288; sh += m[cc]; sc += m[4096 + cc]; gt += m[8192 + cc]; }
          float* o = modf + (size_t)(li * 9 + r) * 4096;
          o[cc] = in[7][li * 4096 + cc] * (1.0f + sc); o[3 * 4096 + cc] = sh; o[6 * 4096 + cc] = gt; } }
}
DI void phase_filters(const Ctx& F, const float* const* in, int w, int nw) {
    __syncthreads();
    for (int it = w; it < 512; it += nw) { const int cg = it & 255, li = it >> 8;
        const float* hdn = (const float*)(F.ws + WS_HDN) + (li ? (size_t)256 * 64 : 0);
        p0_filter_item(F, hdn, in[29], (float*)(F.ws + (li ? WS_HF4096 : WS_HF256)), (float*)(F.ws + WS_HNRM) + li * 4096, li ? 4096 : 256, cg); }
}
DI void convert_wout(const Ctx& F, const float* const* in, int w, int nw, int li) {
    __syncthreads();
    LAS float* scr = (LAS float*)(F.lds + F.wave * 16384);
    p0_transpose_range(in[10] + (size_t)li * 4096 * 4096, 4096, 4096, (bf16*)(F.ws + WS_WTOUT) + (size_t)li * 4096 * 4096, scr, w * 8 + F.wave, nw * 8, 8192, F.lane);
}
DI void convert_wodd(const Ctx& F, const float* const* in, int w, int nw) {
    __syncthreads();
    LAS float* scr = (LAS float*)(F.lds + F.wave * 16384);
    p0_transpose_range(in[22], 4096, IN_ODD, (bf16*)(F.ws + WS_WTO), scr, WODD_P0 + w * 8 + F.wave, nw * 8, 64 * (IN_ODD / 32), F.lane);
}
constexpr int LDX = 8192;
DI bf16* xr_base(const Ctx& F) { return (bf16*)F.out + 4096; }
template <int MODE> DI void phase_norm(const Ctx& F, const float* const* in) {
    const int gw = F.bid * 8 + F.wave, NGW = F.G * 8;
    bf16* H = (bf16*)(F.ws + WS_H); const float* pe = (const float*)(F.ws + WS_PE); bf16* XR = xr_base(F);
    f32x4 ra[MODE == 0 ? 8 : 1], rb[MODE == 0 ? 8 : 1]; u32x4 rw[MODE == 0 ? 1 : 8];
#define NORM_LOAD(row_) do { if (MODE == 0) { const float* src_ = (row_) < 4096 ? in[0] + (size_t)(row_) * DM : in[1] + (size_t)((row_) - 4096) * DM; \
            _Pragma("unroll") for (int j_ = 0; j_ < 8; ++j_) { ra[MODE == 0 ? j_ : 0] = __builtin_nontemporal_load((const f32x4*)(src_ + j_ * 512 + F.lane * 8)); rb[MODE == 0 ? j_ : 0] = __builtin_nontemporal_load((const f32x4*)(src_ + j_ * 512 + F.lane * 8 + 4)); } } \
        else { _Pragma("unroll") for (int j_ = 0; j_ < 8; ++j_) rw[MODE == 0 ? 0 : j_] = *(const u32x4*)(XR + (size_t)(row_) * LDX + j_ * 512 + F.lane * 8); } } while (0)
    if (gw < NROWS) NORM_LOAD(gw);
#pragma unroll 1
    for (int row = gw; row < NROWS; row += NGW) {
        const int r = row < 4096 ? 0 : 1 + ((row - 4096) >> 12);
        const int t = (row - 4096) & 4095, gr = t >> 6, gc = t & 63;
        float v[8][8]; float ss = 0.f;
        if (MODE == 0) {
#pragma unroll
            for (int j = 0; j < 8; ++j) { const int col = j * 512 + F.lane * 8; const f32x4 a = ra[MODE == 0 ? j : 0], b = rb[MODE == 0 ? j : 0];
                v[j][0] = a[0]; v[j][1] = a[1]; v[j][2] = a[2]; v[j][3] = a[3]; v[j][4] = b[0]; v[j][5] = b[1]; v[j][6] = b[2]; v[j][7] = b[3];
                if (row >= 4096) { const int q4 = j >> 1, jj = col & 1023, vv = (q4 < 2) ? gr : gc, comp = q4 & 1;
                    const f32x4* pp = (const f32x4*)(pe + ((size_t)vv * 1024 + jj) * 2);
#pragma unroll
                    for (int e2 = 0; e2 < 4; ++e2) { const f32x4 p = pp[e2]; v[j][2 * e2] += comp ? p[1] : p[0]; v[j][2 * e2 + 1] += comp ? p[3] : p[2]; } } }
        } else {
#pragma unroll
            for (int j = 0; j < 8; ++j) unpack8(rw[MODE == 0 ? 0 : j], v[j]); }
        if (row + NGW < NROWS) NORM_LOAD(row + NGW);
#pragma unroll
        for (int j = 0; j < 8; ++j)
#pragma unroll
            for (int e = 0; e < 8; ++e) ss += v[j][e] * v[j][e];
        const float rstd = __builtin_amdgcn_rsqf(wave_sum(ss) * (1.0f / DM) + EPS);
        if (MODE == 2) { float* yo = F.out + (size_t)row * DM;
#pragma unroll
            for (int j = 0; j < 8; ++j) { const int col = j * 512 + F.lane * 8; const f32x4 g0 = *(const f32x4*)(in[11] + col), g1 = *(const f32x4*)(in[11] + col + 4);
                __builtin_nontemporal_store((f32x4){v[j][0] * rstd * g0[0], v[j][1] * rstd * g0[1], v[j][2] * rstd * g0[2], v[j][3] * rstd * g0[3]}, (f32x4*)(yo + col));
                __builtin_nontemporal_store((f32x4){v[j][4] * rstd * g1[0], v[j][5] * rstd * g1[1], v[j][6] * rstd * g1[2], v[j][7] * rstd * g1[3]}, (f32x4*)(yo + col + 4)); }
        } else {
            const float* A = (const float*)(F.ws + WS_MODF) + (size_t)((MODE == 1 ? 9 : 0) + r) * 4096;
#pragma unroll
            for (int j = 0; j < 8; ++j) { const int col = j * 512 + F.lane * 8;
                const f32x4 a0 = *(const f32x4*)(A + col), a1 = *(const f32x4*)(A + col + 4), b0 = *(const f32x4*)(A + 3 * 4096 + col), b1 = *(const f32x4*)(A + 3 * 4096 + col + 4);
                u32x4 w; w.x = pk2(v[j][0] * rstd * a0[0] + b0[0], v[j][1] * rstd * a0[1] + b0[1]); w.y = pk2(v[j][2] * rstd * a0[2] + b0[2], v[j][3] * rstd * a0[3] + b0[3]);
                w.z = pk2(v[j][4] * rstd * a1[0] + b1[0], v[j][5] * rstd * a1[1] + b1[1]); w.w = pk2(v[j][6] * rstd * a1[2] + b1[2], v[j][7] * rstd * a1[3] + b1[3]);
                *(u32x4*)(H + (size_t)row * DM + col) = w;
                if (MODE == 0) { u32x4 x; x.x = pk2(v[j][0], v[j][1]); x.y = pk2(v[j][2], v[j][3]); x.z = pk2(v[j][4], v[j][5]); x.w = pk2(v[j][6], v[j][7]);
                    *(u32x4*)(XR + (size_t)row * LDX + col) = x; } }
        }
    }
}
#undef NORM_LOAD

DI void conv3_load(const bf16* Urow, size_t ld, int t, int len, u32x4* r) {
    const u32x4 z = {0u, 0u, 0u, 0u};
    const u32x4* p0 = (const u32x4*)Urow; r[2] = p0[0]; r[3] = p0[1];
    if (t > 0) { const u32x4* p = (const u32x4*)(Urow - ld); r[0] = p[0]; r[1] = p[1]; } else { r[0] = z; r[1] = z; }
    if (t + 1 < len) { const u32x4* p = (const u32x4*)(Urow + ld); r[4] = p[0]; r[5] = p[1]; } else { r[4] = z; r[5] = z; }
}
DI void conv3_calc(const u32x4* r, const LAS float* cw, int cstride, float* o) {
#pragma unroll
    for (int hf = 0; hf < 2; ++hf) { float xm[8], x0[8], xp[8]; unpack8(r[hf], xm); unpack8(r[2 + hf], x0); unpack8(r[4 + hf], xp);
#pragma unroll
        for (int e4 = 0; e4 < 2; ++e4) { const int c = hf * 8 + e4 * 4; const f32x4 w0 = *(const LAS f32x4*)(cw + c), w1 = *(const LAS f32x4*)(cw + cstride + c), w2 = *(const LAS f32x4*)(cw + 2 * cstride + c);
#pragma unroll
            for (int e = 0; e < 4; ++e) o[c + e] = w0[e] * xm[e4 * 4 + e] + w1[e] * x0[e4 * 4 + e] + w2[e] * xp[e4 * 4 + e]; } }
}
#define SCHED_FENCE() __builtin_amdgcn_sched_barrier(0)
DI float wave_scan_incl(float v, int lane) {
#pragma unroll
    for (int o = 1; o < 64; o <<= 1) { const float u = __shfl_up(v, o); if (lane >= o) v += u; }
    return v;
}

DI void gdn_prep_request(const Ctx& F, int c64, int h, u32x4 (&rq_)[6], u32x4 (&rk_)[6], u32x4 (&rv_)[6]) {
    const bf16* U = (const bf16*)(F.ws + WS_U);
    const int r0 = c64 * 64, len = r0 < 4096 ? 256 : 4096, t0 = r0 < 4096 ? (r0 & 255) : ((r0 - 4096) & 4095);
    const int i = F.tid >> 3, sub = F.tid & 7, t = t0 + i;
    const bf16* ur = U + (size_t)(r0 + i) * LD_EVEN;
    conv3_load(ur + E_QKV + h * 128 + sub * 16, LD_EVEN, t, len, rq_);
    conv3_load(ur + E_QKV + 2048 + h * 128 + sub * 16, LD_EVEN, t, len, rk_);
    conv3_load(ur + E_QKV + 4096 + h * 128 + sub * 16, LD_EVEN, t, len, rv_);
}
DI void gdn_prep_item(const Ctx& F, const float* const* in, int c64, int h, bool stage_cw, u32x4 (&rq_)[6], u32x4 (&rk_)[6], u32x4 (&rv_)[6], int next_c64) {
    LAS bf16* Q = (LAS bf16*)(F.lds + 0);
    LAS bf16* K = (LAS bf16*)(F.lds + 17408);
    LAS bf16* KT = (LAS bf16*)(F.lds + 34816);
    LAS bf16* VT = (LAS bf16*)(F.lds + 53248);
    LAS float* KKR = (LAS float*)(F.lds + 71680);
    LAS float* QKR = (LAS float*)(F.lds + 89088);
    LAS bf16* NN = (LAS bf16*)(F.lds + 106496);
    LAS float* NDG = (LAS float*)(F.lds + 115712);
    LAS bf16* DBK = (LAS bf16*)(F.lds + 119808);
    LAS bf16* W = (LAS bf16*)(F.lds + 124928);
    LAS float* TBL = (LAS float*)(F.lds + 142336);
    LAS float* CW = TBL + 384;
    constexpr int LDD = 40, LDR = 68;
    const bf16* U = (const bf16*)(F.ws + WS_U);
    const int r0 = c64 * 64, len = r0 < 4096 ? 256 : 4096, t0 = r0 < 4096 ? (r0 & 255) : ((r0 - 4096) & 4095);
    const int lane_o = F.lane, wave = F.wave;
    LDSBAR();
    if (stage_cw) {
        for (int e = F.tid; e < 3 * 384; e += 512) { const int tap = e / 384, c = e % 384; CW[e] = in[13][tap * 6144 + (c >> 7) * 2048 + h * 128 + (c & 127)]; }
        for (int e = F.tid; e < 4 * 16 * LDD / 2; e += 512) ((LAS unsigned*)DBK)[e] = 0u;
        LDSBAR(); }
    int lane = lane_o; asm volatile("" : "+v"(lane)); const int l15 = lane & 15, q4 = lane >> 4;
    { const int i = F.tid >> 3, sub = F.tid & 7;
      const bf16* ur = U + (size_t)(r0 + i) * LD_EVEN;
      SCHED_FENCE();
      { float qv[16]; conv3_calc(rq_, CW + sub * 16, 384, qv); float sq = 0.f;
#pragma unroll
        for (int e = 0; e < 16; ++e) { qv[e] = siluf_(qv[e]); sq += qv[e] * qv[e]; }
        sq += __shfl_xor(sq, 1); sq += __shfl_xor(sq, 2); sq += __shfl_xor(sq, 4);
        const float rq = 0.08838834764831845f * __builtin_amdgcn_rsqf(sq + EPS);
        u32x4 g0, g1; g0.x = pk2(qv[0] * rq, qv[1] * rq); g0.y = pk2(qv[2] * rq, qv[3] * rq); g0.z = pk2(qv[4] * rq, qv[5] * rq); g0.w = pk2(qv[6] * rq, qv[7] * rq);
        g1.x = pk2(qv[8] * rq, qv[9] * rq); g1.y = pk2(qv[10] * rq, qv[11] * rq); g1.z = pk2(qv[12] * rq, qv[13] * rq); g1.w = pk2(qv[14] * rq, qv[15] * rq);
        *(LAS u32x4*)(Q + i * LDQ + sub * 16) = g0; *(LAS u32x4*)(Q + i * LDQ + sub * 16 + 8) = g1;
        u32x4* gq = (u32x4*)((bf16*)(F.ws + WS_GQN) + (size_t)(r0 + i) * 2048 + h * 128 + sub * 16); gq[0] = g0; gq[1] = g1; }
      SCHED_FENCE();
      { float kv[16]; conv3_calc(rk_, CW + 128 + sub * 16, 384, kv); float sk = 0.f;
#pragma unroll
        for (int e = 0; e < 16; ++e) { kv[e] = siluf_(kv[e]); sk += kv[e] * kv[e]; }
        sk += __shfl_xor(sk, 1); sk += __shfl_xor(sk, 2); sk += __shfl_xor(sk, 4);
        const float rk = __builtin_amdgcn_rsqf(sk + EPS);
#pragma unroll
        for (int e = 0; e < 16; ++e) kv[e] *= rk;
#pragma unroll
        for (int e = 0; e < 16; e += 4) st_bf16x4(K + i * LDQ + sub * 16 + e, kv[e], kv[e + 1], kv[e + 2], kv[e + 3]);
#pragma unroll
        for (int e = 0; e < 16; ++e) KT[swz_idx(sub * 16 + e, i)] = f2bf(kv[e]); }
      SCHED_FENCE();
      { float vv[16]; conv3_calc(rv_, CW + 256 + sub * 16, 384, vv);
#pragma unroll
        for (int e = 0; e < 16; ++e) VT[swz_idx(sub * 16 + e, i)] = f2bf(siluf_(vv[e])); }
      SCHED_FENCE();
      if (sub < 2) { const int d = sub; const float braw = bf2f(ur[E_BETA + d * 16 + h]), araw = bf2f(ur[E_A + d * 16 + h]);
          const int ii = d ? 63 - i : i;
          TBL[d * 192 + ii] = -expf(in[14][d * 16 + h]) * softplusf_(araw + in[15][d * 16 + h]); TBL[d * 192 + 64 + ii] = sigmoidf_(braw); } }
    LDSBAR();
    if (wave < 2) TBL[wave * 192 + 128 + lane] = wave_scan_incl(TBL[wave * 192 + lane], lane);
    { bf16* ktg = (bf16*)(F.ws + WS_GKT) + (size_t)h * 128 * NROWS + r0;
#pragma unroll
      for (int k = 0; k < 2; ++k) { const int e = F.tid + 512 * k, row = e >> 3, pc = e & 7;
          *(u32x4*)(ktg + (size_t)row * NROWS + pc * 8) = *(const LAS u32x4*)(KT + row * LDT + ((pc ^ (row >> 4)) & 7) * 8); } }
#pragma unroll
    for (int tt = 0; tt < 2; ++tt) { const int id = 2 * wave + tt, ti = id >> 2, tj = id & 3;
        f32x4 akk = {0.f, 0.f, 0.f, 0.f}, aqk = akk;
#pragma unroll
        for (int ks = 0; ks < 4; ++ks) { const bf16x8 bk = frag_nat(K, LDQ, tj * 16, ks * 32, lane);
            akk = MFMA16(bk, frag_nat(K, LDQ, ti * 16, ks * 32, lane), akk);
            aqk = MFMA16(bk, frag_nat(Q, LDQ, ti * 16, ks * 32, lane), aqk); }
        *(LAS f32x4*)(KKR + (ti * 16 + l15) * LDR + tj * 16 + 4 * q4) = akk; *(LAS f32x4*)(QKR + (ti * 16 + l15) * LDR + tj * 16 + 4 * q4) = aqk; }
    LDSBAR();
#pragma unroll
    for (int d = 0; d < 2; ++d) {
        const size_t item = ((size_t)c64 * 16 + h) * 2 + d;
        const LAS float* TB_ = TBL + d * 192;
        if (d == 1 && next_c64 >= 0) { gdn_prep_request(F, next_c64, h, rq_, rk_, rv_); }
#pragma unroll
        for (int tt = 0; tt < 2; ++tt) { const int id = 2 * wave + tt, ti = id >> 2, tj = id & 3;
            const int i = ti * 16 + l15, j0 = tj * 16 + 4 * q4;
            f32x4 kk, qk;
            if (d == 0) { kk = *(const LAS f32x4*)(KKR + i * LDR + j0); qk = *(const LAS f32x4*)(QKR + i * LDR + j0); }
            else { const f32x4 a = *(const LAS f32x4*)(KKR + (63 - i) * LDR + 60 - j0), b = *(const LAS f32x4*)(QKR + (63 - i) * LDR + 60 - j0);
                kk = (f32x4){a[3], a[2], a[1], a[0]}; qk = (f32x4){b[3], b[2], b[1], b[0]}; }
            const float gi = TB_[128 + i], bi = TB_[64 + i];
            float nv[4], pv[4];
#pragma unroll
            for (int r = 0; r < 4; ++r) { const int j = j0 + r; const float dec = (i >= j) ? __expf(gi - TB_[128 + j]) : 0.f;
                nv[r] = (i > j) ? bi * kk[r] * dec : 0.f; pv[r] = qk[r] * dec; }
            st_bf16x4(NN + i * LDT + j0, -nv[0], -nv[1], -nv[2], -nv[3]);
            { u32x2 w2; w2.x = pk2(pv[0], pv[1]); w2.y = pk2(pv[2], pv[3]); *(u32x2*)((bf16*)(F.ws + WS_GPP) + (item * 64 + i) * 64 + j0) = w2; }
            if (ti == tj) *(LAS f32x4*)(NDG + (ti * 16 + l15) * 16 + 4 * q4) = (f32x4){nv[0], nv[1], nv[2], nv[3]}; }
        if (wave == 1) ((float*)(F.ws + WS_GGC))[item * 64 + lane] = TB_[128 + lane];
        LDSBAR();
        if (wave == 0) { float x[16];
#pragma unroll
            for (int i = 0; i < 16; ++i) { float sa[4] = {0.f, 0.f, 0.f, 0.f};
                const LAS f32x4* nr = (const LAS f32x4*)(NDG + (q4 * 16 + i) * 16);
#pragma unroll
                for (int k4 = 0; k4 < 4; ++k4) { if (4 * k4 < i) { const f32x4 nvv = nr[k4];
#pragma unroll
                        for (int e = 0; e < 4; ++e) if (4 * k4 + e < i) sa[e] += nvv[e] * x[4 * k4 + e]; } }
                const float a = ((i == l15) ? 1.f : 0.f) - ((sa[0] + sa[1]) + (sa[2] + sa[3]));
                x[i] = a; DBK[(q4 * 16 + i) * LDD + l15] = f2bf(a); } }
        LDSBAR();
        { f32x4 u[4], xw[4]; const f32x4 z4 = {0.f, 0.f, 0.f, 0.f};
#pragma unroll
          for (int b = 0; b < 4; ++b) {
              const f32x4 be = *(const LAS f32x4*)(TB_ + 64 + 16 * b + 4 * q4), gcv = *(const LAS f32x4*)(TB_ + 128 + 16 * b + 4 * q4);
              const int c0 = d ? 60 - 16 * b - 4 * q4 : 16 * b + 4 * q4;
              const bf16x4 vraw = *(const LAS bf16x4*)(VT + swz_idx(16 * wave + l15, c0)), kraw = *(const LAS bf16x4*)(KT + swz_idx(16 * wave + l15, c0));
              f32x4 au, aw;
#pragma unroll
              for (int r = 0; r < 4; ++r) { const int rr = d ? 3 - r : r; au[r] = be[r] * bf2f((bf16)vraw[rr]); aw[r] = be[r] * __expf(gcv[r]) * bf2f((bf16)kraw[rr]); }
              if (b >= 1) { const bf16x8 nf = frag_perm(NN, LDT, 16 * b, 0, lane);
                  au = MFMA16(nf, pack2(u[0], b >= 2 ? u[1] : z4), au); aw = MFMA16(nf, pack2(xw[0], b >= 2 ? xw[1] : z4), aw); }
              if (b == 3) { const bf16x8 nf = frag_perm(NN, LDT, 48, 32, lane);
                  au = MFMA16(nf, pack2(u[2], z4), au); aw = MFMA16(nf, pack2(xw[2], z4), aw); }
              const bf16x8 df = frag_perm(DBK + b * 16 * LDD, LDD, 0, 0, lane);
              u[b] = MFMA16(df, pack2(au, z4), z4); xw[b] = MFMA16(df, pack2(aw, z4), z4);
              { u32x2 w2; w2.x = pk2(u[b][0], u[b][1]); w2.y = pk2(u[b][2], u[b][3]);
                *(u32x2*)((bf16*)(F.ws + WS_GUF) + (((item * 8 + wave) * 4 + b) * 64 + lane) * 4) = w2; }
#pragma unroll
              for (int r = 0; r < 4; ++r) W[(16 * b + 4 * q4 + r) * LDQ + 16 * wave + l15] = f2bf(-xw[b][r]); } }
        LDSBAR();
        { bf16* wg = (bf16*)(F.ws + WS_GWN) + item * 8192;
#pragma unroll
          for (int k = 0; k < 2; ++k) { const int e = F.tid + 512 * k, row = e >> 4, pc = e & 15;
              *(u32x4*)(wg + row * 128 + pc * 8) = *(const LAS u32x4*)(W + row * LDQ + pc * 8); } }
    }
}

#define GDN_SETB 79872
DI void gdn_scan_step(const Ctx& F, f32x4 (&S)[2][8], int set, int ci, int d, int len, int row0, int h, bf16* OUT) {
    const int wave = F.wave;
    int lane = F.lane; asm volatile("" : "+v"(lane)); const int l15 = lane & 15, q4 = lane >> 4;
    LAS bf16* W = (LAS bf16*)(F.lds + set * GDN_SETB); LAS bf16* Q = (LAS bf16*)(F.lds + set * GDN_SETB + 17408); LAS bf16* PB = (LAS bf16*)(F.lds + set * GDN_SETB + 34816);
    LAS bf16* KT = (LAS bf16*)(F.lds + set * GDN_SETB + 44032); LAS float* GC = (LAS float*)(F.lds + set * GDN_SETB + 62464); const LAS bf16* UL = (const LAS bf16*)(F.lds + set * GDN_SETB + 63488);
#define LQ(dst, M, it) do { _Pragma("unroll") for (int i_ = 0; i_ < 4; ++i_) dst[i_] = frag_perm(M, LDQ, (it) * 16, i_ * 32, lane); SCHED_FENCE(); } while (0)
#define LT(dst, M, t0) do { _Pragma("unroll") for (int i_ = 0; i_ < 4; ++i_) dst[i_] = frag_perm(M, LDT, ((t0) + (i_ >> 1)) * 16, (i_ & 1) * 32, lane); SCHED_FENCE(); } while (0)
#define CVN(X, it) do { _Pragma("unroll") for (int ks = 0; ks < 4; ++ks) { vn[0][it] = MFMA16(X[ks], Sp[0][ks], vn[0][it]); vn[1][it] = MFMA16(X[ks], Sp[1][ks], vn[1][it]); } SCHED_FENCE(); } while (0)
#define CO(X, j) do { _Pragma("unroll") for (int ks = 0; ks < 4; ++ks) { o[0][j] = MFMA16(Sp[0][ks], X[ks], o[0][j]); o[1][j] = MFMA16(Sp[1][ks], X[ks], o[1][j]); } SCHED_FENCE(); } while (0)
#define CS(X, t0) do { _Pragma("unroll") for (int ks = 0; ks < 2; ++ks) _Pragma("unroll") for (int j = 0; j < 2; ++j) { S[0][(t0) + j] = MFMA16(X[j * 2 + ks], V2p[0][ks], S[0][(t0) + j]); S[1][(t0) + j] = MFMA16(X[j * 2 + ks], V2p[1][ks], S[1][(t0) + j]); } SCHED_FENCE(); } while (0)
#define CPV(X, it0) do { _Pragma("unroll") for (int j = 0; j < 2; ++j) { const float eg = __expf(GC[((it0) + j) * 16 + l15]); o[0][j] = o[0][j] * eg; o[1][j] = o[1][j] * eg; } \
        _Pragma("unroll") for (int ks = 0; ks < 2; ++ks) _Pragma("unroll") for (int j = 0; j < 2; ++j) { o[0][j] = MFMA16(Vp[0][ks], X[j * 2 + ks], o[0][j]); o[1][j] = MFMA16(Vp[1][ks], X[j * 2 + ks], o[1][j]); } \
        _Pragma("unroll") for (int j = 0; j < 2; ++j) { const int i = ((it0) + j) * 16 + l15; const int tl = ci * 64 + i, t = d ? (len - 1 - tl) : tl; bf16* op = OUT + (size_t)(row0 + t) * 2048 + h * 128 + 32 * wave + 4 * q4; \
            u32x2 w2; w2.x = pk2(o[0][j][0], o[0][j][1]); w2.y = pk2(o[0][j][2], o[0][j][3]); *(u32x2*)op = w2; w2.x = pk2(o[1][j][0], o[1][j][1]); w2.y = pk2(o[1][j][2], o[1][j][3]); *(u32x2*)(op + 16) = w2; \
            o[0][j] = (f32x4){0.f, 0.f, 0.f, 0.f}; o[1][j] = (f32x4){0.f, 0.f, 0.f, 0.f}; } SCHED_FENCE(); } while (0)
    bf16x8 X0[4], X1[4], X2[4];
    f32x4 vn[2][4];
#pragma unroll
    for (int x = 0; x < 2; ++x)
#pragma unroll
        for (int b = 0; b < 4; ++b) { const u32x2 ur = *(const LAS u32x2*)(UL + (((2 * wave + x) * 4 + b) * 64 + lane) * 4);
            vn[x][b][0] = __uint_as_float(ur.x << 16); vn[x][b][1] = __uint_as_float(ur.x & 0xffff0000u); vn[x][b][2] = __uint_as_float(ur.y << 16); vn[x][b][3] = __uint_as_float(ur.y & 0xffff0000u); }
    const float gl = GC[63];
    LQ(X0, W, 0); LQ(X1, W, 1);
    bf16x8 Sp[2][4];
#pragma unroll
    for (int x = 0; x < 2; ++x)
#pragma unroll
        for (int ks = 0; ks < 4; ++ks) Sp[x][ks] = pack2(S[x][2 * ks], S[x][2 * ks + 1]);
    SCHED_FENCE();
    LQ(X2, W, 2); CVN(X0, 0);
    LQ(X0, W, 3); CVN(X1, 1);
    LQ(X1, Q, 0); CVN(X2, 2);
    LQ(X2, Q, 1); CVN(X0, 3);
    bf16x8 Vp[2][2], V2p[2][2];
#pragma unroll
    for (int ks = 0; ks < 2; ++ks) { float e0[4], e1[4];
#pragma unroll
        for (int r = 0; r < 4; ++r) { e0[r] = __expf(gl - GC[(2 * ks) * 16 + 4 * q4 + r]); e1[r] = __expf(gl - GC[(2 * ks + 1) * 16 + 4 * q4 + r]); }
#pragma unroll
        for (int x = 0; x < 2; ++x) { Vp[x][ks] = pack2(vn[x][2 * ks], vn[x][2 * ks + 1]);
            f32x4 a, b;
#pragma unroll
            for (int r = 0; r < 4; ++r) { a[r] = vn[x][2 * ks][r] * e0[r]; b[r] = vn[x][2 * ks + 1][r] * e1[r]; }
            V2p[x][ks] = pack2(a, b); } }
    const float egl = __expf(gl);
    SCHED_FENCE();
    f32x4 o[2][2];
#pragma unroll
    for (int x = 0; x < 2; ++x)
#pragma unroll
        for (int j = 0; j < 2; ++j) o[x][j] = (f32x4){0.f, 0.f, 0.f, 0.f};
    LT(X0, PB, 0); CO(X1, 0);
    LQ(X1, Q, 2); CO(X2, 1);
    LQ(X2, Q, 3); CPV(X0, 0);
    LT(X0, PB, 2); CO(X1, 0);
    LT(X1, KT, 0); CO(X2, 1);
    LT(X2, KT, 2); CPV(X0, 2);
#pragma unroll
    for (int x = 0; x < 2; ++x)
#pragma unroll
        for (int t = 0; t < 8; ++t) S[x][t] = S[x][t] * egl;
    SCHED_FENCE();
    LT(X0, KT, 4); CS(X1, 0);
    LT(X1, KT, 6); CS(X2, 2);
    CS(X0, 4); CS(X1, 6);
#undef LQ
#undef LT
#undef CVN
#undef CO
#undef CS
#undef CPV
}
DI void gdn_scan_item(const Ctx& F, const float* const* in, int s, int h, int d) {
    constexpr int SETB = GDN_SETB;
    const int row0 = seq_row0(s), len = seq_len(s), nch = len >> 6, c640 = row0 >> 6;
    const int lane_o = F.lane, wave = F.wave;
    bf16* OUT = (bf16*)(F.ws + (d ? WS_OBA : WS_OFA));
    const bf16* GWN = (const bf16*)(F.ws + WS_GWN); const bf16* GUF = (const bf16*)(F.ws + WS_GUF); const bf16* GPP = (const bf16*)(F.ws + WS_GPP);
    const float* GGC = (const float*)(F.ws + WS_GGC); const bf16* GQN = (const bf16*)(F.ws + WS_GQN); const bf16* GKT = (const bf16*)(F.ws + WS_GKT) + (size_t)h * 128 * NROWS;
    LDSBAR();
    if (wave >= 4) {
        struct Pre { u32x4 w[4], q[4], p[2], k[4], u[4]; float g; };
        Pre PA, PB_;
        const int e = F.tid - 256, er = e >> 2, eq = e & 3;
#define GDN_ISSUE(ci_, P_) do { const int cc = c640 + (d ? nch - 1 - (ci_) : (ci_)); const size_t item = ((size_t)cc * 16 + h) * 2 + d; \
        const u32x4* wsrc = (const u32x4*)(GWN + item * 8192 + er * 128 + eq * 32); \
        const int qrow = cc * 64 + (d ? 63 - er : er); const u32x4* qsrc = (const u32x4*)(GQN + (size_t)qrow * 2048 + h * 128 + eq * 32); \
        _Pragma("unroll") for (int m_ = 0; m_ < 4; ++m_) { P_.w[m_] = wsrc[m_]; P_.q[m_] = qsrc[m_]; } \
        const u32x4* psrc = (const u32x4*)(GPP + item * 4096 + er * 64 + eq * 16); P_.p[0] = psrc[0]; P_.p[1] = psrc[1]; \
        const u32x4* k0src = (const u32x4*)(GKT + (size_t)er * NROWS + cc * 64 + eq * 16); const u32x4* k1src = (const u32x4*)(GKT + (size_t)(64 + er) * NROWS + cc * 64 + eq * 16); \
        P_.k[0] = k0src[0]; P_.k[1] = k0src[1]; P_.k[2] = k1src[0]; P_.k[3] = k1src[1]; \
        const u32x4* usrc = (const u32x4*)(GUF + item * 8192) + e; _Pragma("unroll") for (int m_ = 0; m_ < 4; ++m_) P_.u[m_] = usrc[m_ * 256]; \
        P_.g = (e < 64) ? GGC[item * 64 + e] : 0.f; } while (0)
#define REV8(w_) ((u32x4){((w_).w >> 16) | ((w_).w << 16), ((w_).z >> 16) | ((w_).z << 16), ((w_).y >> 16) | ((w_).y << 16), ((w_).x >> 16) | ((w_).x << 16)})
#define GDN_COMMIT(set_, P_) do { LAS unsigned char* base = F.lds + (set_) * SETB; \
        _Pragma("unroll") for (int m_ = 0; m_ < 4; ++m_) { *(LAS u32x4*)((LAS bf16*)base + er * LDQ + eq * 32 + m_ * 8) = P_.w[m_]; *(LAS u32x4*)((LAS bf16*)(base + 17408) + er * LDQ + eq * 32 + m_ * 8) = P_.q[m_]; } \
        *(LAS u32x4*)((LAS bf16*)(base + 34816) + er * LDT + eq * 16) = P_.p[0]; *(LAS u32x4*)((LAS bf16*)(base + 34816) + er * LDT + eq * 16 + 8) = P_.p[1]; \
        if (d == 0) { *(LAS u32x4*)((LAS bf16*)(base + 44032) + er * LDT + eq * 16) = P_.k[0]; *(LAS u32x4*)((LAS bf16*)(base + 44032) + er * LDT + eq * 16 + 8) = P_.k[1]; \
            *(LAS u32x4*)((LAS bf16*)(base + 44032) + (64 + er) * LDT + eq * 16) = P_.k[2]; *(LAS u32x4*)((LAS bf16*)(base + 44032) + (64 + er) * LDT + eq * 16 + 8) = P_.k[3]; } \
        else { *(LAS u32x4*)((LAS bf16*)(base + 44032) + er * LDT + (3 - eq) * 16 + 8) = REV8(P_.k[0]); *(LAS u32x4*)((LAS bf16*)(base + 44032) + er * LDT + (3 - eq) * 16) = REV8(P_.k[1]); \
            *(LAS u32x4*)((LAS bf16*)(base + 44032) + (64 + er) * LDT + (3 - eq) * 16 + 8) = REV8(P_.k[2]); *(LAS u32x4*)((LAS bf16*)(base + 44032) + (64 + er) * LDT + (3 - eq) * 16) = REV8(P_.k[3]); } \
        _Pragma("unroll") for (int m_ = 0; m_ < 4; ++m_) *((LAS u32x4*)(base + 63488) + e + m_ * 256) = P_.u[m_]; \
        if (e < 64) ((LAS float*)(base + 62464))[e] = P_.g; } while (0)
        GDN_ISSUE(0, PA); GDN_ISSUE(1, PB_);
#pragma unroll 1
        for (int ci = 0; ci < nch; ci += 2) {
            GDN_COMMIT(0, PA); LDSBAR(); if (ci + 2 < nch) GDN_ISSUE(ci + 2, PA);
            GDN_COMMIT(1, PB_); LDSBAR(); if (ci + 3 < nch) GDN_ISSUE(ci + 3, PB_); }
#undef GDN_ISSUE
#undef GDN_COMMIT
#undef REV8
    } else {
        f32x4 S[2][8];
        if (s >= 16) { int ln = lane_o; asm volatile("" : "+v"(ln)); const int l15 = ln & 15, q4 = ln >> 4; const float* sp = in[2] + ((size_t)((s - 16) * 2 + d) * 16 + h) * 16384;
#pragma unroll
            for (int x = 0; x < 2; ++x)
#pragma unroll
                for (int t = 0; t < 8; ++t)
#pragma unroll
                    for (int r = 0; r < 4; ++r) S[x][t][r] = sp[(size_t)(16 * t + 4 * q4 + r) * 128 + 32 * wave + 16 * x + l15];
        } else {
#pragma unroll
            for (int x = 0; x < 2; ++x)
#pragma unroll
                for (int t = 0; t < 8; ++t) S[x][t] = (f32x4){0.f, 0.f, 0.f, 0.f}; }
#pragma unroll 1
        for (int ci = 0; ci < nch; ci += 2) { LDSBAR(); gdn_scan_step(F, S, 0, ci, d, len, row0, h, OUT); LDSBAR(); gdn_scan_step(F, S, 1, ci + 1, d, len, row0, h, OUT); }
        if (s < 16) { int ln = lane_o; asm volatile("" : "+v"(ln)); const int l15 = ln & 15, q4 = ln >> 4; float* sp = F.out + OUT_SG + ((size_t)(s * 2 + d) * 16 + h) * 16384;
#pragma unroll
            for (int x = 0; x < 2; ++x)
#pragma unroll
                for (int t = 0; t < 8; ++t)
#pragma unroll
                    for (int r = 0; r < 4; ++r) sp[(size_t)(16 * t + 4 * q4 + r) * 128 + 32 * wave + 16 * x + l15] = S[x][t][r]; }
    }
}

DI void ssd_prep_request(const Ctx& F, int c64, int g, u32x4 (&rx0)[6], u32x4 (&rx1)[6], u32x4 (&rb_)[6], u32x4 (&rc_)[6]) {
    const bf16* U = (const bf16*)(F.ws + WS_U);
    const int r0 = c64 * 64, len = r0 < 4096 ? 256 : 4096, t0 = r0 < 4096 ? (r0 & 255) : ((r0 - 4096) & 4095);
    const int i = F.tid >> 3, sub = F.tid & 7, t = t0 + i;
    const bf16* ur = U + (size_t)(r0 + i) * LD_EVEN;
    conv3_load(ur + E_XBC + g * 256 + sub * 32, LD_EVEN, t, len, rx0);
    conv3_load(ur + E_XBC + g * 256 + sub * 32 + 16, LD_EVEN, t, len, rx1);
    conv3_load(ur + E_XBC + 2048 + g * 128 + sub * 16, LD_EVEN, t, len, rb_);
    conv3_load(ur + E_XBC + 3072 + g * 128 + sub * 16, LD_EVEN, t, len, rc_);
}
DI void ssd_prep_item(const Ctx& F, const float* const* in, int c64, int g, bool stage_cw, u32x4 (&rx0)[6], u32x4 (&rx1)[6], u32x4 (&rb_)[6], u32x4 (&rc_)[6], int next_c64, int next_g) {
    LAS bf16* C = (LAS bf16*)(F.lds + 0);
    LAS bf16* B = (LAS bf16*)(F.lds + 17408);
    LAS bf16* BT = (LAS bf16*)(F.lds + 34816);
    LAS bf16* XT = (LAS bf16*)(F.lds + 53248);
    LAS float* CBR = (LAS float*)(F.lds + 90112);
    LAS float* TBL = (LAS float*)(F.lds + 107520);
    LAS float* CW = TBL + 8 * 192;
    constexpr int LDR = 68;
    const bf16* U = (const bf16*)(F.ws + WS_U);
    const int r0 = c64 * 64, len = r0 < 4096 ? 256 : 4096, t0 = r0 < 4096 ? (r0 & 255) : ((r0 - 4096) & 4095);
    const int lane_o = F.lane, wave = F.wave;
    LDSBAR();
    if (stage_cw) {
        for (int e = F.tid; e < 3 * 512; e += 512) { const int tap = e >> 9, c = e & 511; const int col = c < 256 ? g * 256 + c : (c < 384 ? 2048 + g * 128 + (c - 256) : 3072 + g * 128 + (c - 384)); CW[e] = in[17][tap * 4096 + col]; }
        LDSBAR(); }
    int lane = lane_o; asm volatile("" : "+v"(lane)); const int l15 = lane & 15, q4 = lane >> 4;
    { const int i = F.tid >> 3, sub = F.tid & 7; const int t = t0 + i;
      const bf16* ur = U + (size_t)(r0 + i) * LD_EVEN;
      SCHED_FENCE();
      { float xv[16]; conv3_calc(rx0, CW + sub * 32, 512, xv);
#pragma unroll
        for (int e = 0; e < 16; ++e) XT[swz_idx((sub >> 1) * 64 + (sub & 1) * 32 + e, i)] = f2bf(siluf_(xv[e])); }
      SCHED_FENCE();
      { float xv[16]; conv3_calc(rx1, CW + sub * 32 + 16, 512, xv);
#pragma unroll
        for (int e = 0; e < 16; ++e) XT[swz_idx((sub >> 1) * 64 + (sub & 1) * 32 + 16 + e, i)] = f2bf(siluf_(xv[e])); }
      SCHED_FENCE();
      { float bv[16]; conv3_calc(rb_, CW + 256 + sub * 16, 512, bv);
#pragma unroll
        for (int e = 0; e < 16; ++e) bv[e] = siluf_(bv[e]);
#pragma unroll
        for (int e = 0; e < 16; e += 4) st_bf16x4(B + i * LDQ + sub * 16 + e, bv[e], bv[e + 1], bv[e + 2], bv[e + 3]);
#pragma unroll
        for (int e = 0; e < 16; ++e) BT[swz_idx(sub * 16 + e, i)] = f2bf(bv[e]); }
      SCHED_FENCE();
      { float cv[16]; conv3_calc(rc_, CW + 384 + sub * 16, 512, cv);
        u32x4 g0, g1; g0.x = pk2(siluf_(cv[0]), siluf_(cv[1])); g0.y = pk2(siluf_(cv[2]), siluf_(cv[3])); g0.z = pk2(siluf_(cv[4]), siluf_(cv[5])); g0.w = pk2(siluf_(cv[6]), siluf_(cv[7]));
        g1.x = pk2(siluf_(cv[8]), siluf_(cv[9])); g1.y = pk2(siluf_(cv[10]), siluf_(cv[11])); g1.z = pk2(siluf_(cv[12]), siluf_(cv[13])); g1.w = pk2(siluf_(cv[14]), siluf_(cv[15]));
        *(LAS u32x4*)(C + i * LDQ + sub * 16) = g0; *(LAS u32x4*)(C + i * LDQ + sub * 16 + 8) = g1;
        u32x4* gc_ = (u32x4*)((bf16*)(F.ws + WS_SCN) + (size_t)(r0 + i) * 1024 + g * 128 + sub * 16); gc_[0] = g0; gc_[1] = g1; }
      SCHED_FENCE();
      { const int d = sub >> 2, hx = sub & 3, hd = g * 4 + hx, ii = d ? 63 - i : i;
        const float dt = softplusf_(bf2f(ur[E_DT + d * 32 + hd]) + in[19][d * 32 + hd]);
        TBL[sub * 192 + ii] = -expf(in[18][d * 32 + hd]) * dt; TBL[sub * 192 + 128 + ii] = dt; } }
    if (next_c64 >= 0) ssd_prep_request(F, next_c64, next_g, rx0, rx1, rb_, rc_);
    LDSBAR();
    TBL[wave * 192 + 64 + lane] = wave_scan_incl(TBL[wave * 192 + lane], lane);
    { bf16* btg = (bf16*)(F.ws + WS_SBT) + (size_t)g * 128 * NROWS + r0;
#pragma unroll
      for (int k = 0; k < 2; ++k) { const int e = F.tid + 512 * k, row = e >> 3, pc = e & 7;
          *(u32x4*)(btg + (size_t)row * NROWS + pc * 8) = *(const LAS u32x4*)(BT + row * LDT + ((pc ^ (row >> 4)) & 7) * 8); } }
#pragma unroll
    for (int k = 0; k < 8; ++k) { const int e = F.tid + 512 * k, pc = e & 7, row = (e >> 3) & 63, hx = (e >> 9) & 3, d = e >> 11;
        const u32x4 raw = *(const LAS u32x4*)(XT + (hx * 64 + row) * LDT + ((pc ^ ((hx * 64 + row) >> 4)) & 7) * 8); float f[8]; unpack8(raw, f);
        const LAS float* dtp = TBL + (d * 4 + hx) * 192 + 128;
        u32x4 o;
        if (d == 0) { const f32x4 d0 = *(const LAS f32x4*)(dtp + pc * 8), d1 = *(const LAS f32x4*)(dtp + pc * 8 + 4);
            o.x = pk2(f[0] * d0[0], f[1] * d0[1]); o.y = pk2(f[2] * d0[2], f[3] * d0[3]); o.z = pk2(f[4] * d1[0], f[5] * d1[1]); o.w = pk2(f[6] * d1[2], f[7] * d1[3]); }
        else { const f32x4 d0 = *(const LAS f32x4*)(dtp + 56 - pc * 8), d1 = *(const LAS f32x4*)(dtp + 60 - pc * 8);
            o.x = pk2(f[0] * d1[3], f[1] * d1[2]); o.y = pk2(f[2] * d1[1], f[3] * d1[0]); o.z = pk2(f[4] * d0[3], f[5] * d0[2]); o.w = pk2(f[6] * d0[1], f[7] * d0[0]); }
        *(u32x4*)((bf16*)(F.ws + WS_SVT) + ((size_t)((g * 4 + hx) * 2 + d) * 64 + row) * NROWS + r0 + pc * 8) = o; }
#pragma unroll
    for (int tt = 0; tt < 2; ++tt) { const int id = 2 * wave + tt, ti = id >> 2, tj = id & 3;
        f32x4 cb = {0.f, 0.f, 0.f, 0.f};
#pragma unroll
        for (int ks = 0; ks < 4; ++ks) cb = MFMA16(frag_nat(B, LDQ, tj * 16, ks * 32, lane), frag_nat(C, LDQ, ti * 16, ks * 32, lane), cb);
        *(LAS f32x4*)(CBR + (ti * 16 + l15) * LDR + tj * 16 + 4 * q4) = cb; }
    LDSBAR();
    { const int d = wave >> 2, hx = wave & 3; const size_t item = ((size_t)c64 * 32 + g * 4 + hx) * 2 + d;
      const LAS float* gcp = TBL + wave * 192 + 64; const float gi = gcp[lane];
      ((float*)(F.ws + WS_SSG))[item * 64 + lane] = gi;
      const LAS float* crow = CBR + (d ? 63 - lane : lane) * LDR;
      bf16* pg = (bf16*)(F.ws + WS_SSP) + (item * 64 + lane) * 64;
#pragma unroll
      for (int j8 = 0; j8 < 8; ++j8) { float pv[8];
          f32x4 c0, c1;
          if (d == 0) { c0 = *(const LAS f32x4*)(crow + j8 * 8); c1 = *(const LAS f32x4*)(crow + j8 * 8 + 4); }
          else { const f32x4 a0 = *(const LAS f32x4*)(crow + 60 - j8 * 8), a1 = *(const LAS f32x4*)(crow + 56 - j8 * 8); c0 = (f32x4){a0[3], a0[2], a0[1], a0[0]}; c1 = (f32x4){a1[3], a1[2], a1[1], a1[0]}; }
          const f32x4 g0 = *(const LAS f32x4*)(gcp + j8 * 8), g1 = *(const LAS f32x4*)(gcp + j8 * 8 + 4);
#pragma unroll
          for (int e = 0; e < 4; ++e) { const int j = j8 * 8 + e; pv[e] = (lane >= j) ? c0[e] * __expf(gi - g0[e]) : 0.f; pv[4 + e] = (lane >= j + 4) ? c1[e] * __expf(gi - g1[e]) : 0.f; }
          u32x4 o; o.x = pk2(pv[0], pv[1]); o.y = pk2(pv[2], pv[3]); o.z = pk2(pv[4], pv[5]); o.w = pk2(pv[6], pv[7]);
          *(u32x4*)(pg + j8 * 8) = o; } }
}

#define SSD_SETB 73728
DI void ssd_scan_step(const Ctx& F, f32x4 (&S)[2][8], int set, int ci, int d, int len, int row0, int head0, bf16* OUT) {
    const int pq = F.wave;
    int lane = F.lane; asm volatile("" : "+v"(lane)); const int l15 = lane & 15, q4 = lane >> 4;
    LAS unsigned char* base = F.lds + set * SSD_SETB;
    LAS bf16* C = (LAS bf16*)base; LAS bf16* BT = (LAS bf16*)(base + 17408); LAS bf16* PH = (LAS bf16*)(base + 35840); LAS bf16* VT = (LAS bf16*)(base + 54272);
    LAS float* GC = (LAS float*)(base + 72704);
#define LC(dst, it) do { _Pragma("unroll") for (int i_ = 0; i_ < 4; ++i_) dst[i_] = frag_perm(C, LDQ, (it) * 16, i_ * 32, lane); SCHED_FENCE(); } while (0)
#define LP(dst, it) do { _Pragma("unroll") for (int i_ = 0; i_ < 4; ++i_) dst[i_] = frag_nat(PH + (i_ >> 1) * 4608, LDT, (it) * 16, (i_ & 1) * 32, lane); SCHED_FENCE(); } while (0)
#define LB(dst, t0) do { _Pragma("unroll") for (int i_ = 0; i_ < 4; ++i_) dst[i_] = frag_nat(BT, LDT, ((t0) + (i_ >> 1)) * 16, (i_ & 1) * 32, lane); SCHED_FENCE(); } while (0)
#define CY(X, it) do { y[0] = (f32x4){0.f, 0.f, 0.f, 0.f}; y[1] = y[0]; _Pragma("unroll") for (int ks = 0; ks < 4; ++ks) { y[0] = MFMA16(Sp[0][ks], X[ks], y[0]); y[1] = MFMA16(Sp[1][ks], X[ks], y[1]); } \
        y[0] = y[0] * __expf(GC[(it) * 16 + l15]); y[1] = y[1] * __expf(GC[64 + (it) * 16 + l15]); SCHED_FENCE(); } while (0)
#define CP(X, it) do { _Pragma("unroll") for (int ks = 0; ks < 2; ++ks) { y[0] = MFMA16(VF[0][ks], X[ks], y[0]); y[1] = MFMA16(VF[1][ks], X[2 + ks], y[1]); } \
        { const int i = (it) * 16 + l15; const int tl = ci * 64 + i, t = d ? (len - 1 - tl) : tl; bf16* op = OUT + (size_t)(row0 + t) * 2048 + head0 * 64 + 16 * pq + 4 * q4; \
          u32x2 w2; w2.x = pk2(y[0][0], y[0][1]); w2.y = pk2(y[0][2], y[0][3]); *(u32x2*)op = w2; w2.x = pk2(y[1][0], y[1][1]); w2.y = pk2(y[1][2], y[1][3]); *(u32x2*)(op + 64) = w2; } SCHED_FENCE(); } while (0)
#define CS(X, t0) do { _Pragma("unroll") for (int ks = 0; ks < 2; ++ks) _Pragma("unroll") for (int j = 0; j < 2; ++j) { S[0][(t0) + j] = MFMA16(X[j * 2 + ks], V2[0][ks], S[0][(t0) + j]); S[1][(t0) + j] = MFMA16(X[j * 2 + ks], V2[1][ks], S[1][(t0) + j]); } SCHED_FENCE(); } while (0)
    bf16x8 X0[4], X1[4], X2[4];
    bf16x8 VF[2][2];
#pragma unroll
    for (int x = 0; x < 2; ++x)
#pragma unroll
        for (int ks = 0; ks < 2; ++ks) VF[x][ks] = frag_nat(VT + x * 4608, LDT, 16 * pq, ks * 32, lane);
    const float gl0 = GC[63], gl1 = GC[127];
    LC(X0, 0); LP(X1, 0);
    bf16x8 Sp[2][4];
#pragma unroll
    for (int x = 0; x < 2; ++x)
#pragma unroll
        for (int ks = 0; ks < 4; ++ks) Sp[x][ks] = pack2(S[x][2 * ks], S[x][2 * ks + 1]);
    bf16x8 V2[2][2];
#pragma unroll
    for (int x = 0; x < 2; ++x) { const float gl = x ? gl1 : gl0;
#pragma unroll
        for (int ks = 0; ks < 2; ++ks) { float f[8]; unpack8(__builtin_bit_cast(u32x4, VF[x][ks]), f);
            const f32x4 g0 = *(const LAS f32x4*)(GC + x * 64 + ks * 32 + 8 * q4), g1 = *(const LAS f32x4*)(GC + x * 64 + ks * 32 + 8 * q4 + 4);
            u32x4 w; w.x = pk2(f[0] * __expf(gl - g0[0]), f[1] * __expf(gl - g0[1])); w.y = pk2(f[2] * __expf(gl - g0[2]), f[3] * __expf(gl - g0[3]));
            w.z = pk2(f[4] * __expf(gl - g1[0]), f[5] * __expf(gl - g1[1])); w.w = pk2(f[6] * __expf(gl - g1[2]), f[7] * __expf(gl - g1[3]));
            V2[x][ks] = __builtin_bit_cast(bf16x8, w); } }
    const float egl0 = __expf(gl0), egl1 = __expf(gl1);
    SCHED_FENCE();
    f32x4 y[2];
    LC(X2, 1); CY(X0, 0);
    LP(X0, 1); CP(X1, 0);
    LC(X1, 2); CY(X2, 1);
    LP(X2, 2); CP(X0, 1);
    LC(X0, 3); CY(X1, 2);
    LP(X1, 3); CP(X2, 2);
    LB(X2, 0); CY(X0, 3);
    LB(X0, 2); CP(X1, 3);
#pragma unroll
    for (int t = 0; t < 8; ++t) { S[0][t] = S[0][t] * egl0; S[1][t] = S[1][t] * egl1; }
    SCHED_FENCE();
    LB(X1, 4); CS(X2, 0);
    LB(X2, 6); CS(X0, 2);
    CS(X1, 4); CS(X2, 6);
#undef LC
#undef LP
#undef LB
#undef CY
#undef CP
#undef CS
}
DI void ssd_scan_item(const Ctx& F, const float* const* in, int s, int g, int d, int hp) {
    constexpr int SETB = SSD_SETB;
    const int row0 = seq_row0(s), len = seq_len(s), nch = len >> 6, c640 = row0 >> 6;
    const int lane_o = F.lane, wave = F.wave;
    const int head0 = g * 4 + hp * 2;
    bf16* OUT = (bf16*)(F.ws + (d ? WS_OBB : WS_OFB));
    const bf16* SCN = (const bf16*)(F.ws + WS_SCN); const bf16* SBT = (const bf16*)(F.ws + WS_SBT) + (size_t)g * 128 * NROWS;
    const bf16* SVT = (const bf16*)(F.ws + WS_SVT); const bf16* SSP = (const bf16*)(F.ws + WS_SSP); const float* SSG = (const float*)(F.ws + WS_SSG);
    LDSBAR();
    if (wave >= 4) {
        struct Pre { u32x4 c[4], b[4], p[4], v[4]; float g; };
        Pre PA, PB_;
        const int e = F.tid - 256, er = e >> 2, eq = e & 3;
#define REV8(w_) ((u32x4){((w_).w >> 16) | ((w_).w << 16), ((w_).z >> 16) | ((w_).z << 16), ((w_).y >> 16) | ((w_).y << 16), ((w_).x >> 16) | ((w_).x << 16)})
#define SSD_ISSUE(ci_, P_) do { const int cc = c640 + (d ? nch - 1 - (ci_) : (ci_)); \
        const int crow = cc * 64 + (d ? 63 - er : er); const u32x4* csrc = (const u32x4*)(SCN + (size_t)crow * 1024 + g * 128 + eq * 32); \
        _Pragma("unroll") for (int m_ = 0; m_ < 4; ++m_) P_.c[m_] = csrc[m_]; \
        const u32x4* b0src = (const u32x4*)(SBT + (size_t)er * NROWS + cc * 64 + eq * 16); const u32x4* b1src = (const u32x4*)(SBT + (size_t)(64 + er) * NROWS + cc * 64 + eq * 16); \
        P_.b[0] = b0src[0]; P_.b[1] = b0src[1]; P_.b[2] = b1src[0]; P_.b[3] = b1src[1]; \
        const size_t it0 = ((size_t)cc * 32 + head0) * 2 + d, it1 = it0 + 2; \
        const u32x4* p0src = (const u32x4*)(SSP + (it0 * 64 + er) * 64 + eq * 16); const u32x4* p1src = (const u32x4*)(SSP + (it1 * 64 + er) * 64 + eq * 16); \
        P_.p[0] = p0src[0]; P_.p[1] = p0src[1]; P_.p[2] = p1src[0]; P_.p[3] = p1src[1]; \
        const u32x4* v0src = (const u32x4*)(SVT + ((size_t)(head0 * 2 + d) * 64 + er) * NROWS + cc * 64 + eq * 16); const u32x4* v1src = (const u32x4*)(SVT + ((size_t)((head0 + 1) * 2 + d) * 64 + er) * NROWS + cc * 64 + eq * 16); \
        P_.v[0] = v0src[0]; P_.v[1] = v0src[1]; P_.v[2] = v1src[0]; P_.v[3] = v1src[1]; \
        P_.g = 0.f; if (e < 128) P_.g = SSG[((e < 64) ? it0 : it1) * 64 + (e & 63)]; } while (0)
#define SSD_COMMIT(set_, P_) do { LAS unsigned char* base = F.lds + (set_) * SETB; \
        _Pragma("unroll") for (int m_ = 0; m_ < 4; ++m_) *(LAS u32x4*)((LAS bf16*)base + er * LDQ + eq * 32 + m_ * 8) = P_.c[m_]; \
        *(LAS u32x4*)((LAS bf16*)(base + 35840) + er * LDT + eq * 16) = P_.p[0]; *(LAS u32x4*)((LAS bf16*)(base + 35840) + er * LDT + eq * 16 + 8) = P_.p[1]; \
        *(LAS u32x4*)((LAS bf16*)(base + 45056) + er * LDT + eq * 16) = P_.p[2]; *(LAS u32x4*)((LAS bf16*)(base + 45056) + er * LDT + eq * 16 + 8) = P_.p[3]; \
        if (d == 0) { *(LAS u32x4*)((LAS bf16*)(base + 17408) + er * LDT + eq * 16) = P_.b[0]; *(LAS u32x4*)((LAS bf16*)(base + 17408) + er * LDT + eq * 16 + 8) = P_.b[1]; \
            *(LAS u32x4*)((LAS bf16*)(base + 17408) + (64 + er) * LDT + eq * 16) = P_.b[2]; *(LAS u32x4*)((LAS bf16*)(base + 17408) + (64 + er) * LDT + eq * 16 + 8) = P_.b[3]; \
            *(LAS u32x4*)((LAS bf16*)(base + 54272) + er * LDT + eq * 16) = P_.v[0]; *(LAS u32x4*)((LAS bf16*)(base + 54272) + er * LDT + eq * 16 + 8) = P_.v[1]; \
            *(LAS u32x4*)((LAS bf16*)(base + 63488) + er * LDT + eq * 16) = P_.v[2]; *(LAS u32x4*)((LAS bf16*)(base + 63488) + er * LDT + eq * 16 + 8) = P_.v[3]; } \
        else { *(LAS u32x4*)((LAS bf16*)(base + 17408) + er * LDT + (3 - eq) * 16 + 8) = REV8(P_.b[0]); *(LAS u32x4*)((LAS bf16*)(base + 17408) + er * LDT + (3 - eq) * 16) = REV8(P_.b[1]); \
            *(LAS u32x4*)((LAS bf16*)(base + 17408) + (64 + er) * LDT + (3 - eq) * 16 + 8) = REV8(P_.b[2]); *(LAS u32x4*)((LAS bf16*)(base + 17408) + (64 + er) * LDT + (3 - eq) * 16) = REV8(P_.b[3]); \
            *(LAS u32x4*)((LAS bf16*)(base + 54272) + er * LDT + (3 - eq) * 16 + 8) = REV8(P_.v[0]); *(LAS u32x4*)((LAS bf16*)(base + 54272) + er * LDT + (3 - eq) * 16) = REV8(P_.v[1]); \
            *(LAS u32x4*)((LAS bf16*)(base + 63488) + er * LDT + (3 - eq) * 16 + 8) = REV8(P_.v[2]); *(LAS u32x4*)((LAS bf16*)(base + 63488) + er * LDT + (3 - eq) * 16) = REV8(P_.v[3]); } \
        if (e < 128) ((LAS float*)(base + 72704))[e] = P_.g; } while (0)
        SSD_ISSUE(0, PA); SSD_ISSUE(1, PB_);
#pragma unroll 1
        for (int ci = 0; ci < nch; ci += 2) {
            SSD_COMMIT(0, PA); LDSBAR(); if (ci + 2 < nch) SSD_ISSUE(ci + 2, PA);
            SSD_COMMIT(1, PB_); LDSBAR(); if (ci + 3 < nch) SSD_ISSUE(ci + 3, PB_); }
#undef SSD_ISSUE
#undef SSD_COMMIT
#undef REV8
    } else {
        const int pq = wave;
        f32x4 S[2][8];
        if (s >= 16) { int ln = lane_o; asm volatile("" : "+v"(ln)); const int l15 = ln & 15, q4 = ln >> 4;
#pragma unroll
            for (int x = 0; x < 2; ++x) { const float* sp = in[3] + ((size_t)((s - 16) * 2 + d) * 32 + head0 + x) * 8192;
#pragma unroll
                for (int t = 0; t < 8; ++t) S[x][t] = *(const f32x4*)(sp + (size_t)(16 * pq + l15) * 128 + 16 * t + 4 * q4); }
        } else {
#pragma unroll
            for (int x = 0; x < 2; ++x)
#pragma unroll
                for (int t = 0; t < 8; ++t) S[x][t] = (f32x4){0.f, 0.f, 0.f, 0.f}; }
#pragma unroll 1
        for (int ci = 0; ci < nch; ci += 2) { LDSBAR(); ssd_scan_step(F, S, 0, ci, d, len, row0, head0, OUT); LDSBAR(); ssd_scan_step(F, S, 1, ci + 1, d, len, row0, head0, OUT); }
        if (s < 16) { int ln = lane_o; asm volatile("" : "+v"(ln)); const int l15 = ln & 15, q4 = ln >> 4;
#pragma unroll
            for (int x = 0; x < 2; ++x) { float* sp = F.out + OUT_SS + ((size_t)(s * 2 + d) * 32 + head0 + x) * 8192;
#pragma unroll
                for (int t = 0; t < 8; ++t) *(f32x4*)(sp + (size_t)(16 * pq + l15) * 128 + 16 * t + 4 * q4) = S[x][t]; } }
    }
}

DI void phase_m0a(const Ctx& F, const float* const* in) {
    { int prev = -1; u32x4 rq_[6], rk_[6], rv_[6];
      if (F.bid < 3072) gdn_prep_request(F, F.bid >> 4, F.bid & 15, rq_, rk_, rv_);
      for (int it = F.bid; it < 3072; it += F.G) { const int h = it & 15; const int nx = it + F.G;
          const int next_c64 = (nx < 3072 && (nx & 15) == h) ? (nx >> 4) : -1;
          gdn_prep_item(F, in, it >> 4, h, h != prev, rq_, rk_, rv_, next_c64);
          if (next_c64 < 0 && nx < 3072) gdn_prep_request(F, nx >> 4, nx & 15, rq_, rk_, rv_);
          prev = h; } }
    { int prev = -1; u32x4 rx0[6], rx1[6], rb_[6], rc_[6];
      if (F.bid < 1536) ssd_prep_request(F, F.bid >> 3, F.bid & 7, rx0, rx1, rb_, rc_);
#pragma unroll 1
      for (int it = F.bid; it < 1536; it += F.G) { const int g = it & 7; const int nx = it + F.G;
          ssd_prep_item(F, in, it >> 3, g, g != prev, rx0, rx1, rb_, rc_, nx < 1536 ? (nx >> 3) : -1, nx & 7); prev = g; } }
}
DI int queue_grab(const Ctx& F, unsigned* head, int n) {
    volatile LAS int* slot = (volatile LAS int*)(F.lds + 163840 - 128);
    LDSBAR();
    if (F.tid == 0) *slot = (int)__hip_atomic_fetch_add(head, (unsigned)n, __ATOMIC_RELAXED, __HIP_MEMORY_SCOPE_AGENT);
    LDSBAR();
    return *slot;
}
DI void phase_m0(const Ctx& F, const float* const* in, int only = 0) {
    const int b = F.bid;
    const int nw = F.G > 128 ? F.G - 128 : F.G, w = F.G > 128 ? b - 128 : b;
    { int it = (F.G > 128 && b < 64) ? b : (F.G > 128 ? 64 + w : b); const int step = (F.G > 128 && b < 64) ? (1 << 20) : nw;
      if (!(F.G > 128 && b >= 64 && b < 128) && only != 2)
        for (; it < 64 + 512; it += step) { int s, h, d;
            if (it < 64) { s = 16 + (it >> 5); h = (it >> 1) & 15; d = it & 1; } else { const int k = it - 64; s = k >> 5; h = (k >> 1) & 15; d = k & 1; }
            gdn_scan_item(F, in, s, h, d); } }
    { int it = (F.G > 128 && b >= 64 && b < 128) ? b - 64 : (F.G > 128 ? 64 + w : b); const int step = (F.G > 128 && b >= 64 && b < 128) ? (1 << 20) : nw;
      if (!(F.G > 128 && b < 64) && only != 1)
        for (; it < 64 + 512; it += step) { int s, g, d, hp;
            if (it < 64) { s = 16 + (it >> 5); g = (it >> 2) & 7; d = (it >> 1) & 1; hp = it & 1; } else { const int k = it - 64; s = k >> 5; g = (k >> 2) & 7; d = (k >> 1) & 1; hp = k & 1; }
            ssd_scan_item(F, in, s, g, d, hp); } }
}
DI void phase_m0c(const Ctx& F, const float* const* in) {
    const int gw = F.bid * 8 + F.wave, NGW = F.G * 8, lane = F.lane;
    const bf16* U = (const bf16*)(F.ws + WS_U); bf16* MIX = (bf16*)(F.ws + WS_MIX);
    const bf16 *OFA = (const bf16*)(F.ws + WS_OFA), *OBA = (const bf16*)(F.ws + WS_OBA), *OFB = (const bf16*)(F.ws + WS_OFB), *OBB = (const bf16*)(F.ws + WS_OBB);
    for (int row = gw; row < NROWS; row += NGW) {
        const int len = row < 4096 ? 256 : 4096, t = row < 4096 ? (row & 255) : ((row - 4096) & 4095);
        const bf16* ur = U + (size_t)row * LD_EVEN;
        { const int hsub = lane >> 4, c8 = (lane & 15) * 8;
          const f32x4 gn0 = *(const f32x4*)(in[16] + c8), gn1 = *(const f32x4*)(in[16] + c8 + 4);
          u32x4 af[4], ab[4], az[4];
#pragma unroll
          for (int hq = 0; hq < 4; ++hq) { const size_t o = (size_t)row * 2048 + (hq * 4 + hsub) * 128 + c8;
              af[hq] = *(const u32x4*)(OFA + o); ab[hq] = *(const u32x4*)(OBA + o); az[hq] = *(const u32x4*)(ur + E_ZA + (hq * 4 + hsub) * 128 + c8); }
#pragma unroll
          for (int hq = 0; hq < 4; ++hq) { float x[8], y[8], z[8]; unpack8(af[hq], x); unpack8(ab[hq], y); unpack8(az[hq], z);
              float ss = 0.f;
#pragma unroll
              for (int e = 0; e < 8; ++e) { x[e] += y[e]; ss += x[e] * x[e]; }
              ss += __shfl_xor(ss, 1); ss += __shfl_xor(ss, 2); ss += __shfl_xor(ss, 4); ss += __shfl_xor(ss, 8);
              const float rn = __builtin_amdgcn_rsqf(ss * (1.0f / 128.0f) + EPS);
              u32x4 w; w.x = pk2(x[0] * rn * gn0[0] * siluf_(z[0]), x[1] * rn * gn0[1] * siluf_(z[1])); w.y = pk2(x[2] * rn * gn0[2] * siluf_(z[2]), x[3] * rn * gn0[3] * siluf_(z[3]));
              w.z = pk2(x[4] * rn * gn1[0] * siluf_(z[4]), x[5] * rn * gn1[1] * siluf_(z[5])); w.w = pk2(x[6] * rn * gn1[2] * siluf_(z[6]), x[7] * rn * gn1[3] * siluf_(z[7]));
              *(u32x4*)(MIX + (size_t)row * DM + (hq * 4 + hsub) * 128 + c8) = w; } }
        { const int gsub = lane >> 5, c8 = (lane & 31) * 8;
#pragma unroll 2
          for (int gq = 0; gq < 4; ++gq) { const int ch = (gq * 2 + gsub) * 256 + c8; const size_t o = (size_t)row * 2048 + ch;
              const u32x4 af = *(const u32x4*)(OFB + o), ab = *(const u32x4*)(OBB + o), x0 = *(const u32x4*)(ur + E_XBC + ch), zz = *(const u32x4*)(ur + E_ZB + ch);
              u32x4 xm = {0u, 0u, 0u, 0u}, xp = {0u, 0u, 0u, 0u};
              if (t > 0) xm = *(const u32x4*)(ur - LD_EVEN + E_XBC + ch);
              if (t + 1 < len) xp = *(const u32x4*)(ur + LD_EVEN + E_XBC + ch);
              const float dsk = in[20][ch >> 6];
              float a[8], bq[8], fm[8], f0[8], fp[8], zb[8], y[8]; unpack8(af, a); unpack8(ab, bq); unpack8(xm, fm); unpack8(x0, f0); unpack8(xp, fp); unpack8(zz, zb);
              float ss = 0.f;
#pragma unroll
              for (int e4 = 0; e4 < 2; ++e4) { const f32x4 w0 = *(const f32x4*)(in[17] + ch + 4 * e4), w1 = *(const f32x4*)(in[17] + 4096 + ch + 4 * e4), w2 = *(const f32x4*)(in[17] + 8192 + ch + 4 * e4);
#pragma unroll
                  for (int e = 0; e < 4; ++e) { const int k = 4 * e4 + e; const float xs = w0[e] * fm[k] + w1[e] * f0[k] + w2[e] * fp[k];
                      y[k] = (a[k] + bq[k] + dsk * siluf_(xs)) * siluf_(zb[k]); ss += y[k] * y[k]; } }
              ss += __shfl_xor(ss, 1); ss += __shfl_xor(ss, 2); ss += __shfl_xor(ss, 4); ss += __shfl_xor(ss, 8); ss += __shfl_xor(ss, 16);
              const float rn = __builtin_amdgcn_rsqf(ss * (1.0f / 256.0f) + EPS);
              const f32x4 g0 = *(const f32x4*)(in[21] + ch), g1 = *(const f32x4*)(in[21] + ch + 4);
              u32x4 w; w.x = pk2(y[0] * rn * g0[0], y[1] * rn * g0[1]); w.y = pk2(y[2] * rn * g0[2], y[3] * rn * g0[3]); w.z = pk2(y[4] * rn * g1[0], y[5] * rn * g1[1]); w.w = pk2(y[6] * rn * g1[2], y[7] * rn * g1[3]);
              *(u32x4*)(MIX + (size_t)row * DM + 2048 + ch) = w; } }
    }
}
DI void gla_prep_all(const Ctx& F, const float* const* in) {
    LAS bf16* QS = (LAS bf16*)(F.lds + 0);
    LAS bf16* KS = (LAS bf16*)(F.lds + 17408);
    LAS bf16* KST = (LAS bf16*)(F.lds + 34816);
    LAS bf16* VT = (LAS bf16*)(F.lds + 53248);
    LAS float* GL = (LAS float*)(F.lds + 71680);
    LAS float* PART = GL + 128;
    LAS bf16* RF0 = (LAS bf16*)(F.lds + 74240);
    LAS bf16* RF1 = (LAS bf16*)(F.lds + 91648);
    LAS bf16* RQ = (LAS bf16*)(F.lds + 109056);
    LAS bf16* RV = (LAS bf16*)(F.lds + 126464);
    const bf16* U = (const bf16*)(F.ws + WS_U);
    const int lane_o = F.lane, wave = F.wave;
    const int kch = F.tid & 127, qtr = F.tid >> 7;
    const int er = F.tid >> 3, ep = F.tid & 7;
    u32x4 pr[8];
#define GLA_PRE(it_) do { const bf16* ur_ = U + (size_t)(((it_) >> 4) * 64 + er) * IN_ODD + ((it_) & 15) * 128 + ep * 16; \
        const u32x4* a_ = (const u32x4*)(ur_ + O_Q); const u32x4* b_ = (const u32x4*)(ur_ + O_I); const u32x4* c_ = (const u32x4*)(ur_ + O_F); const u32x4* d_ = (const u32x4*)(ur_ + O_F + 2048); \
        pr[0] = a_[0]; pr[1] = a_[1]; pr[2] = b_[0]; pr[3] = b_[1]; pr[4] = c_[0]; pr[5] = c_[1]; pr[6] = d_[0]; pr[7] = d_[1]; } while (0)
    int it = F.bid;
    if (it < 3072) GLA_PRE(it);
#pragma unroll 1
  for (; it < 3072; it += F.G) {
    const int c64 = it >> 4, h = it & 15, r0 = c64 * 64;
    LDSBAR();
    *(LAS u32x4*)(RQ + er * LDQ + ep * 16) = pr[0]; *(LAS u32x4*)(RQ + er * LDQ + ep * 16 + 8) = pr[1];
    *(LAS u32x4*)(RV + er * LDQ + ep * 16) = pr[2]; *(LAS u32x4*)(RV + er * LDQ + ep * 16 + 8) = pr[3];
    *(LAS u32x4*)(RF0 + er * LDQ + ep * 16) = pr[4]; *(LAS u32x4*)(RF0 + er * LDQ + ep * 16 + 8) = pr[5];
    *(LAS u32x4*)(RF1 + er * LDQ + ep * 16) = pr[6]; *(LAS u32x4*)(RF1 + er * LDQ + ep * 16 + 8) = pr[7];
    if (it + F.G < 3072) GLA_PRE(it + F.G);
    float sq[16];
#pragma unroll 1
    for (int d = 0; d < 2; ++d) {
        const size_t item = ((size_t)c64 * 16 + h) * 2 + d;
        LAS bf16* RF = d ? RF1 : RF0;
        int lane = lane_o; asm volatile("" : "+v"(lane)); const int l15 = lane & 15, q4 = lane >> 4;
        const float lb = 1.0f / (1.0f + expf(in[31][4096 + d * 2048 + h * 128 + kch] - in[31][d * 2048 + h * 128 + kch]));
        LDSBAR();
#ifndef PROBE_GE
#define PROBE_GE 1
#endif
#pragma unroll 1
        for (int rp_ = 0; rp_ < PROBE_GE; ++rp_)
        { const int sqt = d ? 3 - qtr : qtr;
          float pr_[16], kk[16]; float run = 1.f;
#pragma unroll
          for (int ii = 0; ii < 16; ++ii) { const int i = 16 * sqt + ii, tok = d ? 63 - i : i;
              const float fr = bf2f(RF[tok * LDQ + kch]);
              const float f = lb + (1.0f - lb) * sigmoidf_(fr); kk[ii] = 1.0f - f; run *= f; pr_[ii] = run; }
          PART[sqt * 128 + kch] = run;
          if (d == 0) {
#pragma unroll
              for (int ii = 0; ii < 16; ++ii) { const int i = 16 * qtr + ii; sq[ii] = siluf_(bf2f(RQ[i * LDQ + kch])) * 0.08838834764831845f; } }
          LDSBAR();
          float off = 1.f, tot = 1.f;
#pragma unroll
          for (int qq = 0; qq < 4; ++qq) { const float pq = PART[qq * 128 + kch]; if (qq < sqt) off *= pq; tot *= pq; }
          if (qtr == 0) ((float*)(F.ws + WS_LGL))[item * 128 + kch] = __logf(tot);
          unsigned kp[8], vp[8];
          float kvs[16];
          { float inv = __builtin_amdgcn_rcpf(off * pr_[15]);
#pragma unroll
            for (int ii = 15; ii >= 0; --ii) { kvs[ii] = kk[ii] * inv; inv *= 1.0f - kk[ii]; } }
#pragma unroll
          for (int ii = 0; ii < 16; ++ii) { const int i = 16 * sqt + ii, tok = d ? 63 - i : i;
              const float eg = off * pr_[ii];
              const float qv = (d ? sq[15 - ii] : sq[ii]) * eg;
              const float kv = kvs[ii];
              QS[i * LDQ + kch] = f2bf(qv); const bf16 kb = f2bf(kv); KS[i * LDQ + kch] = kb;
              if (ii & 1) kp[ii >> 1] |= (unsigned)kb << 16; else kp[ii >> 1] = kb;
              if (d == 0) { const unsigned vb = RV[tok * LDQ + kch]; if (ii & 1) vp[ii >> 1] |= vb << 16; else vp[ii >> 1] = vb; } }
          *(LAS u32x4*)(KST + kch * LDT + 16 * sqt) = (u32x4){kp[0], kp[1], kp[2], kp[3]}; *(LAS u32x4*)(KST + kch * LDT + 16 * sqt + 8) = (u32x4){kp[4], kp[5], kp[6], kp[7]};
          if (d == 0) { *(LAS u32x4*)(VT + kch * LDT + 16 * qtr) = (u32x4){vp[0], vp[1], vp[2], vp[3]}; *(LAS u32x4*)(VT + kch * LDT + 16 * qtr + 8) = (u32x4){vp[4], vp[5], vp[6], vp[7]}; } }
        LDSBAR();
#ifndef PROBE_GA
#define PROBE_GA 1
#endif
#pragma unroll 1
        for (int rq_ = 0; rq_ < PROBE_GA; ++rq_) {
#pragma unroll
        for (int tt = 0; tt < 2; ++tt) { const int id = 2 * wave + tt, ti = id >> 2, tj = id & 3;
            f32x4 a = {0.f, 0.f, 0.f, 0.f};
#pragma unroll
            for (int ks = 0; ks < 4; ++ks) a = MFMA16(frag_nat(KS, LDQ, tj * 16, ks * 32, lane), frag_nat(QS, LDQ, ti * 16, ks * 32, lane), a);
            const int i = ti * 16 + l15; float pv[4];
#pragma unroll
            for (int r = 0; r < 4; ++r) { const int j = tj * 16 + 4 * q4 + r; pv[r] = (i >= j) ? a[r] : 0.f; }
            u32x2 w2; w2.x = pk2(pv[0], pv[1]); w2.y = pk2(pv[2], pv[3]);
            *(u32x2*)((bf16*)(F.ws + WS_LAT) + (item * 64 + i) * 64 + tj * 16 + 4 * q4) = w2; }
        { bf16* qg = (bf16*)(F.ws + WS_LQS) + item * 8192; bf16* kg = (bf16*)(F.ws + WS_LKS) + item * 8192;
#pragma unroll
          for (int k = 0; k < 2; ++k) { const int e = F.tid + 512 * k;
              { const int row = e >> 4, pc = e & 15; *(u32x4*)(qg + row * 128 + pc * 8) = *(const LAS u32x4*)(QS + row * LDQ + pc * 8); }
              { const int row = e >> 3, pc = e & 7; *(u32x4*)(kg + row * 64 + pc * 8) = *(const LAS u32x4*)(KST + row * LDT + pc * 8);
                if (d == 0) *(u32x4*)((bf16*)(F.ws + WS_LVT) + ((size_t)h * 128 + row) * NROWS + r0 + pc * 8) = *(const LAS u32x4*)(VT + row * LDT + pc * 8); } } }
        }
    }
  }
#undef GLA_PRE
}

#define GLA_SETB 64000
DI void gla_scan_step(const Ctx& F, f32x4 (&S)[2][8], int set, int ci, int d, int len, int row0, int h, bf16* OUT) {
    const int wave = F.wave;
    int lane = F.lane; asm volatile("" : "+v"(lane)); const int l15 = lane & 15, q4 = lane >> 4;
    LAS unsigned char* base = F.lds + set * GLA_SETB;
    LAS bf16* QS = (LAS bf16*)base; LAS bf16* KST = (LAS bf16*)(base + 17408); LAS bf16* ATT = (LAS bf16*)(base + 35840); LAS bf16* VT = (LAS bf16*)(base + 45056); LAS float* GL = (LAS float*)(base + 63488);
#define LQ(dst, it) do { _Pragma("unroll") for (int i_ = 0; i_ < 4; ++i_) dst[i_] = frag_perm(QS, LDQ, (it) * 16, i_ * 32, lane); SCHED_FENCE(); } while (0)
#define LT(dst, M, t0) do { _Pragma("unroll") for (int i_ = 0; i_ < 4; ++i_) dst[i_] = frag_nat(M, LDT, ((t0) + (i_ >> 1)) * 16, (i_ & 1) * 32, lane); SCHED_FENCE(); } while (0)
#define CO(X, j) do { _Pragma("unroll") for (int ks = 0; ks < 4; ++ks) { o[0][j] = MFMA16(Sp[0][ks], X[ks], o[0][j]); o[1][j] = MFMA16(Sp[1][ks], X[ks], o[1][j]); } SCHED_FENCE(); } while (0)
#define CA(X, it0) do { _Pragma("unroll") for (int ks = 0; ks < 2; ++ks) _Pragma("unroll") for (int j = 0; j < 2; ++j) { o[0][j] = MFMA16(VF[0][ks], X[j * 2 + ks], o[0][j]); o[1][j] = MFMA16(VF[1][ks], X[j * 2 + ks], o[1][j]); } \
        _Pragma("unroll") for (int j = 0; j < 2; ++j) { const int i = ((it0) + j) * 16 + l15; const int tl = ci * 64 + i, t = d ? (len - 1 - tl) : tl; bf16* op = OUT + (size_t)(row0 + t) * 2048 + h * 128 + 32 * wave + 4 * q4; \
            u32x2 w2; w2.x = pk2(o[0][j][0], o[0][j][1]); w2.y = pk2(o[0][j][2], o[0][j][3]); *(u32x2*)op = w2; w2.x = pk2(o[1][j][0], o[1][j][1]); w2.y = pk2(o[1][j][2], o[1][j][3]); *(u32x2*)(op + 16) = w2; \
            o[0][j] = (f32x4){0.f, 0.f, 0.f, 0.f}; o[1][j] = (f32x4){0.f, 0.f, 0.f, 0.f}; } SCHED_FENCE(); } while (0)
#define CS(X, t0) do { _Pragma("unroll") for (int ks = 0; ks < 2; ++ks) _Pragma("unroll") for (int j = 0; j < 2; ++j) { S[0][(t0) + j] = MFMA16(X[j * 2 + ks], VF[0][ks], S[0][(t0) + j]); S[1][(t0) + j] = MFMA16(X[j * 2 + ks], VF[1][ks], S[1][(t0) + j]); } SCHED_FENCE(); } while (0)
    bf16x8 X0[4], X1[4], X2[4];
    bf16x8 VF[2][2];
#pragma unroll
    for (int x = 0; x < 2; ++x)
#pragma unroll
        for (int ks = 0; ks < 2; ++ks) VF[x][ks] = frag_nat(VT, LDT, 16 * (2 * wave + x), ks * 32, lane);
    LQ(X0, 0); LQ(X1, 1);
    bf16x8 Sp[2][4];
#pragma unroll
    for (int x = 0; x < 2; ++x)
#pragma unroll
        for (int ks = 0; ks < 4; ++ks) Sp[x][ks] = pack2(S[x][2 * ks], S[x][2 * ks + 1]);
    f32x4 o[2][2];
#pragma unroll
    for (int x = 0; x < 2; ++x)
#pragma unroll
        for (int j = 0; j < 2; ++j) o[x][j] = (f32x4){0.f, 0.f, 0.f, 0.f};
    SCHED_FENCE();
    LT(X2, ATT, 0); CO(X0, 0);
    LQ(X0, 2); CO(X1, 1);
    LQ(X1, 3); CA(X2, 0);
    LT(X2, ATT, 2); CO(X0, 0);
    LT(X0, KST, 0); CO(X1, 1);
    LT(X1, KST, 2); CA(X2, 2);
    LT(X2, KST, 4); CS(X0, 0);
    LT(X0, KST, 6); CS(X1, 2);
    CS(X2, 4); CS(X0, 6);
#pragma unroll
    for (int t = 0; t < 8; ++t) { const f32x4 gl = *(const LAS f32x4*)(GL + 16 * t + 4 * q4);
#pragma unroll
        for (int r = 0; r < 4; ++r) { const float eg = __expf(gl[r]); S[0][t][r] *= eg; S[1][t][r] *= eg; } }
#undef LQ
#undef LT
#undef CO
#undef CA
#undef CS
}
DI void gla_scan_item(const Ctx& F, const float* const* in, int s, int h, int d) {
    constexpr int SETB = GLA_SETB;
    const int row0 = seq_row0(s), len = seq_len(s), nch = len >> 6, c640 = row0 >> 6;
    const int lane_o = F.lane, wave = F.wave;
    bf16* OUT = (bf16*)(F.ws + (d ? WS_OBA : WS_OFA));
    const bf16* LQS = (const bf16*)(F.ws + WS_LQS); const bf16* LKS = (const bf16*)(F.ws + WS_LKS); const bf16* LAT = (const bf16*)(F.ws + WS_LAT);
    const bf16* LVT = (const bf16*)(F.ws + WS_LVT) + (size_t)h * 128 * NROWS; const float* LGL = (const float*)(F.ws + WS_LGL);
    LDSBAR();
    if (wave >= 4) {
        struct Pre { u32x4 q[4], k[4], a[2], v[4]; float g; };
        Pre PA, PB_;
        const int e = F.tid - 256, er = e >> 2, eq = e & 3;
#define REV8(w_) ((u32x4){((w_).w >> 16) | ((w_).w << 16), ((w_).z >> 16) | ((w_).z << 16), ((w_).y >> 16) | ((w_).y << 16), ((w_).x >> 16) | ((w_).x << 16)})
#define GLA_ISSUE(ci_, P_) do { const int cc = c640 + (d ? nch - 1 - (ci_) : (ci_)); const size_t item = ((size_t)cc * 16 + h) * 2 + d; \
        const u32x4* qsrc = (const u32x4*)(LQS + item * 8192 + er * 128 + eq * 32); _Pragma("unroll") for (int m_ = 0; m_ < 4; ++m_) P_.q[m_] = qsrc[m_]; \
        const u32x4* k0src = (const u32x4*)(LKS + item * 8192 + er * 64 + eq * 16); const u32x4* k1src = (const u32x4*)(LKS + item * 8192 + (64 + er) * 64 + eq * 16); \
        P_.k[0] = k0src[0]; P_.k[1] = k0src[1]; P_.k[2] = k1src[0]; P_.k[3] = k1src[1]; \
        const u32x4* asrc = (const u32x4*)(LAT + item * 4096 + er * 64 + eq * 16); P_.a[0] = asrc[0]; P_.a[1] = asrc[1]; \
        const u32x4* v0src = (const u32x4*)(LVT + (size_t)er * NROWS + cc * 64 + eq * 16); const u32x4* v1src = (const u32x4*)(LVT + (size_t)(64 + er) * NROWS + cc * 64 + eq * 16); \
        P_.v[0] = v0src[0]; P_.v[1] = v0src[1]; P_.v[2] = v1src[0]; P_.v[3] = v1src[1]; \
        P_.g = 0.f; if (e < 128) P_.g = LGL[item * 128 + e]; } while (0)
#define GLA_COMMIT(set_, P_) do { LAS unsigned char* base = F.lds + (set_) * SETB; \
        _Pragma("unroll") for (int m_ = 0; m_ < 4; ++m_) *(LAS u32x4*)((LAS bf16*)base + er * LDQ + eq * 32 + m_ * 8) = P_.q[m_]; \
        *(LAS u32x4*)((LAS bf16*)(base + 17408) + er * LDT + eq * 16) = P_.k[0]; *(LAS u32x4*)((LAS bf16*)(base + 17408) + er * LDT + eq * 16 + 8) = P_.k[1]; \
        *(LAS u32x4*)((LAS bf16*)(base + 17408) + (64 + er) * LDT + eq * 16) = P_.k[2]; *(LAS u32x4*)((LAS bf16*)(base + 17408) + (64 + er) * LDT + eq * 16 + 8) = P_.k[3]; \
        *(LAS u32x4*)((LAS bf16*)(base + 35840) + er * LDT + eq * 16) = P_.a[0]; *(LAS u32x4*)((LAS bf16*)(base + 35840) + er * LDT + eq * 16 + 8) = P_.a[1]; \
        if (d == 0) { *(LAS u32x4*)((LAS bf16*)(base + 45056) + er * LDT + eq * 16) = P_.v[0]; *(LAS u32x4*)((LAS bf16*)(base + 45056) + er * LDT + eq * 16 + 8) = P_.v[1]; \
            *(LAS u32x4*)((LAS bf16*)(base + 45056) + (64 + er) * LDT + eq * 16) = P_.v[2]; *(LAS u32x4*)((LAS bf16*)(base + 45056) + (64 + er) * LDT + eq * 16 + 8) = P_.v[3]; } \
        else { *(LAS u32x4*)((LAS bf16*)(base + 45056) + er * LDT + (3 - eq) * 16 + 8) = REV8(P_.v[0]); *(LAS u32x4*)((LAS bf16*)(base + 45056) + er * LDT + (3 - eq) * 16) = REV8(P_.v[1]); \
            *(LAS u32x4*)((LAS bf16*)(base + 45056) + (64 + er) * LDT + (3 - eq) * 16 + 8) = REV8(P_.v[2]); *(LAS u32x4*)((LAS bf16*)(base + 45056) + (64 + er) * LDT + (3 - eq) * 16) = REV8(P_.v[3]); } \
        if (e < 128) ((LAS float*)(base + 63488))[e] = P_.g; } while (0)
        GLA_ISSUE(0, PA); GLA_ISSUE(1, PB_);
#pragma unroll 1
        for (int ci = 0; ci < nch; ci += 2) {
            GLA_COMMIT(0, PA); LDSBAR(); if (ci + 2 < nch) GLA_ISSUE(ci + 2, PA);
            GLA_COMMIT(1, PB_); LDSBAR(); if (ci + 3 < nch) GLA_ISSUE(ci + 3, PB_); }
#undef GLA_ISSUE
#undef GLA_COMMIT
#undef REV8
    } else {
        f32x4 S[2][8];
        if (s >= 16) { int ln = lane_o; asm volatile("" : "+v"(ln)); const int l15 = ln & 15, q4 = ln >> 4; const float* sp = in[4] + ((size_t)((s - 16) * 2 + d) * 16 + h) * 16384;
#pragma unroll
            for (int x = 0; x < 2; ++x)
#pragma unroll
                for (int t = 0; t < 8; ++t)
#pragma unroll
                    for (int r = 0; r < 4; ++r) S[x][t][r] = sp[(size_t)(16 * t + 4 * q4 + r) * 128 + 32 * wave + 16 * x + l15];
        } else {
#pragma unroll
            for (int x = 0; x < 2; ++x)
#pragma unroll
                for (int t = 0; t < 8; ++t) S[x][t] = (f32x4){0.f, 0.f, 0.f, 0.f}; }
#pragma unroll 1
        for (int ci = 0; ci < nch; ci += 2) { LDSBAR(); gla_scan_step(F, S, 0, ci, d, len, row0, h, OUT); LDSBAR(); gla_scan_step(F, S, 1, ci + 1, d, len, row0, h, OUT); }
        if (s < 16) { int ln = lane_o; asm volatile("" : "+v"(ln)); const int l15 = ln & 15, q4 = ln >> 4; float* sp = F.out + OUT_SH + ((size_t)(s * 2 + d) * 16 + h) * 16384;
#pragma unroll
            for (int x = 0; x < 2; ++x)
#pragma unroll
                for (int t = 0; t < 8; ++t)
#pragma unroll
                    for (int r = 0; r < 4; ++r) sp[(size_t)(16 * t + 4 * q4 + r) * 128 + 32 * wave + 16 * x + l15] = S[x][t][r]; }
    }
}

struct M1aRaw { u32x4 a[2], b[2], m[2], p[2]; };
DI void m1a_load(const Ctx& F, int item, M1aRaw& R) {
    const int tt = item >> 5, cb = item & 31, r0 = tt * 64, c0 = cb * 256;
    const bf16* U = (const bf16*)(F.ws + WS_U);
    const int cg = F.lane & 31;
    const int len = r0 < 4096 ? 256 : 4096, tbase = r0 < 4096 ? (r0 & 255) : ((r0 - 4096) & 4095);
    const int col = c0 + cg * 8;
#pragma unroll
    for (int itk = 0; itk < 2; ++itk) { const int tp = itk * 16 + F.wave * 2 + (F.lane >> 5);
        const int tl = 2 * tp, t = tbase + tl; const bf16* ur = U + (size_t)(r0 + tl) * IN_ODD + col;
        R.a[itk] = *(const u32x4*)ur; R.b[itk] = *(const u32x4*)(ur + IN_ODD);
        R.m[itk] = (u32x4){0u, 0u, 0u, 0u}; R.p[itk] = (u32x4){0u, 0u, 0u, 0u};
        if (col < 6144) { if (t > 0) R.m[itk] = *(const u32x4*)(ur - IN_ODD); if (t + 2 < len) R.p[itk] = *(const u32x4*)(ur + 2 * IN_ODD); } }
}
DI void m1a_item(const Ctx& F, const float* const* in, int item, M1aRaw& R, int next_item) {
    LAS unsigned* T = (LAS unsigned*)F.lds;
    const int tt = item >> 5, cb = item & 31, r0 = tt * 64, c0 = cb * 256;
    bf16* TB = (bf16*)(F.ws + WS_TB);
    const int cg = F.lane & 31;
    const int col = c0 + cg * 8;
#pragma unroll
    for (int itk = 0; itk < 2; ++itk) { const int tp = itk * 16 + F.wave * 2 + (F.lane >> 5);
        float xa[8], xb[8], oa[8], ob[8]; unpack8(R.a[itk], xa); unpack8(R.b[itk], xb);
        if (col < 6144) { float xm[8], xp[8]; unpack8(R.m[itk], xm); unpack8(R.p[itk], xp);
            const float* cw = in[23] + col;
#pragma unroll
            for (int e = 0; e < 8; ++e) { oa[e] = cw[e] * xm[e] + cw[6144 + e] * xa[e] + cw[12288 + e] * xb[e]; ob[e] = cw[e] * xa[e] + cw[6144 + e] * xb[e] + cw[12288 + e] * xp[e]; }
        } else {
#pragma unroll
            for (int e = 0; e < 8; ++e) { oa[e] = siluf_(xa[e]); ob[e] = siluf_(xb[e]); } }
#pragma unroll
        for (int e = 0; e < 8; ++e) T[(e * 32 + cg) * 33 + tp] = pk2(oa[e], ob[e]); }
    if (next_item >= 0) m1a_load(F, next_item, R);
    LDSBAR();
#pragma unroll
    for (int k = 0; k < 4; ++k) { const int e = F.tid + 512 * k, part = e & 7, chi = e >> 3;
        const int ch = (chi & 31) * 8 + (chi >> 5);
        const LAS unsigned* sp = T + chi * 33 + part * 4;
        u32x4 w; w.x = sp[0]; w.y = sp[1]; w.z = sp[2]; w.w = sp[3];
        *(u32x4*)(TB + (size_t)(c0 + ch) * NROWS + r0 + part * 8) = w; }
    LDSBAR();
}

DI f32x2 w16(int k) {
    switch (k & 7) {
        case 0: return (f32x2){1.0f, 0.0f};
        case 1: return (f32x2){0.9238795325112867f, -0.3826834323650898f};
        case 2: return (f32x2){0.7071067811865476f, -0.7071067811865476f};
        case 3: return (f32x2){0.3826834323650898f, -0.9238795325112867f};
        case 4: return (f32x2){0.0f, -1.0f};
        case 5: return (f32x2){-0.3826834323650898f, -0.9238795325112867f};
        case 6: return (f32x2){-0.7071067811865476f, -0.7071067811865476f};
        default: return (f32x2){-0.9238795325112867f, -0.3826834323650898f};
    }
}
DI f32x2 cmul(f32x2 a, f32x2 b) { return (f32x2){a[0] * b[0] - a[1] * b[1], a[0] * b[1] + a[1] * b[0]}; }
DI f32x2 cmulc(f32x2 a, f32x2 b) { return (f32x2){a[0] * b[0] + a[1] * b[1], a[1] * b[0] - a[0] * b[1]}; }
template <int LOGR, bool INV, bool UNIT = false> DI void fft_bfly(f32x2 (&x)[1 << LOGR], f32x2 w0) {
    constexpr int R = 1 << LOGR;
    f32x2 wj[LOGR];
    wj[0] = w0;
#pragma unroll
    for (int s = 1; s < LOGR; ++s) wj[s] = cmul(wj[s - 1], wj[s - 1]);
#pragma unroll
    for (int ss = 0; ss < LOGR; ++ss) { const int s = INV ? (LOGR - 1 - ss) : ss; const int hm = R >> (s + 1);
#pragma unroll
        for (int m = 0; m < R; ++m) { if (m & hm) continue; const int mm = m % hm;
            const int k16 = mm * (16 >> (LOGR - s));
            if (UNIT && k16 == 0) { const f32x2 a = x[m], b = x[m + hm]; x[m] = a + b; x[m + hm] = a - b; continue; }
            if (UNIT && k16 == 4) {
                if (!INV) { const f32x2 a = x[m], b = x[m + hm], d = a - b; x[m] = a + b; x[m + hm] = (f32x2){d[1], -d[0]}; }
                else { const f32x2 a = x[m], bb = x[m + hm], b = (f32x2){-bb[1], bb[0]}; x[m] = a + b; x[m + hm] = a - b; }
                continue; }
            f32x2 w;
            if (UNIT) w = w16(k16);
            else if (k16 == 0) w = wj[s];
            else if (k16 == 4) w = (f32x2){wj[s][1], -wj[s][0]};
            else w = cmul(wj[s], w16(k16));
            if (!INV) { const f32x2 a = x[m], b = x[m + hm]; x[m] = a + b; x[m + hm] = cmul(a - b, w); }
            else { const f32x2 a = x[m], b = cmulc(x[m + hm], w); x[m] = a + b; x[m + hm] = a - b; } } }
}
template <int LOGR, bool INV, int PADSH> DI void fft_group(LAS f32x2* buf, const LAS f32x2* TW, int B, int tws, int g) {
    constexpr int R = 1 << LOGR;
    const int stride = B >> LOGR, blk = g / stride, j = g - blk * stride;
    const int base = blk * B + j;
    LAS f32x2* p = buf + base + (base >> PADSH);
    const int pstride = stride >= (1 << PADSH) ? stride + (stride >> PADSH) : stride;
    f32x2 x[R];
#pragma unroll
    for (int m = 0; m < R; ++m) x[m] = p[m * pstride];
    fft_bfly<LOGR, INV>(x, TW[j * tws]);
#pragma unroll
    for (int m = 0; m < R; ++m) p[m * pstride] = x[m];
}
template <int LOGR, bool INV, int PADSH> DI void fft_group2(LAS f32x2* buf, const LAS f32x2* TW, int B, int tws, int g0, int g1) {
    constexpr int R = 1 << LOGR;
    const int stride = B >> LOGR, pstride = stride >= (1 << PADSH) ? stride + (stride >> PADSH) : stride;
    const int blk0 = g0 / stride, j0 = g0 - blk0 * stride, base0 = blk0 * B + j0;
    const int blk1 = g1 / stride, j1 = g1 - blk1 * stride, base1 = blk1 * B + j1;
    LAS f32x2* p0 = buf + base0 + (base0 >> PADSH); LAS f32x2* p1 = buf + base1 + (base1 >> PADSH);
    f32x2 xa[R], xb[R];
#pragma unroll
    for (int m = 0; m < R; ++m) xa[m] = p0[m * pstride];
#pragma unroll
    for (int m = 0; m < R; ++m) xb[m] = p1[m * pstride];
    const f32x2 wa = TW[j0 * tws], wb = TW[j1 * tws];
    SCHED_FENCE();
    fft_bfly<LOGR, INV>(xa, wa);
#pragma unroll
    for (int m = 0; m < R; ++m) p0[m * pstride] = xa[m];
    fft_bfly<LOGR, INV>(xb, wb);
#pragma unroll
    for (int m = 0; m < R; ++m) p1[m * pstride] = xb[m];
}
template <int PADSH> DI void fft_first8(LAS f32x2* buf, f32x2 w0, int N, int j, f32x2 i0, f32x2 i1, f32x2 i2, f32x2 i3) {
    const int stride = N >> 3, pstride = stride + (stride >> PADSH);
    f32x2 x[8] = {i0, i1, i2, i3, (f32x2){0.f, 0.f}, (f32x2){0.f, 0.f}, (f32x2){0.f, 0.f}, (f32x2){0.f, 0.f}};
    fft_bfly<3, false>(x, w0);
    LAS f32x2* p = buf + j + (j >> PADSH);
#pragma unroll
    for (int m = 0; m < 8; ++m) p[m * pstride] = x[m];
}
template <int PADSH> DI void fft_last8(const LAS f32x2* buf, f32x2 w0, int N, int j, f32x2& o0, f32x2& o1, f32x2& o2, f32x2& o3) {
    const int stride = N >> 3, pstride = stride + (stride >> PADSH);
    const LAS f32x2* p = buf + j + (j >> PADSH);
    f32x2 x[8];
#pragma unroll
    for (int m = 0; m < 8; ++m) x[m] = p[m * pstride];
    fft_bfly<3, true>(x, w0);
    o0 = x[0]; o1 = x[1]; o2 = x[2]; o3 = x[3];
}
#define PD4(i_) ((i_) + ((i_) >> 4))
#define PD3(i_) ((i_) + ((i_) >> 3))
template <bool INV> DI void fft8192(LAS f32x2* buf, const LAS f32x2* TW, int tid) {
    if (!INV) {
        fft_group2<3, false, 4>(buf, TW, 8192, 1, tid, tid + 512); LDSBAR();
        fft_group2<3, false, 4>(buf, TW, 1024, 8, tid, tid + 512); LDSBAR();
        fft_group2<3, false, 4>(buf, TW, 128, 64, tid, tid + 512); LDSBAR();
        fft_group<4, false, 4>(buf, TW, 16, 0, tid); LDSBAR();
    } else {
        fft_group<4, true, 4>(buf, TW, 16, 0, tid); LDSBAR();
        fft_group2<3, true, 4>(buf, TW, 128, 64, tid, tid + 512); LDSBAR();
        fft_group2<3, true, 4>(buf, TW, 1024, 8, tid, tid + 512); LDSBAR();
        fft_group2<3, true, 4>(buf, TW, 8192, 1, tid, tid + 512); LDSBAR();
    }
}
#define WSYNC() asm volatile("s_waitcnt lgkmcnt(0)" ::: "memory")
template <bool INV> DI void fft512(LAS f32x2* buf, const LAS f32x2* TW, int lane) {
    if (!INV) { fft_group<3, false, 3>(buf, TW, 512, 16, lane); WSYNC(); fft_group<3, false, 3>(buf, TW, 64, 128, lane); WSYNC(); fft_group<3, false, 3>(buf, TW, 8, 0, lane); WSYNC(); }
    else { fft_group<3, true, 3>(buf, TW, 8, 0, lane); WSYNC(); fft_group<3, true, 3>(buf, TW, 64, 128, lane); WSYNC(); fft_group<3, true, 3>(buf, TW, 512, 16, lane); WSYNC(); }
}
constexpr int LDS_TW = 139264;
DI void fft_table_init(const Ctx& F) { LAS f32x2* TW = (LAS f32x2*)(F.lds + LDS_TW);
    for (int j = F.tid; j < 1024; j += 512) { float sn, cs; sincospif(-2.0f * (float)j / 8192.0f, &sn, &cs); TW[j] = (f32x2){cs, sn}; }
    LDSBAR(); }
DI f32x2 filt_spec(f32x2 z1, f32x2 z2, int ord) { const float sg = ord ? -0.5f : 0.5f; const float ar = 0.5f * z1[0] + sg * z2[0], ai = 0.5f * z1[1] - sg * z2[1];
    return ord ? (f32x2){ai, -ar} : (f32x2){ar, ai}; }

template <int LOGR, int PADSH, int LOGN> DI void fft_mid(LAS f32x2* D, const LAS f32x2* HZ, int ord, int g) {
    constexpr int R = 1 << LOGR, N = 1 << LOGN;
    LAS f32x2* p = D + g * R + ((g * R) >> PADSH);
    f32x2 x[R];
#pragma unroll
    for (int m = 0; m < R; ++m) x[m] = p[m];
    fft_bfly<LOGR, false, true>(x, (f32x2){1.f, 0.f});
#pragma unroll
    for (int m = 0; m < R; ++m) { const int t = g * R + m; const int fq = (int)(__brev((unsigned)t) >> (32 - LOGN)), t2 = (int)(__brev((unsigned)((N - fq) & (N - 1))) >> (32 - LOGN));
        x[m] = cmul(x[m], filt_spec(HZ[t + (t >> PADSH)], HZ[t2 + (t2 >> PADSH)], ord)) * (1.0f / (float)N); }
    fft_bfly<LOGR, true, true>(x, (f32x2){1.f, 0.f});
#pragma unroll
    for (int m = 0; m < R; ++m) p[m] = x[m];
}
DI void hyena_dec_item(const Ctx& F, const float* const* in, int c) {
    LAS f32x2* HB = (LAS f32x2*)F.lds;
    LAS f32x2* DB = HB + 8704;
    const LAS f32x2* TW = (const LAS f32x2*)(F.lds + LDS_TW);
    const bf16* TB = (const bf16*)(F.ws + WS_TB); bf16* YT = (bf16*)(F.ws + WS_YT);
    const float* HF = (const float*)(F.ws + WS_HF4096); const float* HN = (const float*)(F.ws + WS_HNRM) + 4096;
    const int tid_o = F.tid;
    float va[8], vb[8];
#pragma unroll
    for (int k = 0; k < 8; ++k) { const int t = tid_o + 512 * k; va[k] = bf2f(TB[(size_t)c * NROWS + 4096 + t]); vb[k] = bf2f(TB[(size_t)c * NROWS + 8192 + t]); }
    { const float n0 = HN[c], n1 = HN[2048 + c]; const float* h0 = HF + (size_t)c * 8192; const float* h1 = HF + ((size_t)2048 + c) * 8192;
#pragma unroll 8
      for (int k = 0; k < 16; ++k) { const int t = tid_o + 512 * k; HB[PD4(t)] = (f32x2){h0[t] * n0, h1[t] * n1}; } }
    LDSBAR();
    fft8192<false>(HB, TW, tid_o);
#pragma unroll 1
    for (int ord = 0; ord < 2; ++ord) {
        int tid = tid_o; asm volatile("" : "+v"(tid));
        const size_t xoff = (size_t)((ord + 1) * 2048 + c) * NROWS, zoff = (size_t)(6144 + c) * NROWS;
        bf16 rxa[8], rxb[8], rza[8], rzb[8];
#pragma unroll
        for (int k = 0; k < 8; ++k) { const int t = tid + 512 * k; rxa[k] = TB[xoff + 4096 + t]; rxb[k] = TB[xoff + 8192 + t];
            if (ord == 1) { rza[k] = TB[zoff + 4096 + t]; rzb[k] = TB[zoff + 8192 + t]; } else { rza[k] = 0; rzb[k] = 0; } }
        fft_first8<4>(DB, TW[tid], 8192, tid, (f32x2){va[0], vb[0]}, (f32x2){va[2], vb[2]}, (f32x2){va[4], vb[4]}, (f32x2){va[6], vb[6]});
        fft_first8<4>(DB, TW[tid + 512], 8192, tid + 512, (f32x2){va[1], vb[1]}, (f32x2){va[3], vb[3]}, (f32x2){va[5], vb[5]}, (f32x2){va[7], vb[7]});
        LDSBAR();
        fft_group2<3, false, 4>(DB, TW, 1024, 8, tid, tid + 512); LDSBAR();
        fft_group2<3, false, 4>(DB, TW, 128, 64, tid, tid + 512); LDSBAR();
        fft_mid<4, 4, 13>(DB, HB, ord, tid); LDSBAR();
        fft_group2<3, true, 4>(DB, TW, 128, 64, tid, tid + 512); LDSBAR();
        fft_group2<3, true, 4>(DB, TW, 1024, 8, tid, tid + 512); LDSBAR();
        f32x2 y[8];
        fft_last8<4>(DB, TW[tid], 8192, tid, y[0], y[2], y[4], y[6]);
        fft_last8<4>(DB, TW[tid + 512], 8192, tid + 512, y[1], y[3], y[5], y[7]);
        const float bias = in[30][ord * 2048 + c];
#pragma unroll
        for (int k = 0; k < 8; ++k) { const int t = tid + 512 * k;
            va[k] = bf2f(rxa[k]) * (y[k][0] + bias * va[k]); vb[k] = bf2f(rxb[k]) * (y[k][1] + bias * vb[k]);
            if (ord == 1) { YT[(size_t)c * NROWS + 4096 + t] = f2bf(va[k] * bf2f(rza[k])); YT[(size_t)c * NROWS + 8192 + t] = f2bf(vb[k] * bf2f(rzb[k])); } }
    }
    LDSBAR();
}
DI void hyena_ctx_item(const Ctx& F, const float* const* in, int c, int p0) {
    LAS f32x2* HZ = (LAS f32x2*)F.lds + F.wave * 1152;
    LAS f32x2* D = HZ + 576;
    const LAS f32x2* TW = (const LAS f32x2*)(F.lds + LDS_TW);
    const bf16* TB = (const bf16*)(F.ws + WS_TB); bf16* YT = (bf16*)(F.ws + WS_YT);
    const float* HF = (const float*)(F.ws + WS_HF256); const float* HN = (const float*)(F.ws + WS_HNRM);
    const int lane = F.lane;
    bf16 nva[4], nvb[4];
#pragma unroll
    for (int k = 0; k < 4; ++k) { const int t = lane + 64 * k; nva[k] = TB[(size_t)c * NROWS + (2 * p0) * 256 + t]; nvb[k] = TB[(size_t)c * NROWS + (2 * p0 + 1) * 256 + t]; }
    { const float n0 = HN[c], n1 = HN[2048 + c]; const float* h0 = HF + (size_t)c * 512; const float* h1 = HF + ((size_t)2048 + c) * 512;
#pragma unroll
      for (int k = 0; k < 8; ++k) { const int t = lane + 64 * k; HZ[PD3(t)] = (f32x2){h0[t] * n0, h1[t] * n1}; } }
    WSYNC();
    fft512<false>(HZ, TW, lane);
#pragma unroll 1
    for (int pp = p0; pp < p0 + 4; ++pp) { const int ra = (2 * pp) * 256, rb = (2 * pp + 1) * 256;
    float va[4], vb[4];
#pragma unroll
    for (int k = 0; k < 4; ++k) { va[k] = bf2f(nva[k]); vb[k] = bf2f(nvb[k]); }
    if (pp + 1 < p0 + 4) {
#pragma unroll
        for (int k = 0; k < 4; ++k) { const int t = lane + 64 * k; nva[k] = TB[(size_t)c * NROWS + (2 * pp + 2) * 256 + t]; nvb[k] = TB[(size_t)c * NROWS + (2 * pp + 3) * 256 + t]; } }
#pragma unroll 1
    for (int ord = 0; ord < 2; ++ord) {
        const size_t xoff = (size_t)((ord + 1) * 2048 + c) * NROWS, zoff = (size_t)(6144 + c) * NROWS;
        bf16 rxa[4], rxb[4], rza[4], rzb[4];
#pragma unroll
        for (int k = 0; k < 4; ++k) { const int t = lane + 64 * k; rxa[k] = TB[xoff + ra + t]; rxb[k] = TB[xoff + rb + t];
            if (ord == 1) { rza[k] = TB[zoff + ra + t]; rzb[k] = TB[zoff + rb + t]; } else { rza[k] = 0; rzb[k] = 0; } }
        fft_first8<3>(D, TW[lane * 16], 512, lane, (f32x2){va[0], vb[0]}, (f32x2){va[1], vb[1]}, (f32x2){va[2], vb[2]}, (f32x2){va[3], vb[3]}); WSYNC();
        fft_group<3, false, 3>(D, TW, 64, 128, lane); WSYNC();
        fft_mid<3, 3, 9>(D, HZ, ord, lane); WSYNC();
        fft_group<3, true, 3>(D, TW, 64, 128, lane); WSYNC();
        f32x2 y[4];
        fft_last8<3>(D, TW[lane * 16], 512, lane, y[0], y[1], y[2], y[3]);
        const float bias = in[30][ord * 2048 + c];
#pragma unroll
        for (int k = 0; k < 4; ++k) { const int t = lane + 64 * k;
            va[k] = bf2f(rxa[k]) * (y[k][0] + bias * va[k]); vb[k] = bf2f(rxb[k]) * (y[k][1] + bias * vb[k]);
            if (ord == 1) { YT[(size_t)c * NROWS + ra + t] = f2bf(va[k] * bf2f(rza[k])); YT[(size_t)c * NROWS + rb + t] = f2bf(vb[k] * bf2f(rzb[k])); } }
        WSYNC();
    }
    }
}
DI void phase_m1a(const Ctx& F, const float* const* in) {
    { M1aRaw R; int it = F.bid; if (it < 192 * 32) m1a_load(F, it, R);
#pragma unroll 1
      for (; it < 192 * 32; it += F.G) m1a_item(F, in, it, R, it + F.G < 192 * 32 ? it + F.G : -1); }
    gla_prep_all(F, in);
}
DI void phase_m1b(const Ctx& F, const float* const* in, int pass = 0) {
    const int b = F.bid; unsigned* ctl = (unsigned*)(F.ws + WS_CTL) + pass * 1024;
    fft_table_init(F);
#ifndef P11_ONLY
#define P11_ONLY 0
#endif
    const int only = pass ? P11_ONLY : 0;
    if (b < 64 && (only == 0 || only == 1)) gla_scan_item(F, in, 16 + (b >> 5), (b >> 1) & 15, b & 1);
    if (only == 0 || only == 2) for (;;) { const int it = queue_grab(F, ctl + CW_Q0, 1); if (it >= 2048) break; hyena_dec_item(F, in, it); }
    if (only == 0 || only == 3) for (;;) { const int it = queue_grab(F, ctl + CW_Q1, 1); if (it >= 512) break; gla_scan_item(F, in, it >> 5, (it >> 1) & 15, it & 1); }
    if (only == 0 || only == 4) for (;;) { const int g = queue_grab(F, ctl + CW_Q2, 1); if (g >= 512) break;
        hyena_ctx_item(F, in, (g >> 1) * 8 + F.wave, (g & 1) * 4); }
}
DI void phase_m1c(const Ctx& F, const float* const* in) {
    const int gw = F.bid * 8 + F.wave, NGW = F.G * 8, lane = F.lane;
    const bf16* U = (const bf16*)(F.ws + WS_U); bf16* MIX = (bf16*)(F.ws + WS_MIX);
    const bf16 *OFA = (const bf16*)(F.ws + WS_OFA), *OBA = (const bf16*)(F.ws + WS_OBA);
    const int hsub = lane >> 4, c8 = (lane & 15) * 8;
    const f32x4 gn0 = *(const f32x4*)(in[32] + c8), gn1 = *(const f32x4*)(in[32] + c8 + 4);
    for (int row = gw; row < NROWS; row += NGW) { const bf16* ur = U + (size_t)row * IN_ODD;
        u32x4 af[4], ab[4], az[4];
#pragma unroll
        for (int hq = 0; hq < 4; ++hq) { const size_t o = (size_t)row * 2048 + (hq * 4 + hsub) * 128 + c8;
            af[hq] = *(const u32x4*)(OFA + o); ab[hq] = *(const u32x4*)(OBA + o); az[hq] = *(const u32x4*)(ur + O_ZD + (hq * 4 + hsub) * 128 + c8); }
#pragma unroll
        for (int hq = 0; hq < 4; ++hq) { float x[8], y[8], z[8]; unpack8(af[hq], x); unpack8(ab[hq], y); unpack8(az[hq], z);
            float ss = 0.f;
#pragma unroll
            for (int e = 0; e < 8; ++e) { x[e] += y[e]; ss += x[e] * x[e]; }
            ss += __shfl_xor(ss, 1); ss += __shfl_xor(ss, 2); ss += __shfl_xor(ss, 4); ss += __shfl_xor(ss, 8);
            const float rn = __builtin_amdgcn_rsqf(ss * (1.0f / 128.0f) + EPS);
            u32x4 w; w.x = pk2(x[0] * rn * gn0[0] * siluf_(z[0]), x[1] * rn * gn0[1] * siluf_(z[1])); w.y = pk2(x[2] * rn * gn0[2] * siluf_(z[2]), x[3] * rn * gn0[3] * siluf_(z[3]));
            w.z = pk2(x[4] * rn * gn1[0] * siluf_(z[4]), x[5] * rn * gn1[1] * siluf_(z[5])); w.w = pk2(x[6] * rn * gn1[2] * siluf_(z[6]), x[7] * rn * gn1[3] * siluf_(z[7]));
            *(u32x4*)(MIX + (size_t)row * DM + 2048 + (hq * 4 + hsub) * 128 + c8) = w; } }
    const bf16* YT = (const bf16*)(F.ws + WS_YT);
    LAS bf16* T = (LAS bf16*)(F.lds + F.wave * 8448);
    for (int it = gw; it < 32 * 192; it += NGW) { const int cb = it & 31, rbk = it >> 5, c0 = cb * 64, r0 = rbk * 64;
#pragma unroll
        for (int k = 0; k < 8; ++k) { const int ch = 8 * k + (lane >> 3); const u32x4 w = *(const u32x4*)(YT + (size_t)(c0 + ch) * NROWS + r0 + (lane & 7) * 8);
            LAS bf16* dp = T + ch * 66 + (lane & 7) * 8;
            dp[0] = (bf16)(w.x & 0xffffu); dp[1] = (bf16)(w.x >> 16); dp[2] = (bf16)(w.y & 0xffffu); dp[3] = (bf16)(w.y >> 16); dp[4] = (bf16)(w.z & 0xffffu); dp[5] = (bf16)(w.z >> 16); dp[6] = (bf16)(w.w & 0xffffu); dp[7] = (bf16)(w.w >> 16); }
        asm volatile("s_waitcnt lgkmcnt(0)" ::: "memory");
#pragma unroll
        for (int k = 0; k < 8; ++k) { const int rr = 8 * k + (lane >> 3), cc = (lane & 7) * 8;
            u32x4 w; w.x = (unsigned)T[(cc + 0) * 66 + rr] | ((unsigned)T[(cc + 1) * 66 + rr] << 16); w.y = (unsigned)T[(cc + 2) * 66 + rr] | ((unsigned)T[(cc + 3) * 66 + rr] << 16);
            w.z = (unsigned)T[(cc + 4) * 66 + rr] | ((unsigned)T[(cc + 5) * 66 + rr] << 16); w.w = (unsigned)T[(cc + 6) * 66 + rr] | ((unsigned)T[(cc + 7) * 66 + rr] << 16);
            *(u32x4*)(MIX + (size_t)(r0 + rr) * DM + c0 + cc) = w; }
        asm volatile("s_waitcnt lgkmcnt(0)" ::: "memory"); }
}
constexpr int NWAVES = 8, NTHREADS = 512;
constexpr int LDS_BYTES = 163840;
constexpr int LDS_MISC = LDS_BYTES - 64;
constexpr int N_PHASES = 14;
struct Args { const float* in[33]; float* out; unsigned char* ws; int ph_lo, ph_hi; };

__global__ void __launch_bounds__(NTHREADS, 2) mk_fwd(Args args) {
    extern __shared__ __attribute__((aligned(16))) unsigned char lds_raw[];
    Ctx F;
    F.lds = (LAS unsigned char*)lds_raw; F.in = nullptr; F.ws = args.ws; F.out = args.out;
    F.tid = threadIdx.x; F.lane = F.tid & 63; F.wave = __builtin_amdgcn_readfirstlane(F.tid >> 6); F.bid = blockIdx.x; F.G = gridDim.x;
    const float* const* in = args.in;
    volatile LAS unsigned* xbw = (volatile LAS unsigned*)(F.lds + LDS_MISC);
    if (F.tid < 4) xbw[F.tid] = 0u;
    __syncthreads();
    unsigned* ctl = (unsigned*)(args.ws + WS_CTL);
    XcdBarrier bar = xcd_barrier_post(ctl + CW_BAR, xbw);
    const int lo = args.ph_lo, hi = args.ph_hi;
#ifndef PHASE_MASK
#define PHASE_MASK 0xffffffffu
#endif
#define IN(k) (((PHASE_MASK >> (k)) & 1u) && lo <= (k) && (k) < hi)
#define SEAM(k) do { if (IN(k) && IN((k) + 1)) xcd_barrier(bar); } while (0)
#ifndef DUP_MASK
#define DUP_MASK 0u
#endif
#define DUP(k) (((DUP_MASK >> (k)) & 1u) != 0u)
    if (IN(0)) { phase_p0(F, in); if (DUP(0)) { xcd_barrier(bar); phase_p0(F, in); } }
    SEAM(0);
    if (IN(1)) { phase_p0c(F, in); if (DUP(1)) { xcd_barrier(bar); phase_p0c(F, in); } }
    SEAM(1);
    if (IN(2)) { phase_norm<0>(F, in); if (DUP(2)) { xcd_barrier(bar); phase_norm<0>(F, in); } }
    SEAM(2);
    if (IN(3)) { pg8::Gemm g{(const pg8::bf16_t*)(F.ws + WS_H), (const pg8::bf16_t*)(F.ws + WS_WTE), NROWS, LD_EVEN, DM}; pg8::StaticOrder S; S.init(NROWS, LD_EVEN, F.G, F.bid);
        pg8::EpiStoreBf16 E{(pg8::bf16_t*)(F.ws + WS_U), LD_EVEN};
        pg8::gemm_phase<pg8::EpiStoreBf16, pg8::StaticOrder, true, true>(F.lds, g, S, E);
        if (DUP(3)) { xcd_barrier(bar); pg8::gemm_phase<pg8::EpiStoreBf16, pg8::StaticOrder, true, true>(F.lds, g, S, E); }
        { constexpr int NU = (NROWS / 256) * (LD_EVEN / 256); const int nfull = NU % F.G;
          if (nfull > 0 && F.bid >= nfull) { convert_wout(F, in, F.bid - nfull, F.G - nfull, 0); convert_wodd(F, in, F.bid - nfull, F.G - nfull); } else if (nfull == 0) { convert_wout(F, in, F.bid, F.G, 0); convert_wodd(F, in, F.bid, F.G); } } }
    SEAM(3);
    if (IN(4)) { phase_m0a(F, in); if (DUP(4)) { xcd_barrier(bar); phase_m0a(F, in); } }
    SEAM(4);
#ifndef P5_ONLY
#define P5_ONLY 0
#endif
    if (IN(5)) { phase_m0(F, in); if (DUP(5)) { xcd_barrier(bar); phase_m0(F, in, P5_ONLY); } }
    SEAM(5);
    if (IN(6)) { phase_m0c(F, in); if (DUP(6)) { xcd_barrier(bar); phase_m0c(F, in); } }
    SEAM(6);
    if (IN(7)) { pg8::Gemm g{(const pg8::bf16_t*)(F.ws + WS_MIX), (const pg8::bf16_t*)(F.ws + WS_WTOUT), NROWS, DM, DM}; pg8::StaticOrder S; S.init(NROWS, DM, F.G, F.bid);
        pg8::EpiResGateBf16 E{(pg8::bf16_t*)xr_base(F), LDX, (const float*)(F.ws + WS_MODF) + (size_t)6 * 4096};
        pg8::gemm_phase<pg8::EpiResGateBf16, pg8::StaticOrder, true, true>(F.lds, g, S, E); }
    SEAM(7);
    if (IN(8)) { phase_norm<1>(F, in); if (DUP(8)) { xcd_barrier(bar); phase_norm<1>(F, in); } }
    SEAM(8);
    if (IN(9)) { pg8::Gemm g{(const pg8::bf16_t*)(F.ws + WS_H), (const pg8::bf16_t*)(F.ws + WS_WTO), NROWS, IN_ODD, DM}; pg8::StaticOrder S; S.init(NROWS, IN_ODD, F.G, F.bid);
        pg8::EpiStoreBf16 E{(pg8::bf16_t*)(F.ws + WS_U), IN_ODD};
        pg8::gemm_phase<pg8::EpiStoreBf16, pg8::StaticOrder, true, true>(F.lds, g, S, E);
        if (DUP(9)) { xcd_barrier(bar); pg8::gemm_phase<pg8::EpiStoreBf16, pg8::StaticOrder, true, true>(F.lds, g, S, E); }
        { constexpr int NU = (NROWS / 256) * (IN_ODD / 256); const int nfull = NU % F.G;
          if (nfull > 0 && F.bid >= nfull) { phase_filters(F, in, F.bid - nfull, F.G - nfull); convert_wout(F, in, F.bid - nfull, F.G - nfull, 1); } else if (nfull == 0) { phase_filters(F, in, F.bid, F.G); convert_wout(F, in, F.bid, F.G, 1); } } }
    SEAM(9);
    if (IN(10)) { phase_m1a(F, in); if (DUP(10)) { xcd_barrier(bar); phase_m1a(F, in); } }
    SEAM(10);
    if (IN(11)) { phase_m1b(F, in); if (DUP(11)) { xcd_barrier(bar); phase_m1b(F, in, 1); } }
    SEAM(11);
    if (IN(12)) { phase_m1c(F, in); if (DUP(12)) { xcd_barrier(bar); phase_m1c(F, in); } }
    SEAM(12);
    if (IN(13)) { pg8::Gemm g{(const pg8::bf16_t*)(F.ws + WS_MIX), (const pg8::bf16_t*)(F.ws + WS_WTOUT) + (size_t)DM * DM, NROWS, DM, DM}; pg8::StaticOrder S; S.init(NROWS, DM, F.G, F.bid);
        pg8::EpiResGateBf16 E{(pg8::bf16_t*)xr_base(F), LDX, (const float*)(F.ws + WS_MODF) + (size_t)(9 + 6) * 4096};
        pg8::gemm_phase<pg8::EpiResGateBf16, pg8::StaticOrder, true, true>(F.lds, g, S, E); }
    SEAM(13);
    if (IN(14)) phase_norm<2>(F, in);
#ifdef DBG_DUMP
    xcd_barrier(bar);
#define DUMP_ONE(OOFF, ONEXT, PTR, NB, ISBF) do { const size_t no = (size_t)(ONEXT) - (size_t)(OOFF), nb = (NB); float* op = F.out + (OOFF); \
        for (size_t i = (size_t)F.bid * 512 + F.tid; i < no; i += (size_t)F.G * 512) { float acc = 0.f; \
            for (size_t j = i; j < nb; j += no) acc += (ISBF) ? bf2f(((const bf16*)(PTR))[j]) : ((const float*)(PTR))[j]; \
            op[i] = acc; } } while (0)
#if DBG_DUMP == 1
    DUMP_ONE(0, 16777216, F.ws + WS_H, (size_t)NROWS * DM, 1);
    DUMP_ONE(16777216, 50331648, F.ws + WS_U, (size_t)NROWS * LD_EVEN, 1);
    DUMP_ONE(50331648, 58720256, F.ws + WS_OFA, (size_t)2 * NROWS * 2048, 0);
    DUMP_ONE(58720256, 67108864, F.ws + WS_OFB, (size_t)2 * NROWS * 2048, 0);
    DUMP_ONE(67108864, 75497472, F.ws + WS_MIX, (size_t)NROWS * DM, 1);
#elif DBG_DUMP == 4
    DUMP_ONE(0, 16777216, F.ws + WS_OFA, (size_t)NROWS * 2048, 0);
    DUMP_ONE(16777216, 50331648, F.ws + WS_OBA, (size_t)NROWS * 2048, 0);
    DUMP_ONE(58720256, 67108864, F.ws + WS_H, (size_t)NROWS * DM, 1);
    DUMP_ONE(67108864, 75497472, F.ws + WS_H, (size_t)NROWS * DM, 1);
#elif DBG_DUMP == 7
    { unsigned fl = 0u; const float* pa = (const float*)(F.ws + WS_OFA); const float* pb = (const float*)(F.ws + WS_OBA); const float* ps = F.out + OUT_SG;
      for (size_t i = (size_t)F.bid * 512 + F.tid; i < (size_t)NROWS * 2048; i += (size_t)F.G * 512) { const size_t row = i >> 11; const float va = pa[i], vb = pb[i];
          if (!(fabsf(va) <= 3.0e38f)) { fl |= row < 4096 ? 1u : 2u; if (row >= 4096 && ((row - 4096) & 4095) < 64) fl |= 32u; }
          if (!(fabsf(vb) <= 3.0e38f)) fl |= row < 4096 ? 4u : 8u; }
      for (size_t i = (size_t)F.bid * 512 + F.tid; i < (size_t)8388608; i += (size_t)F.G * 512) { const float v = ps[i]; if (!(fabsf(v) <= 3.0e38f)) fl |= 16u; }
      if (fl) atomicOr(ctl + 64, fl); }
    xcd_barrier(bar);
    { const unsigned fl = __hip_atomic_load(ctl + 64, __ATOMIC_RELAXED, __HIP_MEMORY_SCOPE_AGENT);
      const unsigned d1 = 1u + (fl & 1u) + ((fl >> 1) & 1u) * 2u + ((fl >> 2) & 1u) * 4u, d2 = 1u + ((fl >> 3) & 1u) + ((fl >> 4) & 1u) * 2u + ((fl >> 5) & 1u) * 4u;
      const unsigned total = d1 * 1000000u + d2 * 100000u;
      for (size_t i = (size_t)F.bid * 512 + F.tid; i < (size_t)75497472; i += (size_t)F.G * 512) F.out[i] = (i < total) ? __uint_as_float(0xAAAAAAAAu) : 1.0f; }
#elif DBG_DUMP == 6
    { unsigned cnt = 0u; const float* pa = (const float*)(F.ws + WS_OFA); const float* ps = F.out + OUT_SG;
      for (size_t i = (size_t)F.bid * 512 + F.tid; i < (size_t)2 * NROWS * 2048; i += (size_t)F.G * 512) { const float v = pa[i]; if (!(fabsf(v) <= 3.0e38f)) ++cnt; }
      for (size_t i = (size_t)F.bid * 512 + F.tid; i < (size_t)8388608; i += (size_t)F.G * 512) { const float v = ps[i]; if (!(fabsf(v) <= 3.0e38f)) ++cnt; }
      if (cnt) atomicAdd(ctl + 64, cnt); }
    xcd_barrier(bar);
    { const unsigned total = __hip_atomic_load(ctl + 64, __ATOMIC_RELAXED, __HIP_MEMORY_SCOPE_AGENT);
      const float* pa = (const float*)(F.ws + WS_OFA);
      for (size_t i = (size_t)F.bid * 512 + F.tid; i < (size_t)75497472; i += (size_t)F.G * 512) {
          float v = 1.0f;
          if (i < 16777216) { if (i < total) v = __uint_as_float(0xAAAAAAAAu); }
          else if (i < 50331648) { const size_t k = i - 16777216; float a = pa[k]; if (!(fabsf(a) <= 3.0e38f)) a = 7.0f; v = a; }
          F.out[i] = v; } }
#elif DBG_DUMP == 5
    DUMP_ONE(0, 16777216, F.ws + WS_OFB, (size_t)NROWS * 2048, 0);
    DUMP_ONE(16777216, 50331648, F.ws + WS_OBB, (size_t)NROWS * 2048, 0);
    DUMP_ONE(50331648, 58720256, F.ws + WS_H, (size_t)NROWS * DM, 1);
    DUMP_ONE(67108864, 75497472, F.ws + WS_H, (size_t)NROWS * DM, 1);
#elif DBG_DUMP == 3
    DUMP_ONE(0, 16777216, F.ws + WS_H, (size_t)NROWS * DM, 1);
    DUMP_ONE(16777216, 50331648, F.ws + WS_U, (size_t)NROWS * LD_EVEN, 1);
    DUMP_ONE(50331648, 58720256, F.ws + WS_WTE, (size_t)LD_EVEN * DM, 1);
    DUMP_ONE(58720256, 67108864, F.ws + WS_MODF, (size_t)(1 * MiB + 512 * 1024) / 4, 0);
    DUMP_ONE(67108864, 75497472, F.ws + WS_HF256, (size_t)2 * 2048 * 512, 0);
#else
    DUMP_ONE(0, 16777216, F.ws + WS_H, (size_t)NROWS * DM, 1);
    DUMP_ONE(16777216, 50331648, F.ws + WS_U, (size_t)NROWS * IN_ODD, 1);
    DUMP_ONE(50331648, 58720256, F.ws + WS_TB, (size_t)8192 * NROWS, 1);
    DUMP_ONE(58720256, 67108864, F.ws + WS_OFA, (size_t)2 * NROWS * 2048, 0);
    DUMP_ONE(67108864, 75497472, F.ws + WS_YT, (size_t)2048 * NROWS, 1);
#endif
#endif
#undef IN
#undef SEAM
}

extern "C" void kernel_launch(void* const* d_in, const int* in_sizes, int n_in, void* d_out, int out_size, void* d_ws, size_t ws_size, hipStream_t stream) {
    static int grid = 0;
    if (grid == 0) {
        if (n_in != 33 || out_size != 75497472 || ws_size < WS_END2) { fprintf(stderr, "kernel_launch: unexpected problem (n_in %d, out %d, ws %zu)\n", n_in, out_size, ws_size); grid = -1; return; }
        int dev = 0, cus = 0, per_cu = 0;
        if (hipGetDevice(&dev) != hipSuccess || hipDeviceGetAttribute(&cus, hipDeviceAttributeMultiprocessorCount, dev) != hipSuccess) { grid = -1; return; }
        if (hipFuncSetAttribute((const void*)mk_fwd, hipFuncAttributeMaxDynamicSharedMemorySize, LDS_BYTES) != hipSuccess) { fprintf(stderr, "kernel_launch: hipFuncSetAttribute failed\n"); grid = -1; return; }
        if (hipOccupancyMaxActiveBlocksPerMultiprocessor(&per_cu, (const void*)mk_fwd, NTHREADS, LDS_BYTES) != hipSuccess || per_cu < 1) { fprintf(stderr, "kernel_launch: occupancy query says %d\n", per_cu); }
        (void)hipGetLastError();
        grid = cus;
        if (grid < 128) { grid = -1; return; }
    }
    if (grid < 0) return;
    (void)hipMemsetAsync((char*)d_ws + WS_CTL, 0, CTL_ZERO_BYTES, stream);
    Args a{};
    for (int i = 0; i < 33; ++i) a.in[i] = (const float*)d_in[i];
    a.out = (float*)d_out; a.ws = (unsigned char*)d_ws;
#ifndef MK_SPLIT
    a.ph_lo = 0; a.ph_hi = N_PHASES + 1;
#ifdef DBG_STOP
    a.ph_hi = DBG_STOP + 1;
#endif
    hipLaunchKernelGGL(mk_fwd, dim3(grid), dim3(NTHREADS), LDS_BYTES, stream, a);
#else
    for (int p = 0; p <= N_PHASES; ++p) { a.ph_lo = p; a.ph_hi = p + 1; hipLaunchKernelGGL(mk_fwd, dim3(grid), dim3(NTHREADS), LDS_BYTES, stream, a); }
#endif
}
```

```cpp
#include <hip/hip_runtime.h>
#include <cstdio>
#include <cstdint>
namespace pg8 {
#define PG8_LAS __attribute__((address_space(3)))
typedef unsigned short bf16_t;
typedef short bf16x8 __attribute__((ext_vector_type(8)));
typedef float f32x4 __attribute__((ext_vector_type(4)));
typedef unsigned u32x4 __attribute__((ext_vector_type(4)));
constexpr int BM = 256, BK = 64, HALF = 128, HTB = HALF * BK * 2  , STAGE_BYTES = 8 * HTB, NXCD = 8, WGM = 8;

__host__ __device__ __forceinline__ int lds_byte(int r, int c) { const int st = (r >> 4) * 2 + (c >> 5), rr = r & 15, cc = c & 31, ob = rr * 64 + cc * 2; return st * 1024 + (ob ^ (((ob >> 9) & 1) << 5)); }
__host__ __device__ __forceinline__ void stage_rc(int b, int& R, int& C) { const int st = b / 1024, sb = b % 1024, swz = sb ^ (((sb >> 9) & 1) << 5); R = (st >> 1) * 16 + swz / 64; C = (st & 1) * 32 + (swz % 64) / 2; }
__host__ __device__ __forceinline__ int perm32(int rho) { const int n = rho >> 4, i = rho & 15; return 8 * (i >> 2) + 4 * n + (i & 3); }

struct Unit { int pm, pn; };
struct Gemm { const bf16_t* A; const bf16_t* Bt; int M, N, K; };

struct StaticOrder {
    int nM, nN, nwg, G, c;
    __host__ __device__ void init(int M, int N, int G_, int c_) { nM = M / BM; nN = N / BM; nwg = nM * nN; G = G_; c = c_; }
    __host__ __device__ bool next(int i, Unit& u) const {
        const long L = (long)i * G + c; if (L >= nwg) return false;
        int wgid = (int)L; { const int q = nwg / NXCD, r = nwg % NXCD, xcd = wgid % NXCD, off = wgid / NXCD; wgid = (xcd < r ? xcd * (q + 1) : r * (q + 1) + (xcd - r) * q) + off; }
        const int nig = WGM * nN, gid = wgid / nig, fm = gid * WGM, gsz = (nM - fm) < WGM ? (nM - fm) : WGM;
        u.pm = fm + ((wgid % nig) % gsz); u.pn = (wgid % nig) / gsz; return true;
    }
    __device__ __forceinline__ void a_ready(const Unit&) const {}
    __device__ __forceinline__ void done(const Unit&) const {}
};
__device__ __forceinline__ unsigned cvt_pk_bf16(float lo, float hi) { unsigned r; asm volatile("v_cvt_pk_bf16_f32 %0, %1, %2" : "=v"(r) : "v"(lo), "v"(hi)); return r; }
typedef __bf16 bf16x2v __attribute__((ext_vector_type(2)));
typedef float f32x2v_ __attribute__((ext_vector_type(2)));
__device__ __forceinline__ unsigned pk_bf16(float lo, float hi) { f32x2v_ v = {lo, hi}; return __builtin_bit_cast(unsigned, __builtin_convertvector(v, bf16x2v)); }
struct EpiStoreBf16 {
    static constexpr bool PERM = true, AFTER_DRAIN = false;
    bf16_t* O; int ldc;
    __device__ __forceinline__ void operator()(const f32x4 (&acc)[2][2][4][2], const Unit& u, int wr, int wc, int fr, int fq) const {
        const int row0 = u.pm * BM + wr * 64 + fr, col0 = u.pn * BM + wc * 32 + 8 * fq;
#pragma unroll
        for (int ai = 0; ai < 2; ++ai)
#pragma unroll
            for (int m = 0; m < 4; ++m) { bf16_t* rowp = O + (size_t)(row0 + ai * HALF + m * 16) * ldc + col0;
#pragma unroll
                for (int bj = 0; bj < 2; ++bj) { const f32x4 v0 = acc[ai][bj][m][0], v1 = acc[ai][bj][m][1];
                    u32x4 w; w.x = pk_bf16(v0[0], v0[1]); w.y = pk_bf16(v0[2], v0[3]); w.z = pk_bf16(v1[0], v1[1]); w.w = pk_bf16(v1[2], v1[3]);
                    *(u32x4*)(rowp + bj * HALF) = w; } }
    }
};
struct EpiResGate {
    static constexpr bool PERM = false, AFTER_DRAIN = false;
    float* io; int ldc; const float* gate;
    __device__ __forceinline__ void operator()(const f32x4 (&acc)[2][2][4][2], const Unit& u, int wr, int wc, int fr, int fq) const {
        const int row0 = u.pm * BM + wr * 64 + fr, col0 = u.pn * BM + wc * 32 + 4 * fq;
        const int rb = u.pm * BM; const int r = rb < 4096 ? 0 : 1 + ((rb - 4096) >> 12);
        const float* g = gate + r * 4096 + col0;
        f32x4 gv[2][2];
#pragma unroll
        for (int bj = 0; bj < 2; ++bj)
#pragma unroll
            for (int n = 0; n < 2; ++n) gv[bj][n] = *(const f32x4*)(g + bj * HALF + n * 16);
#pragma unroll
        for (int ai = 0; ai < 2; ++ai)
#pragma unroll
            for (int m = 0; m < 4; ++m) { float* rowp = io + (size_t)(row0 + ai * HALF + m * 16) * ldc + col0;
#pragma unroll
                for (int bj = 0; bj < 2; ++bj)
#pragma unroll
                    for (int n = 0; n < 2; ++n) { f32x4* p = (f32x4*)(rowp + bj * HALF + n * 16); const f32x4 b = *p; *p = b + gv[bj][n] * acc[ai][bj][m][n]; }
                if (m == 3) asm volatile("" ::: "memory"); }
    }
};

struct EpiResGateBf16 {
    static constexpr bool PERM = true, AFTER_DRAIN = false;
    bf16_t* io; int ldc; const float* gate;
    __device__ __forceinline__ void operator()(const f32x4 (&acc)[2][2][4][2], const Unit& u, int wr, int wc, int fr, int fq) const {
        const int row0 = u.pm * BM + wr * 64 + fr, col0 = u.pn * BM + wc * 32 + 8 * fq;
        const int rb = u.pm * BM; const int r = rb < 4096 ? 0 : 1 + ((rb - 4096) >> 12);
        const float* g = gate + r * 4096 + col0;
        f32x4 gv[2][2];
#pragma unroll
        for (int bj = 0; bj < 2; ++bj)
#pragma unroll
            for (int n = 0; n < 2; ++n) gv[bj][n] = *(const f32x4*)(g + bj * HALF + 4 * n);
#pragma unroll
        for (int ai = 0; ai < 2; ++ai)
#pragma unroll
            for (int m = 0; m < 4; ++m) { bf16_t* rowp = io + (size_t)(row0 + ai * HALF + m * 16) * ldc + col0;
#pragma unroll
                for (int bj = 0; bj < 2; ++bj) { u32x4* p = (u32x4*)(rowp + bj * HALF); const u32x4 b = *p;
                    const f32x4 a0 = acc[ai][bj][m][0] * gv[bj][0], a1 = acc[ai][bj][m][1] * gv[bj][1];
                    u32x4 w;
                    w.x = pk_bf16(__uint_as_float(b.x << 16) + a0[0], __uint_as_float(b.x & 0xffff0000u) + a0[1]); w.y = pk_bf16(__uint_as_float(b.y << 16) + a0[2], __uint_as_float(b.y & 0xffff0000u) + a0[3]);
                    w.z = pk_bf16(__uint_as_float(b.z << 16) + a1[0], __uint_as_float(b.z & 0xffff0000u) + a1[1]); w.w = pk_bf16(__uint_as_float(b.w << 16) + a1[2], __uint_as_float(b.w & 0xffff0000u) + a1[3]);
                    *p = w; }
                if (m == 3) asm volatile("" ::: "memory"); }
    }
};
template <class Epi, class Sched, bool ALIGN_EPI = false, bool SP2 = false>
__device__ __forceinline__ void gemm_phase(PG8_LAS unsigned char* lds, const Gemm g, const Sched& S, const Epi& E) {
    const int tid = threadIdx.x, wid = __builtin_amdgcn_readfirstlane(tid >> 6), lane = tid & 63, wr = wid >> 2, wc = wid & 3, fr = lane & 15, fq = lane >> 4;
    const int K = g.K, nt = K / BK;
    unsigned voffA[2], voffB[2];
#pragma unroll
    for (int i = 0; i < 2; ++i) { int R, C; stage_rc(tid * 16 + i * 8192, R, C); const int Rb = Epi::PERM ? ((R & ~31) + perm32(R & 31)) : R;
        voffA[i] = (unsigned)(R * K + C) * 2u; voffB[i] = (unsigned)(Rb * K + C) * 2u; }
    const size_t kstep = (size_t)(BK * 2);
    const size_t hstep = (size_t)HALF * K * 2;
    const size_t tstep = 2 * hstep;
    const unsigned ldsw = (unsigned)wid * 1024u;
    const int aoff = lds_byte(wr * 64 + fr, fq * 8), boff = lds_byte(wc * 32 + fr, fq * 8);
#define PG8_SA(b, h) (((b) * 2 + (h)) * HTB)
#define PG8_SB(b, h) ((4 + (b) * 2 + (h)) * HTB)
#define PG8_STAGE(bufoff, gbase, voff) do { _Pragma("unroll") for (int _i = 0; _i < 2; ++_i) \
        __builtin_amdgcn_global_load_lds((const unsigned*)((const char*)(gbase) + (voff)[_i]), (PG8_LAS unsigned*)(lds + (bufoff) + ldsw + _i * 8192), 16, 0, 0); } while (0)
#define PG8_LDA(dst, b, h) do { _Pragma("unroll") for (int m = 0; m < 4; ++m) _Pragma("unroll") for (int k = 0; k < 2; ++k) dst[m][k] = *(const PG8_LAS bf16x8*)(lds + PG8_SA(b, h) + aoff + m * 2048 + k * 1024); } while (0)
#define PG8_LDB(dst, b, h) do { _Pragma("unroll") for (int n = 0; n < 2; ++n) _Pragma("unroll") for (int k = 0; k < 2; ++k) dst[n][k] = *(const PG8_LAS bf16x8*)(lds + PG8_SB(b, h) + boff + n * 2048 + k * 1024); } while (0)
#define PG8_MMA(ai, bj, At, Bt) do { __builtin_amdgcn_s_setprio(1); _Pragma("unroll") for (int m = 0; m < 4; ++m) _Pragma("unroll") for (int n = 0; n < 2; ++n) _Pragma("unroll") for (int k = 0; k < 2; ++k) \
        acc[ai][bj][m][n] = __builtin_amdgcn_mfma_f32_16x16x32_bf16(Bt[n][k], At[m][k], acc[ai][bj][m][n], 0, 0, 0); __builtin_amdgcn_s_setprio(0); } while (0)
#define PG8_WAIT_V(n) asm volatile("s_waitcnt vmcnt(" #n ")" ::: "memory")
#define PG8_WAIT_L(n) asm volatile("s_waitcnt lgkmcnt(" #n ")" ::: "memory")
#define PG8_BAR __builtin_amdgcn_s_barrier()
#define PG8_SCHED __builtin_amdgcn_sched_barrier(0)
    Unit cur, nxt; int ui = 0;
    if (!S.next(0, cur)) return;
    f32x4 acc[2][2][4][2];
#pragma unroll
    for (int a = 0; a < 2; ++a)
#pragma unroll
        for (int b = 0; b < 2; ++b)
#pragma unroll
            for (int m = 0; m < 4; ++m)
#pragma unroll
                for (int n = 0; n < 2; ++n) acc[a][b][m][n] = (f32x4){0.f, 0.f, 0.f, 0.f};
    bf16x8 At[4][2], B0[2][2], B1[2][2];
    const char* cA = (const char*)g.A + (size_t)cur.pm * tstep; const char* cB = (const char*)g.Bt + (size_t)cur.pn * tstep;
    S.a_ready(cur);
    if constexpr (SP2) {
        PG8_STAGE(PG8_SB(0, 0), cB, voffB); PG8_STAGE(PG8_SB(0, 1), cB + hstep, voffB); PG8_STAGE(PG8_SA(0, 0), cA, voffA); PG8_STAGE(PG8_SA(0, 1), cA + hstep, voffA);
        if (wr == 1) PG8_BAR;
        PG8_WAIT_V(2); PG8_BAR;
        PG8_STAGE(PG8_SB(1, 0), cB + kstep, voffB); PG8_STAGE(PG8_SA(1, 0), cA + kstep, voffA); PG8_STAGE(PG8_SB(1, 1), cB + hstep + kstep, voffB);
        PG8_WAIT_V(6); PG8_BAR;
    } else {
        PG8_STAGE(PG8_SB(0, 0), cB, voffB); PG8_STAGE(PG8_SA(0, 0), cA, voffA); PG8_STAGE(PG8_SB(0, 1), cB + hstep, voffB); PG8_STAGE(PG8_SA(0, 1), cA + hstep, voffA);
        if (wr == 1) PG8_BAR;
        PG8_WAIT_V(4); PG8_BAR;
        PG8_STAGE(PG8_SB(1, 0), cB + kstep, voffB); PG8_STAGE(PG8_SA(1, 0), cA + kstep, voffA); PG8_STAGE(PG8_SB(1, 1), cB + hstep + kstep, voffB);
        PG8_WAIT_V(6); PG8_BAR;
    }
    for (;;) {
        const bool has_next = S.next(ui + 1, nxt);
        const char* nA = has_next ? (const char*)g.A + (size_t)nxt.pm * tstep : cA; const char* nB = has_next ? (const char*)g.Bt + (size_t)nxt.pn * tstep : cB;
        for (int t = 0; t < nt; t += 2) {
            const bool last = (t == nt - 2);
            const char* a1 = cA + (size_t)(t + 1) * kstep;
            const char* a2 = last ? nA : cA + (size_t)(t + 2) * kstep; const char* b2 = last ? nB : cB + (size_t)(t + 2) * kstep;
            const char* a3 = a2 + kstep; const char* b3 = b2 + kstep;
            if (last && has_next) S.a_ready(nxt);
            if constexpr (SP2) {
            PG8_LDB(B0, 0, 0); PG8_LDB(B1, 0, 1); PG8_SCHED; PG8_LDA(At, 0, 0); PG8_STAGE(PG8_SA(1, 1), a1 + hstep, voffA);
            PG8_WAIT_V(8); PG8_WAIT_L(0); PG8_BAR; PG8_MMA(0, 0, At, B0); PG8_MMA(0, 1, At, B1); PG8_BAR; PG8_SCHED;
            PG8_LDA(At, 0, 1); PG8_STAGE(PG8_SB(0, 0), b2, voffB); PG8_STAGE(PG8_SB(0, 1), b2 + hstep, voffB); PG8_STAGE(PG8_SA(0, 0), a2, voffA);
            PG8_WAIT_V(8); PG8_WAIT_L(0); PG8_BAR; PG8_MMA(1, 0, At, B0); PG8_MMA(1, 1, At, B1); PG8_BAR; PG8_SCHED;
            PG8_LDB(B0, 1, 0); PG8_LDB(B1, 1, 1); PG8_SCHED; PG8_LDA(At, 1, 0); PG8_STAGE(PG8_SA(0, 1), a2 + hstep, voffA);
            PG8_WAIT_V(8); PG8_WAIT_L(0); PG8_BAR; PG8_MMA(0, 0, At, B0); PG8_MMA(0, 1, At, B1); PG8_BAR; PG8_SCHED;
            PG8_LDA(At, 1, 1); PG8_STAGE(PG8_SB(1, 0), b3, voffB); PG8_STAGE(PG8_SB(1, 1), b3 + hstep, voffB); PG8_STAGE(PG8_SA(1, 0), a3, voffA);
            PG8_WAIT_V(8); PG8_WAIT_L(0); PG8_BAR; PG8_MMA(1, 0, At, B0); PG8_MMA(1, 1, At, B1); PG8_BAR; PG8_SCHED;
            } else {
            PG8_LDB(B0, 0, 0); PG8_SCHED; PG8_LDA(At, 0, 0); PG8_STAGE(PG8_SA(1, 1), a1 + hstep, voffA);
            PG8_WAIT_L(8); PG8_BAR; PG8_WAIT_L(0); PG8_MMA(0, 0, At, B0); PG8_BAR; PG8_SCHED;
            PG8_LDB(B1, 0, 1); PG8_STAGE(PG8_SB(0, 0), b2, voffB);
            PG8_BAR; PG8_WAIT_L(0); PG8_MMA(0, 1, At, B1); PG8_BAR;
            PG8_LDA(At, 0, 1); PG8_STAGE(PG8_SA(0, 0), a2, voffA);
            PG8_BAR; PG8_WAIT_L(0); PG8_MMA(1, 0, At, B0); PG8_BAR; PG8_SCHED;
            PG8_STAGE(PG8_SB(0, 1), b2 + hstep, voffB);
            PG8_WAIT_V(6); PG8_BAR; PG8_MMA(1, 1, At, B1); PG8_BAR;
            PG8_LDB(B0, 1, 0); PG8_SCHED; PG8_LDA(At, 1, 0); PG8_STAGE(PG8_SA(0, 1), a2 + hstep, voffA);
            PG8_WAIT_L(8); PG8_BAR; PG8_WAIT_L(0); PG8_MMA(0, 0, At, B0); PG8_BAR; PG8_SCHED;
            PG8_LDB(B1, 1, 1); PG8_STAGE(PG8_SB(1, 0), b3, voffB);
            PG8_BAR; PG8_WAIT_L(0); PG8_MMA(0, 1, At, B1); PG8_BAR;
            PG8_LDA(At, 1, 1); PG8_STAGE(PG8_SA(1, 0), a3, voffA);
            PG8_BAR; PG8_WAIT_L(0); PG8_MMA(1, 0, At, B0); PG8_BAR; PG8_SCHED;
            PG8_STAGE(PG8_SB(1, 1), b3 + hstep, voffB);
            PG8_WAIT_V(6); PG8_BAR; PG8_MMA(1, 1, At, B1); PG8_BAR;
            }
        }
        if constexpr (ALIGN_EPI) { if (wr == 0) PG8_BAR; }
        if constexpr (!Epi::AFTER_DRAIN) { E(acc, cur, wr, wc, fr, fq); S.done(cur); }
        if (!has_next) break;
#pragma unroll
        for (int a = 0; a < 2; ++a)
#pragma unroll
            for (int b = 0; b < 2; ++b)
#pragma unroll
                for (int m = 0; m < 4; ++m)
#pragma unroll
                    for (int n = 0; n < 2; ++n) acc[a][b][m][n] = (f32x4){0.f, 0.f, 0.f, 0.f};
        cur = nxt; cA = nA; cB = nB; ++ui;
        if constexpr (ALIGN_EPI) { if (wr == 1) PG8_BAR; }
    }
    PG8_WAIT_V(0);
    if constexpr (!ALIGN_EPI) { if (wr == 0) PG8_BAR; }
    PG8_BAR;
    if constexpr (Epi::AFTER_DRAIN) { E.fused(acc, cur, wr, wc, fr, fq, lds, wid, lane); S.done(cur); }
#undef PG8_SA
#undef PG8_SB
#undef PG8_STAGE
#undef PG8_LDA
#undef PG8_LDB
#undef PG8_MMA
#undef PG8_WAIT_V
#undef PG8_WAIT_L
#undef PG8_BAR
#undef PG8_SCHED
}
}
#define XB_TMO      128
#define XB_XCNT(j)  (256  + 64 * (j))
#define XB_XSUB(j)  (1280 + 64 * (j))
#define XB_XGEN(j)  (2304 + 64 * (j))
#define XB_TOP      3328
#define XB_TOPGEN   3392
#define XCD_BAR_WORDS 3456
#define XB_SPIN_CAP (1u << 18)
#define LAS __attribute__((address_space(3)))

__device__ __forceinline__ unsigned xb_ld(unsigned* p)              { return __hip_atomic_load(p, __ATOMIC_RELAXED, __HIP_MEMORY_SCOPE_AGENT); }
__device__ __forceinline__ unsigned xb_add(unsigned* p, unsigned v) { return __hip_atomic_fetch_add(p, v, __ATOMIC_RELAXED, __HIP_MEMORY_SCOPE_AGENT); }
__device__ __forceinline__ unsigned xb_xcc_id() { return (unsigned)__builtin_amdgcn_s_getreg((3 << 11) | 20) & 0xFu; }
#define XB_SPIN(cond, bar) do { unsigned _sp = 0; while (cond) { __builtin_amdgcn_s_sleep(1); \
    if ((++_sp & 255u) == 0u) { if (xb_ld(&(bar)[XB_TMO])) break; if (_sp > XB_SPIN_CAP) { atomicAdd(&(bar)[XB_TMO], 1u); break; } } } } while (0)

struct XcdBarrier {
    unsigned* bar; unsigned x;
    volatile LAS unsigned* st;
};

__device__ __forceinline__ XcdBarrier xcd_barrier_post(unsigned* bar, volatile LAS unsigned* st) {
    XcdBarrier b; b.bar = bar; b.x = xb_xcc_id(); b.st = st;
    if (threadIdx.x == 0) (void)xb_add(&bar[XB_XCNT(b.x)], 1u);
    return b;
}
__device__ __forceinline__ void xcd_barrier_complete(unsigned* bar, unsigned x, unsigned& nloc, unsigned& nx) {
    const unsigned G = gridDim.x * gridDim.y * gridDim.z;
    unsigned sum, cnt, mine, sp = 0u;
    for (;;) {
        sum = 0u; cnt = 0u; mine = 0u;
#pragma unroll
        for (unsigned j = 0; j < 16; ++j) { const unsigned c = xb_ld(&bar[XB_XCNT(j)]); sum += c; cnt += (c > 0u) ? 1u : 0u; mine = (j == x) ? c : mine; }
        if (sum == G) break;
        __builtin_amdgcn_s_sleep(1);
        if ((++sp & 255u) == 0u) { if (xb_ld(&bar[XB_TMO])) break; if (sp > XB_SPIN_CAP) { atomicAdd(&bar[XB_TMO], 1u); break; } }
    }
    nloc = mine > 0u ? mine : 1u; nx = cnt > 0u ? cnt : 1u;
}

__device__ __forceinline__ void xcd_barrier(const XcdBarrier& b) {
    asm volatile("s_waitcnt vmcnt(0)" ::: "memory");
    __syncthreads();
    if (threadIdx.x == 0) {
        unsigned* bar = b.bar;
        __builtin_amdgcn_s_waitcnt(0);
        unsigned nloc = b.st[0], nx = b.st[1];
        if (nloc == 0u) { xcd_barrier_complete(bar, b.x, nloc, nx); b.st[0] = nloc; b.st[1] = nx; }
        const unsigned old = xb_add(&bar[XB_XSUB(b.x)], 1u);
        const unsigned gen = old / nloc;
        if (old + 1u == (gen + 1u) * nloc) {
            __builtin_amdgcn_fence(__ATOMIC_RELEASE, "agent");
            asm volatile("s_waitcnt vmcnt(0)" ::: "memory");
            const unsigned og = xb_add(&bar[XB_TOP], 1u);
            const unsigned tg = og / nx;
            if (og + 1u == (tg + 1u) * nx) xb_add(&bar[XB_TOPGEN], 1u);
            else XB_SPIN(xb_ld(&bar[XB_TOPGEN]) == tg, bar);
            __builtin_amdgcn_fence(__ATOMIC_ACQUIRE, "agent");
            xb_add(&bar[XB_XGEN(b.x)], 1u);
            asm volatile("s_waitcnt vmcnt(0)" ::: "memory");
        } else {
            XB_SPIN(xb_ld(&bar[XB_XGEN(b.x)]) == gen, bar);
            __builtin_amdgcn_fence(__ATOMIC_ACQUIRE, "agent");
            asm volatile("s_waitcnt vmcnt(0)" ::: "memory");
        }
    }
    __syncthreads();
}
#define DI __device__ __forceinline__
typedef unsigned short bf16;
typedef short bf16x8 __attribute__((ext_vector_type(8)));
typedef short bf16x4 __attribute__((ext_vector_type(4)));
typedef float f32x4 __attribute__((ext_vector_type(4)));
typedef float f32x2 __attribute__((ext_vector_type(2)));
typedef unsigned u32x4 __attribute__((ext_vector_type(4)));
typedef unsigned u32x2 __attribute__((ext_vector_type(2)));
typedef __bf16 bf16x2n __attribute__((ext_vector_type(2)));
#define MFMA16(a, b, c) __builtin_amdgcn_mfma_f32_16x16x32_bf16((a), (b), (c), 0, 0, 0)

constexpr int DM = 4096, NROWS = 12288;
constexpr int IN_EVEN = 14464, LD_EVEN = 14592, IN_ODD = 18432;
constexpr int E_QKV = 0, E_BETA = 6144, E_A = 6176, E_ZA = 6208, E_XBC = 8256, E_DT = 12352, E_ZB = 12416;
constexpr int O_VX = 0, O_ZC = 6144, O_Q = 8192, O_F = 10240, O_I = 14336, O_ZD = 16384;
constexpr float EPS = 1e-6f;
constexpr int NSEQ = 18;
DI int seq_row0(int s) { return s < 16 ? s * 256 : 4096 + (s - 16) * 4096; }
DI int seq_len(int s) { return s < 16 ? 256 : 4096; }
constexpr size_t OUT_SG = 50331648, OUT_SS = 58720256, OUT_SH = 67108864;

constexpr size_t MiB = 1u << 20;
constexpr size_t WS_CTL = 0, CTL_ZERO_BYTES = 1 * MiB;
constexpr size_t WS_MODP = 1 * MiB;
constexpr size_t WS_MODF = 4 * MiB;
constexpr size_t WS_PE = 5 * MiB;
constexpr size_t WS_HDN = 6 * MiB;
constexpr size_t WS_HNRM = 8 * MiB;
constexpr size_t WS_HF256 = 16 * MiB;
constexpr size_t WS_HF4096 = 32 * MiB;
constexpr size_t WS_WTE = 160 * MiB;
constexpr size_t WS_WTO = 274 * MiB;
constexpr size_t WS_WTOUT = 418 * MiB;
constexpr size_t WS_H = 482 * MiB;
constexpr size_t WS_U = 578 * MiB;
constexpr size_t WS_MIX = 1010 * MiB;
constexpr size_t WS_OFA = 1106 * MiB;
constexpr size_t WS_OBA = 1154 * MiB;
constexpr size_t WS_OFB = 1202 * MiB;
constexpr size_t WS_OBB = 1250 * MiB;
constexpr size_t WS_TB = 1298 * MiB;
constexpr size_t WS_END = 1490 * MiB;
constexpr size_t WS_YT = WS_WTE;
constexpr size_t WS_GWN = 1298 * MiB;
constexpr size_t WS_GUF = 1394 * MiB;
constexpr size_t WS_GPP = 920 * MiB;
constexpr size_t WS_GGC = 968 * MiB;
constexpr size_t WS_GQN = WS_WTE;
constexpr size_t WS_GKT = WS_WTE + 48 * MiB;
constexpr size_t WS_SSP = 32 * MiB;
constexpr size_t WS_SCN = 128 * MiB;
constexpr size_t WS_SSG = 152 * MiB;
constexpr size_t WS_SBT = 1490 * MiB;
constexpr size_t WS_SVT = WS_H;
constexpr size_t WS_END2 = 1514 * MiB;
constexpr size_t WS_LQS = WS_H;
constexpr size_t WS_LKS = WS_WTO;
constexpr size_t WS_LAT = WS_WTO + 96 * MiB;
constexpr size_t WS_LVT = WS_OFB;
constexpr size_t WS_LGL = WS_OBB;
constexpr int CW_Q0 = 8192, CW_Q1 = 8256, CW_Q2 = 8320, CW_Q3 = 8384, CW_Q4 = 8448;
constexpr int CW_BAR = 4096;

DI float bf2f(bf16 b) { return __uint_as_float(((unsigned)b) << 16); }
DI unsigned pk2(float lo, float hi) { f32x2 v = {lo, hi}; return __builtin_bit_cast(unsigned, __builtin_convertvector(v, bf16x2n)); }
DI bf16 f2bf(float f) { return (bf16)(pk2(f, 0.f) & 0xffffu); }
DI float wave_sum(float v) {
#pragma unroll
    for (int o = 1; o < 64; o <<= 1) v += __shfl_xor(v, o);
    return v;
}
DI float sigmoidf_(float x) { return __builtin_amdgcn_rcpf(1.0f + __expf(-x)); }
DI float siluf_(float x) { return x * __builtin_amdgcn_rcpf(1.0f + __expf(-x)); }
DI float softplusf_(float x) { return x > 20.f ? x : log1pf(__expf(x)); }
DI void unpack8(const u32x4 w, float* o) {
    o[0] = __uint_as_float(w.x << 16); o[1] = __uint_as_float(w.x & 0xffff0000u); o[2] = __uint_as_float(w.y << 16); o[3] = __uint_as_float(w.y & 0xffff0000u);
    o[4] = __uint_as_float(w.z << 16); o[5] = __uint_as_float(w.z & 0xffff0000u); o[6] = __uint_as_float(w.w << 16); o[7] = __uint_as_float(w.w & 0xffff0000u);
}
DI bf16x8 frag_nat(const LAS bf16* M, int ld, int r0, int k0, int lane) { return *(const LAS bf16x8*)(M + (r0 + (lane & 15)) * ld + k0 + 8 * (lane >> 4)); }
DI bf16x8 frag_perm(const LAS bf16* M, int ld, int r0, int k0, int lane) {
    const LAS bf16* p = M + (r0 + (lane & 15)) * ld + k0 + 4 * (lane >> 4);
    const bf16x4 lo = *(const LAS bf16x4*)p, hi = *(const LAS bf16x4*)(p + 16);
    return __builtin_shufflevector(lo, hi, 0, 1, 2, 3, 4, 5, 6, 7);
}
DI bf16x8 pack2(const f32x4 a, const f32x4 b) {
    u32x4 w; w.x = pk2(a[0], a[1]); w.y = pk2(a[2], a[3]); w.z = pk2(b[0], b[1]); w.w = pk2(b[2], b[3]);
    return __builtin_bit_cast(bf16x8, w);
}
DI void st_bf16x4(LAS bf16* p, float a, float b, float c, float d) { u32x2 w; w.x = pk2(a, b); w.y = pk2(c, d); *(LAS u32x2*)p = w; }
constexpr int LDQ = 136, LDT = 72;
DI int swz_idx(int row, int col) { return row * LDT + (((((col >> 3) ^ (row >> 4)) & 7) << 3) | (col & 7)); }
DI bf16x8 frag_nat_sw(const LAS bf16* M, int r0, int k0, int lane) { const int q = lane >> 4; return *(const LAS bf16x8*)(M + (r0 + (lane & 15)) * LDT + ((((k0 >> 3) + q) ^ (r0 >> 4)) & 7) * 8); }
DI bf16x8 frag_perm_sw(const LAS bf16* M, int r0, int k0, int lane) { const int q = lane >> 4, sw = r0 >> 4; const LAS bf16* p = M + (r0 + (lane & 15)) * LDT + 4 * (q & 1);
    const bf16x4 lo = *(const LAS bf16x4*)(p + ((((k0 >> 3) + (q >> 1)) ^ sw) & 7) * 8), hi = *(const LAS bf16x4*)(p + ((((k0 >> 3) + 2 + (q >> 1)) ^ sw) & 7) * 8);
    return __builtin_shufflevector(lo, hi, 0, 1, 2, 3, 4, 5, 6, 7); }
#define LDSBAR() do { asm volatile("s_waitcnt lgkmcnt(0)" ::: "memory"); __builtin_amdgcn_s_barrier(); asm volatile("" ::: "memory"); } while (0)
#ifndef WODD_KEEP
#define WODD_KEEP 288
#endif
constexpr int WODD_P0 = 64 * WODD_KEEP;
struct Ctx {
    LAS unsigned char* lds;
    const float* const* in;
    unsigned char* ws;
    float* out;
    int tid, lane, wave, bid, G;
};
DI void p0_transpose_pair(const float* W, int K, int N, bf16* WT, LAS float* scr, int item0, int item1, int lane) {
    const int nblk = N / 32;
    float va[32], vb[32];
    { const int kb = item0 / nblk, nb = item0 % nblk; const float* src = W + (size_t)(64 * kb + (lane >> 5)) * N + 32 * nb + (lane & 31);
#pragma unroll
      for (int i = 0; i < 32; ++i) va[i] = __builtin_nontemporal_load(src + (size_t)(2 * i) * N); }
    if (item1 >= 0) { const int kb = item1 / nblk, nb = item1 % nblk; const float* src = W + (size_t)(64 * kb + (lane >> 5)) * N + 32 * nb + (lane & 31);
#pragma unroll
      for (int i = 0; i < 32; ++i) vb[i] = __builtin_nontemporal_load(src + (size_t)(2 * i) * N); }
#pragma unroll
    for (int half = 0; half < 2; ++half) { const int item = half ? item1 : item0; if (item < 0) break;
        const int kb = item / nblk, nb = item % nblk, k0 = 64 * kb, n0 = 32 * nb;
#pragma unroll
        for (int i = 0; i < 32; ++i) scr[(2 * i + (lane >> 5)) * 33 + (lane & 31)] = half ? vb[i] : va[i];
        asm volatile("s_waitcnt lgkmcnt(0)" ::: "memory");
        const int c = lane & 7;
#pragma unroll
        for (int j = 0; j < 4; ++j) { const int n = (lane >> 3) + 8 * j; const LAS float* s = scr + (8 * c) * 33 + n;
            u32x4 o; o.x = pk2(s[0 * 33], s[1 * 33]); o.y = pk2(s[2 * 33], s[3 * 33]); o.z = pk2(s[4 * 33], s[5 * 33]); o.w = pk2(s[6 * 33], s[7 * 33]);
            *(u32x4*)(WT + (size_t)(n0 + n) * K + k0 + 8 * c) = o; }
        asm volatile("s_waitcnt lgkmcnt(0)" ::: "memory"); }
}
DI void p0_transpose_range(const float* W, int K, int N, bf16* WT, LAS float* scr, int first, int stride, int total, int lane) {
    for (int it = first; it < total; it += 2 * stride) p0_transpose_pair(W, K, N, WT, scr, it, it + stride < total ? it + stride : -1, lane);
}
DI void p0_adaln_item(const Ctx& F, const float* w_ada, const float* c, const float* c_ctx, int item) {
    const int li = item / 384, rem = item % 384, strip = rem >> 3, kseg = rem & 7;
    const float* W = w_ada + (size_t)li * 4096 * 12288 + strip * 256 + F.lane * 4;
    const int k0 = kseg * 512 + F.wave * 64;
    f32x4 a0 = {0.f, 0.f, 0.f, 0.f}, a1 = a0, a2 = a0;
#pragma unroll 8
    for (int kk = 0; kk < 64; ++kk) { const int k = k0 + kk;
        const float s0 = siluf_(c_ctx[k]), s1 = siluf_(c[k]), s2 = siluf_(c[4096 + k]);
        const f32x4 w = __builtin_nontemporal_load((const f32x4*)(W + (size_t)k * 12288));
        a0 += s0 * w; a1 += s1 * w; a2 += s2 * w; }
    LAS float* scr = (LAS float*)F.lds;
    *(LAS f32x4*)(scr + F.wave * 768 + 0 * 256 + F.lane * 4) = a0;
    *(LAS f32x4*)(scr + F.wave * 768 + 1 * 256 + F.lane * 4) = a1;
    *(LAS f32x4*)(scr + F.wave * 768 + 2 * 256 + F.lane * 4) = a2;
    __syncthreads();
    float* modp = (float*)(F.ws + WS_MODP);
    for (int o = F.tid; o < 768; o += 512) { float s = 0.f;
#pragma unroll
        for (int w = 0; w < 8; ++w) s += scr[w * 768 + o];
        const int r = o >> 8, ci = o & 255;
        modp[((size_t)(kseg * 2 + li) * 3 + r) * 12288 + strip * 256 + ci] = s; }
    __syncthreads();
}
DI void p0_hdn_item(const float* w1, const float* b1, const float* freq, const float* w2, const float* b2, int L, int p, float* out, int lane) {
    const float t = (float)p / (float)(L - 1);
    float zk = 0.f;
    if (lane == 0) zk = t;
    else if (lane <= 32) { const int b = (lane - 1) & 15; const float band = 1e-4f + (float)b * ((15.0f - 1e-4f) / 15.0f);
        const float ang = (6.283185307179586f / (float)L) * (float)p * band; zk = (lane <= 16) ? cosf(ang) : -sinf(ang); }
    float a = b1[lane];
#pragma unroll
    for (int k = 0; k < 33; ++k) a += __shfl(zk, k) * w1[k * 64 + lane];
    const float h1 = sinf(freq[lane] * a);
    float a2 = b2[lane];
#pragma unroll 16
    for (int k = 0; k < 64; ++k) a2 += __shfl(h1, k) * w2[k * 64 + lane];
    out[lane] = sinf(freq[64 + lane] * a2);
}
DI void p0_filter_item(const Ctx& F, const float* hdn, const float* w3, float* HF, float* HNRM, int L, int cg) {
    LAS float* wl = (LAS float*)F.lds;
    LAS float* red = wl + 2048;
    for (int e = F.tid; e < 2048; e += 512) { const int k = e >> 5, x = e & 31, dir = x >> 4, ord = (x >> 3) & 1, cc = x & 7;
        wl[e] = w3[(size_t)k * 8192 + dir * 4096 + ord * 2048 + cg * 8 + cc]; }
    __syncthreads();
    float asum[16];
#pragma unroll
    for (int i = 0; i < 16; ++i) asum[i] = 0.f;
    const float tinv = 1.0f / (float)(L - 1);
    float dl2[8];
#pragma unroll
    for (int cc = 0; cc < 8; ++cc) dl2[cc] = 1.4426950408889634f * fabsf(-3.0701134573253945f + (-15.350567286626972f + 3.0701134573253945f) * ((float)(cg * 8 + cc) * (1.0f / 2047.0f)));
    const int half = L > 512 ? L / 2 : L;
    for (int p = F.tid; p < half; p += 512) { const bool two = (L > 512); const int p1 = two ? p + half : p;
        float acc0[32], acc1[32];
#pragma unroll
        for (int i = 0; i < 32; ++i) { acc0[i] = 0.f; acc1[i] = 0.f; }
        const f32x4* hp0 = (const f32x4*)(hdn + (size_t)p * 64); const f32x4* hp1 = (const f32x4*)(hdn + (size_t)p1 * 64);
#pragma unroll 2
        for (int k4 = 0; k4 < 16; ++k4) { const f32x4 hv0 = hp0[k4], hv1 = hp1[k4];
#pragma unroll
            for (int kk = 0; kk < 4; ++kk) { const float h0 = hv0[kk], h1 = hv1[kk]; const LAS f32x4* wr = (const LAS f32x4*)(wl + (k4 * 4 + kk) * 32);
#pragma unroll
                for (int x4 = 0; x4 < 8; ++x4) { const f32x4 w = wr[x4];
                    acc0[x4 * 4 + 0] += h0 * w[0]; acc0[x4 * 4 + 1] += h0 * w[1]; acc0[x4 * 4 + 2] += h0 * w[2]; acc0[x4 * 4 + 3] += h0 * w[3];
                    acc1[x4 * 4 + 0] += h1 * w[0]; acc1[x4 * 4 + 1] += h1 * w[1]; acc1[x4 * 4 + 2] += h1 * w[2]; acc1[x4 * 4 + 3] += h1 * w[3]; } } }
#pragma unroll
        for (int pp = 0; pp < 2; ++pp) { if (pp == 1 && !two) break; const int q = pp ? p1 : p; const float t = (float)q * tinv;
            float win[8];
#pragma unroll
            for (int cc = 0; cc < 8; ++cc) win[cc] = __builtin_amdgcn_exp2f(-t * dl2[cc]);
#pragma unroll
            for (int x = 0; x < 32; ++x) { const int dir = x >> 4, ord = (x >> 3) & 1, cc = x & 7, c = cg * 8 + cc;
                const float val = (pp ? acc1[x] : acc0[x]) * win[cc];
                float* row = HF + ((size_t)ord * 2048 + c) * (size_t)(2 * L);
                if (dir == 0) { row[q] = val; asum[ord * 8 + cc] += fabsf(val); if (q == 0) row[L] = 0.f; }
                else if (q >= 1) { row[2 * L - q] = val; asum[ord * 8 + cc] += fabsf(val); } } }
    }
#pragma unroll
    for (int i = 0; i < 16; ++i) { const float s = wave_sum(asum[i]); if (F.lane == 0) red[F.wave * 16 + i] = s; }
    __syncthreads();
    if (F.tid < 16) { float s = 0.f;
#pragma unroll
        for (int w = 0; w < 8; ++w) s += red[w * 16 + F.tid];
        const int ord = F.tid >> 3, cc = F.tid & 7; HNRM[ord * 2048 + cg * 8 + cc] = 1.0f / s; }
    __syncthreads();
}
DI void phase_p0(const Ctx& F, const float* const* in) {
    const int gw = F.bid * 8 + F.wave, NGW = F.G * 8;
    for (int it = F.bid; it < 768; it += F.G) p0_adaln_item(F, in[8], in[5], in[6], it);
    LAS float* scr = (LAS float*)(F.lds + F.wave * 16384);
    constexpr int I_E = 64 * (IN_EVEN / 32);
    p0_transpose_range(in[12], 4096, IN_EVEN, (bf16*)(F.ws + WS_WTE), scr, gw, NGW, I_E, F.lane);
    p0_transpose_range(in[22], 4096, IN_ODD, (bf16*)(F.ws + WS_WTO), scr, gw, NGW, WODD_P0, F.lane);
    { u32x4* z = (u32x4*)((bf16*)(F.ws + WS_WTE) + (size_t)IN_EVEN * 4096); const u32x4 zero = {0u, 0u, 0u, 0u};
      for (int i = F.bid * 512 + F.tid; i < (LD_EVEN - IN_EVEN) * 4096 / 8; i += F.G * 512) z[i] = zero; }
    { float* pe = (float*)(F.ws + WS_PE);
      for (int i = F.bid * 512 + F.tid; i < 65536; i += F.G * 512) { const int v = i >> 10, j = i & 1023;
          const float omega = 1.0f / powf(10000.0f, (float)j / 1024.0f); const float ang = (float)v * omega;
          pe[2 * i] = sinf(ang); pe[2 * i + 1] = cosf(ang); } }
    { float* hdn = (float*)(F.ws + WS_HDN);
      for (int it = gw; it < 256 + 4096; it += NGW) { const int L = it < 256 ? 256 : 4096, p = it < 256 ? it : it - 256;
          p0_hdn_item(in[24], in[25], in[26], in[27], in[28], L, p, hdn + (size_t)it * 64, F.lane); } }
}
DI void phase_p0c(const Ctx& F, const float* const* in) {
    { const float* modp = (const float*)(F.ws + WS_MODP); float* modf = (float*)(F.ws + WS_MODF);
      for (int i = F.bid * 512 + F.tid; i < 2 * 3 * 4096; i += F.G * 512) { const int li = i / 12288, r = (i / 4096) % 3, cc = i & 4095;
          float sh = in[9][li * 12288 + cc], sc = in[9][li * 12288 + 4096 + cc], gt = in[9][li * 12288 + 8192 + cc];
#pragma unroll
          for (int ks = 0; ks < 8; ++ks) { const float* m = modp + ((size_t)(ks * 2 + li) * 3 + r) * 12288; sh += m[cc]; sc += m[4096 + cc]; gt += m[8192 + cc]; }
          float* o = modf + (size_t)(li * 9 + r) * 4096;
          o[cc] = in[7][li * 4096 + cc] * (1.0f + sc); o[3 * 4096 + cc] = sh; o[6 * 4096 + cc] = gt; } }
}
DI void phase_filters(const Ctx& F, const float* const* in, int w, int nw) {
    __syncthreads();
    for (int it = w; it < 512; it += nw) { const int cg = it & 255, li = it >> 8;
        const float* hdn = (const float*)(F.ws + WS_HDN) + (li ? (size_t)256 * 64 : 0);
        p0_filter_item(F, hdn, in[29], (float*)(F.ws + (li ? WS_HF4096 : WS_HF256)), (float*)(F.ws + WS_HNRM) + li * 4096, li ? 4096 : 256, cg); }
}
DI void convert_wout(const Ctx& F, const float* const* in, int w, int nw, int li) {
    __syncthreads();
    LAS float* scr = (LAS float*)(F.lds + F.wave * 16384);
    p0_transpose_range(in[10] + (size_t)li * 4096 * 4096, 4096, 4096, (bf16*)(F.ws + WS_WTOUT) + (size_t)li * 4096 * 4096, scr, w * 8 + F.wave, nw * 8, 8192, F.lane);
}
DI void convert_wodd(const Ctx& F, const float* const* in, int w, int nw) {
    __syncthreads();
    LAS float* scr = (LAS float*)(F.lds + F.wave * 16384);
    p0_transpose_range(in[22], 4096, IN_ODD, (bf16*)(F.ws + WS_WTO), scr, WODD_P0 + w * 8 + F.wave, nw * 8, 64 * (IN_ODD / 32), F.lane);
}
constexpr int LDX = 8192;
DI bf16* xr_base(const Ctx& F) { return (bf16*)F.out + 4096; }
template <int MODE> DI void phase_norm(const Ctx& F, const float* const* in) {
    const int gw = F.bid * 8 + F.wave, NGW = F.G * 8;
    bf16* H = (bf16*)(F.ws + WS_H); const float* pe = (const float*)(F.ws + WS_PE); bf16* XR = xr_base(F);
    f32x4 ra[MODE == 0 ? 8 : 1], rb[MODE == 0 ? 8 : 1]; u32x4 rw[MODE == 0 ? 1 : 8];
#define NORM_LOAD(row_) do { if (MODE == 0) { const float* src_ = (row_) < 4096 ? in[0] + (size_t)(row_) * DM : in[1] + (size_t)((row_) - 4096) * DM; \
            _Pragma("unroll") for (int j_ = 0; j_ < 8; ++j_) { ra[MODE == 0 ? j_ : 0] = __builtin_nontemporal_load((const f32x4*)(src_ + j_ * 512 + F.lane * 8)); rb[MODE == 0 ? j_ : 0] = __builtin_nontemporal_load((const f32x4*)(src_ + j_ * 512 + F.lane * 8 + 4)); } } \
        else { _Pragma("unroll") for (int j_ = 0; j_ < 8; ++j_) rw[MODE == 0 ? 0 : j_] = *(const u32x4*)(XR + (size_t)(row_) * LDX + j_ * 512 + F.lane * 8); } } while (0)
    if (gw < NROWS) NORM_LOAD(gw);
#pragma unroll 1
    for (int row = gw; row < NROWS; row += NGW) {
        const int r = row < 4096 ? 0 : 1 + ((row - 4096) >> 12);
        const int t = (row - 4096) & 4095, gr = t >> 6, gc = t & 63;
        float v[8][8]; float ss = 0.f;
        if (MODE == 0) {
#pragma unroll
            for (int j = 0; j < 8; ++j) { const int col = j * 512 + F.lane * 8; const f32x4 a = ra[MODE == 0 ? j : 0], b = rb[MODE == 0 ? j : 0];
                v[j][0] = a[0]; v[j][1] = a[1]; v[j][2] = a[2]; v[j][3] = a[3]; v[j][4] = b[0]; v[j][5] = b[1]; v[j][6] = b[2]; v[j][7] = b[3];
                if (row >= 4096) { const int q4 = j >> 1, jj = col & 1023, vv = (q4 < 2) ? gr : gc, comp = q4 & 1;
                    const f32x4* pp = (const f32x4*)(pe + ((size_t)vv * 1024 + jj) * 2);
#pragma unroll
                    for (int e2 = 0; e2 < 4; ++e2) { const f32x4 p = pp[e2]; v[j][2 * e2] += comp ? p[1] : p[0]; v[j][2 * e2 + 1] += comp ? p[3] : p[2]; } } }
        } else {
#pragma unroll
            for (int j = 0; j < 8; ++j) unpack8(rw[MODE == 0 ? 0 : j], v[j]); }
        if (row + NGW < NROWS) NORM_LOAD(row + NGW);
#pragma unroll
        for (int j = 0; j < 8; ++j)
#pragma unroll
            for (int e = 0; e < 8; ++e) ss += v[j][e] * v[j][e];
        const float rstd = __builtin_amdgcn_rsqf(wave_sum(ss) * (1.0f / DM) + EPS);
        if (MODE == 2) { float* yo = F.out + (size_t)row * DM;
#pragma unroll
            for (int j = 0; j < 8; ++j) { const int col = j * 512 + F.lane * 8; const f32x4 g0 = *(const f32x4*)(in[11] + col), g1 = *(const f32x4*)(in[11] + col + 4);
                __builtin_nontemporal_store((f32x4){v[j][0] * rstd * g0[0], v[j][1] * rstd * g0[1], v[j][2] * rstd * g0[2], v[j][3] * rstd * g0[3]}, (f32x4*)(yo + col));
                __builtin_nontemporal_store((f32x4){v[j][4] * rstd * g1[0], v[j][5] * rstd * g1[1], v[j][6] * rstd * g1[2], v[j][7] * rstd * g1[3]}, (f32x4*)(yo + col + 4)); }
        } else {
            const float* A = (const float*)(F.ws + WS_MODF) + (size_t)((MODE == 1 ? 9 : 0) + r) * 4096;
#pragma unroll
            for (int j = 0; j < 8; ++j) { const int col = j * 512 + F.lane * 8;
                const f32x4 a0 = *(const f32x4*)(A + col), a1 = *(const f32x4*)(A + col + 4), b0 = *(const f32x4*)(A + 3 * 4096 + col), b1 = *(const f32x4*)(A + 3 * 4096 + col + 4);
                u32x4 w; w.x = pk2(v[j][0] * rstd * a0[0] + b0[0], v[j][1] * rstd * a0[1] + b0[1]); w.y = pk2(v[j][2] * rstd * a0[2] + b0[2], v[j][3] * rstd * a0[3] + b0[3]);
                w.z = pk2(v[j][4] * rstd * a1[0] + b1[0], v[j][5] * rstd * a1[1] + b1[1]); w.w = pk2(v[j][6] * rstd * a1[2] + b1[2], v[j][7] * rstd * a1[3] + b1[3]);
                *(u32x4*)(H + (size_t)row * DM + col) = w;
                if (MODE == 0) { u32x4 x; x.x = pk2(v[j][0], v[j][1]); x.y = pk2(v[j][2], v[j][3]); x.z = pk2(v[j][4], v[j][5]); x.w = pk2(v[j][6], v[j][7]);
                    *(u32x4*)(XR + (size_t)row * LDX + col) = x; } }
        }
    }
}
#undef NORM_LOAD

DI void conv3_load(const bf16* Urow, size_t ld, int t, int len, u32x4* r) {
    const u32x4 z = {0u, 0u, 0u, 0u};
    const u32x4* p0 = (const u32x4*)Urow; r[2] = p0[0]; r[3] = p0[1];
    if (t > 0) { const u32x4* p = (const u32x4*)(Urow - ld); r[0] = p[0]; r[1] = p[1]; } else { r[0] = z; r[1] = z; }
    if (t + 1 < len) { const u32x4* p = (const u32x4*)(Urow + ld); r[4] = p[0]; r[5] = p[1]; } else { r[4] = z; r[5] = z; }
}
DI void conv3_calc(const u32x4* r, const LAS float* cw, int cstride, float* o) {
#pragma unroll
    for (int hf = 0; hf < 2; ++hf) { float xm[8], x0[8], xp[8]; unpack8(r[hf], xm); unpack8(r[2 + hf], x0); unpack8(r[4 + hf], xp);
#pragma unroll
        for (int e4 = 0; e4 < 2; ++e4) { const int c = hf * 8 + e4 * 4; const f32x4 w0 = *(const LAS f32x4*)(cw + c), w1 = *(const LAS f32x4*)(cw + cstride + c), w2 = *(const LAS f32x4*)(cw + 2 * cstride + c);
#pragma unroll
            for (int e = 0; e < 4; ++e) o[c + e] = w0[e] * xm[e4 * 4 + e] + w1[e] * x0[e4 * 4 + e] + w2[e] * xp[e4 * 4 + e]; } }
}
#define SCHED_FENCE() __builtin_amdgcn_sched_barrier(0)
DI float wave_scan_incl(float v, int lane) {
#pragma unroll
    for (int o = 1; o < 64; o <<= 1) { const float u = __shfl_up(v, o); if (lane >= o) v += u; }
    return v;
}

DI void gdn_prep_request(const Ctx& F, int c64, int h, u32x4 (&rq_)[6], u32x4 (&rk_)[6], u32x4 (&rv_)[6], unsigned& rgate) {
    const bf16* U = (const bf16*)(F.ws + WS_U);
    const int r0 = c64 * 64, len = r0 < 4096 ? 256 : 4096, t0 = r0 < 4096 ? (r0 & 255) : ((r0 - 4096) & 4095);
    const int i = F.tid >> 3, sub = F.tid & 7, t = t0 + i;
    const bf16* ur = U + (size_t)(r0 + i) * LD_EVEN;
    conv3_load(ur + E_QKV + h * 128 + sub * 16, LD_EVEN, t, len, rq_);
    conv3_load(ur + E_QKV + 2048 + h * 128 + sub * 16, LD_EVEN, t, len, rk_);
    conv3_load(ur + E_QKV + 4096 + h * 128 + sub * 16, LD_EVEN, t, len, rv_);
    rgate = (unsigned)ur[E_BETA + (sub & 1) * 16 + h] | ((unsigned)ur[E_A + (sub & 1) * 16 + h] << 16);
}
DI void gdn_prep_item(const Ctx& F, const float* const* in, int c64, int h, bool stage_cw, u32x4 (&rq_)[6], u32x4 (&rk_)[6], u32x4 (&rv_)[6], unsigned& rgate, int next_c64) {
    LAS bf16* Q = (LAS bf16*)(F.lds + 0);
    LAS bf16* K = (LAS bf16*)(F.lds + 17408);
    LAS bf16* KT = (LAS bf16*)(F.lds + 34816);
    LAS bf16* VT = (LAS bf16*)(F.lds + 53248);
    LAS float* KKR = (LAS float*)(F.lds + 71680);
    LAS float* QKR = (LAS float*)(F.lds + 89088);
    LAS bf16* NN = (LAS bf16*)(F.lds + 106496);
    LAS float* NDG = (LAS float*)(F.lds + 115712);
    LAS bf16* DBK = (LAS bf16*)(F.lds + 119808);
    LAS bf16* W = (LAS bf16*)(F.lds + 124928);
    LAS float* TBL = (LAS float*)(F.lds + 142336);
    LAS float* CW = TBL + 384;
    constexpr int LDD = 40, LDR = 68;
    const bf16* U = (const bf16*)(F.ws + WS_U);
    const int r0 = c64 * 64, len = r0 < 4096 ? 256 : 4096, t0 = r0 < 4096 ? (r0 & 255) : ((r0 - 4096) & 4095);
    const int lane_o = F.lane, wave = F.wave;
    LDSBAR();
    if (stage_cw) {
        for (int e = F.tid; e < 3 * 384; e += 512) { const int tap = e / 384, c = e % 384; CW[e] = in[13][tap * 6144 + (c >> 7) * 2048 + h * 128 + (c & 127)]; }
        for (int e = F.tid; e < 4 * 16 * LDD / 2; e += 512) ((LAS unsigned*)DBK)[e] = 0u;
        LDSBAR(); }
    int lane = lane_o; asm volatile("" : "+v"(lane)); const int l15 = lane & 15, q4 = lane >> 4;
    { const int i = F.tid >> 3, sub = F.tid & 7;
      const bf16* ur = U + (size_t)(r0 + i) * LD_EVEN;
      SCHED_FENCE();
      { float qv[16]; conv3_calc(rq_, CW + sub * 16, 384, qv); float sq = 0.f;
#pragma unroll
        for (int e = 0; e < 16; ++e) { qv[e] = siluf_(qv[e]); sq += qv[e] * qv[e]; }
        sq += __shfl_xor(sq, 1); sq += __shfl_xor(sq, 2); sq += __shfl_xor(sq, 4);
        const float rq = 0.08838834764831845f * __builtin_amdgcn_rsqf(sq + EPS);
        u32x4 g0, g1; g0.x = pk2(qv[0] * rq, qv[1] * rq); g0.y = pk2(qv[2] * rq, qv[3] * rq); g0.z = pk2(qv[4] * rq, qv[5] * rq); g0.w = pk2(qv[6] * rq, qv[7] * rq);
        g1.x = pk2(qv[8] * rq, qv[9] * rq); g1.y = pk2(qv[10] * rq, qv[11] * rq); g1.z = pk2(qv[12] * rq, qv[13] * rq); g1.w = pk2(qv[14] * rq, qv[15] * rq);
        *(LAS u32x4*)(Q + i * LDQ + sub * 16) = g0; *(LAS u32x4*)(Q + i * LDQ + sub * 16 + 8) = g1;
        u32x4* gq = (u32x4*)((bf16*)(F.ws + WS_GQN) + (size_t)(r0 + i) * 2048 + h * 128 + sub * 16); gq[0] = g0; gq[1] = g1; }
      SCHED_FENCE();
      { float kv[16]; conv3_calc(rk_, CW + 128 + sub * 16, 384, kv); float sk = 0.f;
#pragma unroll
        for (int e = 0; e < 16; ++e) { kv[e] = siluf_(kv[e]); sk += kv[e] * kv[e]; }
        sk += __shfl_xor(sk, 1); sk += __shfl_xor(sk, 2); sk += __shfl_xor(sk, 4);
        const float rk = __builtin_amdgcn_rsqf(sk + EPS);
#pragma unroll
        for (int e = 0; e < 16; ++e) kv[e] *= rk;
#pragma unroll
        for (int e = 0; e < 16; e += 4) st_bf16x4(K + i * LDQ + sub * 16 + e, kv[e], kv[e + 1], kv[e + 2], kv[e + 3]);
#pragma unroll
        for (int e = 0; e < 16; ++e) KT[swz_idx(sub * 16 + e, i)] = f2bf(kv[e]); }
      SCHED_FENCE();
      { float vv[16]; conv3_calc(rv_, CW + 256 + sub * 16, 384, vv);
#pragma unroll
        for (int e = 0; e < 16; ++e) VT[swz_idx(sub * 16 + e, i)] = f2bf(siluf_(vv[e])); }
      SCHED_FENCE();
      if (sub < 2) { const int d = sub; const float braw = bf2f((bf16)(rgate & 0xffffu)), araw = bf2f((bf16)(rgate >> 16));
          const int ii = d ? 63 - i : i;
          TBL[d * 192 + ii] = -expf(in[14][d * 16 + h]) * softplusf_(araw + in[15][d * 16 + h]); TBL[d * 192 + 64 + ii] = sigmoidf_(braw); } }
    LDSBAR();
    if (wave < 2) TBL[wave * 192 + 128 + lane] = wave_scan_incl(TBL[wave * 192 + lane], lane);
    { bf16* ktg = (bf16*)(F.ws + WS_GKT) + (size_t)h * 128 * NROWS + r0;
#pragma unroll
      for (int k = 0; k < 2; ++k) { const int e = F.tid + 512 * k, row = e >> 3, pc = e & 7;
          *(u32x4*)(ktg + (size_t)row * NROWS + pc * 8) = *(const LAS u32x4*)(KT + row * LDT + ((pc ^ (row >> 4)) & 7) * 8); } }
#pragma unroll
    for (int tt = 0; tt < 2; ++tt) { const int id = 2 * wave + tt, ti = id >> 2, tj = id & 3;
        f32x4 akk = {0.f, 0.f, 0.f, 0.f}, aqk = akk;
#pragma unroll
        for (int ks = 0; ks < 4; ++ks) { const bf16x8 bk = frag_nat(K, LDQ, tj * 16, ks * 32, lane);
            akk = MFMA16(bk, frag_nat(K, LDQ, ti * 16, ks * 32, lane), akk);
            aqk = MFMA16(bk, frag_nat(Q, LDQ, ti * 16, ks * 32, lane), aqk); }
        *(LAS f32x4*)(KKR + (ti * 16 + l15) * LDR + tj * 16 + 4 * q4) = akk; *(LAS f32x4*)(QKR + (ti * 16 + l15) * LDR + tj * 16 + 4 * q4) = aqk; }
    LDSBAR();
#pragma unroll
    for (int d = 0; d < 2; ++d) {
        const size_t item = ((size_t)c64 * 16 + h) * 2 + d;
        const LAS float* TB_ = TBL + d * 192;
        if (d == 1 && next_c64 >= 0) { gdn_prep_request(F, next_c64, h, rq_, rk_, rv_, rgate); }
#pragma unroll
        for (int tt = 0; tt < 2; ++tt) { const int id = 2 * wave + tt, ti = id >> 2, tj = id & 3;
            const int i = ti * 16 + l15, j0 = tj * 16 + 4 * q4;
            f32x4 kk, qk;
            if (d == 0) { kk = *(const LAS f32x4*)(KKR + i * LDR + j0); qk = *(const LAS f32x4*)(QKR + i * LDR + j0); }
            else { const f32x4 a = *(const LAS f32x4*)(KKR + (63 - i) * LDR + 60 - j0), b = *(const LAS f32x4*)(QKR + (63 - i) * LDR + 60 - j0);
                kk = (f32x4){a[3], a[2], a[1], a[0]}; qk = (f32x4){b[3], b[2], b[1], b[0]}; }
            const float gi = TB_[128 + i], bi = TB_[64 + i];
            float nv[4], pv[4];
#pragma unroll
            for (int r = 0; r < 4; ++r) { const int j = j0 + r; const float dec = (i >= j) ? __expf(gi - TB_[128 + j]) : 0.f;
                nv[r] = (i > j) ? bi * kk[r] * dec : 0.f; pv[r] = qk[r] * dec; }
            st_bf16x4(NN + i * LDT + j0, -nv[0], -nv[1], -nv[2], -nv[3]);
            { u32x2 w2; w2.x = pk2(pv[0], pv[1]); w2.y = pk2(pv[2], pv[3]); *(u32x2*)((bf16*)(F.ws + WS_GPP) + (item * 64 + i) * 64 + j0) = w2; }
            if (ti == tj) *(LAS f32x4*)(NDG + (ti * 16 + l15) * 16 + 4 * q4) = (f32x4){nv[0], nv[1], nv[2], nv[3]}; }
        if (wave == 1) ((float*)(F.ws + WS_GGC))[item * 64 + lane] = TB_[128 + lane];
        LDSBAR();
        if (wave == 0) { float x[16];
#pragma unroll
            for (int i = 0; i < 16; ++i) { float sa[4] = {0.f, 0.f, 0.f, 0.f};
                const LAS f32x4* nr = (const LAS f32x4*)(NDG + (q4 * 16 + i) * 16);
#pragma unroll
                for (int k4 = 0; k4 < 4; ++k4) { if (4 * k4 < i) { const f32x4 nvv = nr[k4];
#pragma unroll
                        for (int e = 0; e < 4; ++e) if (4 * k4 + e < i) sa[e] += nvv[e] * x[4 * k4 + e]; } }
                const float a = ((i == l15) ? 1.f : 0.f) - ((sa[0] + sa[1]) + (sa[2] + sa[3]));
                x[i] = a; DBK[(q4 * 16 + i) * LDD + l15] = f2bf(a); } }
        LDSBAR();
        { f32x4 u[4], xw[4]; const f32x4 z4 = {0.f, 0.f, 0.f, 0.f};
#pragma unroll
          for (int b = 0; b < 4; ++b) {
              const f32x4 be = *(const LAS f32x4*)(TB_ + 64 + 16 * b + 4 * q4), gcv = *(const LAS f32x4*)(TB_ + 128 + 16 * b + 4 * q4);
              const int c0 = d ? 60 - 16 * b - 4 * q4 : 16 * b + 4 * q4;
              const bf16x4 vraw = *(const LAS bf16x4*)(VT + swz_idx(16 * wave + l15, c0)), kraw = *(const LAS bf16x4*)(KT + swz_idx(16 * wave + l15, c0));
              f32x4 au, aw;
#pragma unroll
              for (int r = 0; r < 4; ++r) { const int rr = d ? 3 - r : r; au[r] = be[r] * bf2f((bf16)vraw[rr]); aw[r] = be[r] * __expf(gcv[r]) * bf2f((bf16)kraw[rr]); }
              if (b >= 1) { const bf16x8 nf = frag_perm(NN, LDT, 16 * b, 0, lane);
                  au = MFMA16(nf, pack2(u[0], b >= 2 ? u[1] : z4), au); aw = MFMA16(nf, pack2(xw[0], b >= 2 ? xw[1] : z4), aw); }
              if (b == 3) { const bf16x8 nf = frag_perm(NN, LDT, 48, 32, lane);
                  au = MFMA16(nf, pack2(u[2], z4), au); aw = MFMA16(nf, pack2(xw[2], z4), aw); }
              const bf16x8 df = frag_perm(DBK + b * 16 * LDD, LDD, 0, 0, lane);
              u[b] = MFMA16(df, pack2(au, z4), z4); xw[b] = MFMA16(df, pack2(aw, z4), z4);
              { u32x2 w2; w2.x = pk2(u[b][0], u[b][1]); w2.y = pk2(u[b][2], u[b][3]);
                *(u32x2*)((bf16*)(F.ws + WS_GUF) + (((item * 8 + wave) * 4 + b) * 64 + lane) * 4) = w2; }
#pragma unroll
              for (int r = 0; r < 4; ++r) W[(16 * b + 4 * q4 + r) * LDQ + 16 * wave + l15] = f2bf(-xw[b][r]); } }
        LDSBAR();
        { bf16* wg = (bf16*)(F.ws + WS_GWN) + item * 8192;
#pragma unroll
          for (int k = 0; k < 2; ++k) { const int e = F.tid + 512 * k, row = e >> 4, pc = e & 15;
              *(u32x4*)(wg + row * 128 + pc * 8) = *(const LAS u32x4*)(W + row * LDQ + pc * 8); } }
    }
}

#define GDN_SETB 79872
DI void gdn_scan_step(const Ctx& F, f32x4 (&S)[2][8], int set, int ci, int d, int len, int row0, int h, bf16* OUT) {
    const int wave = F.wave;
    int lane = F.lane; asm volatile("" : "+v"(lane)); const int l15 = lane & 15, q4 = lane >> 4;
    LAS bf16* W = (LAS bf16*)(F.lds + set * GDN_SETB); LAS bf16* Q = (LAS bf16*)(F.lds + set * GDN_SETB + 17408); LAS bf16* PB = (LAS bf16*)(F.lds + set * GDN_SETB + 34816);
    LAS bf16* KT = (LAS bf16*)(F.lds + set * GDN_SETB + 44032); LAS float* GC = (LAS float*)(F.lds + set * GDN_SETB + 62464); const LAS bf16* UL = (const LAS bf16*)(F.lds + set * GDN_SETB + 63488);
#define LQ(dst, M, it) do { _Pragma("unroll") for (int i_ = 0; i_ < 4; ++i_) dst[i_] = frag_perm(M, LDQ, (it) * 16, i_ * 32, lane); SCHED_FENCE(); } while (0)
#define LT(dst, M, t0) do { _Pragma("unroll") for (int i_ = 0; i_ < 4; ++i_) dst[i_] = frag_perm(M, LDT, ((t0) + (i_ >> 1)) * 16, (i_ & 1) * 32, lane); SCHED_FENCE(); } while (0)
#define CVN(X, it) do { _Pragma("unroll") for (int ks = 0; ks < 4; ++ks) { vn[0][it] = MFMA16(X[ks], Sp[0][ks], vn[0][it]); vn[1][it] = MFMA16(X[ks], Sp[1][ks], vn[1][it]); } SCHED_FENCE(); } while (0)
#define CO(X, j) do { _Pragma("unroll") for (int ks = 0; ks < 4; ++ks) { o[0][j] = MFMA16(Sp[0][ks], X[ks], o[0][j]); o[1][j] = MFMA16(Sp[1][ks], X[ks], o[1][j]); } SCHED_FENCE(); } while (0)
#define CS(X, t0) do { _Pragma("unroll") for (int ks = 0; ks < 2; ++ks) _Pragma("unroll") for (int j = 0; j < 2; ++j) { S[0][(t0) + j] = MFMA16(X[j * 2 + ks], V2p[0][ks], S[0][(t0) + j]); S[1][(t0) + j] = MFMA16(X[j * 2 + ks], V2p[1][ks], S[1][(t0) + j]); } SCHED_FENCE(); } while (0)
#define CPV(X, it0) do { _Pragma("unroll") for (int j = 0; j < 2; ++j) { const float eg = __expf(GC[((it0) + j) * 16 + l15]); o[0][j] = o[0][j] * eg; o[1][j] = o[1][j] * eg; } \
        _Pragma("unroll") for (int ks = 0; ks < 2; ++ks) _Pragma("unroll") for (int j = 0; j < 2; ++j) { o[0][j] = MFMA16(Vp[0][ks], X[j * 2 + ks], o[0][j]); o[1][j] = MFMA16(Vp[1][ks], X[j * 2 + ks], o[1][j]); } \
        _Pragma("unroll") for (int j = 0; j < 2; ++j) { const int i = ((it0) + j) * 16 + l15; const int tl = ci * 64 + i, t = d ? (len - 1 - tl) : tl; bf16* op = OUT + (size_t)(row0 + t) * 2048 + h * 128 + 32 * wave + 4 * q4; \
            u32x2 w2; w2.x = pk2(o[0][j][0], o[0][j][1]); w2.y = pk2(o[0][j][2], o[0][j][3]); *(u32x2*)op = w2; w2.x = pk2(o[1][j][0], o[1][j][1]); w2.y = pk2(o[1][j][2], o[1][j][3]); *(u32x2*)(op + 16) = w2; \
            o[0][j] = (f32x4){0.f, 0.f, 0.f, 0.f}; o[1][j] = (f32x4){0.f, 0.f, 0.f, 0.f}; } SCHED_FENCE(); } while (0)
    bf16x8 X0[4], X1[4], X2[4];
    f32x4 vn[2][4];
#pragma unroll
    for (int x = 0; x < 2; ++x)
#pragma unroll
        for (int b = 0; b < 4; ++b) { const u32x2 ur = *(const LAS u32x2*)(UL + (((2 * wave + x) * 4 + b) * 64 + lane) * 4);
            vn[x][b][0] = __uint_as_float(ur.x << 16); vn[x][b][1] = __uint_as_float(ur.x & 0xffff0000u); vn[x][b][2] = __uint_as_float(ur.y << 16); vn[x][b][3] = __uint_as_float(ur.y & 0xffff0000u); }
    const float gl = GC[63];
    LQ(X0, W, 0); LQ(X1, W, 1);
    bf16x8 Sp[2][4];
#pragma unroll
    for (int x = 0; x < 2; ++x)
#pragma unroll
        for (int ks = 0; ks < 4; ++ks) Sp[x][ks] = pack2(S[x][2 * ks], S[x][2 * ks + 1]);
    SCHED_FENCE();
    LQ(X2, W, 2); CVN(X0, 0);
    LQ(X0, W, 3); CVN(X1, 1);
    LQ(X1, Q, 0); CVN(X2, 2);
    LQ(X2, Q, 1); CVN(X0, 3);
    bf16x8 Vp[2][2], V2p[2][2];
#pragma unroll
    for (int ks = 0; ks < 2; ++ks) { float e0[4], e1[4];
#pragma unroll
        for (int r = 0; r < 4; ++r) { e0[r] = __expf(gl - GC[(2 * ks) * 16 + 4 * q4 + r]); e1[r] = __expf(gl - GC[(2 * ks + 1) * 16 + 4 * q4 + r]); }
#pragma unroll
        for (int x = 0; x < 2; ++x) { Vp[x][ks] = pack2(vn[x][2 * ks], vn[x][2 * ks + 1]);
            f32x4 a, b;
#pragma unroll
            for (int r = 0; r < 4; ++r) { a[r] = vn[x][2 * ks][r] * e0[r]; b[r] = vn[x][2 * ks + 1][r] * e1[r]; }
            V2p[x][ks] = pack2(a, b); } }
    const float egl = __expf(gl);
    SCHED_FENCE();
    f32x4 o[2][2];
#pragma unroll
    for (int x = 0; x < 2; ++x)
#pragma unroll
        for (int j = 0; j < 2; ++j) o[x][j] = (f32x4){0.f, 0.f, 0.f, 0.f};
    LT(X0, PB, 0); CO(X1, 0);
    LQ(X1, Q, 2); CO(X2, 1);
    LQ(X2, Q, 3); CPV(X0, 0);
    LT(X0, PB, 2); CO(X1, 0);
    LT(X1, KT, 0); CO(X2, 1);
    LT(X2, KT, 2); CPV(X0, 2);
#pragma unroll
    for (int x = 0; x < 2; ++x)
#pragma unroll
        for (int t = 0; t < 8; ++t) S[x][t] = S[x][t] * egl;
    SCHED_FENCE();
    LT(X0, KT, 4); CS(X1, 0);
    LT(X1, KT, 6); CS(X2, 2);
    CS(X0, 4); CS(X1, 6);
#undef LQ
#undef LT
#undef CVN
#undef CO
#undef CS
#undef CPV
}
DI void gdn_scan_item(const Ctx& F, const float* const* in, int s, int h, int d) {
    constexpr int SETB = GDN_SETB;
    const int row0 = seq_row0(s), len = seq_len(s), nch = len >> 6, c640 = row0 >> 6;
    const int lane_o = F.lane, wave = F.wave;
    bf16* OUT = (bf16*)(F.ws + (d ? WS_OBA : WS_OFA));
    const bf16* GWN = (const bf16*)(F.ws + WS_GWN); const bf16* GUF = (const bf16*)(F.ws + WS_GUF); const bf16* GPP = (const bf16*)(F.ws + WS_GPP);
    const float* GGC = (const float*)(F.ws + WS_GGC); const bf16* GQN = (const bf16*)(F.ws + WS_GQN); const bf16* GKT = (const bf16*)(F.ws + WS_GKT) + (size_t)h * 128 * NROWS;
    LDSBAR();
    if (wave >= 4) {
        struct Pre { u32x4 w[4], q[4], p[2], k[4], u[4]; float g; };
        Pre PA, PB_;
        const int e = F.tid - 256, er = e >> 2, eq = e & 3;
#define GDN_ISSUE(ci_, P_) do { const int cc = c640 + (d ? nch - 1 - (ci_) : (ci_)); const size_t item = ((size_t)cc * 16 + h) * 2 + d; \
        const u32x4* wsrc = (const u32x4*)(GWN + item * 8192 + er * 128 + eq * 32); \
        const int qrow = cc * 64 + (d ? 63 - er : er); const u32x4* qsrc = (const u32x4*)(GQN + (size_t)qrow * 2048 + h * 128 + eq * 32); \
        _Pragma("unroll") for (int m_ = 0; m_ < 4; ++m_) { P_.w[m_] = wsrc[m_]; P_.q[m_] = qsrc[m_]; } \
        const u32x4* psrc = (const u32x4*)(GPP + item * 4096 + er * 64 + eq * 16); P_.p[0] = psrc[0]; P_.p[1] = psrc[1]; \
        const u32x4* k0src = (const u32x4*)(GKT + (size_t)er * NROWS + cc * 64 + eq * 16); const u32x4* k1src = (const u32x4*)(GKT + (size_t)(64 + er) * NROWS + cc * 64 + eq * 16); \
        P_.k[0] = k0src[0]; P_.k[1] = k0src[1]; P_.k[2] = k1src[0]; P_.k[3] = k1src[1]; \
        const u32x4* usrc = (const u32x4*)(GUF + item * 8192) + e; _Pragma("unroll") for (int m_ = 0; m_ < 4; ++m_) P_.u[m_] = usrc[m_ * 256]; \
        P_.g = (e < 64) ? GGC[item * 64 + e] : 0.f; } while (0)
#define REV8(w_) ((u32x4){((w_).w >> 16) | ((w_).w << 16), ((w_).z >> 16) | ((w_).z << 16), ((w_).y >> 16) | ((w_).y << 16), ((w_).x >> 16) | ((w_).x << 16)})
#define GDN_COMMIT(set_, P_) do { LAS unsigned char* base = F.lds + (set_) * SETB; \
        _Pragma("unroll") for (int m_ = 0; m_ < 4; ++m_) { *(LAS u32x4*)((LAS bf16*)base + er * LDQ + eq * 32 + m_ * 8) = P_.w[m_]; *(LAS u32x4*)((LAS bf16*)(base + 17408) + er * LDQ + eq * 32 + m_ * 8) = P_.q[m_]; } \
        *(LAS u32x4*)((LAS bf16*)(base + 34816) + er * LDT + eq * 16) = P_.p[0]; *(LAS u32x4*)((LAS bf16*)(base + 34816) + er * LDT + eq * 16 + 8) = P_.p[1]; \
        if (d == 0) { *(LAS u32x4*)((LAS bf16*)(base + 44032) + er * LDT + eq * 16) = P_.k[0]; *(LAS u32x4*)((LAS bf16*)(base + 44032) + er * LDT + eq * 16 + 8) = P_.k[1]; \
            *(LAS u32x4*)((LAS bf16*)(base + 44032) + (64 + er) * LDT + eq * 16) = P_.k[2]; *(LAS u32x4*)((LAS bf16*)(base + 44032) + (64 + er) * LDT + eq * 16 + 8) = P_.k[3]; } \
        else { *(LAS u32x4*)((LAS bf16*)(base + 44032) + er * LDT + (3 - eq) * 16 + 8) = REV8(P_.k[0]); *(LAS u32x4*)((LAS bf16*)(base + 44032) + er * LDT + (3 - eq) * 16) = REV8(P_.k[1]); \
            *(LAS u32x4*)((LAS bf16*)(base + 44032) + (64 + er) * LDT + (3 - eq) * 16 + 8) = REV8(P_.k[2]); *(LAS u32x4*)((LAS bf16*)(base + 44032) + (64 + er) * LDT + (3 - eq) * 16) = REV8(P_.k[3]); } \
        _Pragma("unroll") for (int m_ = 0; m_ < 4; ++m_) *((LAS u32x4*)(base + 63488) + e + m_ * 256) = P_.u[m_]; \
        if (e < 64) ((LAS float*)(base + 62464))[e] = P_.g; } while (0)
        GDN_ISSUE(0, PA); GDN_ISSUE(1, PB_);
#pragma unroll 1
        for (int ci = 0; ci < nch; ci += 2) {
            GDN_COMMIT(0, PA); LDSBAR(); if (ci + 2 < nch) GDN_ISSUE(ci + 2, PA);
            GDN_COMMIT(1, PB_); LDSBAR(); if (ci + 3 < nch) GDN_ISSUE(ci + 3, PB_); }
#undef GDN_ISSUE
#undef GDN_COMMIT
#undef REV8
    } else {
        f32x4 S[2][8];
        if (s >= 16) { int ln = lane_o; asm volatile("" : "+v"(ln)); const int l15 = ln & 15, q4 = ln >> 4; const float* sp = in[2] + ((size_t)((s - 16) * 2 + d) * 16 + h) * 16384;
#pragma unroll
            for (int x = 0; x < 2; ++x)
#pragma unroll
                for (int t = 0; t < 8; ++t)
#pragma unroll
                    for (int r = 0; r < 4; ++r) S[x][t][r] = sp[(size_t)(16 * t + 4 * q4 + r) * 128 + 32 * wave + 16 * x + l15];
        } else {
#pragma unroll
            for (int x = 0; x < 2; ++x)
#pragma unroll
                for (int t = 0; t < 8; ++t) S[x][t] = (f32x4){0.f, 0.f, 0.f, 0.f}; }
#pragma unroll 1
        for (int ci = 0; ci < nch; ci += 2) { LDSBAR(); gdn_scan_step(F, S, 0, ci, d, len, row0, h, OUT); LDSBAR(); gdn_scan_step(F, S, 1, ci + 1, d, len, row0, h, OUT); }
        if (s < 16) { int ln = lane_o; asm volatile("" : "+v"(ln)); const int l15 = ln & 15, q4 = ln >> 4; float* sp = F.out + OUT_SG + ((size_t)(s * 2 + d) * 16 + h) * 16384;
#pragma unroll
            for (int x = 0; x < 2; ++x)
#pragma unroll
                for (int t = 0; t < 8; ++t)
#pragma unroll
                    for (int r = 0; r < 4; ++r) sp[(size_t)(16 * t + 4 * q4 + r) * 128 + 32 * wave + 16 * x + l15] = S[x][t][r]; }
    }
}

DI void ssd_prep_request(const Ctx& F, int c64, int g, u32x4 (&rx0)[6], u32x4 (&rx1)[6], u32x4 (&rb_)[6], u32x4 (&rc_)[6], unsigned& rdt) {
    const bf16* U = (const bf16*)(F.ws + WS_U);
    const int r0 = c64 * 64, len = r0 < 4096 ? 256 : 4096, t0 = r0 < 4096 ? (r0 & 255) : ((r0 - 4096) & 4095);
    const int i = F.tid >> 3, sub = F.tid & 7, t = t0 + i;
    const bf16* ur = U + (size_t)(r0 + i) * LD_EVEN;
    conv3_load(ur + E_XBC + g * 256 + sub * 32, LD_EVEN, t, len, rx0);
    conv3_load(ur + E_XBC + g * 256 + sub * 32 + 16, LD_EVEN, t, len, rx1);
    conv3_load(ur + E_XBC + 2048 + g * 128 + sub * 16, LD_EVEN, t, len, rb_);
    conv3_load(ur + E_XBC + 3072 + g * 128 + sub * 16, LD_EVEN, t, len, rc_);
    rdt = (unsigned)ur[E_DT + (sub >> 2) * 32 + g * 4 + (sub & 3)];
}
DI void ssd_prep_item(const Ctx& F, const float* const* in, int c64, int g, bool stage_cw, u32x4 (&rx0)[6], u32x4 (&rx1)[6], u32x4 (&rb_)[6], u32x4 (&rc_)[6], unsigned& rdt, int next_c64, int next_g) {
    LAS bf16* C = (LAS bf16*)(F.lds + 0);
    LAS bf16* B = (LAS bf16*)(F.lds + 17408);
    LAS bf16* BT = (LAS bf16*)(F.lds + 34816);
    LAS bf16* XT = (LAS bf16*)(F.lds + 53248);
    LAS float* CBR = (LAS float*)(F.lds + 90112);
    LAS float* TBL = (LAS float*)(F.lds + 107520);
    LAS float* CW = TBL + 8 * 192;
    constexpr int LDR = 68;
    const bf16* U = (const bf16*)(F.ws + WS_U);
    const int r0 = c64 * 64, len = r0 < 4096 ? 256 : 4096, t0 = r0 < 4096 ? (r0 & 255) : ((r0 - 4096) & 4095);
    const int lane_o = F.lane, wave = F.wave;
    LDSBAR();
    if (stage_cw) {
        for (int e = F.tid; e < 3 * 512; e += 512) { const int tap = e >> 9, c = e & 511; const int col = c < 256 ? g * 256 + c : (c < 384 ? 2048 + g * 128 + (c - 256) : 3072 + g * 128 + (c - 384)); CW[e] = in[17][tap * 4096 + col]; }
        LDSBAR(); }
    int lane = lane_o; asm volatile("" : "+v"(lane)); const int l15 = lane & 15, q4 = lane >> 4;
    { const int i = F.tid >> 3, sub = F.tid & 7; const int t = t0 + i;
      const bf16* ur = U + (size_t)(r0 + i) * LD_EVEN;
      SCHED_FENCE();
      { float xv[16]; conv3_calc(rx0, CW + sub * 32, 512, xv);
#pragma unroll
        for (int e = 0; e < 16; ++e) XT[swz_idx((sub >> 1) * 64 + (sub & 1) * 32 + e, i)] = f2bf(siluf_(xv[e])); }
      SCHED_FENCE();
      { float xv[16]; conv3_calc(rx1, CW + sub * 32 + 16, 512, xv);
#pragma unroll
        for (int e = 0; e < 16; ++e) XT[swz_idx((sub >> 1) * 64 + (sub & 1) * 32 + 16 + e, i)] = f2bf(siluf_(xv[e])); }
      SCHED_FENCE();
      { float bv[16]; conv3_calc(rb_, CW + 256 + sub * 16, 512, bv);
#pragma unroll
        for (int e = 0; e < 16; ++e) bv[e] = siluf_(bv[e]);
#pragma unroll
        for (int e = 0; e < 16; e += 4) st_bf16x4(B + i * LDQ + sub * 16 + e, bv[e], bv[e + 1], bv[e + 2], bv[e + 3]);
#pragma unroll
        for (int e = 0; e < 16; ++e) BT[swz_idx(sub * 16 + e, i)] = f2bf(bv[e]); }
      SCHED_FENCE();
      { float cv[16]; conv3_calc(rc_, CW + 384 + sub * 16, 512, cv);
        u32x4 g0, g1; g0.x = pk2(siluf_(cv[0]), siluf_(cv[1])); g0.y = pk2(siluf_(cv[2]), siluf_(cv[3])); g0.z = pk2(siluf_(cv[4]), siluf_(cv[5])); g0.w = pk2(siluf_(cv[6]), siluf_(cv[7]));
        g1.x = pk2(siluf_(cv[8]), siluf_(cv[9])); g1.y = pk2(siluf_(cv[10]), siluf_(cv[11])); g1.z = pk2(siluf_(cv[12]), siluf_(cv[13])); g1.w = pk2(siluf_(cv[14]), siluf_(cv[15]));
        *(LAS u32x4*)(C + i * LDQ + sub * 16) = g0; *(LAS u32x4*)(C + i * LDQ + sub * 16 + 8) = g1;
        u32x4* gc_ = (u32x4*)((bf16*)(F.ws + WS_SCN) + (size_t)(r0 + i) * 1024 + g * 128 + sub * 16); gc_[0] = g0; gc_[1] = g1; }
      SCHED_FENCE();
      { const int d = sub >> 2, hx = sub & 3, hd = g * 4 + hx, ii = d ? 63 - i : i;
        const float dt = softplusf_(bf2f((bf16)(rdt & 0xffffu)) + in[19][d * 32 + hd]);
        TBL[sub * 192 + ii] = -expf(in[18][d * 32 + hd]) * dt; TBL[sub * 192 + 128 + ii] = dt; } }
    if (next_c64 >= 0) ssd_prep_request(F, next_c64, next_g, rx0, rx1, rb_, rc_, rdt);
    LDSBAR();
    TBL[wave * 192 + 64 + lane] = wave_scan_incl(TBL[wave * 192 + lane], lane);
    { bf16* btg = (bf16*)(F.ws + WS_SBT) + (size_t)g * 128 * NROWS + r0;
#pragma unroll
      for (int k = 0; k < 2; ++k) { const int e = F.tid + 512 * k, row = e >> 3, pc = e & 7;
          *(u32x4*)(btg + (size_t)row * NROWS + pc * 8) = *(const LAS u32x4*)(BT + row * LDT + ((pc ^ (row >> 4)) & 7) * 8); } }
#pragma unroll
    for (int k = 0; k < 8; ++k) { const int e = F.tid + 512 * k, pc = e & 7, row = (e >> 3) & 63, hx = (e >> 9) & 3, d = e >> 11;
        const u32x4 raw = *(const LAS u32x4*)(XT + (hx * 64 + row) * LDT + ((pc ^ ((hx * 64 + row) >> 4)) & 7) * 8); float f[8]; unpack8(raw, f);
        const LAS float* dtp = TBL + (d * 4 + hx) * 192 + 128;
        u32x4 o;
        if (d == 0) { const f32x4 d0 = *(const LAS f32x4*)(dtp + pc * 8), d1 = *(const LAS f32x4*)(dtp + pc * 8 + 4);
            o.x = pk2(f[0] * d0[0], f[1] * d0[1]); o.y = pk2(f[2] * d0[2], f[3] * d0[3]); o.z = pk2(f[4] * d1[0], f[5] * d1[1]); o.w = pk2(f[6] * d1[2], f[7] * d1[3]); }
        else { const f32x4 d0 = *(const LAS f32x4*)(dtp + 56 - pc * 8), d1 = *(const LAS f32x4*)(dtp + 60 - pc * 8);
            o.x = pk2(f[0] * d1[3], f[1] * d1[2]); o.y = pk2(f[2] * d1[1], f[3] * d1[0]); o.z = pk2(f[4] * d0[3], f[5] * d0[2]); o.w = pk2(f[6] * d0[1], f[7] * d0[0]); }
        *(u32x4*)((bf16*)(F.ws + WS_SVT) + ((size_t)((g * 4 + hx) * 2 + d) * 64 + row) * NROWS + r0 + pc * 8) = o; }
#pragma unroll
    for (int tt = 0; tt < 2; ++tt) { const int id = 2 * wave + tt, ti = id >> 2, tj = id & 3;
        f32x4 cb = {0.f, 0.f, 0.f, 0.f};
#pragma unroll
        for (int ks = 0; ks < 4; ++ks) cb = MFMA16(frag_nat(B, LDQ, tj * 16, ks * 32, lane), frag_nat(C, LDQ, ti * 16, ks * 32, lane), cb);
        *(LAS f32x4*)(CBR + (ti * 16 + l15) * LDR + tj * 16 + 4 * q4) = cb; }
    LDSBAR();
    { const int d = wave >> 2, hx = wave & 3; const size_t item = ((size_t)c64 * 32 + g * 4 + hx) * 2 + d;
      const LAS float* gcp = TBL + wave * 192 + 64; const float gi = gcp[lane];
      ((float*)(F.ws + WS_SSG))[item * 64 + lane] = gi;
      const LAS float* crow = CBR + (d ? 63 - lane : lane) * LDR;
      bf16* pg = (bf16*)(F.ws + WS_SSP) + (item * 64 + lane) * 64;
#pragma unroll
      for (int j8 = 0; j8 < 8; ++j8) { float pv[8];
          f32x4 c0, c1;
          if (d == 0) { c0 = *(const LAS f32x4*)(crow + j8 * 8); c1 = *(const LAS f32x4*)(crow + j8 * 8 + 4); }
          else { const f32x4 a0 = *(const LAS f32x4*)(crow + 60 - j8 * 8), a1 = *(const LAS f32x4*)(crow + 56 - j8 * 8); c0 = (f32x4){a0[3], a0[2], a0[1], a0[0]}; c1 = (f32x4){a1[3], a1[2], a1[1], a1[0]}; }
          const f32x4 g0 = *(const LAS f32x4*)(gcp + j8 * 8), g1 = *(const LAS f32x4*)(gcp + j8 * 8 + 4);
#pragma unroll
          for (int e = 0; e < 4; ++e) { const int j = j8 * 8 + e; pv[e] = (lane >= j) ? c0[e] * __expf(gi - g0[e]) : 0.f; pv[4 + e] = (lane >= j + 4) ? c1[e] * __expf(gi - g1[e]) : 0.f; }
          u32x4 o; o.x = pk2(pv[0], pv[1]); o.y = pk2(pv[2], pv[3]); o.z = pk2(pv[4], pv[5]); o.w = pk2(pv[6], pv[7]);
          *(u32x4*)(pg + j8 * 8) = o; } }
}

#define SSD_SETB 73728
DI void ssd_scan_step(const Ctx& F, f32x4 (&S)[2][8], int set, int ci, int d, int len, int row0, int head0, bf16* OUT) {
    const int pq = F.wave;
    int lane = F.lane; asm volatile("" : "+v"(lane)); const int l15 = lane & 15, q4 = lane >> 4;
    LAS unsigned char* base = F.lds + set * SSD_SETB;
    LAS bf16* C = (LAS bf16*)base; LAS bf16* BT = (LAS bf16*)(base + 17408); LAS bf16* PH = (LAS bf16*)(base + 35840); LAS bf16* VT = (LAS bf16*)(base + 54272);
    LAS float* GC = (LAS float*)(base + 72704);
#define LC(dst, it) do { _Pragma("unroll") for (int i_ = 0; i_ < 4; ++i_) dst[i_] = frag_perm(C, LDQ, (it) * 16, i_ * 32, lane); SCHED_FENCE(); } while (0)
#define LP(dst, it) do { _Pragma("unroll") for (int i_ = 0; i_ < 4; ++i_) dst[i_] = frag_nat(PH + (i_ >> 1) * 4608, LDT, (it) * 16, (i_ & 1) * 32, lane); SCHED_FENCE(); } while (0)
#define LB(dst, t0) do { _Pragma("unroll") for (int i_ = 0; i_ < 4; ++i_) dst[i_] = frag_nat(BT, LDT, ((t0) + (i_ >> 1)) * 16, (i_ & 1) * 32, lane); SCHED_FENCE(); } while (0)
#define CY(X, it) do { y[0] = (f32x4){0.f, 0.f, 0.f, 0.f}; y[1] = y[0]; _Pragma("unroll") for (int ks = 0; ks < 4; ++ks) { y[0] = MFMA16(Sp[0][ks], X[ks], y[0]); y[1] = MFMA16(Sp[1][ks], X[ks], y[1]); } \
        y[0] = y[0] * __expf(GC[(it) * 16 + l15]); y[1] = y[1] * __expf(GC[64 + (it) * 16 + l15]); SCHED_FENCE(); } while (0)
#define CP(X, it) do { _Pragma("unroll") for (int ks = 0; ks < 2; ++ks) { y[0] = MFMA16(VF[0][ks], X[ks], y[0]); y[1] = MFMA16(VF[1][ks], X[2 + ks], y[1]); } \
        { const int i = (it) * 16 + l15; const int tl = ci * 64 + i, t = d ? (len - 1 - tl) : tl; bf16* op = OUT + (size_t)(row0 + t) * 2048 + head0 * 64 + 16 * pq + 4 * q4; \
          u32x2 w2; w2.x = pk2(y[0][0], y[0][1]); w2.y = pk2(y[0][2], y[0][3]); *(u32x2*)op = w2; w2.x = pk2(y[1][0], y[1][1]); w2.y = pk2(y[1][2], y[1][3]); *(u32x2*)(op + 64) = w2; } SCHED_FENCE(); } while (0)
#define CS(X, t0) do { _Pragma("unroll") for (int ks = 0; ks < 2; ++ks) _Pragma("unroll") for (int j = 0; j < 2; ++j) { S[0][(t0) + j] = MFMA16(X[j * 2 + ks], V2[0][ks], S[0][(t0) + j]); S[1][(t0) + j] = MFMA16(X[j * 2 + ks], V2[1][ks], S[1][(t0) + j]); } SCHED_FENCE(); } while (0)
    bf16x8 X0[4], X1[4], X2[4];
    bf16x8 VF[2][2];
#pragma unroll
    for (int x = 0; x < 2; ++x)
#pragma unroll
        for (int ks = 0; ks < 2; ++ks) VF[x][ks] = frag_nat(VT + x * 4608, LDT, 16 * pq, ks * 32, lane);
    const float gl0 = GC[63], gl1 = GC[127];
    LC(X0, 0); LP(X1, 0);
    bf16x8 Sp[2][4];
#pragma unroll
    for (int x = 0; x < 2; ++x)
#pragma unroll
        for (int ks = 0; ks < 4; ++ks) Sp[x][ks] = pack2(S[x][2 * ks], S[x][2 * ks + 1]);
    bf16x8 V2[2][2];
#pragma unroll
    for (int x = 0; x < 2; ++x) { const float gl = x ? gl1 : gl0;
#pragma unroll
        for (int ks = 0; ks < 2; ++ks) { float f[8]; unpack8(__builtin_bit_cast(u32x4, VF[x][ks]), f);
            const f32x4 g0 = *(const LAS f32x4*)(GC + x * 64 + ks * 32 + 8 * q4), g1 = *(const LAS f32x4*)(GC + x * 64 + ks * 32 + 8 * q4 + 4);
            u32x4 w; w.x = pk2(f[0] * __expf(gl - g0[0]), f[1] * __expf(gl - g0[1])); w.y = pk2(f[2] * __expf(gl - g0[2]), f[3] * __expf(gl - g0[3]));
            w.z = pk2(f[4] * __expf(gl - g1[0]), f[5] * __expf(gl - g1[1])); w.w = pk2(f[6] * __expf(gl - g1[2]), f[7] * __expf(gl - g1[3]));
            V2[x][ks] = __builtin_bit_cast(bf16x8, w); } }
    const float egl0 = __expf(gl0), egl1 = __expf(gl1);
    SCHED_FENCE();
    f32x4 y[2];
    LC(X2, 1); CY(X0, 0);
    LP(X0, 1); CP(X1, 0);
    LC(X1, 2); CY(X2, 1);
    LP(X2, 2); CP(X0, 1);
    LC(X0, 3); CY(X1, 2);
    LP(X1, 3); CP(X2, 2);
    LB(X2, 0); CY(X0, 3);
    LB(X0, 2); CP(X1, 3);
#pragma unroll
    for (int t = 0; t < 8; ++t) { S[0][t] = S[0][t] * egl0; S[1][t] = S[1][t] * egl1; }
    SCHED_FENCE();
    LB(X1, 4); CS(X2, 0);
    LB(X2, 6); CS(X0, 2);
    CS(X1, 4); CS(X2, 6);
#undef LC
#undef LP
#undef LB
#undef CY
#undef CP
#undef CS
}
DI void ssd_scan_item(const Ctx& F, const float* const* in, int s, int g, int d, int hp) {
    constexpr int SETB = SSD_SETB;
    const int row0 = seq_row0(s), len = seq_len(s), nch = len >> 6, c640 = row0 >> 6;
    const int lane_o = F.lane, wave = F.wave;
    const int head0 = g * 4 + hp * 2;
    bf16* OUT = (bf16*)(F.ws + (d ? WS_OBB : WS_OFB));
    const bf16* SCN = (const bf16*)(F.ws + WS_SCN); const bf16* SBT = (const bf16*)(F.ws + WS_SBT) + (size_t)g * 128 * NROWS;
    const bf16* SVT = (const bf16*)(F.ws + WS_SVT); const bf16* SSP = (const bf16*)(F.ws + WS_SSP); const float* SSG = (const float*)(F.ws + WS_SSG);
    LDSBAR();
    if (wave >= 4) {
        struct Pre { u32x4 c[4], b[4], p[4], v[4]; float g; };
        Pre PA, PB_;
        const int e = F.tid - 256, er = e >> 2, eq = e & 3;
#define REV8(w_) ((u32x4){((w_).w >> 16) | ((w_).w << 16), ((w_).z >> 16) | ((w_).z << 16), ((w_).y >> 16) | ((w_).y << 16), ((w_).x >> 16) | ((w_).x << 16)})
#define SSD_ISSUE(ci_, P_) do { const int cc = c640 + (d ? nch - 1 - (ci_) : (ci_)); \
        const int crow = cc * 64 + (d ? 63 - er : er); const u32x4* csrc = (const u32x4*)(SCN + (size_t)crow * 1024 + g * 128 + eq * 32); \
        _Pragma("unroll") for (int m_ = 0; m_ < 4; ++m_) P_.c[m_] = csrc[m_]; \
        const u32x4* b0src = (const u32x4*)(SBT + (size_t)er * NROWS + cc * 64 + eq * 16); const u32x4* b1src = (const u32x4*)(SBT + (size_t)(64 + er) * NROWS + cc * 64 + eq * 16); \
        P_.b[0] = b0src[0]; P_.b[1] = b0src[1]; P_.b[2] = b1src[0]; P_.b[3] = b1src[1]; \
        const size_t it0 = ((size_t)cc * 32 + head0) * 2 + d, it1 = it0 + 2; \
        const u32x4* p0src = (const u32x4*)(SSP + (it0 * 64 + er) * 64 + eq * 16); const u32x4* p1src = (const u32x4*)(SSP + (it1 * 64 + er) * 64 + eq * 16); \
        P_.p[0] = p0src[0]; P_.p[1] = p0src[1]; P_.p[2] = p1src[0]; P_.p[3] = p1src[1]; \
        const u32x4* v0src = (const u32x4*)(SVT + ((size_t)(head0 * 2 + d) * 64 + er) * NROWS + cc * 64 + eq * 16); const u32x4* v1src = (const u32x4*)(SVT + ((size_t)((head0 + 1) * 2 + d) * 64 + er) * NROWS + cc * 64 + eq * 16); \
        P_.v[0] = v0src[0]; P_.v[1] = v0src[1]; P_.v[2] = v1src[0]; P_.v[3] = v1src[1]; \
        P_.g = 0.f; if (e < 128) P_.g = SSG[((e < 64) ? it0 : it1) * 64 + (e & 63)]; } while (0)
#define SSD_COMMIT(set_, P_) do { LAS unsigned char* base = F.lds + (set_) * SETB; \
        _Pragma("unroll") for (int m_ = 0; m_ < 4; ++m_) *(LAS u32x4*)((LAS bf16*)base + er * LDQ + eq * 32 + m_ * 8) = P_.c[m_]; \
        *(LAS u32x4*)((LAS bf16*)(base + 35840) + er * LDT + eq * 16) = P_.p[0]; *(LAS u32x4*)((LAS bf16*)(base + 35840) + er * LDT + eq * 16 + 8) = P_.p[1]; \
        *(LAS u32x4*)((LAS bf16*)(base + 45056) + er * LDT + eq * 16) = P_.p[2]; *(LAS u32x4*)((LAS bf16*)(base + 45056) + er * LDT + eq * 16 + 8) = P_.p[3]; \
        if (d == 0) { *(LAS u32x4*)((LAS bf16*)(base + 17408) + er * LDT + eq * 16) = P_.b[0]; *(LAS u32x4*)((LAS bf16*)(base + 17408) + er * LDT + eq * 16 + 8) = P_.b[1]; \
            *(LAS u32x4*)((LAS bf16*)(base + 17408) + (64 + er) * LDT + eq * 16) = P_.b[2]; *(LAS u32x4*)((LAS bf16*)(base + 17408) + (64 + er) * LDT + eq * 16 + 8) = P_.b[3]; \
            *(LAS u32x4*)((LAS bf16*)(base + 54272) + er * LDT + eq * 16) = P_.v[0]; *(LAS u32x4*)((LAS bf16*)(base + 54272) + er * LDT + eq * 16 + 8) = P_.v[1]; \
            *(LAS u32x4*)((LAS bf16*)(base + 63488) + er * LDT + eq * 16) = P_.v[2]; *(LAS u32x4*)((LAS bf16*)(base + 63488) + er * LDT + eq * 16 + 8) = P_.v[3]; } \
        else { *(LAS u32x4*)((LAS bf16*)(base + 17408) + er * LDT + (3 - eq) * 16 + 8) = REV8(P_.b[0]); *(LAS u32x4*)((LAS bf16*)(base + 17408) + er * LDT + (3 - eq) * 16) = REV8(P_.b[1]); \
            *(LAS u32x4*)((LAS bf16*)(base + 17408) + (64 + er) * LDT + (3 - eq) * 16 + 8) = REV8(P_.b[2]); *(LAS u32x4*)((LAS bf16*)(base + 17408) + (64 + er) * LDT + (3 - eq) * 16) = REV8(P_.b[3]); \
            *(LAS u32x4*)((LAS bf16*)(base + 54272) + er * LDT + (3 - eq) * 16 + 8) = REV8(P_.v[0]); *(LAS u32x4*)((LAS bf16*)(base + 54272) + er * LDT + (3 - eq) * 16) = REV8(P_.v[1]); \
            *(LAS u32x4*)((LAS bf16*)(base + 63488) + er * LDT + (3 - eq) * 16 + 8) = REV8(P_.v[2]); *(LAS u32x4*)((LAS bf16*)(base + 63488) + er * LDT + (3 - eq) * 16) = REV8(P_.v[3]); } \
        if (e < 128) ((LAS float*)(base + 72704))[e] = P_.g; } while (0)
        SSD_ISSUE(0, PA); SSD_ISSUE(1, PB_);
#pragma unroll 1
        for (int ci = 0; ci < nch; ci += 2) {
            SSD_COMMIT(0, PA); LDSBAR(); if (ci + 2 < nch) SSD_ISSUE(ci + 2, PA);
            SSD_COMMIT(1, PB_); LDSBAR(); if (ci + 3 < nch) SSD_ISSUE(ci + 3, PB_); }
#undef SSD_ISSUE
#undef SSD_COMMIT
#undef REV8
    } else {
        const int pq = wave;
        f32x4 S[2][8];
        if (s >= 16) { int ln = lane_o; asm volatile("" : "+v"(ln)); const int l15 = ln & 15, q4 = ln >> 4;
#pragma unroll
            for (int x = 0; x < 2; ++x) { const float* sp = in[3] + ((size_t)((s - 16) * 2 + d) * 32 + head0 + x) * 8192;
#pragma unroll
                for (int t = 0; t < 8; ++t) S[x][t] = *(const f32x4*)(sp + (size_t)(16 * pq + l15) * 128 + 16 * t + 4 * q4); }
        } else {
#pragma unroll
            for (int x = 0; x < 2; ++x)
#pragma unroll
                for (int t = 0; t < 8; ++t) S[x][t] = (f32x4){0.f, 0.f, 0.f, 0.f}; }
#pragma unroll 1
        for (int ci = 0; ci < nch; ci += 2) { LDSBAR(); ssd_scan_step(F, S, 0, ci, d, len, row0, head0, OUT); LDSBAR(); ssd_scan_step(F, S, 1, ci + 1, d, len, row0, head0, OUT); }
        if (s < 16) { int ln = lane_o; asm volatile("" : "+v"(ln)); const int l15 = ln & 15, q4 = ln >> 4;
#pragma unroll
            for (int x = 0; x < 2; ++x) { float* sp = F.out + OUT_SS + ((size_t)(s * 2 + d) * 32 + head0 + x) * 8192;
#pragma unroll
                for (int t = 0; t < 8; ++t) *(f32x4*)(sp + (size_t)(16 * pq + l15) * 128 + 16 * t + 4 * q4) = S[x][t]; } }
    }
}

DI void phase_m0a(const Ctx& F, const float* const* in) {
    { int prev = -1; u32x4 rq_[6], rk_[6], rv_[6]; unsigned rgate = 0u;
      if (F.bid < 3072) gdn_prep_request(F, F.bid >> 4, F.bid & 15, rq_, rk_, rv_, rgate);
      for (int it = F.bid; it < 3072; it += F.G) { const int h = it & 15; const int nx = it + F.G;
          const int next_c64 = (nx < 3072 && (nx & 15) == h) ? (nx >> 4) : -1;
          gdn_prep_item(F, in, it >> 4, h, h != prev, rq_, rk_, rv_, rgate, next_c64);
          if (next_c64 < 0 && nx < 3072) gdn_prep_request(F, nx >> 4, nx & 15, rq_, rk_, rv_, rgate);
          prev = h; } }
    { int prev = -1; u32x4 rx0[6], rx1[6], rb_[6], rc_[6]; unsigned rdt = 0u;
      if (F.bid < 1536) ssd_prep_request(F, F.bid >> 3, F.bid & 7, rx0, rx1, rb_, rc_, rdt);
#pragma unroll 1
      for (int it = F.bid; it < 1536; it += F.G) { const int g = it & 7; const int nx = it + F.G;
          ssd_prep_item(F, in, it >> 3, g, g != prev, rx0, rx1, rb_, rc_, rdt, nx < 1536 ? (nx >> 3) : -1, nx & 7); prev = g; } }
}
DI int queue_grab(const Ctx& F, unsigned* head, int n) {
    volatile LAS int* slot = (volatile LAS int*)(F.lds + 163840 - 128);
    LDSBAR();
    if (F.tid == 0) *slot = (int)__hip_atomic_fetch_add(head, (unsigned)n, __ATOMIC_RELAXED, __HIP_MEMORY_SCOPE_AGENT);
    LDSBAR();
    return *slot;
}
DI void phase_m0(const Ctx& F, const float* const* in, int only = 0) {
    const int b = F.bid;
    const int nw = F.G > 128 ? F.G - 128 : F.G, w = F.G > 128 ? b - 128 : b;
    { int it = (F.G > 128 && b < 64) ? b : (F.G > 128 ? 64 + w : b); const int step = (F.G > 128 && b < 64) ? (1 << 20) : nw;
      if (!(F.G > 128 && b >= 64 && b < 128) && only != 2)
        for (; it < 64 + 512; it += step) { int s, h, d;
            if (it < 64) { s = 16 + (it >> 5); h = (it >> 1) & 15; d = it & 1; } else { const int k = it - 64; s = k >> 5; h = (k >> 1) & 15; d = k & 1; }
            gdn_scan_item(F, in, s, h, d); } }
    { int it = (F.G > 128 && b >= 64 && b < 128) ? b - 64 : (F.G > 128 ? 64 + w : b); const int step = (F.G > 128 && b >= 64 && b < 128) ? (1 << 20) : nw;
      if (!(F.G > 128 && b < 64) && only != 1)
        for (; it < 64 + 512; it += step) { int s, g, d, hp;
            if (it < 64) { s = 16 + (it >> 5); g = (it >> 2) & 7; d = (it >> 1) & 1; hp = it & 1; } else { const int k = it - 64; s = k >> 5; g = (k >> 2) & 7; d = (k >> 1) & 1; hp = k & 1; }
            ssd_scan_item(F, in, s, g, d, hp); } }
}
DI void phase_m0c(const Ctx& F, const float* const* in) {
    const int gw = F.bid * 8 + F.wave, NGW = F.G * 8, lane = F.lane;
    const bf16* U = (const bf16*)(F.ws + WS_U); bf16* MIX = (bf16*)(F.ws + WS_MIX);
    const bf16 *OFA = (const bf16*)(F.ws + WS_OFA), *OBA = (const bf16*)(F.ws + WS_OBA), *OFB = (const bf16*)(F.ws + WS_OFB), *OBB = (const bf16*)(F.ws + WS_OBB);
    for (int row = gw; row < NROWS; row += NGW) {
        const int len = row < 4096 ? 256 : 4096, t = row < 4096 ? (row & 255) : ((row - 4096) & 4095);
        const bf16* ur = U + (size_t)row * LD_EVEN;
        { const int hsub = lane >> 4, c8 = (lane & 15) * 8;
          const f32x4 gn0 = *(const f32x4*)(in[16] + c8), gn1 = *(const f32x4*)(in[16] + c8 + 4);
          u32x4 af[4], ab[4], az[4];
#pragma unroll
          for (int hq = 0; hq < 4; ++hq) { const size_t o = (size_t)row * 2048 + (hq * 4 + hsub) * 128 + c8;
              af[hq] = *(const u32x4*)(OFA + o); ab[hq] = *(const u32x4*)(OBA + o); az[hq] = *(const u32x4*)(ur + E_ZA + (hq * 4 + hsub) * 128 + c8); }
#pragma unroll
          for (int hq = 0; hq < 4; ++hq) { float x[8], y[8], z[8]; unpack8(af[hq], x); unpack8(ab[hq], y); unpack8(az[hq], z);
              float ss = 0.f;
#pragma unroll
              for (int e = 0; e < 8; ++e) { x[e] += y[e]; ss += x[e] * x[e]; }
              ss += __shfl_xor(ss, 1); ss += __shfl_xor(ss, 2); ss += __shfl_xor(ss, 4); ss += __shfl_xor(ss, 8);
              const float rn = __builtin_amdgcn_rsqf(ss * (1.0f / 128.0f) + EPS);
              u32x4 w; w.x = pk2(x[0] * rn * gn0[0] * siluf_(z[0]), x[1] * rn * gn0[1] * siluf_(z[1])); w.y = pk2(x[2] * rn * gn0[2] * siluf_(z[2]), x[3] * rn * gn0[3] * siluf_(z[3]));
              w.z = pk2(x[4] * rn * gn1[0] * siluf_(z[4]), x[5] * rn * gn1[1] * siluf_(z[5])); w.w = pk2(x[6] * rn * gn1[2] * siluf_(z[6]), x[7] * rn * gn1[3] * siluf_(z[7]));
              *(u32x4*)(MIX + (size_t)row * DM + (hq * 4 + hsub) * 128 + c8) = w; } }
        { const int gsub = lane >> 5, c8 = (lane & 31) * 8;
#pragma unroll 2
          for (int gq = 0; gq < 4; ++gq) { const int ch = (gq * 2 + gsub) * 256 + c8; const size_t o = (size_t)row * 2048 + ch;
              const u32x4 af = *(const u32x4*)(OFB + o), ab = *(const u32x4*)(OBB + o), x0 = *(const u32x4*)(ur + E_XBC + ch), zz = *(const u32x4*)(ur + E_ZB + ch);
              u32x4 xm = {0u, 0u, 0u, 0u}, xp = {0u, 0u, 0u, 0u};
              if (t > 0) xm = *(const u32x4*)(ur - LD_EVEN + E_XBC + ch);
              if (t + 1 < len) xp = *(const u32x4*)(ur + LD_EVEN + E_XBC + ch);
              const float dsk = in[20][ch >> 6];
              float a[8], bq[8], fm[8], f0[8], fp[8], zb[8], y[8]; unpack8(af, a); unpack8(ab, bq); unpack8(xm, fm); unpack8(x0, f0); unpack8(xp, fp); unpack8(zz, zb);
              float ss = 0.f;
#pragma unroll
              for (int e4 = 0; e4 < 2; ++e4) { const f32x4 w0 = *(const f32x4*)(in[17] + ch + 4 * e4), w1 = *(const f32x4*)(in[17] + 4096 + ch + 4 * e4), w2 = *(const f32x4*)(in[17] + 8192 + ch + 4 * e4);
#pragma unroll
                  for (int e = 0; e < 4; ++e) { const int k = 4 * e4 + e; const float xs = w0[e] * fm[k] + w1[e] * f0[k] + w2[e] * fp[k];
                      y[k] = (a[k] + bq[k] + dsk * siluf_(xs)) * siluf_(zb[k]); ss += y[k] * y[k]; } }
              ss += __shfl_xor(ss, 1); ss += __shfl_xor(ss, 2); ss += __shfl_xor(ss, 4); ss += __shfl_xor(ss, 8); ss += __shfl_xor(ss, 16);
              const float rn = __builtin_amdgcn_rsqf(ss * (1.0f / 256.0f) + EPS);
              const f32x4 g0 = *(const f32x4*)(in[21] + ch), g1 = *(const f32x4*)(in[21] + ch + 4);
              u32x4 w; w.x = pk2(y[0] * rn * g0[0], y[1] * rn * g0[1]); w.y = pk2(y[2] * rn * g0[2], y[3] * rn * g0[3]); w.z = pk2(y[4] * rn * g1[0], y[5] * rn * g1[1]); w.w = pk2(y[6] * rn * g1[2], y[7] * rn * g1[3]);
              *(u32x4*)(MIX + (size_t)row * DM + 2048 + ch) = w; } }
    }
}
DI void gla_prep_all(const Ctx& F, const float* const* in) {
    LAS bf16* QS = (LAS bf16*)(F.lds + 0);
    LAS bf16* KS = (LAS bf16*)(F.lds + 17408);
    LAS bf16* KST = (LAS bf16*)(F.lds + 34816);
    LAS bf16* VT = (LAS bf16*)(F.lds + 53248);
    LAS float* GL = (LAS float*)(F.lds + 71680);
    LAS float* PART = GL + 128;
    LAS bf16* RF0 = (LAS bf16*)(F.lds + 74240);
    LAS bf16* RF1 = (LAS bf16*)(F.lds + 91648);
    LAS bf16* RQ = (LAS bf16*)(F.lds + 109056);
    LAS bf16* RV = (LAS bf16*)(F.lds + 126464);
    const bf16* U = (const bf16*)(F.ws + WS_U);
    const int lane_o = F.lane, wave = F.wave;
    const int kch = F.tid & 127, qtr = F.tid >> 7;
    const int er = F.tid >> 3, ep = F.tid & 7;
    u32x4 pr[8];
#define GLA_PRE(it_) do { const bf16* ur_ = U + (size_t)(((it_) >> 4) * 64 + er) * IN_ODD + ((it_) & 15) * 128 + ep * 16; \
        const u32x4* a_ = (const u32x4*)(ur_ + O_Q); const u32x4* b_ = (const u32x4*)(ur_ + O_I); const u32x4* c_ = (const u32x4*)(ur_ + O_F); const u32x4* d_ = (const u32x4*)(ur_ + O_F + 2048); \
        pr[0] = a_[0]; pr[1] = a_[1]; pr[2] = b_[0]; pr[3] = b_[1]; pr[4] = c_[0]; pr[5] = c_[1]; pr[6] = d_[0]; pr[7] = d_[1]; } while (0)
    int it = F.bid;
    if (it < 3072) GLA_PRE(it);
#pragma unroll 1
  for (; it < 3072; it += F.G) {
    const int c64 = it >> 4, h = it & 15, r0 = c64 * 64;
    LDSBAR();
    *(LAS u32x4*)(RQ + er * LDQ + ep * 16) = pr[0]; *(LAS u32x4*)(RQ + er * LDQ + ep * 16 + 8) = pr[1];
    *(LAS u32x4*)(RV + er * LDQ + ep * 16) = pr[2]; *(LAS u32x4*)(RV + er * LDQ + ep * 16 + 8) = pr[3];
    *(LAS u32x4*)(RF0 + er * LDQ + ep * 16) = pr[4]; *(LAS u32x4*)(RF0 + er * LDQ + ep * 16 + 8) = pr[5];
    *(LAS u32x4*)(RF1 + er * LDQ + ep * 16) = pr[6]; *(LAS u32x4*)(RF1 + er * LDQ + ep * 16 + 8) = pr[7];
    if (it + F.G < 3072) GLA_PRE(it + F.G);
    float sq[16];
#pragma unroll 1
    for (int d = 0; d < 2; ++d) {
        const size_t item = ((size_t)c64 * 16 + h) * 2 + d;
        LAS bf16* RF = d ? RF1 : RF0;
        int lane = lane_o; asm volatile("" : "+v"(lane)); const int l15 = lane & 15, q4 = lane >> 4;
        const float lb = 1.0f / (1.0f + expf(in[31][4096 + d * 2048 + h * 128 + kch] - in[31][d * 2048 + h * 128 + kch]));
        LDSBAR();
#ifndef PROBE_GE
#define PROBE_GE 1
#endif
#pragma unroll 1
        for (int rp_ = 0; rp_ < PROBE_GE; ++rp_)
        { const int sqt = d ? 3 - qtr : qtr;
          float pr_[16], kk[16]; float run = 1.f;
#pragma unroll
          for (int ii = 0; ii < 16; ++ii) { const int i = 16 * sqt + ii, tok = d ? 63 - i : i;
              const float fr = bf2f(RF[tok * LDQ + kch]);
              const float f = lb + (1.0f - lb) * sigmoidf_(fr); kk[ii] = 1.0f - f; run *= f; pr_[ii] = run; }
          PART[sqt * 128 + kch] = run;
          if (d == 0) {
#pragma unroll
              for (int ii = 0; ii < 16; ++ii) { const int i = 16 * qtr + ii; sq[ii] = siluf_(bf2f(RQ[i * LDQ + kch])) * 0.08838834764831845f; } }
          LDSBAR();
          float off = 1.f, tot = 1.f;
#pragma unroll
          for (int qq = 0; qq < 4; ++qq) { const float pq = PART[qq * 128 + kch]; if (qq < sqt) off *= pq; tot *= pq; }
          if (qtr == 0) ((float*)(F.ws + WS_LGL))[item * 128 + kch] = __logf(tot);
          unsigned kp[8], vp[8];
          float kvs[16];
          { float inv = __builtin_amdgcn_rcpf(off * pr_[15]);
#pragma unroll
            for (int ii = 15; ii >= 0; --ii) { kvs[ii] = kk[ii] * inv; inv *= 1.0f - kk[ii]; } }
#pragma unroll
          for (int ii = 0; ii < 16; ++ii) { const int i = 16 * sqt + ii, tok = d ? 63 - i : i;
              const float eg = off * pr_[ii];
              const float qv = (d ? sq[15 - ii] : sq[ii]) * eg;
              const float kv = kvs[ii];
              QS[i * LDQ + kch] = f2bf(qv); const bf16 kb = f2bf(kv); KS[i * LDQ + kch] = kb;
              if (ii & 1) kp[ii >> 1] |= (unsigned)kb << 16; else kp[ii >> 1] = kb;
              if (d == 0) { const unsigned vb = RV[tok * LDQ + kch]; if (ii & 1) vp[ii >> 1] |= vb << 16; else vp[ii >> 1] = vb; } }
          *(LAS u32x4*)(KST + kch * LDT + 16 * sqt) = (u32x4){kp[0], kp[1], kp[2], kp[3]}; *(LAS u32x4*)(KST + kch * LDT + 16 * sqt + 8) = (u32x4){kp[4], kp[5], kp[6], kp[7]};
          if (d == 0) { *(LAS u32x4*)(VT + kch * LDT + 16 * qtr) = (u32x4){vp[0], vp[1], vp[2], vp[3]}; *(LAS u32x4*)(VT + kch * LDT + 16 * qtr + 8) = (u32x4){vp[4], vp[5], vp[6], vp[7]}; } }
        LDSBAR();
#ifndef PROBE_GA
#define PROBE_GA 1
#endif
#pragma unroll 1
        for (int rq_ = 0; rq_ < PROBE_GA; ++rq_) {
#pragma unroll
        for (int tt = 0; tt < 2; ++tt) { const int id = 2 * wave + tt, ti = id >> 2, tj = id & 3;
            f32x4 a = {0.f, 0.f, 0.f, 0.f};
#pragma unroll
            for (int ks = 0; ks < 4; ++ks) a = MFMA16(frag_nat(KS, LDQ, tj * 16, ks * 32, lane), frag_nat(QS, LDQ, ti * 16, ks * 32, lane), a);
            const int i = ti * 16 + l15; float pv[4];
#pragma unroll
            for (int r = 0; r < 4; ++r) { const int j = tj * 16 + 4 * q4 + r; pv[r] = (i >= j) ? a[r] : 0.f; }
            u32x2 w2; w2.x = pk2(pv[0], pv[1]); w2.y = pk2(pv[2], pv[3]);
            *(u32x2*)((bf16*)(F.ws + WS_LAT) + (item * 64 + i) * 64 + tj * 16 + 4 * q4) = w2; }
        { bf16* qg = (bf16*)(F.ws + WS_LQS) + item * 8192; bf16* kg = (bf16*)(F.ws + WS_LKS) + item * 8192;
#pragma unroll
          for (int k = 0; k < 2; ++k) { const int e = F.tid + 512 * k;
              { const int row = e >> 4, pc = e & 15; *(u32x4*)(qg + row * 128 + pc * 8) = *(const LAS u32x4*)(QS + row * LDQ + pc * 8); }
              { const int row = e >> 3, pc = e & 7; *(u32x4*)(kg + row * 64 + pc * 8) = *(const LAS u32x4*)(KST + row * LDT + pc * 8);
                if (d == 0) *(u32x4*)((bf16*)(F.ws + WS_LVT) + ((size_t)h * 128 + row) * NROWS + r0 + pc * 8) = *(const LAS u32x4*)(VT + row * LDT + pc * 8); } } }
        }
    }
  }
#undef GLA_PRE
}

#define GLA_SETB 64000
DI void gla_scan_step(const Ctx& F, f32x4 (&S)[2][8], int set, int ci, int d, int len, int row0, int h, bf16* OUT) {
    const int wave = F.wave;
    int lane = F.lane; asm volatile("" : "+v"(lane)); const int l15 = lane & 15, q4 = lane >> 4;
    LAS unsigned char* base = F.lds + set * GLA_SETB;
    LAS bf16* QS = (LAS bf16*)base; LAS bf16* KST = (LAS bf16*)(base + 17408); LAS bf16* ATT = (LAS bf16*)(base + 35840); LAS bf16* VT = (LAS bf16*)(base + 45056); LAS float* GL = (LAS float*)(base + 63488);
#define LQ(dst, it) do { _Pragma("unroll") for (int i_ = 0; i_ < 4; ++i_) dst[i_] = frag_perm(QS, LDQ, (it) * 16, i_ * 32, lane); SCHED_FENCE(); } while (0)
#define LT(dst, M, t0) do { _Pragma("unroll") for (int i_ = 0; i_ < 4; ++i_) dst[i_] = frag_nat(M, LDT, ((t0) + (i_ >> 1)) * 16, (i_ & 1) * 32, lane); SCHED_FENCE(); } while (0)
#define CO(X, j) do { _Pragma("unroll") for (int ks = 0; ks < 4; ++ks) { o[0][j] = MFMA16(Sp[0][ks], X[ks], o[0][j]); o[1][j] = MFMA16(Sp[1][ks], X[ks], o[1][j]); } SCHED_FENCE(); } while (0)
#define CA(X, it0) do { _Pragma("unroll") for (int ks = 0; ks < 2; ++ks) _Pragma("unroll") for (int j = 0; j < 2; ++j) { o[0][j] = MFMA16(VF[0][ks], X[j * 2 + ks], o[0][j]); o[1][j] = MFMA16(VF[1][ks], X[j * 2 + ks], o[1][j]); } \
        _Pragma("unroll") for (int j = 0; j < 2; ++j) { const int i = ((it0) + j) * 16 + l15; const int tl = ci * 64 + i, t = d ? (len - 1 - tl) : tl; bf16* op = OUT + (size_t)(row0 + t) * 2048 + h * 128 + 32 * wave + 4 * q4; \
            u32x2 w2; w2.x = pk2(o[0][j][0], o[0][j][1]); w2.y = pk2(o[0][j][2], o[0][j][3]); *(u32x2*)op = w2; w2.x = pk2(o[1][j][0], o[1][j][1]); w2.y = pk2(o[1][j][2], o[1][j][3]); *(u32x2*)(op + 16) = w2; \
            o[0][j] = (f32x4){0.f, 0.f, 0.f, 0.f}; o[1][j] = (f32x4){0.f, 0.f, 0.f, 0.f}; } SCHED_FENCE(); } while (0)
#define CS(X, t0) do { _Pragma("unroll") for (int ks = 0; ks < 2; ++ks) _Pragma("unroll") for (int j = 0; j < 2; ++j) { S[0][(t0) + j] = MFMA16(X[j * 2 + ks], VF[0][ks], S[0][(t0) + j]); S[1][(t0) + j] = MFMA16(X[j * 2 + ks], VF[1][ks], S[1][(t0) + j]); } SCHED_FENCE(); } while (0)
    bf16x8 X0[4], X1[4], X2[4];
    bf16x8 VF[2][2];
#pragma unroll
    for (int x = 0; x < 2; ++x)
#pragma unroll
        for (int ks = 0; ks < 2; ++ks) VF[x][ks] = frag_nat(VT, LDT, 16 * (2 * wave + x), ks * 32, lane);
    LQ(X0, 0); LQ(X1, 1);
    bf16x8 Sp[2][4];
#pragma unroll
    for (int x = 0; x < 2; ++x)
#pragma unroll
        for (int ks = 0; ks < 4; ++ks) Sp[x][ks] = pack2(S[x][2 * ks], S[x][2 * ks + 1]);
    f32x4 o[2][2];
#pragma unroll
    for (int x = 0; x < 2; ++x)
#pragma unroll
        for (int j = 0; j < 2; ++j) o[x][j] = (f32x4){0.f, 0.f, 0.f, 0.f};
    SCHED_FENCE();
    LT(X2, ATT, 0); CO(X0, 0);
    LQ(X0, 2); CO(X1, 1);
    LQ(X1, 3); CA(X2, 0);
    LT(X2, ATT, 2); CO(X0, 0);
    LT(X0, KST, 0); CO(X1, 1);
    LT(X1, KST, 2); CA(X2, 2);
    LT(X2, KST, 4); CS(X0, 0);
    LT(X0, KST, 6); CS(X1, 2);
    CS(X2, 4); CS(X0, 6);
#pragma unroll
    for (int t = 0; t < 8; ++t) { const f32x4 gl = *(const LAS f32x4*)(GL + 16 * t + 4 * q4);
#pragma unroll
        for (int r = 0; r < 4; ++r) { const float eg = __expf(gl[r]); S[0][t][r] *= eg; S[1][t][r] *= eg; } }
#undef LQ
#undef LT
#undef CO
#undef CA
#undef CS
}
DI void gla_scan_item(const Ctx& F, const float* const* in, int s, int h, int d) {
    constexpr int SETB = GLA_SETB;
    const int row0 = seq_row0(s), len = seq_len(s), nch = len >> 6, c640 = row0 >> 6;
    const int lane_o = F.lane, wave = F.wave;
    bf16* OUT = (bf16*)(F.ws + (d ? WS_OBA : WS_OFA));
    const bf16* LQS = (const bf16*)(F.ws + WS_LQS); const bf16* LKS = (const bf16*)(F.ws + WS_LKS); const bf16* LAT = (const bf16*)(F.ws + WS_LAT);
    const bf16* LVT = (const bf16*)(F.ws + WS_LVT) + (size_t)h * 128 * NROWS; const float* LGL = (const float*)(F.ws + WS_LGL);
    LDSBAR();
    if (wave >= 4) {
        struct Pre { u32x4 q[4], k[4], a[2], v[4]; float g; };
        Pre PA, PB_;
        const int e = F.tid - 256, er = e >> 2, eq = e & 3;
#define REV8(w_) ((u32x4){((w_).w >> 16) | ((w_).w << 16), ((w_).z >> 16) | ((w_).z << 16), ((w_).y >> 16) | ((w_).y << 16), ((w_).x >> 16) | ((w_).x << 16)})
#define GLA_ISSUE(ci_, P_) do { const int cc = c640 + (d ? nch - 1 - (ci_) : (ci_)); const size_t item = ((size_t)cc * 16 + h) * 2 + d; \
        const u32x4* qsrc = (const u32x4*)(LQS + item * 8192 + er * 128 + eq * 32); _Pragma("unroll") for (int m_ = 0; m_ < 4; ++m_) P_.q[m_] = qsrc[m_]; \
        const u32x4* k0src = (const u32x4*)(LKS + item * 8192 + er * 64 + eq * 16); const u32x4* k1src = (const u32x4*)(LKS + item * 8192 + (64 + er) * 64 + eq * 16); \
        P_.k[0] = k0src[0]; P_.k[1] = k0src[1]; P_.k[2] = k1src[0]; P_.k[3] = k1src[1]; \
        const u32x4* asrc = (const u32x4*)(LAT + item * 4096 + er * 64 + eq * 16); P_.a[0] = asrc[0]; P_.a[1] = asrc[1]; \
        const u32x4* v0src = (const u32x4*)(LVT + (size_t)er * NROWS + cc * 64 + eq * 16); const u32x4* v1src = (const u32x4*)(LVT + (size_t)(64 + er) * NROWS + cc * 64 + eq * 16); \
        P_.v[0] = v0src[0]; P_.v[1] = v0src[1]; P_.v[2] = v1src[0]; P_.v[3] = v1src[1]; \
        P_.g = 0.f; if (e < 128) P_.g = LGL[item * 128 + e]; } while (0)
#define GLA_COMMIT(set_, P_) do { LAS unsigned char* base = F.lds + (set_) * SETB; \
        _Pragma("unroll") for (int m_ = 0; m_ < 4; ++m_) *(LAS u32x4*)((LAS bf16*)base + er * LDQ + eq * 32 + m_ * 8) = P_.q[m_]; \
        *(LAS u32x4*)((LAS bf16*)(base + 17408) + er * LDT + eq * 16) = P_.k[0]; *(LAS u32x4*)((LAS bf16*)(base + 17408) + er * LDT + eq * 16 + 8) = P_.k[1]; \
        *(LAS u32x4*)((LAS bf16*)(base + 17408) + (64 + er) * LDT + eq * 16) = P_.k[2]; *(LAS u32x4*)((LAS bf16*)(base + 17408) + (64 + er) * LDT + eq * 16 + 8) = P_.k[3]; \
        *(LAS u32x4*)((LAS bf16*)(base + 35840) + er * LDT + eq * 16) = P_.a[0]; *(LAS u32x4*)((LAS bf16*)(base + 35840) + er * LDT + eq * 16 + 8) = P_.a[1]; \
        if (d == 0) { *(LAS u32x4*)((LAS bf16*)(base + 45056) + er * LDT + eq * 16) = P_.v[0]; *(LAS u32x4*)((LAS bf16*)(base + 45056) + er * LDT + eq * 16 + 8) = P_.v[1]; \
            *(LAS u32x4*)((LAS bf16*)(base + 45056) + (64 + er) * LDT + eq * 16) = P_.v[2]; *(LAS u32x4*)((LAS bf16*)(base + 45056) + (64 + er) * LDT + eq * 16 + 8) = P_.v[3]; } \
        else { *(LAS u32x4*)((LAS bf16*)(base + 45056) + er * LDT + (3 - eq) * 16 + 8) = REV8(P_.v[0]); *(LAS u32x4*)((LAS bf16*)(base + 45056) + er * LDT + (3 - eq) * 16) = REV8(P_.v[1]); \
            *(LAS u32x4*)((LAS bf16*)(base + 45056) + (64 + er) * LDT + (3 - eq) * 16 + 8) = REV8(P_.v[2]); *(LAS u32x4*)((LAS bf16*)(base + 45056) + (64 + er) * LDT + (3 - eq) * 16) = REV8(P_.v[3]); } \
        if (e < 128) ((LAS float*)(base + 63488))[e] = P_.g; } while (0)
        GLA_ISSUE(0, PA); GLA_ISSUE(1, PB_);
#pragma unroll 1
        for (int ci = 0; ci < nch; ci += 2) {
            GLA_COMMIT(0, PA); LDSBAR(); if (ci + 2 < nch) GLA_ISSUE(ci + 2, PA);
            GLA_COMMIT(1, PB_); LDSBAR(); if (ci + 3 < nch) GLA_ISSUE(ci + 3, PB_); }
#undef GLA_ISSUE
#undef GLA_COMMIT
#undef REV8
    } else {
        f32x4 S[2][8];
        if (s >= 16) { int ln = lane_o; asm volatile("" : "+v"(ln)); const int l15 = ln & 15, q4 = ln >> 4; const float* sp = in[4] + ((size_t)((s - 16) * 2 + d) * 16 + h) * 16384;
#pragma unroll
            for (int x = 0; x < 2; ++x)
#pragma unroll
                for (int t = 0; t < 8; ++t)
#pragma unroll
                    for (int r = 0; r < 4; ++r) S[x][t][r] = sp[(size_t)(16 * t + 4 * q4 + r) * 128 + 32 * wave + 16 * x + l15];
        } else {
#pragma unroll
            for (int x = 0; x < 2; ++x)
#pragma unroll
                for (int t = 0; t < 8; ++t) S[x][t] = (f32x4){0.f, 0.f, 0.f, 0.f}; }
#pragma unroll 1
        for (int ci = 0; ci < nch; ci += 2) { LDSBAR(); gla_scan_step(F, S, 0, ci, d, len, row0, h, OUT); LDSBAR(); gla_scan_step(F, S, 1, ci + 1, d, len, row0, h, OUT); }
        if (s < 16) { int ln = lane_o; asm volatile("" : "+v"(ln)); const int l15 = ln & 15, q4 = ln >> 4; float* sp = F.out + OUT_SH + ((size_t)(s * 2 + d) * 16 + h) * 16384;
#pragma unroll
            for (int x = 0; x < 2; ++x)
#pragma unroll
                for (int t = 0; t < 8; ++t)
#pragma unroll
                    for (int r = 0; r < 4; ++r) sp[(size_t)(16 * t + 4 * q4 + r) * 128 + 32 * wave + 16 * x + l15] = S[x][t][r]; }
    }
}

struct M1aRaw { u32x4 a[2], b[2], m[2], p[2]; };
DI void m1a_load(const Ctx& F, int item, M1aRaw& R) {
    const int tt = item >> 5, cb = item & 31, r0 = tt * 64, c0 = cb * 256;
    const bf16* U = (const bf16*)(F.ws + WS_U);
    const int cg = F.lane & 31;
    const int len = r0 < 4096 ? 256 : 4096, tbase = r0 < 4096 ? (r0 & 255) : ((r0 - 4096) & 4095);
    const int col = c0 + cg * 8;
#pragma unroll
    for (int itk = 0; itk < 2; ++itk) { const int tp = itk * 16 + F.wave * 2 + (F.lane >> 5);
        const int tl = 2 * tp, t = tbase + tl; const bf16* ur = U + (size_t)(r0 + tl) * IN_ODD + col;
        R.a[itk] = *(const u32x4*)ur; R.b[itk] = *(const u32x4*)(ur + IN_ODD);
        R.m[itk] = (u32x4){0u, 0u, 0u, 0u}; R.p[itk] = (u32x4){0u, 0u, 0u, 0u};
        if (col < 6144) { if (t > 0) R.m[itk] = *(const u32x4*)(ur - IN_ODD); if (t + 2 < len) R.p[itk] = *(const u32x4*)(ur + 2 * IN_ODD); } }
}
DI void m1a_item(const Ctx& F, const float* const* in, int item, M1aRaw& R, int next_item) {
    LAS unsigned* T = (LAS unsigned*)F.lds;
    const int tt = item >> 5, cb = item & 31, r0 = tt * 64, c0 = cb * 256;
    bf16* TB = (bf16*)(F.ws + WS_TB);
    const int cg = F.lane & 31;
    const int col = c0 + cg * 8;
#pragma unroll
    for (int itk = 0; itk < 2; ++itk) { const int tp = itk * 16 + F.wave * 2 + (F.lane >> 5);
        float xa[8], xb[8], oa[8], ob[8]; unpack8(R.a[itk], xa); unpack8(R.b[itk], xb);
        if (col < 6144) { float xm[8], xp[8]; unpack8(R.m[itk], xm); unpack8(R.p[itk], xp);
            const float* cw = in[23] + col;
#pragma unroll
            for (int e = 0; e < 8; ++e) { oa[e] = cw[e] * xm[e] + cw[6144 + e] * xa[e] + cw[12288 + e] * xb[e]; ob[e] = cw[e] * xa[e] + cw[6144 + e] * xb[e] + cw[12288 + e] * xp[e]; }
        } else {
#pragma unroll
            for (int e = 0; e < 8; ++e) { oa[e] = siluf_(xa[e]); ob[e] = siluf_(xb[e]); } }
#pragma unroll
        for (int e = 0; e < 8; ++e) T[(e * 32 + cg) * 33 + tp] = pk2(oa[e], ob[e]); }
    if (next_item >= 0) m1a_load(F, next_item, R);
    LDSBAR();
#pragma unroll
    for (int k = 0; k < 4; ++k) { const int e = F.tid + 512 * k, part = e & 7, chi = e >> 3;
        const int ch = (chi & 31) * 8 + (chi >> 5);
        const LAS unsigned* sp = T + chi * 33 + part * 4;
        u32x4 w; w.x = sp[0]; w.y = sp[1]; w.z = sp[2]; w.w = sp[3];
        *(u32x4*)(TB + (size_t)(c0 + ch) * NROWS + r0 + part * 8) = w; }
    LDSBAR();
}

DI f32x2 w16(int k) {
    switch (k & 7) {
        case 0: return (f32x2){1.0f, 0.0f};
        case 1: return (f32x2){0.9238795325112867f, -0.3826834323650898f};
        case 2: return (f32x2){0.7071067811865476f, -0.7071067811865476f};
        case 3: return (f32x2){0.3826834323650898f, -0.9238795325112867f};
        case 4: return (f32x2){0.0f, -1.0f};
        case 5: return (f32x2){-0.3826834323650898f, -0.9238795325112867f};
        case 6: return (f32x2){-0.7071067811865476f, -0.7071067811865476f};
        default: return (f32x2){-0.9238795325112867f, -0.3826834323650898f};
    }
}
DI f32x2 cmul(f32x2 a, f32x2 b) { return (f32x2){a[0] * b[0] - a[1] * b[1], a[0] * b[1] + a[1] * b[0]}; }
DI f32x2 cmulc(f32x2 a, f32x2 b) { return (f32x2){a[0] * b[0] + a[1] * b[1], a[1] * b[0] - a[0] * b[1]}; }
template <int LOGR, bool INV, bool UNIT = false> DI void fft_bfly(f32x2 (&x)[1 << LOGR], f32x2 w0) {
    constexpr int R = 1 << LOGR;
    f32x2 wj[LOGR];
    wj[0] = w0;
#pragma unroll
    for (int s = 1; s < LOGR; ++s) wj[s] = cmul(wj[s - 1], wj[s - 1]);
#pragma unroll
    for (int ss = 0; ss < LOGR; ++ss) { const int s = INV ? (LOGR - 1 - ss) : ss; const int hm = R >> (s + 1);
#pragma unroll
        for (int m = 0; m < R; ++m) { if (m & hm) continue; const int mm = m % hm;
            const int k16 = mm * (16 >> (LOGR - s));
            if (UNIT && k16 == 0) { const f32x2 a = x[m], b = x[m + hm]; x[m] = a + b; x[m + hm] = a - b; continue; }
            if (UNIT && k16 == 4) {
                if (!INV) { const f32x2 a = x[m], b = x[m + hm], d = a - b; x[m] = a + b; x[m + hm] = (f32x2){d[1], -d[0]}; }
                else { const f32x2 a = x[m], bb = x[m + hm], b = (f32x2){-bb[1], bb[0]}; x[m] = a + b; x[m + hm] = a - b; }
                continue; }
            f32x2 w;
            if (UNIT) w = w16(k16);
            else if (k16 == 0) w = wj[s];
            else if (k16 == 4) w = (f32x2){wj[s][1], -wj[s][0]};
            else w = cmul(wj[s], w16(k16));
            if (!INV) { const f32x2 a = x[m], b = x[m + hm]; x[m] = a + b; x[m + hm] = cmul(a - b, w); }
            else { const f32x2 a = x[m], b = cmulc(x[m + hm], w); x[m] = a + b; x[m + hm] = a - b; } } }
}
template <int LOGR, bool INV, int PADSH> DI void fft_group(LAS f32x2* buf, const LAS f32x2* TW, int B, int tws, int g) {
    constexpr int R = 1 << LOGR;
    const int stride = B >> LOGR, blk = g / stride, j = g - blk * stride;
    const int base = blk * B + j;
    LAS f32x2* p = buf + base + (base >> PADSH);
    const int pstride = stride >= (1 << PADSH) ? stride + (stride >> PADSH) : stride;
    f32x2 x[R];
#pragma unroll
    for (int m = 0; m < R; ++m) x[m] = p[m * pstride];
    fft_bfly<LOGR, INV>(x, TW[j * tws]);
#pragma unroll
    for (int m = 0; m < R; ++m) p[m * pstride] = x[m];
}
template <int LOGR, bool INV, int PADSH> DI void fft_group2(LAS f32x2* buf, const LAS f32x2* TW, int B, int tws, int g0, int g1) {
    constexpr int R = 1 << LOGR;
    const int stride = B >> LOGR, pstride = stride >= (1 << PADSH) ? stride + (stride >> PADSH) : stride;
    const int blk0 = g0 / stride, j0 = g0 - blk0 * stride, base0 = blk0 * B + j0;
    const int blk1 = g1 / stride, j1 = g1 - blk1 * stride, base1 = blk1 * B + j1;
    LAS f32x2* p0 = buf + base0 + (base0 >> PADSH); LAS f32x2* p1 = buf + base1 + (base1 >> PADSH);
    f32x2 xa[R], xb[R];
#pragma unroll
    for (int m = 0; m < R; ++m) xa[m] = p0[m * pstride];
#pragma unroll
    for (int m = 0; m < R; ++m) xb[m] = p1[m * pstride];
    const f32x2 wa = TW[j0 * tws], wb = TW[j1 * tws];
    SCHED_FENCE();
    fft_bfly<LOGR, INV>(xa, wa);
#pragma unroll
    for (int m = 0; m < R; ++m) p0[m * pstride] = xa[m];
    fft_bfly<LOGR, INV>(xb, wb);
#pragma unroll
    for (int m = 0; m < R; ++m) p1[m * pstride] = xb[m];
}
template <int PADSH> DI void fft_first8(LAS f32x2* buf, f32x2 w0, int N, int j, f32x2 i0, f32x2 i1, f32x2 i2, f32x2 i3) {
    const int stride = N >> 3, pstride = stride + (stride >> PADSH);
    f32x2 x[8] = {i0, i1, i2, i3, (f32x2){0.f, 0.f}, (f32x2){0.f, 0.f}, (f32x2){0.f, 0.f}, (f32x2){0.f, 0.f}};
    fft_bfly<3, false>(x, w0);
    LAS f32x2* p = buf + j + (j >> PADSH);
#pragma unroll
    for (int m = 0; m < 8; ++m) p[m * pstride] = x[m];
}
template <int PADSH> DI void fft_last8(const LAS f32x2* buf, f32x2 w0, int N, int j, f32x2& o0, f32x2& o1, f32x2& o2, f32x2& o3) {
    const int stride = N >> 3, pstride = stride + (stride >> PADSH);
    const LAS f32x2* p = buf + j + (j >> PADSH);
    f32x2 x[8];
#pragma unroll
    for (int m = 0; m < 8; ++m) x[m] = p[m * pstride];
    fft_bfly<3, true>(x, w0);
    o0 = x[0]; o1 = x[1]; o2 = x[2]; o3 = x[3];
}
#define PD4(i_) ((i_) + ((i_) >> 4))
#define PD3(i_) ((i_) + ((i_) >> 3))
template <bool INV> DI void fft8192(LAS f32x2* buf, const LAS f32x2* TW, int tid) {
    if (!INV) {
        fft_group2<3, false, 4>(buf, TW, 8192, 1, tid, tid + 512); LDSBAR();
        fft_group2<3, false, 4>(buf, TW, 1024, 8, tid, tid + 512); LDSBAR();
        fft_group2<3, false, 4>(buf, TW, 128, 64, tid, tid + 512); LDSBAR();
        fft_group<4, false, 4>(buf, TW, 16, 0, tid); LDSBAR();
    } else {
        fft_group<4, true, 4>(buf, TW, 16, 0, tid); LDSBAR();
        fft_group2<3, true, 4>(buf, TW, 128, 64, tid, tid + 512); LDSBAR();
        fft_group2<3, true, 4>(buf, TW, 1024, 8, tid, tid + 512); LDSBAR();
        fft_group2<3, true, 4>(buf, TW, 8192, 1, tid, tid + 512); LDSBAR();
    }
}
#define WSYNC() asm volatile("s_waitcnt lgkmcnt(0)" ::: "memory")
template <bool INV> DI void fft512(LAS f32x2* buf, const LAS f32x2* TW, int lane) {
    if (!INV) { fft_group<3, false, 3>(buf, TW, 512, 16, lane); WSYNC(); fft_group<3, false, 3>(buf, TW, 64, 128, lane); WSYNC(); fft_group<3, false, 3>(buf, TW, 8, 0, lane); WSYNC(); }
    else { fft_group<3, true, 3>(buf, TW, 8, 0, lane); WSYNC(); fft_group<3, true, 3>(buf, TW, 64, 128, lane); WSYNC(); fft_group<3, true, 3>(buf, TW, 512, 16, lane); WSYNC(); }
}
constexpr int LDS_TW = 139264;
DI void fft_table_init(const Ctx& F) { LAS f32x2* TW = (LAS f32x2*)(F.lds + LDS_TW);
    for (int j = F.tid; j < 1024; j += 512) { float sn, cs; sincospif(-2.0f * (float)j / 8192.0f, &sn, &cs); TW[j] = (f32x2){cs, sn}; }
    LDSBAR(); }
DI f32x2 filt_spec(f32x2 z1, f32x2 z2, int ord) { const float sg = ord ? -0.5f : 0.5f; const float ar = 0.5f * z1[0] + sg * z2[0], ai = 0.5f * z1[1] - sg * z2[1];
    return ord ? (f32x2){ai, -ar} : (f32x2){ar, ai}; }

template <int LOGR, int PADSH, int LOGN> DI void fft_mid(LAS f32x2* D, const LAS f32x2* HZ, int ord, int g) {
    constexpr int R = 1 << LOGR, N = 1 << LOGN;
    LAS f32x2* p = D + g * R + ((g * R) >> PADSH);
    f32x2 x[R];
#pragma unroll
    for (int m = 0; m < R; ++m) x[m] = p[m];
    fft_bfly<LOGR, false, true>(x, (f32x2){1.f, 0.f});
#pragma unroll
    for (int m = 0; m < R; ++m) { const int t = g * R + m; const int fq = (int)(__brev((unsigned)t) >> (32 - LOGN)), t2 = (int)(__brev((unsigned)((N - fq) & (N - 1))) >> (32 - LOGN));
        x[m] = cmul(x[m], filt_spec(HZ[t + (t >> PADSH)], HZ[t2 + (t2 >> PADSH)], ord)) * (1.0f / (float)N); }
    fft_bfly<LOGR, true, true>(x, (f32x2){1.f, 0.f});
#pragma unroll
    for (int m = 0; m < R; ++m) p[m] = x[m];
}
DI void hyena_dec_item(const Ctx& F, const float* const* in, int c) {
    LAS f32x2* HB = (LAS f32x2*)F.lds;
    LAS f32x2* DB = HB + 8704;
    const LAS f32x2* TW = (const LAS f32x2*)(F.lds + LDS_TW);
    const bf16* TB = (const bf16*)(F.ws + WS_TB); bf16* YT = (bf16*)(F.ws + WS_YT);
    const float* HF = (const float*)(F.ws + WS_HF4096); const float* HN = (const float*)(F.ws + WS_HNRM) + 4096;
    const int tid_o = F.tid;
    float va[8], vb[8];
#pragma unroll
    for (int k = 0; k < 8; ++k) { const int t = tid_o + 512 * k; va[k] = bf2f(TB[(size_t)c * NROWS + 4096 + t]); vb[k] = bf2f(TB[(size_t)c * NROWS + 8192 + t]); }
    { const float n0 = HN[c], n1 = HN[2048 + c]; const float* h0 = HF + (size_t)c * 8192; const float* h1 = HF + ((size_t)2048 + c) * 8192;
#pragma unroll 8
      for (int k = 0; k < 16; ++k) { const int t = tid_o + 512 * k; HB[PD4(t)] = (f32x2){h0[t] * n0, h1[t] * n1}; } }
    LDSBAR();
    fft8192<false>(HB, TW, tid_o);
#pragma unroll 1
    for (int ord = 0; ord < 2; ++ord) {
        int tid = tid_o; asm volatile("" : "+v"(tid));
        const size_t xoff = (size_t)((ord + 1) * 2048 + c) * NROWS, zoff = (size_t)(6144 + c) * NROWS;
        bf16 rxa[8], rxb[8], rza[8], rzb[8];
#pragma unroll
        for (int k = 0; k < 8; ++k) { const int t = tid + 512 * k; rxa[k] = TB[xoff + 4096 + t]; rxb[k] = TB[xoff + 8192 + t];
            if (ord == 1) { rza[k] = TB[zoff + 4096 + t]; rzb[k] = TB[zoff + 8192 + t]; } else { rza[k] = 0; rzb[k] = 0; } }
        fft_first8<4>(DB, TW[tid], 8192, tid, (f32x2){va[0], vb[0]}, (f32x2){va[2], vb[2]}, (f32x2){va[4], vb[4]}, (f32x2){va[6], vb[6]});
        fft_first8<4>(DB, TW[tid + 512], 8192, tid + 512, (f32x2){va[1], vb[1]}, (f32x2){va[3], vb[3]}, (f32x2){va[5], vb[5]}, (f32x2){va[7], vb[7]});
        LDSBAR();
        fft_group2<3, false, 4>(DB, TW, 1024, 8, tid, tid + 512); LDSBAR();
        fft_group2<3, false, 4>(DB, TW, 128, 64, tid, tid + 512); LDSBAR();
        fft_mid<4, 4, 13>(DB, HB, ord, tid); LDSBAR();
        fft_group2<3, true, 4>(DB, TW, 128, 64, tid, tid + 512); LDSBAR();
        fft_group2<3, true, 4>(DB, TW, 1024, 8, tid, tid + 512); LDSBAR();
        f32x2 y[8];
        fft_last8<4>(DB, TW[tid], 8192, tid, y[0], y[2], y[4], y[6]);
        fft_last8<4>(DB, TW[tid + 512], 8192, tid + 512, y[1], y[3], y[5], y[7]);
        const float bias = in[30][ord * 2048 + c];
#pragma unroll
        for (int k = 0; k < 8; ++k) { const int t = tid + 512 * k;
            va[k] = bf2f(rxa[k]) * (y[k][0] + bias * va[k]); vb[k] = bf2f(rxb[k]) * (y[k][1] + bias * vb[k]);
            if (ord == 1) { YT[(size_t)c * NROWS + 4096 + t] = f2bf(va[k] * bf2f(rza[k])); YT[(size_t)c * NROWS + 8192 + t] = f2bf(vb[k] * bf2f(rzb[k])); } }
    }
    LDSBAR();
}
DI void hyena_ctx_item(const Ctx& F, const float* const* in, int c, int p0) {
    LAS f32x2* HZ = (LAS f32x2*)F.lds + F.wave * 1152;
    LAS f32x2* D = HZ + 576;
    const LAS f32x2* TW = (const LAS f32x2*)(F.lds + LDS_TW);
    const bf16* TB = (const bf16*)(F.ws + WS_TB); bf16* YT = (bf16*)(F.ws + WS_YT);
    const float* HF = (const float*)(F.ws + WS_HF256); const float* HN = (const float*)(F.ws + WS_HNRM);
    const int lane = F.lane;
    { const float n0 = HN[c], n1 = HN[2048 + c]; const float* h0 = HF + (size_t)c * 512; const float* h1 = HF + ((size_t)2048 + c) * 512;
#pragma unroll
      for (int k = 0; k < 8; ++k) { const int t = lane + 64 * k; HZ[PD3(t)] = (f32x2){h0[t] * n0, h1[t] * n1}; } }
    WSYNC();
    fft512<false>(HZ, TW, lane);
#pragma unroll 1
    for (int pp = p0; pp < p0 + 4; ++pp) { const int ra = (2 * pp) * 256, rb = (2 * pp + 1) * 256;
    float va[4], vb[4];
#pragma unroll
    for (int k = 0; k < 4; ++k) { const int t = lane + 64 * k; va[k] = bf2f(TB[(size_t)c * NROWS + ra + t]); vb[k] = bf2f(TB[(size_t)c * NROWS + rb + t]); }
#pragma unroll 1
    for (int ord = 0; ord < 2; ++ord) {
        const size_t xoff = (size_t)((ord + 1) * 2048 + c) * NROWS, zoff = (size_t)(6144 + c) * NROWS;
        bf16 rxa[4], rxb[4], rza[4], rzb[4];
#pragma unroll
        for (int k = 0; k < 4; ++k) { const int t = lane + 64 * k; rxa[k] = TB[xoff + ra + t]; rxb[k] = TB[xoff + rb + t];
            if (ord == 1) { rza[k] = TB[zoff + ra + t]; rzb[k] = TB[zoff + rb + t]; } else { rza[k] = 0; rzb[k] = 0; } }
        fft_first8<3>(D, TW[lane * 16], 512, lane, (f32x2){va[0], vb[0]}, (f32x2){va[1], vb[1]}, (f32x2){va[2], vb[2]}, (f32x2){va[3], vb[3]}); WSYNC();
        fft_group<3, false, 3>(D, TW, 64, 128, lane); WSYNC();
        fft_mid<3, 3, 9>(D, HZ, ord, lane); WSYNC();
        fft_group<3, true, 3>(D, TW, 64, 128, lane); WSYNC();
        f32x2 y[4];
        fft_last8<3>(D, TW[lane * 16], 512, lane, y[0], y[1], y[2], y[3]);
        const float bias = in[30][ord * 2048 + c];
#pragma unroll
        for (int k = 0; k < 4; ++k) { const int t = lane + 64 * k;
            va[k] = bf2f(rxa[k]) * (y[k][0] + bias * va[k]); vb[k] = bf2f(rxb[k]) * (y[k][1] + bias * vb[k]);
            if (ord == 1) { YT[(size_t)c * NROWS + ra + t] = f2bf(va[k] * bf2f(rza[k])); YT[(size_t)c * NROWS + rb + t] = f2bf(vb[k] * bf2f(rzb[k])); } }
        WSYNC();
    }
    }
}
DI void phase_m1a(const Ctx& F, const float* const* in) {
    { M1aRaw R; int it = F.bid; if (it < 192 * 32) m1a_load(F, it, R);
#pragma unroll 1
      for (; it < 192 * 32; it += F.G) m1a_item(F, in, it, R, it + F.G < 192 * 32 ? it + F.G : -1); }
    gla_prep_all(F, in);
}
DI void phase_m1b(const Ctx& F, const float* const* in, int pass = 0) {
    const int b = F.bid; unsigned* ctl = (unsigned*)(F.ws + WS_CTL) + pass * 1024;
    fft_table_init(F);
#ifndef P11_ONLY
#define P11_ONLY 0
#endif
    const int only = pass ? P11_ONLY : 0;
    if (b < 64 && (only == 0 || only == 1)) gla_scan_item(F, in, 16 + (b >> 5), (b >> 1) & 15, b & 1);
    if (only == 0 || only == 2) for (;;) { const int it = queue_grab(F, ctl + CW_Q0, 1); if (it >= 2048) break; hyena_dec_item(F, in, it); }
    if (only == 0 || only == 3) for (;;) { const int it = queue_grab(F, ctl + CW_Q1, 1); if (it >= 512) break; gla_scan_item(F, in, it >> 5, (it >> 1) & 15, it & 1); }
    if (only == 0 || only == 4) for (;;) { const int g = queue_grab(F, ctl + CW_Q2, 1); if (g >= 512) break;
        hyena_ctx_item(F, in, (g >> 1) * 8 + F.wave, (g & 1) * 4); }
}
DI void phase_m1c(const Ctx& F, const float* const* in) {
    const int gw = F.bid * 8 + F.wave, NGW = F.G * 8, lane = F.lane;
    const bf16* U = (const bf16*)(F.ws + WS_U); bf16* MIX = (bf16*)(F.ws + WS_MIX);
    const bf16 *OFA = (const bf16*)(F.ws + WS_OFA), *OBA = (const bf16*)(F.ws + WS_OBA);
    const int hsub = lane >> 4, c8 = (lane & 15) * 8;
    const f32x4 gn0 = *(const f32x4*)(in[32] + c8), gn1 = *(const f32x4*)(in[32] + c8 + 4);
    for (int row = gw; row < NROWS; row += NGW) { const bf16* ur = U + (size_t)row * IN_ODD;
        u32x4 af[4], ab[4], az[4];
#pragma unroll
        for (int hq = 0; hq < 4; ++hq) { const size_t o = (size_t)row * 2048 + (hq * 4 + hsub) * 128 + c8;
            af[hq] = *(const u32x4*)(OFA + o); ab[hq] = *(const u32x4*)(OBA + o); az[hq] = *(const u32x4*)(ur + O_ZD + (hq * 4 + hsub) * 128 + c8); }
#pragma unroll
        for (int hq = 0; hq < 4; ++hq) { float x[8], y[8], z[8]; unpack8(af[hq], x); unpack8(ab[hq], y); unpack8(az[hq], z);
            float ss = 0.f;
#pragma unroll
            for (int e = 0; e < 8; ++e) { x[e] += y[e]; ss += x[e] * x[e]; }
            ss += __shfl_xor(ss, 1); ss += __shfl_xor(ss, 2); ss += __shfl_xor(ss, 4); ss += __shfl_xor(ss, 8);
            const float rn = __builtin_amdgcn_rsqf(ss * (1.0f / 128.0f) + EPS);
            u32x4 w; w.x = pk2(x[0] * rn * gn0[0] * siluf_(z[0]), x[1] * rn * gn0[1] * siluf_(z[1])); w.y = pk2(x[2] * rn * gn0[2] * siluf_(z[2]), x[3] * rn * gn0[3] * siluf_(z[3]));
            w.z = pk2(x[4] * rn * gn1[0] * siluf_(z[4]), x[5] * rn * gn1[1] * siluf_(z[5])); w.w = pk2(x[6] * rn * gn1[2] * siluf_(z[6]), x[7] * rn * gn1[3] * siluf_(z[7]));
            *(u32x4*)(MIX + (size_t)row * DM + 2048 + (hq * 4 + hsub) * 128 + c8) = w; } }
    const bf16* YT = (const bf16*)(F.ws + WS_YT);
    LAS bf16* T = (LAS bf16*)(F.lds + F.wave * 8448);
    for (int it = gw; it < 32 * 192; it += NGW) { const int cb = it & 31, rbk = it >> 5, c0 = cb * 64, r0 = rbk * 64;
#pragma unroll
        for (int k = 0; k < 8; ++k) { const int ch = 8 * k + (lane >> 3); const u32x4 w = *(const u32x4*)(YT + (size_t)(c0 + ch) * NROWS + r0 + (lane & 7) * 8);
            LAS bf16* dp = T + ch * 66 + (lane & 7) * 8;
            dp[0] = (bf16)(w.x & 0xffffu); dp[1] = (bf16)(w.x >> 16); dp[2] = (bf16)(w.y & 0xffffu); dp[3] = (bf16)(w.y >> 16); dp[4] = (bf16)(w.z & 0xffffu); dp[5] = (bf16)(w.z >> 16); dp[6] = (bf16)(w.w & 0xffffu); dp[7] = (bf16)(w.w >> 16); }
        asm volatile("s_waitcnt lgkmcnt(0)" ::: "memory");
#pragma unroll
        for (int k = 0; k < 8; ++k) { const int rr = 8 * k + (lane >> 3), cc = (lane & 7) * 8;
            u32x4 w; w.x = (unsigned)T[(cc + 0) * 66 + rr] | ((unsigned)T[(cc + 1) * 66 + rr] << 16); w.y = (unsigned)T[(cc + 2) * 66 + rr] | ((unsigned)T[(cc + 3) * 66 + rr] << 16);
            w.z = (unsigned)T[(cc + 4) * 66 + rr] | ((unsigned)T[(cc + 5) * 66 + rr] << 16); w.w = (unsigned)T[(cc + 6) * 66 + rr] | ((unsigned)T[(cc + 7) * 66 + rr] << 16);
            *(u32x4*)(MIX + (size_t)(r0 + rr) * DM + c0 + cc) = w; }
        asm volatile("s_waitcnt lgkmcnt(0)" ::: "memory"); }
}
constexpr int NWAVES = 8, NTHREADS = 512;
constexpr int LDS_BYTES = 163840;
constexpr int LDS_MISC = LDS_BYTES - 64;
constexpr int N_PHASES = 14;
struct Args { const float* in[33]; float* out; unsigned char* ws; int ph_lo, ph_hi; };

__global__ void __launch_bounds__(NTHREADS, 2) mk_fwd(Args args) {
    extern __shared__ __attribute__((aligned(16))) unsigned char lds_raw[];
    Ctx F;
    F.lds = (LAS unsigned char*)lds_raw; F.in = nullptr; F.ws = args.ws; F.out = args.out;
    F.tid = threadIdx.x; F.lane = F.tid & 63; F.wave = __builtin_amdgcn_readfirstlane(F.tid >> 6); F.bid = blockIdx.x; F.G = gridDim.x;
    const float* const* in = args.in;
    volatile LAS unsigned* xbw = (volatile LAS unsigned*)(F.lds + LDS_MISC);
    if (F.tid < 4) xbw[F.tid] = 0u;
    __syncthreads();
    unsigned* ctl = (unsigned*)(args.ws + WS_CTL);
    XcdBarrier bar = xcd_barrier_post(ctl + CW_BAR, xbw);
    const int lo = args.ph_lo, hi = args.ph_hi;
#ifndef PHASE_MASK
#define PHASE_MASK 0xffffffffu
#endif
#define IN(k) (((PHASE_MASK >> (k)) & 1u) && lo <= (k) && (k) < hi)
#define SEAM(k) do { if (IN(k) && IN((k) + 1)) xcd_barrier(bar); } while (0)
#ifndef DUP_MASK
#define DUP_MASK 0u
#endif
#define DUP(k) (((DUP_MASK >> (k)) & 1u) != 0u)
    if (IN(0)) { phase_p0(F, in); if (DUP(0)) { xcd_barrier(bar); phase_p0(F, in); } }
    SEAM(0);
    if (IN(1)) { phase_p0c(F, in); if (DUP(1)) { xcd_barrier(bar); phase_p0c(F, in); } }
    SEAM(1);
    if (IN(2)) { phase_norm<0>(F, in); if (DUP(2)) { xcd_barrier(bar); phase_norm<0>(F, in); } }
    SEAM(2);
    if (IN(3)) { pg8::Gemm g{(const pg8::bf16_t*)(F.ws + WS_H), (const pg8::bf16_t*)(F.ws + WS_WTE), NROWS, LD_EVEN, DM}; pg8::StaticOrder S; S.init(NROWS, LD_EVEN, F.G, F.bid);
        pg8::EpiStoreBf16 E{(pg8::bf16_t*)(F.ws + WS_U), LD_EVEN};
        pg8::gemm_phase<pg8::EpiStoreBf16, pg8::StaticOrder, true, true>(F.lds, g, S, E);
        if (DUP(3)) { xcd_barrier(bar); pg8::gemm_phase<pg8::EpiStoreBf16, pg8::StaticOrder, true, true>(F.lds, g, S, E); }
        { constexpr int NU = (NROWS / 256) * (LD_EVEN / 256); const int nfull = NU % F.G;
          if (nfull > 0 && F.bid >= nfull) { convert_wout(F, in, F.bid - nfull, F.G - nfull, 0); convert_wodd(F, in, F.bid - nfull, F.G - nfull); } else if (nfull == 0) { convert_wout(F, in, F.bid, F.G, 0); convert_wodd(F, in, F.bid, F.G); } } }
    SEAM(3);
    if (IN(4)) { phase_m0a(F, in); if (DUP(4)) { xcd_barrier(bar); phase_m0a(F, in); } }
    SEAM(4);
#ifndef P5_ONLY
#define P5_ONLY 0
#endif
    if (IN(5)) { phase_m0(F, in); if (DUP(5)) { xcd_barrier(bar); phase_m0(F, in, P5_ONLY); } }
    SEAM(5);
    if (IN(6)) { phase_m0c(F, in); if (DUP(6)) { xcd_barrier(bar); phase_m0c(F, in); } }
    SEAM(6);
    if (IN(7)) { pg8::Gemm g{(const pg8::bf16_t*)(F.ws + WS_MIX), (const pg8::bf16_t*)(F.ws + WS_WTOUT), NROWS, DM, DM}; pg8::StaticOrder S; S.init(NROWS, DM, F.G, F.bid);
        pg8::EpiResGateBf16 E{(pg8::bf16_t*)xr_base(F), LDX, (const float*)(F.ws + WS_MODF) + (size_t)6 * 4096};
        pg8::gemm_phase<pg8::EpiResGateBf16, pg8::StaticOrder, true, true>(F.lds, g, S, E); }
    SEAM(7);
    if (IN(8)) { phase_norm<1>(F, in); if (DUP(8)) { xcd_barrier(bar); phase_norm<1>(F, in); } }
    SEAM(8);
    if (IN(9)) { pg8::Gemm g{(const pg8::bf16_t*)(F.ws + WS_H), (const pg8::bf16_t*)(F.ws + WS_WTO), NROWS, IN_ODD, DM}; pg8::StaticOrder S; S.init(NROWS, IN_ODD, F.G, F.bid);
        pg8::EpiStoreBf16 E{(pg8::bf16_t*)(F.ws + WS_U), IN_ODD};
        pg8::gemm_phase<pg8::EpiStoreBf16, pg8::StaticOrder, true, true>(F.lds, g, S, E);
        if (DUP(9)) { xcd_barrier(bar); pg8::gemm_phase<pg8::EpiStoreBf16, pg8::StaticOrder, true, true>(F.lds, g, S, E); }
        { constexpr int NU = (NROWS / 256) * (IN_ODD / 256); const int nfull = NU % F.G;
          if (nfull > 0 && F.bid >= nfull) { phase_filters(F, in, F.bid - nfull, F.G - nfull); convert_wout(F, in, F.bid - nfull, F.G - nfull, 1); } else if (nfull == 0) { phase_filters(F, in, F.bid, F.G); convert_wout(F, in, F.bid, F.G, 1); } } }
    SEAM(9);
    if (IN(10)) { phase_m1a(F, in); if (DUP(10)) { xcd_barrier(bar); phase_m1a(F, in); } }
    SEAM(10);
    if (IN(11)) { phase_m1b(F, in); if (DUP(11)) { xcd_barrier(bar); phase_m1b(F, in, 1); } }
    SEAM(11);
    if (IN(12)) { phase_m1c(F, in); if (DUP(12)) { xcd_barrier(bar); phase_m1c(F, in); } }
    SEAM(12);
    if (IN(13)) { pg8::Gemm g{(const pg8::bf16_t*)(F.ws + WS_MIX), (const pg8::bf16_t*)(F.ws + WS_WTOUT) + (size_t)DM * DM, NROWS, DM, DM}; pg8::StaticOrder S; S.init(NROWS, DM, F.G, F.bid);
        pg8::EpiResGateBf16 E{(pg8::bf16_t*)xr_base(F), LDX, (const float*)(F.ws + WS_MODF) + (size_t)(9 + 6) * 4096};
        pg8::gemm_phase<pg8::EpiResGateBf16, pg8::StaticOrder, true, true>(F.lds, g, S, E); }
    SEAM(13);
    if (IN(14)) phase_norm<2>(F, in);
#ifdef DBG_DUMP
    xcd_barrier(bar);
#define DUMP_ONE(OOFF, ONEXT, PTR, NB, ISBF) do { const size_t no = (size_t)(ONEXT) - (size_t)(OOFF), nb = (NB); float* op = F.out + (OOFF); \
        for (size_t i = (size_t)F.bid * 512 + F.tid; i < no; i += (size_t)F.G * 512) { float acc = 0.f; \
            for (size_t j = i; j < nb; j += no) acc += (ISBF) ? bf2f(((const bf16*)(PTR))[j]) : ((const float*)(PTR))[j]; \
            op[i] = acc; } } while (0)
#if DBG_DUMP == 1
    DUMP_ONE(0, 16777216, F.ws + WS_H, (size_t)NROWS * DM, 1);
    DUMP_ONE(16777216, 50331648, F.ws + WS_U, (size_t)NROWS * LD_EVEN, 1);
    DUMP_ONE(50331648, 58720256, F.ws + WS_OFA, (size_t)2 * NROWS * 2048, 0);
    DUMP_ONE(58720256, 67108864, F.ws + WS_OFB, (size_t)2 * NROWS * 2048, 0);
    DUMP_ONE(67108864, 75497472, F.ws + WS_MIX, (size_t)NROWS * DM, 1);
#elif DBG_DUMP == 4
    DUMP_ONE(0, 16777216, F.ws + WS_OFA, (size_t)NROWS * 2048, 0);
    DUMP_ONE(16777216, 50331648, F.ws + WS_OBA, (size_t)NROWS * 2048, 0);
    DUMP_ONE(58720256, 67108864, F.ws + WS_H, (size_t)NROWS * DM, 1);
    DUMP_ONE(67108864, 75497472, F.ws + WS_H, (size_t)NROWS * DM, 1);
#elif DBG_DUMP == 7
    { unsigned fl = 0u; const float* pa = (const float*)(F.ws + WS_OFA); const float* pb = (const float*)(F.ws + WS_OBA); const float* ps = F.out + OUT_SG;
      for (size_t i = (size_t)F.bid * 512 + F.tid; i < (size_t)NROWS * 2048; i += (size_t)F.G * 512) { const size_t row = i >> 11; const float va = pa[i], vb = pb[i];
          if (!(fabsf(va) <= 3.0e38f)) { fl |= row < 4096 ? 1u : 2u; if (row >= 4096 && ((row - 4096) & 4095) < 64) fl |= 32u; }
          if (!(fabsf(vb) <= 3.0e38f)) fl |= row < 4096 ? 4u : 8u; }
      for (size_t i = (size_t)F.bid * 512 + F.tid; i < (size_t)8388608; i += (size_t)F.G * 512) { const float v = ps[i]; if (!(fabsf(v) <= 3.0e38f)) fl |= 16u; }
      if (fl) atomicOr(ctl + 64, fl); }
    xcd_barrier(bar);
    { const unsigned fl = __hip_atomic_load(ctl + 64, __ATOMIC_RELAXED, __HIP_MEMORY_SCOPE_AGENT);
      const unsigned d1 = 1u + (fl & 1u) + ((fl >> 1) & 1u) * 2u + ((fl >> 2) & 1u) * 4u, d2 = 1u + ((fl >> 3) & 1u) + ((fl >> 4) & 1u) * 2u + ((fl >> 5) & 1u) * 4u;
      const unsigned total = d1 * 1000000u + d2 * 100000u;
      for (size_t i = (size_t)F.bid * 512 + F.tid; i < (size_t)75497472; i += (size_t)F.G * 512) F.out[i] = (i < total) ? __uint_as_float(0xAAAAAAAAu) : 1.0f; }
#elif DBG_DUMP == 6
    { unsigned cnt = 0u; const float* pa = (const float*)(F.ws + WS_OFA); const float* ps = F.out + OUT_SG;
      for (size_t i = (size_t)F.bid * 512 + F.tid; i < (size_t)2 * NROWS * 2048; i += (size_t)F.G * 512) { const float v = pa[i]; if (!(fabsf(v) <= 3.0e38f)) ++cnt; }
      for (size_t i = (size_t)F.bid * 512 + F.tid; i < (size_t)8388608; i += (size_t)F.G * 512) { const float v = ps[i]; if (!(fabsf(v) <= 3.0e38f)) ++cnt; }
      if (cnt) atomicAdd(ctl + 64, cnt); }
    xcd_barrier(bar);
    { const unsigned total = __hip_atomic_load(ctl + 64, __ATOMIC_RELAXED, __HIP_MEMORY_SCOPE_AGENT);
      const float* pa = (const float*)(F.ws + WS_OFA);
      for (size_t i = (size_t)F.bid * 512 + F.tid; i < (size_t)75497472; i += (size_t)F.G * 512) {
          float v = 1.0f;
          if (i < 16777216) { if (i < total) v = __uint_as_float(0xAAAAAAAAu); }
          else if (i < 50331648) { const size_t k = i - 16777216; float a = pa[k]; if (!(fabsf(a) <= 3.0e38f)) a = 7.0f; v = a; }
          F.out[i] = v; } }
#elif DBG_DUMP == 5
    DUMP_ONE(0, 16777216, F.ws + WS_OFB, (size_t)NROWS * 2048, 0);
    DUMP_ONE(16777216, 50331648, F.ws + WS_OBB, (size_t)NROWS * 2048, 0);
    DUMP_ONE(50331648, 58720256, F.ws + WS_H, (size_t)NROWS * DM, 1);
    DUMP_ONE(67108864, 75497472, F.ws + WS_H, (size_t)NROWS * DM, 1);
#elif DBG_DUMP == 3
    DUMP_ONE(0, 16777216, F.ws + WS_H, (size_t)NROWS * DM, 1);
    DUMP_ONE(16777216, 50331648, F.ws + WS_U, (size_t)NROWS * LD_EVEN, 1);
    DUMP_ONE(50331648, 58720256, F.ws + WS_WTE, (size_t)LD_EVEN * DM, 1);
    DUMP_ONE(58720256, 67108864, F.ws + WS_MODF, (size_t)(1 * MiB + 512 * 1024) / 4, 0);
    DUMP_ONE(67108864, 75497472, F.ws + WS_HF256, (size_t)2 * 2048 * 512, 0);
#else
    DUMP_ONE(0, 16777216, F.ws + WS_H, (size_t)NROWS * DM, 1);
    DUMP_ONE(16777216, 50331648, F.ws + WS_U, (size_t)NROWS * IN_ODD, 1);
    DUMP_ONE(50331648, 58720256, F.ws + WS_TB, (size_t)8192 * NROWS, 1);
    DUMP_ONE(58720256, 67108864, F.ws + WS_OFA, (size_t)2 * NROWS * 2048, 0);
    DUMP_ONE(67108864, 75497472, F.ws + WS_YT, (size_t)2048 * NROWS, 1);
#endif
#endif
#undef IN
#undef SEAM
}

extern "C" void kernel_launch(void* const* d_in, const int* in_sizes, int n_in, void* d_out, int out_size, void* d_ws, size_t ws_size, hipStream_t stream) {
    static int grid = 0;
    if (grid == 0) {
        if (n_in != 33 || out_size != 75497472 || ws_size < WS_END2) { fprintf(stderr, "kernel_launch: unexpected problem (n_in %d, out %d, ws %zu)\n", n_in, out_size, ws_size); grid = -1; return; }
        int dev = 0, cus = 0, per_cu = 0;
        if (hipGetDevice(&dev) != hipSuccess || hipDeviceGetAttribute(&cus, hipDeviceAttributeMultiprocessorCount, dev) != hipSuccess) { grid = -1; return; }
        if (hipFuncSetAttribute((const void*)mk_fwd, hipFuncAttributeMaxDynamicSharedMemorySize, LDS_BYTES) != hipSuccess) { fprintf(stderr, "kernel_launch: hipFuncSetAttribute failed\n"); grid = -1; return; }
        if (hipOccupancyMaxActiveBlocksPerMultiprocessor(&per_cu, (const void*)mk_fwd, NTHREADS, LDS_BYTES) != hipSuccess || per_cu < 1) { fprintf(stderr, "kernel_launch: occupancy query says %d\n", per_cu); }
        (void)hipGetLastError();
        grid = cus;
        if (grid < 128) { grid = -1; return; }
    }
    if (grid < 0) return;
    (void)hipMemsetAsync((char*)d_ws + WS_CTL, 0, CTL_ZERO_BYTES, stream);
    Args a{};
    for (int i = 0; i < 33; ++i) a.in[i] = (const float*)d_in[i];
    a.out = (float*)d_out; a.ws = (unsigned char*)d_ws;
#ifndef MK_SPLIT
    a.ph_lo = 0; a.ph_hi = N_PHASES + 1;
#ifdef DBG_STOP
    a.ph_hi = DBG_STOP + 1;
#endif
    hipLaunchKernelGGL(mk_fwd, dim3(grid), dim3(NTHREADS), LDS_BYTES, stream, a);
#else
    for (int p = 0; p <= N_PHASES; ++p) { a.ph_lo = p; a.ph_hi = p + 1; hipLaunchKernelGGL(mk_fwd, dim3(grid), dim3(NTHREADS), LDS_BYTES, stream, a); }
#endif
}
```

```cpp
#include <hip/hip_runtime.h>
#include <cstdio>
#include <cstdint>
namespace pg8 {
#define PG8_LAS __attribute__((address_space(3)))
typedef unsigned short bf16_t;
typedef short bf16x8 __attribute__((ext_vector_type(8)));
typedef float f32x4 __attribute__((ext_vector_type(4)));
typedef unsigned u32x4 __attribute__((ext_vector_type(4)));
constexpr int BM = 256, BK = 64, HALF = 128, HTB = HALF * BK * 2  , STAGE_BYTES = 8 * HTB, NXCD = 8, WGM = 8;

__host__ __device__ __forceinline__ int lds_byte(int r, int c) { const int st = (r >> 4) * 2 + (c >> 5), rr = r & 15, cc = c & 31, ob = rr * 64 + cc * 2; return st * 1024 + (ob ^ (((ob >> 9) & 1) << 5)); }
__host__ __device__ __forceinline__ void stage_rc(int b, int& R, int& C) { const int st = b / 1024, sb = b % 1024, swz = sb ^ (((sb >> 9) & 1) << 5); R = (st >> 1) * 16 + swz / 64; C = (st & 1) * 32 + (swz % 64) / 2; }
__host__ __device__ __forceinline__ int perm32(int rho) { const int n = rho >> 4, i = rho & 15; return 8 * (i >> 2) + 4 * n + (i & 3); }

struct Unit { int pm, pn; };
struct Gemm { const bf16_t* A; const bf16_t* Bt; int M, N, K; };

struct StaticOrder {
    int nM, nN, nwg, G, c;
    __host__ __device__ void init(int M, int N, int G_, int c_) { nM = M / BM; nN = N / BM; nwg = nM * nN; G = G_; c = c_; }
    __host__ __device__ bool next(int i, Unit& u) const {
        const long L = (long)i * G + c; if (L >= nwg) return false;
        int wgid = (int)L; { const int q = nwg / NXCD, r = nwg % NXCD, xcd = wgid % NXCD, off = wgid / NXCD; wgid = (xcd < r ? xcd * (q + 1) : r * (q + 1) + (xcd - r) * q) + off; }
        const int nig = WGM * nN, gid = wgid / nig, fm = gid * WGM, gsz = (nM - fm) < WGM ? (nM - fm) : WGM;
        u.pm = fm + ((wgid % nig) % gsz); u.pn = (wgid % nig) / gsz; return true;
    }
    __device__ __forceinline__ void a_ready(const Unit&) const {}
    __device__ __forceinline__ void done(const Unit&) const {}
};
__device__ __forceinline__ unsigned cvt_pk_bf16(float lo, float hi) { unsigned r; asm volatile("v_cvt_pk_bf16_f32 %0, %1, %2" : "=v"(r) : "v"(lo), "v"(hi)); return r; }
typedef __bf16 bf16x2v __attribute__((ext_vector_type(2)));
typedef float f32x2v_ __attribute__((ext_vector_type(2)));
__device__ __forceinline__ unsigned pk_bf16(float lo, float hi) { f32x2v_ v = {lo, hi}; return __builtin_bit_cast(unsigned, __builtin_convertvector(v, bf16x2v)); }
struct EpiStoreBf16 {
    static constexpr bool PERM = true, AFTER_DRAIN = false;
    bf16_t* O; int ldc;
    __device__ __forceinline__ void operator()(const f32x4 (&acc)[2][2][4][2], const Unit& u, int wr, int wc, int fr, int fq) const {
        const int row0 = u.pm * BM + wr * 64 + fr, col0 = u.pn * BM + wc * 32 + 8 * fq;
#pragma unroll
        for (int ai = 0; ai < 2; ++ai)
#pragma unroll
            for (int m = 0; m < 4; ++m) { bf16_t* rowp = O + (size_t)(row0 + ai * HALF + m * 16) * ldc + col0;
#pragma unroll
                for (int bj = 0; bj < 2; ++bj) { const f32x4 v0 = acc[ai][bj][m][0], v1 = acc[ai][bj][m][1];
                    u32x4 w; w.x = pk_bf16(v0[0], v0[1]); w.y = pk_bf16(v0[2], v0[3]); w.z = pk_bf16(v1[0], v1[1]); w.w = pk_bf16(v1[2], v1[3]);
                    *(u32x4*)(rowp + bj * HALF) = w; } }
    }
};
struct EpiResGate {
    static constexpr bool PERM = false, AFTER_DRAIN = false;
    float* io; int ldc; const float* gate;
    __device__ __forceinline__ void operator()(const f32x4 (&acc)[2][2][4][2], const Unit& u, int wr, int wc, int fr, int fq) const {
        const int row0 = u.pm * BM + wr * 64 + fr, col0 = u.pn * BM + wc * 32 + 4 * fq;
        const int rb = u.pm * BM; const int r = rb < 4096 ? 0 : 1 + ((rb - 4096) >> 12);
        const float* g = gate + r * 4096 + col0;
        f32x4 gv[2][2];
#pragma unroll
        for (int bj = 0; bj < 2; ++bj)
#pragma unroll
            for (int n = 0; n < 2; ++n) gv[bj][n] = *(const f32x4*)(g + bj * HALF + n * 16);
#pragma unroll
        for (int ai = 0; ai < 2; ++ai)
#pragma unroll
            for (int m = 0; m < 4; ++m) { float* rowp = io + (size_t)(row0 + ai * HALF + m * 16) * ldc + col0;
#pragma unroll
                for (int bj = 0; bj < 2; ++bj)
#pragma unroll
                    for (int n = 0; n < 2; ++n) { f32x4* p = (f32x4*)(rowp + bj * HALF + n * 16); const f32x4 b = *p; *p = b + gv[bj][n] * acc[ai][bj][m][n]; }
                if (m == 3) asm volatile("" ::: "memory"); }
    }
};

struct EpiResGateBf16 {
    static constexpr bool PERM = true, AFTER_DRAIN = false;
    bf16_t* io; int ldc; const float* gate;
    __device__ __forceinline__ void operator()(const f32x4 (&acc)[2][2][4][2], const Unit& u, int wr, int wc, int fr, int fq) const {
        const int row0 = u.pm * BM + wr * 64 + fr, col0 = u.pn * BM + wc * 32 + 8 * fq;
        const int rb = u.pm * BM; const int r = rb < 4096 ? 0 : 1 + ((rb - 4096) >> 12);
        const float* g = gate + r * 4096 + col0;
        f32x4 gv[2][2];
#pragma unroll
        for (int bj = 0; bj < 2; ++bj)
#pragma unroll
            for (int n = 0; n < 2; ++n) gv[bj][n] = *(const f32x4*)(g + bj * HALF + 4 * n);
#pragma unroll
        for (int ai = 0; ai < 2; ++ai)
#pragma unroll
            for (int m = 0; m < 4; ++m) { bf16_t* rowp = io + (size_t)(row0 + ai * HALF + m * 16) * ldc + col0;
#pragma unroll
                for (int bj = 0; bj < 2; ++bj) { u32x4* p = (u32x4*)(rowp + bj * HALF); const u32x4 b = *p;
                    const f32x4 a0 = acc[ai][bj][m][0] * gv[bj][0], a1 = acc[ai][bj][m][1] * gv[bj][1];
                    u32x4 w;
                    w.x = pk_bf16(__uint_as_float(b.x << 16) + a0[0], __uint_as_float(b.x & 0xffff0000u) + a0[1]); w.y = pk_bf16(__uint_as_float(b.y << 16) + a0[2], __uint_as_float(b.y & 0xffff0000u) + a0[3]);
                    w.z = pk_bf16(__uint_as_float(b.z << 16) + a1[0], __uint_as_float(b.z & 0xffff0000u) + a1[1]); w.w = pk_bf16(__uint_as_float(b.w << 16) + a1[2], __uint_as_float(b.w & 0xffff0000u) + a1[3]);
                    *p = w; }
                if (m == 3) asm volatile("" ::: "memory"); }
    }
};
template <class Epi, class Sched, bool ALIGN_EPI = false, bool SP2 = false>
__device__ __forceinline__ void gemm_phase(PG8_LAS unsigned char* lds, const Gemm g, const Sched& S, const Epi& E) {
    const int tid = threadIdx.x, wid = __builtin_amdgcn_readfirstlane(tid >> 6), lane = tid & 63, wr = wid >> 2, wc = wid & 3, fr = lane & 15, fq = lane >> 4;
    const int K = g.K, nt = K / BK;
    unsigned voffA[2], voffB[2];
#pragma unroll
    for (int i = 0; i < 2; ++i) { int R, C; stage_rc(tid * 16 + i * 8192, R, C); const int Rb = Epi::PERM ? ((R & ~31) + perm32(R & 31)) : R;
        voffA[i] = (unsigned)(R * K + C) * 2u; voffB[i] = (unsigned)(Rb * K + C) * 2u; }
    const size_t kstep = (size_t)(BK * 2);
    const size_t hstep = (size_t)HALF * K * 2;
    const size_t tstep = 2 * hstep;
    const unsigned ldsw = (unsigned)wid * 1024u;
    const int aoff = lds_byte(wr * 64 + fr, fq * 8), boff = lds_byte(wc * 32 + fr, fq * 8);
#define PG8_SA(b, h) (((b) * 2 + (h)) * HTB)
#define PG8_SB(b, h) ((4 + (b) * 2 + (h)) * HTB)
#define PG8_STAGE(bufoff, gbase, voff) do { _Pragma("unroll") for (int _i = 0; _i < 2; ++_i) \
        __builtin_amdgcn_global_load_lds((const unsigned*)((const char*)(gbase) + (voff)[_i]), (PG8_LAS unsigned*)(lds + (bufoff) + ldsw + _i * 8192), 16, 0, 0); } while (0)
#define PG8_LDA(dst, b, h) do { _Pragma("unroll") for (int m = 0; m < 4; ++m) _Pragma("unroll") for (int k = 0; k < 2; ++k) dst[m][k] = *(const PG8_LAS bf16x8*)(lds + PG8_SA(b, h) + aoff + m * 2048 + k * 1024); } while (0)
#define PG8_LDB(dst, b, h) do { _Pragma("unroll") for (int n = 0; n < 2; ++n) _Pragma("unroll") for (int k = 0; k < 2; ++k) dst[n][k] = *(const PG8_LAS bf16x8*)(lds + PG8_SB(b, h) + boff + n * 2048 + k * 1024); } while (0)
#define PG8_MMA(ai, bj, At, Bt) do { __builtin_amdgcn_s_setprio(1); _Pragma("unroll") for (int m = 0; m < 4; ++m) _Pragma("unroll") for (int n = 0; n < 2; ++n) _Pragma("unroll") for (int k = 0; k < 2; ++k) \
        acc[ai][bj][m][n] = __builtin_amdgcn_mfma_f32_16x16x32_bf16(Bt[n][k], At[m][k], acc[ai][bj][m][n], 0, 0, 0); __builtin_amdgcn_s_setprio(0); } while (0)
#define PG8_WAIT_V(n) asm volatile("s_waitcnt vmcnt(" #n ")" ::: "memory")
#define PG8_WAIT_L(n) asm volatile("s_waitcnt lgkmcnt(" #n ")" ::: "memory")
#define PG8_BAR __builtin_amdgcn_s_barrier()
#define PG8_SCHED __builtin_amdgcn_sched_barrier(0)
    Unit cur, nxt; int ui = 0;
    if (!S.next(0, cur)) return;
    f32x4 acc[2][2][4][2];
#pragma unroll
    for (int a = 0; a < 2; ++a)
#pragma unroll
        for (int b = 0; b < 2; ++b)
#pragma unroll
            for (int m = 0; m < 4; ++m)
#pragma unroll
                for (int n = 0; n < 2; ++n) acc[a][b][m][n] = (f32x4){0.f, 0.f, 0.f, 0.f};
    bf16x8 At[4][2], B0[2][2], B1[2][2];
    const char* cA = (const char*)g.A + (size_t)cur.pm * tstep; const char* cB = (const char*)g.Bt + (size_t)cur.pn * tstep;
    S.a_ready(cur);
    if constexpr (SP2) {
        PG8_STAGE(PG8_SB(0, 0), cB, voffB); PG8_STAGE(PG8_SB(0, 1), cB + hstep, voffB); PG8_STAGE(PG8_SA(0, 0), cA, voffA); PG8_STAGE(PG8_SA(0, 1), cA + hstep, voffA);
        if (wr == 1) PG8_BAR;
        PG8_WAIT_V(2); PG8_BAR;
        PG8_STAGE(PG8_SB(1, 0), cB + kstep, voffB); PG8_STAGE(PG8_SA(1, 0), cA + kstep, voffA); PG8_STAGE(PG8_SB(1, 1), cB + hstep + kstep, voffB);
        PG8_WAIT_V(6); PG8_BAR;
    } else {
        PG8_STAGE(PG8_SB(0, 0), cB, voffB); PG8_STAGE(PG8_SA(0, 0), cA, voffA); PG8_STAGE(PG8_SB(0, 1), cB + hstep, voffB); PG8_STAGE(PG8_SA(0, 1), cA + hstep, voffA);
        if (wr == 1) PG8_BAR;
        PG8_WAIT_V(4); PG8_BAR;
        PG8_STAGE(PG8_SB(1, 0), cB + kstep, voffB); PG8_STAGE(PG8_SA(1, 0), cA + kstep, voffA); PG8_STAGE(PG8_SB(1, 1), cB + hstep + kstep, voffB);
        PG8_WAIT_V(6); PG8_BAR;
    }
    for (;;) {
        const bool has_next = S.next(ui + 1, nxt);
        const char* nA = has_next ? (const char*)g.A + (size_t)nxt.pm * tstep : cA; const char* nB = has_next ? (const char*)g.Bt + (size_t)nxt.pn * tstep : cB;
        for (int t = 0; t < nt; t += 2) {
            const bool last = (t == nt - 2);
            const char* a1 = cA + (size_t)(t + 1) * kstep;
            const char* a2 = last ? nA : cA + (size_t)(t + 2) * kstep; const char* b2 = last ? nB : cB + (size_t)(t + 2) * kstep;
            const char* a3 = a2 + kstep; const char* b3 = b2 + kstep;
            if (last && has_next) S.a_ready(nxt);
            if constexpr (SP2) {
            PG8_LDB(B0, 0, 0); PG8_LDB(B1, 0, 1); PG8_SCHED; PG8_LDA(At, 0, 0); PG8_STAGE(PG8_SA(1, 1), a1 + hstep, voffA);
            PG8_WAIT_V(8); PG8_WAIT_L(0); PG8_BAR; PG8_MMA(0, 0, At, B0); PG8_MMA(0, 1, At, B1); PG8_BAR; PG8_SCHED;
            PG8_LDA(At, 0, 1); PG8_STAGE(PG8_SB(0, 0), b2, voffB); PG8_STAGE(PG8_SB(0, 1), b2 + hstep, voffB); PG8_STAGE(PG8_SA(0, 0), a2, voffA);
            PG8_WAIT_V(8); PG8_WAIT_L(0); PG8_BAR; PG8_MMA(1, 0, At, B0); PG8_MMA(1, 1, At, B1); PG8_BAR; PG8_SCHED;
            PG8_LDB(B0, 1, 0); PG8_LDB(B1, 1, 1); PG8_SCHED; PG8_LDA(At, 1, 0); PG8_STAGE(PG8_SA(0, 1), a2 + hstep, voffA);
            PG8_WAIT_V(8); PG8_WAIT_L(0); PG8_BAR; PG8_MMA(0, 0, At, B0); PG8_MMA(0, 1, At, B1); PG8_BAR; PG8_SCHED;
            PG8_LDA(At, 1, 1); PG8_STAGE(PG8_SB(1, 0), b3, voffB); PG8_STAGE(PG8_SB(1, 1), b3 + hstep, voffB); PG8_STAGE(PG8_SA(1, 0), a3, voffA);
            PG8_WAIT_V(8); PG8_WAIT_L(0); PG8_BAR; PG8_MMA(1, 0, At, B0); PG8_MMA(1, 1, At, B1); PG8_BAR; PG8_SCHED;
            } else {
            PG8_LDB(B0, 0, 0); PG8_SCHED; PG8_LDA(At, 0, 0); PG8_STAGE(PG8_SA(1, 1), a1 + hstep, voffA);
            PG8_WAIT_L(8); PG8_BAR; PG8_WAIT_L(0); PG8_MMA(0, 0, At, B0); PG8_BAR; PG8_SCHED;
            PG8_LDB(B1, 0, 1); PG8_STAGE(PG8_SB(0, 0), b2, voffB);
            PG8_BAR; PG8_WAIT_L(0); PG8_MMA(0, 1, At, B1); PG8_BAR;
            PG8_LDA(At, 0, 1); PG8_STAGE(PG8_SA(0, 0), a2, voffA);
            PG8_BAR; PG8_WAIT_L(0); PG8_MMA(1, 0, At, B0); PG8_BAR; PG8_SCHED;
            PG8_STAGE(PG8_SB(0, 1), b2 + hstep, voffB);
            PG8_WAIT_V(6); PG8_BAR; PG8_MMA(1, 1, At, B1); PG8_BAR;
            PG8_LDB(B0, 1, 0); PG8_SCHED; PG8_LDA(At, 1, 0); PG8_STAGE(PG8_SA(0, 1), a2 + hstep, voffA);
            PG8_WAIT_L(8); PG8_BAR; PG8_WAIT_L(0); PG8_MMA(0, 0, At, B0); PG8_BAR; PG8_SCHED;
            PG8_LDB(B1, 1, 1); PG8_STAGE(PG8_SB(1, 0), b3, voffB);
            PG8_BAR; PG8_WAIT_L(0); PG8_MMA(0, 1, At, B1); PG8_BAR;
            PG8_LDA(At, 1, 1); PG8_STAGE(PG8_SA(1, 0), a3, voffA);
            PG8_BAR; PG8_WAIT_L(0); PG8_MMA(1, 0, At, B0); PG8_BAR; PG8_SCHED;
            PG8_STAGE(PG8_SB(1, 1), b3 + hstep, voffB);
            PG8_WAIT_V(6); PG8_BAR; PG8_MMA(1, 1, At, B1); PG8_BAR;
            }
        }
        if constexpr (ALIGN_EPI) { if (wr == 0) PG8_BAR; }
        if constexpr (!Epi::AFTER_DRAIN) { E(acc, cur, wr, wc, fr, fq); S.done(cur); }
        if (!has_next) break;
#pragma unroll
        for (int a = 0; a < 2; ++a)
#pragma unroll
            for (int b = 0; b < 2; ++b)
#pragma unroll
                for (int m = 0; m < 4; ++m)
#pragma unroll
                    for (int n = 0; n < 2; ++n) acc[a][b][m][n] = (f32x4){0.f, 0.f, 0.f, 0.f};
        cur = nxt; cA = nA; cB = nB; ++ui;
        if constexpr (ALIGN_EPI) { if (wr == 1) PG8_BAR; }
    }
    PG8_WAIT_V(0);
    if constexpr (!ALIGN_EPI) { if (wr == 0) PG8_BAR; }
    PG8_BAR;
    if constexpr (Epi::AFTER_DRAIN) { E.fused(acc, cur, wr, wc, fr, fq, lds, wid, lane); S.done(cur); }
#undef PG8_SA
#undef PG8_SB
#undef PG8_STAGE
#undef PG8_LDA
#undef PG8_LDB
#undef PG8_MMA
#undef PG8_WAIT_V
#undef PG8_WAIT_L
#undef PG8_BAR
#undef PG8_SCHED
}
}
#define XB_TMO      128
#define XB_XCNT(j)  (256  + 64 * (j))
#define XB_XSUB(j)  (1280 + 64 * (j))
#define XB_XGEN(j)  (2304 + 64 * (j))
#define XB_TOP      3328
#define XB_TOPGEN   3392
#define XCD_BAR_WORDS 3456
#define XB_SPIN_CAP (1u << 18)
#define LAS __attribute__((address_space(3)))

__device__ __forceinline__ unsigned xb_ld(unsigned* p)              { return __hip_atomic_load(p, __ATOMIC_RELAXED, __HIP_MEMORY_SCOPE_AGENT); }
__device__ __forceinline__ unsigned xb_add(unsigned* p, unsigned v) { return __hip_atomic_fetch_add(p, v, __ATOMIC_RELAXED, __HIP_MEMORY_SCOPE_AGENT); }
__device__ __forceinline__ unsigned xb_xcc_id() { return (unsigned)__builtin_amdgcn_s_getreg((3 << 11) | 20) & 0xFu; }
#define XB_SPIN(cond, bar) do { unsigned _sp = 0; while (cond) { __builtin_amdgcn_s_sleep(1); \
    if ((++_sp & 255u) == 0u) { if (xb_ld(&(bar)[XB_TMO])) break; if (_sp > XB_SPIN_CAP) { atomicAdd(&(bar)[XB_TMO], 1u); break; } } } } while (0)

struct XcdBarrier {
    unsigned* bar; unsigned x;
    volatile LAS unsigned* st;
};

__device__ __forceinline__ XcdBarrier xcd_barrier_post(unsigned* bar, volatile LAS unsigned* st) {
    XcdBarrier b; b.bar = bar; b.x = xb_xcc_id(); b.st = st;
    if (threadIdx.x == 0) (void)xb_add(&bar[XB_XCNT(b.x)], 1u);
    return b;
}
__device__ __forceinline__ void xcd_barrier_complete(unsigned* bar, unsigned x, unsigned& nloc, unsigned& nx) {
    const unsigned G = gridDim.x * gridDim.y * gridDim.z;
    unsigned sum, cnt, mine, sp = 0u;
    for (;;) {
        sum = 0u; cnt = 0u; mine = 0u;
#pragma unroll
        for (unsigned j = 0; j < 16; ++j) { const unsigned c = xb_ld(&bar[XB_XCNT(j)]); sum += c; cnt += (c > 0u) ? 1u : 0u; mine = (j == x) ? c : mine; }
        if (sum == G) break;
        __builtin_amdgcn_s_sleep(1);
        if ((++sp & 255u) == 0u) { if (xb_ld(&bar[XB_TMO])) break; if (sp > XB_SPIN_CAP) { atomicAdd(&bar[XB_TMO], 1u); break; } }
    }
    nloc = mine > 0u ? mine : 1u; nx = cnt > 0u ? cnt : 1u;
}

__device__ __forceinline__ void xcd_barrier(const XcdBarrier& b) {
    asm volatile("s_waitcnt vmcnt(0)" ::: "memory");
    __syncthreads();
    if (threadIdx.x == 0) {
        unsigned* bar = b.bar;
        __builtin_amdgcn_s_waitcnt(0);
        unsigned nloc = b.st[0], nx = b.st[1];
        if (nloc == 0u) { xcd_barrier_complete(bar, b.x, nloc, nx); b.st[0] = nloc; b.st[1] = nx; }
        const unsigned old = xb_add(&bar[XB_XSUB(b.x)], 1u);
        const unsigned gen = old / nloc;
        if (old + 1u == (gen + 1u) * nloc) {
            __builtin_amdgcn_fence(__ATOMIC_RELEASE, "agent");
            asm volatile("s_waitcnt vmcnt(0)" ::: "memory");
            const unsigned og = xb_add(&bar[XB_TOP], 1u);
            const unsigned tg = og / nx;
            if (og + 1u == (tg + 1u) * nx) xb_add(&bar[XB_TOPGEN], 1u);
            else XB_SPIN(xb_ld(&bar[XB_TOPGEN]) == tg, bar);
            __builtin_amdgcn_fence(__ATOMIC_ACQUIRE, "agent");
            xb_add(&bar[XB_XGEN(b.x)], 1u);
            asm volatile("s_waitcnt vmcnt(0)" ::: "memory");
        } else {
            XB_SPIN(xb_ld(&bar[XB_XGEN(b.x)]) == gen, bar);
            __builtin_amdgcn_fence(__ATOMIC_ACQUIRE, "agent");
            asm volatile("s_waitcnt vmcnt(0)" ::: "memory");
        }
    }
    __syncthreads();
}
#define DI __device__ __forceinline__
typedef unsigned short bf16;
typedef short bf16x8 __attribute__((ext_vector_type(8)));
typedef short bf16x4 __attribute__((ext_vector_type(4)));
typedef float f32x4 __attribute__((ext_vector_type(4)));
typedef float f32x2 __attribute__((ext_vector_type(2)));
typedef unsigned u32x4 __attribute__((ext_vector_type(4)));
typedef unsigned u32x2 __attribute__((ext_vector_type(2)));
typedef __bf16 bf16x2n __attribute__((ext_vector_type(2)));
#define MFMA16(a, b, c) __builtin_amdgcn_mfma_f32_16x16x32_bf16((a), (b), (c), 0, 0, 0)

constexpr int DM = 4096, NROWS = 12288;
constexpr int IN_EVEN = 14464, LD_EVEN = 14592, IN_ODD = 18432;
constexpr int E_QKV = 0, E_BETA = 6144, E_A = 6176, E_ZA = 6208, E_XBC = 8256, E_DT = 12352, E_ZB = 12416;
constexpr int O_VX = 0, O_ZC = 6144, O_Q = 8192, O_F = 10240, O_I = 14336, O_ZD = 16384;
constexpr float EPS = 1e-6f;
constexpr int NSEQ = 18;
DI int seq_row0(int s) { return s < 16 ? s * 256 : 4096 + (s - 16) * 4096; }
DI int seq_len(int s) { return s < 16 ? 256 : 4096; }
constexpr size_t OUT_SG = 50331648, OUT_SS = 58720256, OUT_SH = 67108864;

constexpr size_t MiB = 1u << 20;
constexpr size_t WS_CTL = 0, CTL_ZERO_BYTES = 1 * MiB;
constexpr size_t WS_MODP = 1 * MiB;
constexpr size_t WS_MODF = 4 * MiB;
constexpr size_t WS_PE = 5 * MiB;
constexpr size_t WS_HDN = 6 * MiB;
constexpr size_t WS_HNRM = 8 * MiB;
constexpr size_t WS_HF256 = 16 * MiB;
constexpr size_t WS_HF4096 = 32 * MiB;
constexpr size_t WS_WTE = 160 * MiB;
constexpr size_t WS_WTO = 274 * MiB;
constexpr size_t WS_WTOUT = 418 * MiB;
constexpr size_t WS_H = 482 * MiB;
constexpr size_t WS_U = 578 * MiB;
constexpr size_t WS_MIX = 1010 * MiB;
constexpr size_t WS_OFA = 1106 * MiB;
constexpr size_t WS_OBA = 1154 * MiB;
constexpr size_t WS_OFB = 1202 * MiB;
constexpr size_t WS_OBB = 1250 * MiB;
constexpr size_t WS_TB = 1298 * MiB;
constexpr size_t WS_END = 1490 * MiB;
constexpr size_t WS_YT = WS_WTE;
constexpr size_t WS_GWN = 1298 * MiB;
constexpr size_t WS_GUF = 1394 * MiB;
constexpr size_t WS_GPP = 920 * MiB;
constexpr size_t WS_GGC = 968 * MiB;
constexpr size_t WS_GQN = WS_WTE;
constexpr size_t WS_GKT = WS_WTE + 48 * MiB;
constexpr size_t WS_SSP = 32 * MiB;
constexpr size_t WS_SCN = 128 * MiB;
constexpr size_t WS_SSG = 152 * MiB;
constexpr size_t WS_SBT = 1490 * MiB;
constexpr size_t WS_SVT = WS_H;
constexpr size_t WS_END2 = 1514 * MiB;
constexpr size_t WS_LQS = WS_H;
constexpr size_t WS_LKS = WS_WTO;
constexpr size_t WS_LAT = WS_WTO + 96 * MiB;
constexpr size_t WS_LVT = WS_OFB;
constexpr size_t WS_LGL = WS_OBB;
constexpr int CW_Q0 = 8192, CW_Q1 = 8256, CW_Q2 = 8320, CW_Q3 = 8384, CW_Q4 = 8448;
constexpr int CW_BAR = 4096;

DI float bf2f(bf16 b) { return __uint_as_float(((unsigned)b) << 16); }
DI unsigned pk2(float lo, float hi) { f32x2 v = {lo, hi}; return __builtin_bit_cast(unsigned, __builtin_convertvector(v, bf16x2n)); }
DI bf16 f2bf(float f) { return (bf16)(pk2(f, 0.f) & 0xffffu); }
DI float wave_sum(float v) {
#pragma unroll
    for (int o = 1; o < 64; o <<= 1) v += __shfl_xor(v, o);
    return v;
}
DI float sigmoidf_(float x) { return __builtin_amdgcn_rcpf(1.0f + __expf(-x)); }
DI float siluf_(float x) { return x * __builtin_amdgcn_rcpf(1.0f + __expf(-x)); }
DI float softplusf_(float x) { return x > 20.f ? x : log1pf(__expf(x)); }
DI void unpack8(const u32x4 w, float* o) {
    o[0] = __uint_as_float(w.x << 16); o[1] = __uint_as_float(w.x & 0xffff0000u); o[2] = __uint_as_float(w.y << 16); o[3] = __uint_as_float(w.y & 0xffff0000u);
    o[4] = __uint_as_float(w.z << 16); o[5] = __uint_as_float(w.z & 0xffff0000u); o[6] = __uint_as_float(w.w << 16); o[7] = __uint_as_float(w.w & 0xffff0000u);
}
DI bf16x8 frag_nat(const LAS bf16* M, int ld, int r0, int k0, int lane) { return *(const LAS bf16x8*)(M + (r0 + (lane & 15)) * ld + k0 + 8 * (lane >> 4)); }
DI bf16x8 frag_perm(const LAS bf16* M, int ld, int r0, int k0, int lane) {
    const LAS bf16* p = M + (r0 + (lane & 15)) * ld + k0 + 4 * (lane >> 4);
    const bf16x4 lo = *(const LAS bf16x4*)p, hi = *(const LAS bf16x4*)(p + 16);
    return __builtin_shufflevector(lo, hi, 0, 1, 2, 3, 4, 5, 6, 7);
}
DI bf16x8 pack2(const f32x4 a, const f32x4 b) {
    u32x4 w; w.x = pk2(a[0], a[1]); w.y = pk2(a[2], a[3]); w.z = pk2(b[0], b[1]); w.w = pk2(b[2], b[3]);
    return __builtin_bit_cast(bf16x8, w);
}
DI void st_bf16x4(LAS bf16* p, float a, float b, float c, float d) { u32x2 w; w.x = pk2(a, b); w.y = pk2(c, d); *(LAS u32x2*)p = w; }
constexpr int LDQ = 136, LDT = 72;
DI int swz_idx(int row, int col) { return row * LDT + (((((col >> 3) ^ (row >> 4)) & 7) << 3) | (col & 7)); }
DI bf16x8 frag_nat_sw(const LAS bf16* M, int r0, int k0, int lane) { const int q = lane >> 4; return *(const LAS bf16x8*)(M + (r0 + (lane & 15)) * LDT + ((((k0 >> 3) + q) ^ (r0 >> 4)) & 7) * 8); }
DI bf16x8 frag_perm_sw(const LAS bf16* M, int r0, int k0, int lane) { const int q = lane >> 4, sw = r0 >> 4; const LAS bf16* p = M + (r0 + (lane & 15)) * LDT + 4 * (q & 1);
    const bf16x4 lo = *(const LAS bf16x4*)(p + ((((k0 >> 3) + (q >> 1)) ^ sw) & 7) * 8), hi = *(const LAS bf16x4*)(p + ((((k0 >> 3) + 2 + (q >> 1)) ^ sw) & 7) * 8);
    return __builtin_shufflevector(lo, hi, 0, 1, 2, 3, 4, 5, 6, 7); }
#define LDSBAR() do { asm volatile("s_waitcnt lgkmcnt(0)" ::: "memory"); __builtin_amdgcn_s_barrier(); asm volatile("" ::: "memory"); } while (0)
#ifndef WODD_KEEP
#define WODD_KEEP 288
#endif
constexpr int WODD_P0 = 64 * WODD_KEEP;
struct Ctx {
    LAS unsigned char* lds;
    const float* const* in;
    unsigned char* ws;
    float* out;
    int tid, lane, wave, bid, G;
};
DI void p0_transpose_pair(const float* W, int K, int N, bf16* WT, LAS float* scr, int item0, int item1, int lane) {
    const int nblk = N / 32;
    float va[32], vb[32];
    { const int kb = item0 / nblk, nb = item0 % nblk; const float* src = W + (size_t)(64 * kb + (lane >> 5)) * N + 32 * nb + (lane & 31);
#pragma unroll
      for (int i = 0; i < 32; ++i) va[i] = __builtin_nontemporal_load(src + (size_t)(2 * i) * N); }
    if (item1 >= 0) { const int kb = item1 / nblk, nb = item1 % nblk; const float* src = W + (size_t)(64 * kb + (lane >> 5)) * N + 32 * nb + (lane & 31);
#pragma unroll
      for (int i = 0; i < 32; ++i) vb[i] = __builtin_nontemporal_load(src + (size_t)(2 * i) * N); }
#pragma unroll
    for (int half = 0; half < 2; ++half) { const int item = half ? item1 : item0; if (item < 0) break;
        const int kb = item / nblk, nb = item % nblk, k0 = 64 * kb, n0 = 32 * nb;
#pragma unroll
        for (int i = 0; i < 32; ++i) scr[(2 * i + (lane >> 5)) * 33 + (lane & 31)] = half ? vb[i] : va[i];
        asm volatile("s_waitcnt lgkmcnt(0)" ::: "memory");
        const int c = lane & 7;
#pragma unroll
        for (int j = 0; j < 4; ++j) { const int n = (lane >> 3) + 8 * j; const LAS float* s = scr + (8 * c) * 33 + n;
            u32x4 o; o.x = pk2(s[0 * 33], s[1 * 33]); o.y = pk2(s[2 * 33], s[3 * 33]); o.z = pk2(s[4 * 33], s[5 * 33]); o.w = pk2(s[6 * 33], s[7 * 33]);
            *(u32x4*)(WT + (size_t)(n0 + n) * K + k0 + 8 * c) = o; }
        asm volatile("s_waitcnt lgkmcnt(0)" ::: "memory"); }
}
DI void p0_transpose_range(const float* W, int K, int N, bf16* WT, LAS float* scr, int first, int stride, int total, int lane) {
    for (int it = first; it < total; it += 2 * stride) p0_transpose_pair(W, K, N, WT, scr, it, it + stride < total ? it + stride : -1, lane);
}
DI void p0_adaln_item(const Ctx& F, const float* w_ada, const float* c, const float* c_ctx, int item) {
    const int li = item / 384, rem = item % 384, strip = rem >> 3, kseg = rem & 7;
    const float* W = w_ada + (size_t)li * 4096 * 12288 + strip * 256 + F.lane * 4;
    const int k0 = kseg * 512 + F.wave * 64;
    f32x4 a0 = {0.f, 0.f, 0.f, 0.f}, a1 = a0, a2 = a0;
#pragma unroll 8
    for (int kk = 0; kk < 64; ++kk) { const int k = k0 + kk;
        const float s0 = siluf_(c_ctx[k]), s1 = siluf_(c[k]), s2 = siluf_(c[4096 + k]);
        const f32x4 w = __builtin_nontemporal_load((const f32x4*)(W + (size_t)k * 12288));
        a0 += s0 * w; a1 += s1 * w; a2 += s2 * w; }
    LAS float* scr = (LAS float*)F.lds;
    *(LAS f32x4*)(scr + F.wave * 768 + 0 * 256 + F.lane * 4) = a0;
    *(LAS f32x4*)(scr + F.wave * 768 + 1 * 256 + F.lane * 4) = a1;
    *(LAS f32x4*)(scr + F.wave * 768 + 2 * 256 + F.lane * 4) = a2;
    __syncthreads();
    float* modp = (float*)(F.ws + WS_MODP);
    for (int o = F.tid; o < 768; o += 512) { float s = 0.f;
#pragma unroll
        for (int w = 0; w < 8; ++w) s += scr[w * 768 + o];
        const int r = o >> 8, ci = o & 255;
        modp[((size_t)(kseg * 2 + li) * 3 + r) * 12288 + strip * 256 + ci] = s; }
    __syncthreads();
}
DI void p0_hdn_item(const float* w1, const float* b1, const float* freq, const float* w2, const float* b2, int L, int p, float* out, int lane) {
    const float t = (float)p / (float)(L - 1);
    float zk = 0.f;
    if (lane == 0) zk = t;
    else if (lane <= 32) { const int b = (lane - 1) & 15; const float band = 1e-4f + (float)b * ((15.0f - 1e-4f) / 15.0f);
        const float ang = (6.283185307179586f / (float)L) * (float)p * band; zk = (lane <= 16) ? cosf(ang) : -sinf(ang); }
    float a = b1[lane];
#pragma unroll
    for (int k = 0; k < 33; ++k) a += __shfl(zk, k) * w1[k * 64 + lane];
    const float h1 = sinf(freq[lane] * a);
    float a2 = b2[lane];
#pragma unroll 16
    for (int k = 0; k < 64; ++k) a2 += __shfl(h1, k) * w2[k * 64 + lane];
    out[lane] = sinf(freq[64 + lane] * a2);
}
DI void p0_filter_item(const Ctx& F, const float* hdn, const float* w3, float* HF, float* HNRM, int L, int cg) {
    LAS float* wl = (LAS float*)F.lds;
    LAS float* red = wl + 2048;
    for (int e = F.tid; e < 2048; e += 512) { const int k = e >> 5, x = e & 31, dir = x >> 4, ord = (x >> 3) & 1, cc = x & 7;
        wl[e] = w3[(size_t)k * 8192 + dir * 4096 + ord * 2048 + cg * 8 + cc]; }
    __syncthreads();
    float asum[16];
#pragma unroll
    for (int i = 0; i < 16; ++i) asum[i] = 0.f;
    const float tinv = 1.0f / (float)(L - 1);
    float dl2[8];
#pragma unroll
    for (int cc = 0; cc < 8; ++cc) dl2[cc] = 1.4426950408889634f * fabsf(-3.0701134573253945f + (-15.350567286626972f + 3.0701134573253945f) * ((float)(cg * 8 + cc) * (1.0f / 2047.0f)));
    const int half = L > 512 ? L / 2 : L;
    for (int p = F.tid; p < half; p += 512) { const bool two = (L > 512); const int p1 = two ? p + half : p;
        float acc0[32], acc1[32];
#pragma unroll
        for (int i = 0; i < 32; ++i) { acc0[i] = 0.f; acc1[i] = 0.f; }
        const f32x4* hp0 = (const f32x4*)(hdn + (size_t)p * 64); const f32x4* hp1 = (const f32x4*)(hdn + (size_t)p1 * 64);
#pragma unroll 2
        for (int k4 = 0; k4 < 16; ++k4) { const f32x4 hv0 = hp0[k4], hv1 = hp1[k4];
#pragma unroll
            for (int kk = 0; kk < 4; ++kk) { const float h0 = hv0[kk], h1 = hv1[kk]; const LAS f32x4* wr = (const LAS f32x4*)(wl + (k4 * 4 + kk) * 32);
#pragma unroll
                for (int x4 = 0; x4 < 8; ++x4) { const f32x4 w = wr[x4];
                    acc0[x4 * 4 + 0] += h0 * w[0]; acc0[x4 * 4 + 1] += h0 * w[1]; acc0[x4 * 4 + 2] += h0 * w[2]; acc0[x4 * 4 + 3] += h0 * w[3];
                    acc1[x4 * 4 + 0] += h1 * w[0]; acc1[x4 * 4 + 1] += h1 * w[1]; acc1[x4 * 4 + 2] += h1 * w[2]; acc1[x4 * 4 + 3] += h1 * w[3]; } } }
#pragma unroll
        for (int pp = 0; pp < 2; ++pp) { if (pp == 1 && !two) break; const int q = pp ? p1 : p; const float t = (float)q * tinv;
            float win[8];
#pragma unroll
            for (int cc = 0; cc < 8; ++cc) win[cc] = __builtin_amdgcn_exp2f(-t * dl2[cc]);
#pragma unroll
            for (int x = 0; x < 32; ++x) { const int dir = x >> 4, ord = (x >> 3) & 1, cc = x & 7, c = cg * 8 + cc;
                const float val = (pp ? acc1[x] : acc0[x]) * win[cc];
                float* row = HF + ((size_t)ord * 2048 + c) * (size_t)(2 * L);
                if (dir == 0) { row[q] = val; asum[ord * 8 + cc] += fabsf(val); if (q == 0) row[L] = 0.f; }
                else if (q >= 1) { row[2 * L - q] = val; asum[ord * 8 + cc] += fabsf(val); } } }
    }
#pragma unroll
    for (int i = 0; i < 16; ++i) { const float s = wave_sum(asum[i]); if (F.lane == 0) red[F.wave * 16 + i] = s; }
    __syncthreads();
    if (F.tid < 16) { float s = 0.f;
#pragma unroll
        for (int w = 0; w < 8; ++w) s += red[w * 16 + F.tid];
        const int ord = F.tid >> 3, cc = F.tid & 7; HNRM[ord * 2048 + cg * 8 + cc] = 1.0f / s; }
    __syncthreads();
}
DI void phase_p0(const Ctx& F, const float* const* in) {
    const int gw = F.bid * 8 + F.wave, NGW = F.G * 8;
    for (int it = F.bid; it < 768; it += F.G) p0_adaln_item(F, in[8], in[5], in[6], it);
    LAS float* scr = (LAS float*)(F.lds + F.wave * 16384);
    constexpr int I_E = 64 * (IN_EVEN / 32);
    p0_transpose_range(in[12], 4096, IN_EVEN, (bf16*)(F.ws + WS_WTE), scr, gw, NGW, I_E, F.lane);
    p0_transpose_range(in[22], 4096, IN_ODD, (bf16*)(F.ws + WS_WTO), scr, gw, NGW, WODD_P0, F.lane);
    { u32x4* z = (u32x4*)((bf16*)(F.ws + WS_WTE) + (size_t)IN_EVEN * 4096); const u32x4 zero = {0u, 0u, 0u, 0u};
      for (int i = F.bid * 512 + F.tid; i < (LD_EVEN - IN_EVEN) * 4096 / 8; i += F.G * 512) z[i] = zero; }
    { float* pe = (float*)(F.ws + WS_PE);
      for (int i = F.bid * 512 + F.tid; i < 65536; i += F.G * 512) { const int v = i >> 10, j = i & 1023;
          const float omega = 1.0f / powf(10000.0f, (float)j / 1024.0f); const float ang = (float)v * omega;
          pe[2 * i] = sinf(ang); pe[2 * i + 1] = cosf(ang); } }
    { float* hdn = (float*)(F.ws + WS_HDN);
      for (int it = gw; it < 256 + 4096; it += NGW) { const int L = it < 256 ? 256 : 4096, p = it < 256 ? it : it - 256;
          p0_hdn_item(in[24], in[25], in[26], in[27], in[28], L, p, hdn + (size_t)it * 64, F.lane); } }
}
DI void phase_p0c(const Ctx& F, const float* const* in) {
    { const float* modp = (const float*)(F.ws + WS_MODP); float* modf = (float*)(F.ws + WS_MODF);
      for (int i = F.bid * 512 + F.tid; i < 2 * 3 * 4096; i += F.G * 512) { const int li = i / 12288, r = (i / 4096) % 3, cc = i & 4095;
          float sh = in[9][li * 12288 + cc], sc = in[9][li * 12288 + 4096 + cc], gt = in[9][li * 12288 + 8192 + cc];
#pragma unroll
          for (int ks = 0; ks < 8; ++ks) { const float* m = modp + ((size_t)(ks * 2 + li) * 3 + r) * 12288; sh += m[cc]; sc += m[4096 + cc]; gt += m[8192 + cc]; }
          float* o = modf + (size_t)(li * 9 + r) * 4096;
          o[cc] = in[7][li * 4096 + cc] * (1.0f + sc); o[3 * 4096 + cc] = sh; o[6 * 4096 + cc] = gt; } }
}
DI void phase_filters(const Ctx& F, const float* const* in, int w, int nw) {
    __syncthreads();
    for (int it = w; it < 512; it += nw) { const int cg = it & 255, li = it >> 8;
        const float* hdn = (const float*)(F.ws + WS_HDN) + (li ? (size_t)256 * 64 : 0);
        p0_filter_item(F, hdn, in[29], (float*)(F.ws + (li ? WS_HF4096 : WS_HF256)), (float*)(F.ws + WS_HNRM) + li * 4096, li ? 4096 : 256, cg); }
}
DI void convert_wout(const Ctx& F, const float* const* in, int w, int nw, int li) {
    __syncthreads();
    LAS float* scr = (LAS float*)(F.lds + F.wave * 16384);
    p0_transpose_range(in[10] + (size_t)li * 4096 * 4096, 4096, 4096, (bf16*)(F.ws + WS_WTOUT) + (size_t)li * 4096 * 4096, scr, w * 8 + F.wave, nw * 8, 8192, F.lane);
}
DI void convert_wodd(const Ctx& F, const float* const* in, int w, int nw) {
    __syncthreads();
    LAS float* scr = (LAS float*)(F.lds + F.wave * 16384);
    p0_transpose_range(in[22], 4096, IN_ODD, (bf16*)(F.ws + WS_WTO), scr, WODD_P0 + w * 8 + F.wave, nw * 8, 64 * (IN_ODD / 32), F.lane);
}
constexpr int LDX = 8192;
DI bf16* xr_base(const Ctx& F) { return (bf16*)F.out + 4096; }
template <int MODE> DI void phase_norm(const Ctx& F, const float* const* in) {
    const int gw = F.bid * 8 + F.wave, NGW = F.G * 8;
    bf16* H = (bf16*)(F.ws + WS_H); const float* pe = (const float*)(F.ws + WS_PE); bf16* XR = xr_base(F);
    f32x4 ra[MODE == 0 ? 8 : 1], rb[MODE == 0 ? 8 : 1]; u32x4 rw[MODE == 0 ? 1 : 8];
#define NORM_LOAD(row_) do { if (MODE == 0) { const float* src_ = (row_) < 4096 ? in[0] + (size_t)(row_) * DM : in[1] + (size_t)((row_) - 4096) * DM; \
            _Pragma("unroll") for (int j_ = 0; j_ < 8; ++j_) { ra[MODE == 0 ? j_ : 0] = __builtin_nontemporal_load((const f32x4*)(src_ + j_ * 512 + F.lane * 8)); rb[MODE == 0 ? j_ : 0] = __builtin_nontemporal_load((const f32x4*)(src_ + j_ * 512 + F.lane * 8 + 4)); } } \
        else { _Pragma("unroll") for (int j_ = 0; j_ < 8; ++j_) rw[MODE == 0 ? 0 : j_] = *(const u32x4*)(XR + (size_t)(row_) * LDX + j_ * 512 + F.lane * 8); } } while (0)
    if (gw < NROWS) NORM_LOAD(gw);
#pragma unroll 1
    for (int row = gw; row < NROWS; row += NGW) {
        const int r = row < 4096 ? 0 : 1 + ((row - 4096) >> 12);
        const int t = (row - 4096) & 4095, gr = t >> 6, gc = t & 63;
        float v[8][8]; float ss = 0.f;
        if (MODE == 0) {
#pragma unroll
            for (int j = 0; j < 8; ++j) { const int col = j * 512 + F.lane * 8; const f32x4 a = ra[MODE == 0 ? j : 0], b = rb[MODE == 0 ? j : 0];
                v[j][0] = a[0]; v[j][1] = a[1]; v[j][2] = a[2]; v[j][3] = a[3]; v[j][4] = b[0]; v[j][5] = b[1]; v[j][6] = b[2]; v[j][7] = b[3];
                if (row >= 4096) { const int q4 = j >> 1, jj = col & 1023, vv = (q4 < 2) ? gr : gc, comp = q4 & 1;
                    const f32x4* pp = (const f32x4*)(pe + ((size_t)vv * 1024 + jj) * 2);
#pragma unroll
                    for (int e2 = 0; e2 < 4; ++e2) { const f32x4 p = pp[e2]; v[j][2 * e2] += comp ? p[1] : p[0]; v[j][2 * e2 + 1] += comp ? p[3] : p[2]; } } }
        } else {
#pragma unroll
            for (int j = 0; j < 8; ++j) unpack8(rw[MODE == 0 ? 0 : j], v[j]); }
        if (row + NGW < NROWS) NORM_LOAD(row + NGW);
#pragma unroll
        for (int j = 0; j < 8; ++j)
#pragma unroll
            for (int e = 0; e < 8; ++e) ss += v[j][e] * v[j][e];
        const float rstd = __builtin_amdgcn_rsqf(wave_sum(ss) * (1.0f / DM) + EPS);
        if (MODE == 2) { float* yo = F.out + (size_t)row * DM;
#pragma unroll
            for (int j = 0; j < 8; ++j) { const int col = j * 512 + F.lane * 8; const f32x4 g0 = *(const f32x4*)(in[11] + col), g1 = *(const f32x4*)(in[11] + col + 4);
                __builtin_nontemporal_store((f32x4){v[j][0] * rstd * g0[0], v[j][1] * rstd * g0[1], v[j][2] * rstd * g0[2], v[j][3] * rstd * g0[3]}, (f32x4*)(yo + col));
                __builtin_nontemporal_store((f32x4){v[j][4] * rstd * g1[0], v[j][5] * rstd * g1[1], v[j][6] * rstd * g1[2], v[j][7] * rstd * g1[3]}, (f32x4*)(yo + col + 4)); }
        } else {
            const float* A = (const float*)(F.ws + WS_MODF) + (size_t)((MODE == 1 ? 9 : 0) + r) * 4096;
#pragma unroll
            for (int j = 0; j < 8; ++j) { const int col = j * 512 + F.lane * 8;
                const f32x4 a0 = *(const f32x4*)(A + col), a1 = *(const f32x4*)(A + col + 4), b0 = *(const f32x4*)(A + 3 * 4096 + col), b1 = *(const f32x4*)(A + 3 * 4096 + col + 4);
                u32x4 w; w.x = pk2(v[j][0] * rstd * a0[0] + b0[0], v[j][1] * rstd * a0[1] + b0[1]); w.y = pk2(v[j][2] * rstd * a0[2] + b0[2], v[j][3] * rstd * a0[3] + b0[3]);
                w.z = pk2(v[j][4] * rstd * a1[0] + b1[0], v[j][5] * rstd * a1[1] + b1[1]); w.w = pk2(v[j][6] * rstd * a1[2] + b1[2], v[j][7] * rstd * a1[3] + b1[3]);
                *(u32x4*)(H + (size_t)row * DM + col) = w;
                if (MODE == 0) { u32x4 x; x.x = pk2(v[j][0], v[j][1]); x.y = pk2(v[j][2], v[j][3]); x.z = pk2(v[j][4], v[j][5]); x.w = pk2(v[j][6], v[j][7]);
                    *(u32x4*)(XR + (size_t)row * LDX + col) = x; } }
        }
    }
}
#undef NORM_LOAD

DI void conv3_load(const bf16* Urow, size_t ld, int t, int len, u32x4* r) {
    const u32x4 z = {0u, 0u, 0u, 0u};
    const u32x4* p0 = (const u32x4*)Urow; r[2] = p0[0]; r[3] = p0[1];
    if (t > 0) { const u32x4* p = (const u32x4*)(Urow - ld); r[0] = p[0]; r[1] = p[1]; } else { r[0] = z; r[1] = z; }
    if (t + 1 < len) { const u32x4* p = (const u32x4*)(Urow + ld); r[4] = p[0]; r[5] = p[1]; } else { r[4] = z; r[5] = z; }
}
DI void conv3_calc(const u32x4* r, const LAS float* cw, int cstride, float* o) {
#pragma unroll
    for (int hf = 0; hf < 2; ++hf) { float xm[8], x0[8], xp[8]; unpack8(r[hf], xm); unpack8(r[2 + hf], x0); unpack8(r[4 + hf], xp);
#pragma unroll
        for (int e4 = 0; e4 < 2; ++e4) { const int c = hf * 8 + e4 * 4; const f32x4 w0 = *(const LAS f32x4*)(cw + c), w1 = *(const LAS f32x4*)(cw + cstride + c), w2 = *(const LAS f32x4*)(cw + 2 * cstride + c);
#pragma unroll
            for (int e = 0; e < 4; ++e) o[c + e] = w0[e] * xm[e4 * 4 + e] + w1[e] * x0[e4 * 4 + e] + w2[e] * xp[e4 * 4 + e]; } }
}
#define SCHED_FENCE() __builtin_amdgcn_sched_barrier(0)
DI float wave_scan_incl(float v, int lane) {
#pragma unroll
    for (int o = 1; o < 64; o <<= 1) { const float u = __shfl_up(v, o); if (lane >= o) v += u; }
    return v;
}

DI void gdn_prep_request(const Ctx& F, int c64, int h, u32x4 (&rq_)[6], u32x4 (&rk_)[6], u32x4 (&rv_)[6], unsigned& rgate) {
    const bf16* U = (const bf16*)(F.ws + WS_U);
    const int r0 = c64 * 64, len = r0 < 4096 ? 256 : 4096, t0 = r0 < 4096 ? (r0 & 255) : ((r0 - 4096) & 4095);
    const int i = F.tid >> 3, sub = F.tid & 7, t = t0 + i;
    const bf16* ur = U + (size_t)(r0 + i) * LD_EVEN;
    conv3_load(ur + E_QKV + h * 128 + sub * 16, LD_EVEN, t, len, rq_);
    conv3_load(ur + E_QKV + 2048 + h * 128 + sub * 16, LD_EVEN, t, len, rk_);
    conv3_load(ur + E_QKV + 4096 + h * 128 + sub * 16, LD_EVEN, t, len, rv_);
    rgate = (unsigned)ur[E_BETA + (sub & 1) * 16 + h] | ((unsigned)ur[E_A + (sub & 1) * 16 + h] << 16);
}
DI void gdn_prep_item(const Ctx& F, const float* const* in, int c64, int h, bool stage_cw, u32x4 (&rq_)[6], u32x4 (&rk_)[6], u32x4 (&rv_)[6], unsigned& rgate, float (&gpar)[2], int next_c64) {
    LAS bf16* Q = (LAS bf16*)(F.lds + 0);
    LAS bf16* K = (LAS bf16*)(F.lds + 17408);
    LAS bf16* KT = (LAS bf16*)(F.lds + 34816);
    LAS bf16* VT = (LAS bf16*)(F.lds + 53248);
    LAS float* KKR = (LAS float*)(F.lds + 71680);
    LAS float* QKR = (LAS float*)(F.lds + 89088);
    LAS bf16* NN = (LAS bf16*)(F.lds + 106496);
    LAS float* NDG = (LAS float*)(F.lds + 115712);
    LAS bf16* DBK = (LAS bf16*)(F.lds + 119808);
    LAS bf16* W = (LAS bf16*)(F.lds + 124928);
    LAS float* TBL = (LAS float*)(F.lds + 142336);
    LAS float* CW = TBL + 384;
    constexpr int LDD = 40, LDR = 68;
    const bf16* U = (const bf16*)(F.ws + WS_U);
    const int r0 = c64 * 64, len = r0 < 4096 ? 256 : 4096, t0 = r0 < 4096 ? (r0 & 255) : ((r0 - 4096) & 4095);
    const int lane_o = F.lane, wave = F.wave;
    LDSBAR();
    if (stage_cw) { const int sd = (F.tid & 1); gpar[0] = -expf(in[14][sd * 16 + h]); gpar[1] = in[15][sd * 16 + h]; }
    if (stage_cw) {
        for (int e = F.tid; e < 3 * 384; e += 512) { const int tap = e / 384, c = e % 384; CW[e] = in[13][tap * 6144 + (c >> 7) * 2048 + h * 128 + (c & 127)]; }
        for (int e = F.tid; e < 4 * 16 * LDD / 2; e += 512) ((LAS unsigned*)DBK)[e] = 0u;
        LDSBAR(); }
    int lane = lane_o; asm volatile("" : "+v"(lane)); const int l15 = lane & 15, q4 = lane >> 4;
    { const int i = F.tid >> 3, sub = F.tid & 7;
      const bf16* ur = U + (size_t)(r0 + i) * LD_EVEN;
      SCHED_FENCE();
      { float qv[16]; conv3_calc(rq_, CW + sub * 16, 384, qv); float sq = 0.f;
#pragma unroll
        for (int e = 0; e < 16; ++e) { qv[e] = siluf_(qv[e]); sq += qv[e] * qv[e]; }
        sq += __shfl_xor(sq, 1); sq += __shfl_xor(sq, 2); sq += __shfl_xor(sq, 4);
        const float rq = 0.08838834764831845f * __builtin_amdgcn_rsqf(sq + EPS);
        u32x4 g0, g1; g0.x = pk2(qv[0] * rq, qv[1] * rq); g0.y = pk2(qv[2] * rq, qv[3] * rq); g0.z = pk2(qv[4] * rq, qv[5] * rq); g0.w = pk2(qv[6] * rq, qv[7] * rq);
        g1.x = pk2(qv[8] * rq, qv[9] * rq); g1.y = pk2(qv[10] * rq, qv[11] * rq); g1.z = pk2(qv[12] * rq, qv[13] * rq); g1.w = pk2(qv[14] * rq, qv[15] * rq);
        *(LAS u32x4*)(Q + i * LDQ + sub * 16) = g0; *(LAS u32x4*)(Q + i * LDQ + sub * 16 + 8) = g1;
        u32x4* gq = (u32x4*)((bf16*)(F.ws + WS_GQN) + (size_t)(r0 + i) * 2048 + h * 128 + sub * 16); gq[0] = g0; gq[1] = g1; }
      SCHED_FENCE();
      { float kv[16]; conv3_calc(rk_, CW + 128 + sub * 16, 384, kv); float sk = 0.f;
#pragma unroll
        for (int e = 0; e < 16; ++e) { kv[e] = siluf_(kv[e]); sk += kv[e] * kv[e]; }
        sk += __shfl_xor(sk, 1); sk += __shfl_xor(sk, 2); sk += __shfl_xor(sk, 4);
        const float rk = __builtin_amdgcn_rsqf(sk + EPS);
#pragma unroll
        for (int e = 0; e < 16; ++e) kv[e] *= rk;
#pragma unroll
        for (int e = 0; e < 16; e += 4) st_bf16x4(K + i * LDQ + sub * 16 + e, kv[e], kv[e + 1], kv[e + 2], kv[e + 3]);
#pragma unroll
        for (int e = 0; e < 16; ++e) KT[swz_idx(sub * 16 + e, i)] = f2bf(kv[e]); }
      SCHED_FENCE();
      { float vv[16]; conv3_calc(rv_, CW + 256 + sub * 16, 384, vv);
#pragma unroll
        for (int e = 0; e < 16; ++e) VT[swz_idx(sub * 16 + e, i)] = f2bf(siluf_(vv[e])); }
      SCHED_FENCE();
      if (sub < 2) { const int d = sub; const float braw = bf2f((bf16)(rgate & 0xffffu)), araw = bf2f((bf16)(rgate >> 16));
          const int ii = d ? 63 - i : i;
          TBL[d * 192 + ii] = gpar[0] * softplusf_(araw + gpar[1]); TBL[d * 192 + 64 + ii] = sigmoidf_(braw); } }
    LDSBAR();
    if (wave < 2) TBL[wave * 192 + 128 + lane] = wave_scan_incl(TBL[wave * 192 + lane], lane);
    { bf16* ktg = (bf16*)(F.ws + WS_GKT) + (size_t)h * 128 * NROWS + r0;
#pragma unroll
      for (int k = 0; k < 2; ++k) { const int e = F.tid + 512 * k, row = e >> 3, pc = e & 7;
          *(u32x4*)(ktg + (size_t)row * NROWS + pc * 8) = *(const LAS u32x4*)(KT + row * LDT + ((pc ^ (row >> 4)) & 7) * 8); } }
#pragma unroll
    for (int tt = 0; tt < 2; ++tt) { const int id = 2 * wave + tt, ti = id >> 2, tj = id & 3;
        f32x4 akk = {0.f, 0.f, 0.f, 0.f}, aqk = akk;
#pragma unroll
        for (int ks = 0; ks < 4; ++ks) { const bf16x8 bk = frag_nat(K, LDQ, tj * 16, ks * 32, lane);
            akk = MFMA16(bk, frag_nat(K, LDQ, ti * 16, ks * 32, lane), akk);
            aqk = MFMA16(bk, frag_nat(Q, LDQ, ti * 16, ks * 32, lane), aqk); }
        *(LAS f32x4*)(KKR + (ti * 16 + l15) * LDR + tj * 16 + 4 * q4) = akk; *(LAS f32x4*)(QKR + (ti * 16 + l15) * LDR + tj * 16 + 4 * q4) = aqk; }
    LDSBAR();
#pragma unroll
    for (int d = 0; d < 2; ++d) {
        const size_t item = ((size_t)c64 * 16 + h) * 2 + d;
        const LAS float* TB_ = TBL + d * 192;
        if (d == 1 && next_c64 >= 0) { gdn_prep_request(F, next_c64, h, rq_, rk_, rv_, rgate); }
#pragma unroll
        for (int tt = 0; tt < 2; ++tt) { const int id = 2 * wave + tt, ti = id >> 2, tj = id & 3;
            const int i = ti * 16 + l15, j0 = tj * 16 + 4 * q4;
            f32x4 kk, qk;
            if (d == 0) { kk = *(const LAS f32x4*)(KKR + i * LDR + j0); qk = *(const LAS f32x4*)(QKR + i * LDR + j0); }
            else { const f32x4 a = *(const LAS f32x4*)(KKR + (63 - i) * LDR + 60 - j0), b = *(const LAS f32x4*)(QKR + (63 - i) * LDR + 60 - j0);
                kk = (f32x4){a[3], a[2], a[1], a[0]}; qk = (f32x4){b[3], b[2], b[1], b[0]}; }
            const float gi = TB_[128 + i], bi = TB_[64 + i];
            float nv[4], pv[4];
#pragma unroll
            for (int r = 0; r < 4; ++r) { const int j = j0 + r; const float dec = (i >= j) ? __expf(gi - TB_[128 + j]) : 0.f;
                nv[r] = (i > j) ? bi * kk[r] * dec : 0.f; pv[r] = qk[r] * dec; }
            st_bf16x4(NN + i * LDT + j0, -nv[0], -nv[1], -nv[2], -nv[3]);
            { u32x2 w2; w2.x = pk2(pv[0], pv[1]); w2.y = pk2(pv[2], pv[3]); *(u32x2*)((bf16*)(F.ws + WS_GPP) + (item * 64 + i) * 64 + j0) = w2; }
            if (ti == tj) *(LAS f32x4*)(NDG + (ti * 16 + l15) * 16 + 4 * q4) = (f32x4){nv[0], nv[1], nv[2], nv[3]}; }
        if (wave == 1) ((float*)(F.ws + WS_GGC))[item * 64 + lane] = TB_[128 + lane];
        LDSBAR();
        if (wave == 0) { float x[16];
#pragma unroll
            for (int i = 0; i < 16; ++i) { float sa[4] = {0.f, 0.f, 0.f, 0.f};
                const LAS f32x4* nr = (const LAS f32x4*)(NDG + (q4 * 16 + i) * 16);
#pragma unroll
                for (int k4 = 0; k4 < 4; ++k4) { if (4 * k4 < i) { const f32x4 nvv = nr[k4];
#pragma unroll
                        for (int e = 0; e < 4; ++e) if (4 * k4 + e < i) sa[e] += nvv[e] * x[4 * k4 + e]; } }
                const float a = ((i == l15) ? 1.f : 0.f) - ((sa[0] + sa[1]) + (sa[2] + sa[3]));
                x[i] = a; DBK[(q4 * 16 + i) * LDD + l15] = f2bf(a); } }
        LDSBAR();
        { f32x4 u[4], xw[4]; const f32x4 z4 = {0.f, 0.f, 0.f, 0.f};
#pragma unroll
          for (int b = 0; b < 4; ++b) {
              const f32x4 be = *(const LAS f32x4*)(TB_ + 64 + 16 * b + 4 * q4), gcv = *(const LAS f32x4*)(TB_ + 128 + 16 * b + 4 * q4);
              const int c0 = d ? 60 - 16 * b - 4 * q4 : 16 * b + 4 * q4;
              const bf16x4 vraw = *(const LAS bf16x4*)(VT + swz_idx(16 * wave + l15, c0)), kraw = *(const LAS bf16x4*)(KT + swz_idx(16 * wave + l15, c0));
              f32x4 au, aw;
#pragma unroll
              for (int r = 0; r < 4; ++r) { const int rr = d ? 3 - r : r; au[r] = be[r] * bf2f((bf16)vraw[rr]); aw[r] = be[r] * __expf(gcv[r]) * bf2f((bf16)kraw[rr]); }
              if (b >= 1) { const bf16x8 nf = frag_perm(NN, LDT, 16 * b, 0, lane);
                  au = MFMA16(nf, pack2(u[0], b >= 2 ? u[1] : z4), au); aw = MFMA16(nf, pack2(xw[0], b >= 2 ? xw[1] : z4), aw); }
              if (b == 3) { const bf16x8 nf = frag_perm(NN, LDT, 48, 32, lane);
                  au = MFMA16(nf, pack2(u[2], z4), au); aw = MFMA16(nf, pack2(xw[2], z4), aw); }
              const bf16x8 df = frag_perm(DBK + b * 16 * LDD, LDD, 0, 0, lane);
              u[b] = MFMA16(df, pack2(au, z4), z4); xw[b] = MFMA16(df, pack2(aw, z4), z4);
              { u32x2 w2; w2.x = pk2(u[b][0], u[b][1]); w2.y = pk2(u[b][2], u[b][3]);
                *(u32x2*)((bf16*)(F.ws + WS_GUF) + (((item * 8 + wave) * 4 + b) * 64 + lane) * 4) = w2; }
#pragma unroll
              for (int r = 0; r < 4; ++r) W[(16 * b + 4 * q4 + r) * LDQ + 16 * wave + l15] = f2bf(-xw[b][r]); } }
        LDSBAR();
        { bf16* wg = (bf16*)(F.ws + WS_GWN) + item * 8192;
#pragma unroll
          for (int k = 0; k < 2; ++k) { const int e = F.tid + 512 * k, row = e >> 4, pc = e & 15;
              *(u32x4*)(wg + row * 128 + pc * 8) = *(const LAS u32x4*)(W + row * LDQ + pc * 8); } }
    }
}

#define GDN_SETB 79872
DI void gdn_scan_step(const Ctx& F, f32x4 (&S)[2][8], int set, int ci, int d, int len, int row0, int h, bf16* OUT) {
    const int wave = F.wave;
    int lane = F.lane; asm volatile("" : "+v"(lane)); const int l15 = lane & 15, q4 = lane >> 4;
    LAS bf16* W = (LAS bf16*)(F.lds + set * GDN_SETB); LAS bf16* Q = (LAS bf16*)(F.lds + set * GDN_SETB + 17408); LAS bf16* PB = (LAS bf16*)(F.lds + set * GDN_SETB + 34816);
    LAS bf16* KT = (LAS bf16*)(F.lds + set * GDN_SETB + 44032); LAS float* GC = (LAS float*)(F.lds + set * GDN_SETB + 62464); const LAS bf16* UL = (const LAS bf16*)(F.lds + set * GDN_SETB + 63488);
#define LQ(dst, M, it) do { _Pragma("unroll") for (int i_ = 0; i_ < 4; ++i_) dst[i_] = frag_perm(M, LDQ, (it) * 16, i_ * 32, lane); SCHED_FENCE(); } while (0)
#define LT(dst, M, t0) do { _Pragma("unroll") for (int i_ = 0; i_ < 4; ++i_) dst[i_] = frag_perm(M, LDT, ((t0) + (i_ >> 1)) * 16, (i_ & 1) * 32, lane); SCHED_FENCE(); } while (0)
#define CVN(X, it) do { _Pragma("unroll") for (int ks = 0; ks < 4; ++ks) { vn[0][it] = MFMA16(X[ks], Sp[0][ks], vn[0][it]); vn[1][it] = MFMA16(X[ks], Sp[1][ks], vn[1][it]); } SCHED_FENCE(); } while (0)
#define CO(X, j) do { _Pragma("unroll") for (int ks = 0; ks < 4; ++ks) { o[0][j] = MFMA16(Sp[0][ks], X[ks], o[0][j]); o[1][j] = MFMA16(Sp[1][ks], X[ks], o[1][j]); } SCHED_FENCE(); } while (0)
#define CS(X, t0) do { _Pragma("unroll") for (int ks = 0; ks < 2; ++ks) _Pragma("unroll") for (int j = 0; j < 2; ++j) { S[0][(t0) + j] = MFMA16(X[j * 2 + ks], V2p[0][ks], S[0][(t0) + j]); S[1][(t0) + j] = MFMA16(X[j * 2 + ks], V2p[1][ks], S[1][(t0) + j]); } SCHED_FENCE(); } while (0)
#define CPV(X, it0) do { _Pragma("unroll") for (int j = 0; j < 2; ++j) { const float eg = __expf(GC[((it0) + j) * 16 + l15]); o[0][j] = o[0][j] * eg; o[1][j] = o[1][j] * eg; } \
        _Pragma("unroll") for (int ks = 0; ks < 2; ++ks) _Pragma("unroll") for (int j = 0; j < 2; ++j) { o[0][j] = MFMA16(Vp[0][ks], X[j * 2 + ks], o[0][j]); o[1][j] = MFMA16(Vp[1][ks], X[j * 2 + ks], o[1][j]); } \
        _Pragma("unroll") for (int j = 0; j < 2; ++j) { const int i = ((it0) + j) * 16 + l15; const int tl = ci * 64 + i, t = d ? (len - 1 - tl) : tl; bf16* op = OUT + (size_t)(row0 + t) * 2048 + h * 128 + 32 * wave + 4 * q4; \
            u32x2 w2; w2.x = pk2(o[0][j][0], o[0][j][1]); w2.y = pk2(o[0][j][2], o[0][j][3]); *(u32x2*)op = w2; w2.x = pk2(o[1][j][0], o[1][j][1]); w2.y = pk2(o[1][j][2], o[1][j][3]); *(u32x2*)(op + 16) = w2; \
            o[0][j] = (f32x4){0.f, 0.f, 0.f, 0.f}; o[1][j] = (f32x4){0.f, 0.f, 0.f, 0.f}; } SCHED_FENCE(); } while (0)
    bf16x8 X0[4], X1[4], X2[4];
    f32x4 vn[2][4];
#pragma unroll
    for (int x = 0; x < 2; ++x)
#pragma unroll
        for (int b = 0; b < 4; ++b) { const u32x2 ur = *(const LAS u32x2*)(UL + (((2 * wave + x) * 4 + b) * 64 + lane) * 4);
            vn[x][b][0] = __uint_as_float(ur.x << 16); vn[x][b][1] = __uint_as_float(ur.x & 0xffff0000u); vn[x][b][2] = __uint_as_float(ur.y << 16); vn[x][b][3] = __uint_as_float(ur.y & 0xffff0000u); }
    const float gl = GC[63];
    LQ(X0, W, 0); LQ(X1, W, 1);
    bf16x8 Sp[2][4];
#pragma unroll
    for (int x = 0; x < 2; ++x)
#pragma unroll
        for (int ks = 0; ks < 4; ++ks) Sp[x][ks] = pack2(S[x][2 * ks], S[x][2 * ks + 1]);
    SCHED_FENCE();
    LQ(X2, W, 2); CVN(X0, 0);
    LQ(X0, W, 3); CVN(X1, 1);
    LQ(X1, Q, 0); CVN(X2, 2);
    LQ(X2, Q, 1); CVN(X0, 3);
    bf16x8 Vp[2][2], V2p[2][2];
#pragma unroll
    for (int ks = 0; ks < 2; ++ks) { float e0[4], e1[4];
#pragma unroll
        for (int r = 0; r < 4; ++r) { e0[r] = __expf(gl - GC[(2 * ks) * 16 + 4 * q4 + r]); e1[r] = __expf(gl - GC[(2 * ks + 1) * 16 + 4 * q4 + r]); }
#pragma unroll
        for (int x = 0; x < 2; ++x) { Vp[x][ks] = pack2(vn[x][2 * ks], vn[x][2 * ks + 1]);
            f32x4 a, b;
#pragma unroll
            for (int r = 0; r < 4; ++r) { a[r] = vn[x][2 * ks][r] * e0[r]; b[r] = vn[x][2 * ks + 1][r] * e1[r]; }
            V2p[x][ks] = pack2(a, b); } }
    const float egl = __expf(gl);
    SCHED_FENCE();
    f32x4 o[2][2];
#pragma unroll
    for (int x = 0; x < 2; ++x)
#pragma unroll
        for (int j = 0; j < 2; ++j) o[x][j] = (f32x4){0.f, 0.f, 0.f, 0.f};
    LT(X0, PB, 0); CO(X1, 0);
    LQ(X1, Q, 2); CO(X2, 1);
    LQ(X2, Q, 3); CPV(X0, 0);
    LT(X0, PB, 2); CO(X1, 0);
    LT(X1, KT, 0); CO(X2, 1);
    LT(X2, KT, 2); CPV(X0, 2);
#pragma unroll
    for (int x = 0; x < 2; ++x)
#pragma unroll
        for (int t = 0; t < 8; ++t) S[x][t] = S[x][t] * egl;
    SCHED_FENCE();
    LT(X0, KT, 4); CS(X1, 0);
    LT(X1, KT, 6); CS(X2, 2);
    CS(X0, 4); CS(X1, 6);
#undef LQ
#undef LT
#undef CVN
#undef CO
#undef CS
#undef CPV
}
DI void gdn_scan_item(const Ctx& F, const float* const* in, int s, int h, int d) {
    constexpr int SETB = GDN_SETB;
    const int row0 = seq_row0(s), len = seq_len(s), nch = len >> 6, c640 = row0 >> 6;
    const int lane_o = F.lane, wave = F.wave;
    bf16* OUT = (bf16*)(F.ws + (d ? WS_OBA : WS_OFA));
    const bf16* GWN = (const bf16*)(F.ws + WS_GWN); const bf16* GUF = (const bf16*)(F.ws + WS_GUF); const bf16* GPP = (const bf16*)(F.ws + WS_GPP);
    const float* GGC = (const float*)(F.ws + WS_GGC); const bf16* GQN = (const bf16*)(F.ws + WS_GQN); const bf16* GKT = (const bf16*)(F.ws + WS_GKT) + (size_t)h * 128 * NROWS;
    LDSBAR();
    if (wave >= 4) {
        struct Pre { u32x4 w[4], q[4], p[2], k[4], u[4]; float g; };
        Pre PA, PB_;
        const int e = F.tid - 256, er = e >> 2, eq = e & 3;
#define GDN_ISSUE(ci_, P_) do { const int cc = c640 + (d ? nch - 1 - (ci_) : (ci_)); const size_t item = ((size_t)cc * 16 + h) * 2 + d; \
        const u32x4* wsrc = (const u32x4*)(GWN + item * 8192 + er * 128 + eq * 32); \
        const int qrow = cc * 64 + (d ? 63 - er : er); const u32x4* qsrc = (const u32x4*)(GQN + (size_t)qrow * 2048 + h * 128 + eq * 32); \
        _Pragma("unroll") for (int m_ = 0; m_ < 4; ++m_) { P_.w[m_] = wsrc[m_]; P_.q[m_] = qsrc[m_]; } \
        const u32x4* psrc = (const u32x4*)(GPP + item * 4096 + er * 64 + eq * 16); P_.p[0] = psrc[0]; P_.p[1] = psrc[1]; \
        const u32x4* k0src = (const u32x4*)(GKT + (size_t)er * NROWS + cc * 64 + eq * 16); const u32x4* k1src = (const u32x4*)(GKT + (size_t)(64 + er) * NROWS + cc * 64 + eq * 16); \
        P_.k[0] = k0src[0]; P_.k[1] = k0src[1]; P_.k[2] = k1src[0]; P_.k[3] = k1src[1]; \
        const u32x4* usrc = (const u32x4*)(GUF + item * 8192) + e; _Pragma("unroll") for (int m_ = 0; m_ < 4; ++m_) P_.u[m_] = usrc[m_ * 256]; \
        P_.g = (e < 64) ? GGC[item * 64 + e] : 0.f; } while (0)
#define REV8(w_) ((u32x4){((w_).w >> 16) | ((w_).w << 16), ((w_).z >> 16) | ((w_).z << 16), ((w_).y >> 16) | ((w_).y << 16), ((w_).x >> 16) | ((w_).x << 16)})
#define GDN_COMMIT(set_, P_) do { LAS unsigned char* base = F.lds + (set_) * SETB; \
        _Pragma("unroll") for (int m_ = 0; m_ < 4; ++m_) { *(LAS u32x4*)((LAS bf16*)base + er * LDQ + eq * 32 + m_ * 8) = P_.w[m_]; *(LAS u32x4*)((LAS bf16*)(base + 17408) + er * LDQ + eq * 32 + m_ * 8) = P_.q[m_]; } \
        *(LAS u32x4*)((LAS bf16*)(base + 34816) + er * LDT + eq * 16) = P_.p[0]; *(LAS u32x4*)((LAS bf16*)(base + 34816) + er * LDT + eq * 16 + 8) = P_.p[1]; \
        if (d == 0) { *(LAS u32x4*)((LAS bf16*)(base + 44032) + er * LDT + eq * 16) = P_.k[0]; *(LAS u32x4*)((LAS bf16*)(base + 44032) + er * LDT + eq * 16 + 8) = P_.k[1]; \
            *(LAS u32x4*)((LAS bf16*)(base + 44032) + (64 + er) * LDT + eq * 16) = P_.k[2]; *(LAS u32x4*)((LAS bf16*)(base + 44032) + (64 + er) * LDT + eq * 16 + 8) = P_.k[3]; } \
        else { *(LAS u32x4*)((LAS bf16*)(base + 44032) + er * LDT + (3 - eq) * 16 + 8) = REV8(P_.k[0]); *(LAS u32x4*)((LAS bf16*)(base + 44032) + er * LDT + (3 - eq) * 16) = REV8(P_.k[1]); \
            *(LAS u32x4*)((LAS bf16*)(base + 44032) + (64 + er) * LDT + (3 - eq) * 16 + 8) = REV8(P_.k[2]); *(LAS u32x4*)((LAS bf16*)(base + 44032) + (64 + er) * LDT + (3 - eq) * 16) = REV8(P_.k[3]); } \
        _Pragma("unroll") for (int m_ = 0; m_ < 4; ++m_) *((LAS u32x4*)(base + 63488) + e + m_ * 256) = P_.u[m_]; \
        if (e < 64) ((LAS float*)(base + 62464))[e] = P_.g; } while (0)
        GDN_ISSUE(0, PA); GDN_ISSUE(1, PB_);
#pragma unroll 1
        for (int ci = 0; ci < nch; ci += 2) {
            GDN_COMMIT(0, PA); LDSBAR(); if (ci + 2 < nch) GDN_ISSUE(ci + 2, PA);
            GDN_COMMIT(1, PB_); LDSBAR(); if (ci + 3 < nch) GDN_ISSUE(ci + 3, PB_); }
#undef GDN_ISSUE
#undef GDN_COMMIT
#undef REV8
    } else {
        f32x4 S[2][8];
        if (s >= 16) { int ln = lane_o; asm volatile("" : "+v"(ln)); const int l15 = ln & 15, q4 = ln >> 4; const float* sp = in[2] + ((size_t)((s - 16) * 2 + d) * 16 + h) * 16384;
#pragma unroll
            for (int x = 0; x < 2; ++x)
#pragma unroll
                for (int t = 0; t < 8; ++t)
#pragma unroll
                    for (int r = 0; r < 4; ++r) S[x][t][r] = sp[(size_t)(16 * t + 4 * q4 + r) * 128 + 32 * wave + 16 * x + l15];
        } else {
#pragma unroll
            for (int x = 0; x < 2; ++x)
#pragma unroll
                for (int t = 0; t < 8; ++t) S[x][t] = (f32x4){0.f, 0.f, 0.f, 0.f}; }
#pragma unroll 1
        for (int ci = 0; ci < nch; ci += 2) { LDSBAR(); gdn_scan_step(F, S, 0, ci, d, len, row0, h, OUT); LDSBAR(); gdn_scan_step(F, S, 1, ci + 1, d, len, row0, h, OUT); }
        if (s < 16) { int ln = lane_o; asm volatile("" : "+v"(ln)); const int l15 = ln & 15, q4 = ln >> 4; float* sp = F.out + OUT_SG + ((size_t)(s * 2 + d) * 16 + h) * 16384;
#pragma unroll
            for (int x = 0; x < 2; ++x)
#pragma unroll
                for (int t = 0; t < 8; ++t)
#pragma unroll
                    for (int r = 0; r < 4; ++r) sp[(size_t)(16 * t + 4 * q4 + r) * 128 + 32 * wave + 16 * x + l15] = S[x][t][r]; }
    }
}

DI void ssd_prep_request(const Ctx& F, int c64, int g, u32x4 (&rx0)[6], u32x4 (&rx1)[6], u32x4 (&rb_)[6], u32x4 (&rc_)[6], unsigned& rdt) {
    const bf16* U = (const bf16*)(F.ws + WS_U);
    const int r0 = c64 * 64, len = r0 < 4096 ? 256 : 4096, t0 = r0 < 4096 ? (r0 & 255) : ((r0 - 4096) & 4095);
    const int i = F.tid >> 3, sub = F.tid & 7, t = t0 + i;
    const bf16* ur = U + (size_t)(r0 + i) * LD_EVEN;
    conv3_load(ur + E_XBC + g * 256 + sub * 32, LD_EVEN, t, len, rx0);
    conv3_load(ur + E_XBC + g * 256 + sub * 32 + 16, LD_EVEN, t, len, rx1);
    conv3_load(ur + E_XBC + 2048 + g * 128 + sub * 16, LD_EVEN, t, len, rb_);
    conv3_load(ur + E_XBC + 3072 + g * 128 + sub * 16, LD_EVEN, t, len, rc_);
    rdt = (unsigned)ur[E_DT + (sub >> 2) * 32 + g * 4 + (sub & 3)];
}
DI void ssd_prep_item(const Ctx& F, const float* const* in, int c64, int g, bool stage_cw, u32x4 (&rx0)[6], u32x4 (&rx1)[6], u32x4 (&rb_)[6], u32x4 (&rc_)[6], unsigned& rdt, float (&spar)[2], int next_c64, int next_g) {
    LAS bf16* C = (LAS bf16*)(F.lds + 0);
    LAS bf16* B = (LAS bf16*)(F.lds + 17408);
    LAS bf16* BT = (LAS bf16*)(F.lds + 34816);
    LAS bf16* XT = (LAS bf16*)(F.lds + 53248);
    LAS float* CBR = (LAS float*)(F.lds + 90112);
    LAS float* TBL = (LAS float*)(F.lds + 107520);
    LAS float* CW = TBL + 8 * 192;
    constexpr int LDR = 68;
    const bf16* U = (const bf16*)(F.ws + WS_U);
    const int r0 = c64 * 64, len = r0 < 4096 ? 256 : 4096, t0 = r0 < 4096 ? (r0 & 255) : ((r0 - 4096) & 4095);
    const int lane_o = F.lane, wave = F.wave;
    LDSBAR();
    if (stage_cw) { const int sd = (F.tid & 7) >> 2, shd = g * 4 + (F.tid & 3); spar[0] = -expf(in[18][sd * 32 + shd]); spar[1] = in[19][sd * 32 + shd]; }
    if (stage_cw) {
        for (int e = F.tid; e < 3 * 512; e += 512) { const int tap = e >> 9, c = e & 511; const int col = c < 256 ? g * 256 + c : (c < 384 ? 2048 + g * 128 + (c - 256) : 3072 + g * 128 + (c - 384)); CW[e] = in[17][tap * 4096 + col]; }
        LDSBAR(); }
    int lane = lane_o; asm volatile("" : "+v"(lane)); const int l15 = lane & 15, q4 = lane >> 4;
    { const int i = F.tid >> 3, sub = F.tid & 7; const int t = t0 + i;
      const bf16* ur = U + (size_t)(r0 + i) * LD_EVEN;
      SCHED_FENCE();
      { float xv[16]; conv3_calc(rx0, CW + sub * 32, 512, xv);
#pragma unroll
        for (int e = 0; e < 16; ++e) XT[swz_idx((sub >> 1) * 64 + (sub & 1) * 32 + e, i)] = f2bf(siluf_(xv[e])); }
      SCHED_FENCE();
      { float xv[16]; conv3_calc(rx1, CW + sub * 32 + 16, 512, xv);
#pragma unroll
        for (int e = 0; e < 16; ++e) XT[swz_idx((sub >> 1) * 64 + (sub & 1) * 32 + 16 + e, i)] = f2bf(siluf_(xv[e])); }
      SCHED_FENCE();
      { float bv[16]; conv3_calc(rb_, CW + 256 + sub * 16, 512, bv);
#pragma unroll
        for (int e = 0; e < 16; ++e) bv[e] = siluf_(bv[e]);
#pragma unroll
        for (int e = 0; e < 16; e += 4) st_bf16x4(B + i * LDQ + sub * 16 + e, bv[e], bv[e + 1], bv[e + 2], bv[e + 3]);
#pragma unroll
        for (int e = 0; e < 16; ++e) BT[swz_idx(sub * 16 + e, i)] = f2bf(bv[e]); }
      SCHED_FENCE();
      { float cv[16]; conv3_calc(rc_, CW + 384 + sub * 16, 512, cv);
        u32x4 g0, g1; g0.x = pk2(siluf_(cv[0]), siluf_(cv[1])); g0.y = pk2(siluf_(cv[2]), siluf_(cv[3])); g0.z = pk2(siluf_(cv[4]), siluf_(cv[5])); g0.w = pk2(siluf_(cv[6]), siluf_(cv[7]));
        g1.x = pk2(siluf_(cv[8]), siluf_(cv[9])); g1.y = pk2(siluf_(cv[10]), siluf_(cv[11])); g1.z = pk2(siluf_(cv[12]), siluf_(cv[13])); g1.w = pk2(siluf_(cv[14]), siluf_(cv[15]));
        *(LAS u32x4*)(C + i * LDQ + sub * 16) = g0; *(LAS u32x4*)(C + i * LDQ + sub * 16 + 8) = g1;
        u32x4* gc_ = (u32x4*)((bf16*)(F.ws + WS_SCN) + (size_t)(r0 + i) * 1024 + g * 128 + sub * 16); gc_[0] = g0; gc_[1] = g1; }
      SCHED_FENCE();
      { const int d = sub >> 2, hx = sub & 3, hd = g * 4 + hx, ii = d ? 63 - i : i;
        const float dt = softplusf_(bf2f((bf16)(rdt & 0xffffu)) + spar[1]);
        TBL[sub * 192 + ii] = spar[0] * dt; TBL[sub * 192 + 128 + ii] = dt; } }
    if (next_c64 >= 0) ssd_prep_request(F, next_c64, next_g, rx0, rx1, rb_, rc_, rdt);
    LDSBAR();
    TBL[wave * 192 + 64 + lane] = wave_scan_incl(TBL[wave * 192 + lane], lane);
    { bf16* btg = (bf16*)(F.ws + WS_SBT) + (size_t)g * 128 * NROWS + r0;
#pragma unroll
      for (int k = 0; k < 2; ++k) { const int e = F.tid + 512 * k, row = e >> 3, pc = e & 7;
          *(u32x4*)(btg + (size_t)row * NROWS + pc * 8) = *(const LAS u32x4*)(BT + row * LDT + ((pc ^ (row >> 4)) & 7) * 8); } }
#pragma unroll
    for (int k = 0; k < 8; ++k) { const int e = F.tid + 512 * k, pc = e & 7, row = (e >> 3) & 63, hx = (e >> 9) & 3, d = e >> 11;
        const u32x4 raw = *(const LAS u32x4*)(XT + (hx * 64 + row) * LDT + ((pc ^ ((hx * 64 + row) >> 4)) & 7) * 8); float f[8]; unpack8(raw, f);
        const LAS float* dtp = TBL + (d * 4 + hx) * 192 + 128;
        u32x4 o;
        if (d == 0) { const f32x4 d0 = *(const LAS f32x4*)(dtp + pc * 8), d1 = *(const LAS f32x4*)(dtp + pc * 8 + 4);
            o.x = pk2(f[0] * d0[0], f[1] * d0[1]); o.y = pk2(f[2] * d0[2], f[3] * d0[3]); o.z = pk2(f[4] * d1[0], f[5] * d1[1]); o.w = pk2(f[6] * d1[2], f[7] * d1[3]); }
        else { const f32x4 d0 = *(const LAS f32x4*)(dtp + 56 - pc * 8), d1 = *(const LAS f32x4*)(dtp + 60 - pc * 8);
            o.x = pk2(f[0] * d1[3], f[1] * d1[2]); o.y = pk2(f[2] * d1[1], f[3] * d1[0]); o.z = pk2(f[4] * d0[3], f[5] * d0[2]); o.w = pk2(f[6] * d0[1], f[7] * d0[0]); }
        *(u32x4*)((bf16*)(F.ws + WS_SVT) + ((size_t)((g * 4 + hx) * 2 + d) * 64 + row) * NROWS + r0 + pc * 8) = o; }
#pragma unroll
    for (int tt = 0; tt < 2; ++tt) { const int id = 2 * wave + tt, ti = id >> 2, tj = id & 3;
        f32x4 cb = {0.f, 0.f, 0.f, 0.f};
#pragma unroll
        for (int ks = 0; ks < 4; ++ks) cb = MFMA16(frag_nat(B, LDQ, tj * 16, ks * 32, lane), frag_nat(C, LDQ, ti * 16, ks * 32, lane), cb);
        *(LAS f32x4*)(CBR + (ti * 16 + l15) * LDR + tj * 16 + 4 * q4) = cb; }
    LDSBAR();
    { const int d = wave >> 2, hx = wave & 3; const size_t item = ((size_t)c64 * 32 + g * 4 + hx) * 2 + d;
      const LAS float* gcp = TBL + wave * 192 + 64; const float gi = gcp[lane];
      ((float*)(F.ws + WS_SSG))[item * 64 + lane] = gi;
      const LAS float* crow = CBR + (d ? 63 - lane : lane) * LDR;
      bf16* pg = (bf16*)(F.ws + WS_SSP) + (item * 64 + lane) * 64;
#pragma unroll
      for (int j8 = 0; j8 < 8; ++j8) { float pv[8];
          f32x4 c0, c1;
          if (d == 0) { c0 = *(const LAS f32x4*)(crow + j8 * 8); c1 = *(const LAS f32x4*)(crow + j8 * 8 + 4); }
          else { const f32x4 a0 = *(const LAS f32x4*)(crow + 60 - j8 * 8), a1 = *(const LAS f32x4*)(crow + 56 - j8 * 8); c0 = (f32x4){a0[3], a0[2], a0[1], a0[0]}; c1 = (f32x4){a1[3], a1[2], a1[1], a1[0]}; }
          const f32x4 g0 = *(const LAS f32x4*)(gcp + j8 * 8), g1 = *(const LAS f32x4*)(gcp + j8 * 8 + 4);
#pragma unroll
          for (int e = 0; e < 4; ++e) { const int j = j8 * 8 + e; pv[e] = (lane >= j) ? c0[e] * __expf(gi - g0[e]) : 0.f; pv[4 + e] = (lane >= j + 4) ? c1[e] * __expf(gi - g1[e]) : 0.f; }
          u32x4 o; o.x = pk2(pv[0], pv[1]); o.y = pk2(pv[2], pv[3]); o.z = pk2(pv[4], pv[5]); o.w = pk2(pv[6], pv[7]);
          *(u32x4*)(pg + j8 * 8) = o; } }
}

#define SSD_SETB 73728
DI void ssd_scan_step(const Ctx& F, f32x4 (&S)[2][8], int set, int ci, int d, int len, int row0, int head0, bf16* OUT) {
    const int pq = F.wave;
    int lane = F.lane; asm volatile("" : "+v"(lane)); const int l15 = lane & 15, q4 = lane >> 4;
    LAS unsigned char* base = F.lds + set * SSD_SETB;
    LAS bf16* C = (LAS bf16*)base; LAS bf16* BT = (LAS bf16*)(base + 17408); LAS bf16* PH = (LAS bf16*)(base + 35840); LAS bf16* VT = (LAS bf16*)(base + 54272);
    LAS float* GC = (LAS float*)(base + 72704);
#define LC(dst, it) do { _Pragma("unroll") for (int i_ = 0; i_ < 4; ++i_) dst[i_] = frag_perm(C, LDQ, (it) * 16, i_ * 32, lane); SCHED_FENCE(); } while (0)
#define LP(dst, it) do { _Pragma("unroll") for (int i_ = 0; i_ < 4; ++i_) dst[i_] = frag_nat(PH + (i_ >> 1) * 4608, LDT, (it) * 16, (i_ & 1) * 32, lane); SCHED_FENCE(); } while (0)
#define LB(dst, t0) do { _Pragma("unroll") for (int i_ = 0; i_ < 4; ++i_) dst[i_] = frag_nat(BT, LDT, ((t0) + (i_ >> 1)) * 16, (i_ & 1) * 32, lane); SCHED_FENCE(); } while (0)
#define CY(X, it) do { y[0] = (f32x4){0.f, 0.f, 0.f, 0.f}; y[1] = y[0]; _Pragma("unroll") for (int ks = 0; ks < 4; ++ks) { y[0] = MFMA16(Sp[0][ks], X[ks], y[0]); y[1] = MFMA16(Sp[1][ks], X[ks], y[1]); } \
        y[0] = y[0] * __expf(GC[(it) * 16 + l15]); y[1] = y[1] * __expf(GC[64 + (it) * 16 + l15]); SCHED_FENCE(); } while (0)
#define CP(X, it) do { _Pragma("unroll") for (int ks = 0; ks < 2; ++ks) { y[0] = MFMA16(VF[0][ks], X[ks], y[0]); y[1] = MFMA16(VF[1][ks], X[2 + ks], y[1]); } \
        { const int i = (it) * 16 + l15; const int tl = ci * 64 + i, t = d ? (len - 1 - tl) : tl; bf16* op = OUT + (size_t)(row0 + t) * 2048 + head0 * 64 + 16 * pq + 4 * q4; \
          u32x2 w2; w2.x = pk2(y[0][0], y[0][1]); w2.y = pk2(y[0][2], y[0][3]); *(u32x2*)op = w2; w2.x = pk2(y[1][0], y[1][1]); w2.y = pk2(y[1][2], y[1][3]); *(u32x2*)(op + 64) = w2; } SCHED_FENCE(); } while (0)
#define CS(X, t0) do { _Pragma("unroll") for (int ks = 0; ks < 2; ++ks) _Pragma("unroll") for (int j = 0; j < 2; ++j) { S[0][(t0) + j] = MFMA16(X[j * 2 + ks], V2[0][ks], S[0][(t0) + j]); S[1][(t0) + j] = MFMA16(X[j * 2 + ks], V2[1][ks], S[1][(t0) + j]); } SCHED_FENCE(); } while (0)
    bf16x8 X0[4], X1[4], X2[4];
    bf16x8 VF[2][2];
#pragma unroll
    for (int x = 0; x < 2; ++x)
#pragma unroll
        for (int ks = 0; ks < 2; ++ks) VF[x][ks] = frag_nat(VT + x * 4608, LDT, 16 * pq, ks * 32, lane);
    const float gl0 = GC[63], gl1 = GC[127];
    LC(X0, 0); LP(X1, 0);
    bf16x8 Sp[2][4];
#pragma unroll
    for (int x = 0; x < 2; ++x)
#pragma unroll
        for (int ks = 0; ks < 4; ++ks) Sp[x][ks] = pack2(S[x][2 * ks], S[x][2 * ks + 1]);
    bf16x8 V2[2][2];
#pragma unroll
    for (int x = 0; x < 2; ++x) { const float gl = x ? gl1 : gl0;
#pragma unroll
        for (int ks = 0; ks < 2; ++ks) { float f[8]; unpack8(__builtin_bit_cast(u32x4, VF[x][ks]), f);
            const f32x4 g0 = *(const LAS f32x4*)(GC + x * 64 + ks * 32 + 8 * q4), g1 = *(const LAS f32x4*)(GC + x * 64 + ks * 32 + 8 * q4 + 4);
            u32x4 w; w.x = pk2(f[0] * __expf(gl - g0[0]), f[1] * __expf(gl - g0[1])); w.y = pk2(f[2] * __expf(gl - g0[2]), f[3] * __expf(gl - g0[3]));
            w.z = pk2(f[4] * __expf(gl - g1[0]), f[5] * __expf(gl - g1[1])); w.w = pk2(f[6] * __expf(gl - g1[2]), f[7] * __expf(gl - g1[3]));
            V2[x][ks] = __builtin_bit_cast(bf16x8, w); } }
    const float egl0 = __expf(gl0), egl1 = __expf(gl1);
    SCHED_FENCE();
    f32x4 y[2];
    LC(X2, 1); CY(X0, 0);
    LP(X0, 1); CP(X1, 0);
    LC(X1, 2); CY(X2, 1);
    LP(X2, 2); CP(X0, 1);
    LC(X0, 3); CY(X1, 2);
    LP(X1, 3); CP(X2, 2);
    LB(X2, 0); CY(X0, 3);
    LB(X0, 2); CP(X1, 3);
#pragma unroll
    for (int t = 0; t < 8; ++t) { S[0][t] = S[0][t] * egl0; S[1][t] = S[1][t] * egl1; }
    SCHED_FENCE();
    LB(X1, 4); CS(X2, 0);
    LB(X2, 6); CS(X0, 2);
    CS(X1, 4); CS(X2, 6);
#undef LC
#undef LP
#undef LB
#undef CY
#undef CP
#undef CS
}
DI void ssd_scan_item(const Ctx& F, const float* const* in, int s, int g, int d, int hp) {
    constexpr int SETB = SSD_SETB;
    const int row0 = seq_row0(s), len = seq_len(s), nch = len >> 6, c640 = row0 >> 6;
    const int lane_o = F.lane, wave = F.wave;
    const int head0 = g * 4 + hp * 2;
    bf16* OUT = (bf16*)(F.ws + (d ? WS_OBB : WS_OFB));
    const bf16* SCN = (const bf16*)(F.ws + WS_SCN); const bf16* SBT = (const bf16*)(F.ws + WS_SBT) + (size_t)g * 128 * NROWS;
    const bf16* SVT = (const bf16*)(F.ws + WS_SVT); const bf16* SSP = (const bf16*)(F.ws + WS_SSP); const float* SSG = (const float*)(F.ws + WS_SSG);
    LDSBAR();
    if (wave >= 4) {
        struct Pre { u32x4 c[4], b[4], p[4], v[4]; float g; };
        Pre PA, PB_;
        const int e = F.tid - 256, er = e >> 2, eq = e & 3;
#define REV8(w_) ((u32x4){((w_).w >> 16) | ((w_).w << 16), ((w_).z >> 16) | ((w_).z << 16), ((w_).y >> 16) | ((w_).y << 16), ((w_).x >> 16) | ((w_).x << 16)})
#define SSD_ISSUE(ci_, P_) do { const int cc = c640 + (d ? nch - 1 - (ci_) : (ci_)); \
        const int crow = cc * 64 + (d ? 63 - er : er); const u32x4* csrc = (const u32x4*)(SCN + (size_t)crow * 1024 + g * 128 + eq * 32); \
        _Pragma("unroll") for (int m_ = 0; m_ < 4; ++m_) P_.c[m_] = csrc[m_]; \
        const u32x4* b0src = (const u32x4*)(SBT + (size_t)er * NROWS + cc * 64 + eq * 16); const u32x4* b1src = (const u32x4*)(SBT + (size_t)(64 + er) * NROWS + cc * 64 + eq * 16); \
        P_.b[0] = b0src[0]; P_.b[1] = b0src[1]; P_.b[2] = b1src[0]; P_.b[3] = b1src[1]; \
        const size_t it0 = ((size_t)cc * 32 + head0) * 2 + d, it1 = it0 + 2; \
        const u32x4* p0src = (const u32x4*)(SSP + (it0 * 64 + er) * 64 + eq * 16); const u32x4* p1src = (const u32x4*)(SSP + (it1 * 64 + er) * 64 + eq * 16); \
        P_.p[0] = p0src[0]; P_.p[1] = p0src[1]; P_.p[2] = p1src[0]; P_.p[3] = p1src[1]; \
        const u32x4* v0src = (const u32x4*)(SVT + ((size_t)(head0 * 2 + d) * 64 + er) * NROWS + cc * 64 + eq * 16); const u32x4* v1src = (const u32x4*)(SVT + ((size_t)((head0 + 1) * 2 + d) * 64 + er) * NROWS + cc * 64 + eq * 16); \
        P_.v[0] = v0src[0]; P_.v[1] = v0src[1]; P_.v[2] = v1src[0]; P_.v[3] = v1src[1]; \
        P_.g = 0.f; if (e < 128) P_.g = SSG[((e < 64) ? it0 : it1) * 64 + (e & 63)]; } while (0)
#define SSD_COMMIT(set_, P_) do { LAS unsigned char* base = F.lds + (set_) * SETB; \
        _Pragma("unroll") for (int m_ = 0; m_ < 4; ++m_) *(LAS u32x4*)((LAS bf16*)base + er * LDQ + eq * 32 + m_ * 8) = P_.c[m_]; \
        *(LAS u32x4*)((LAS bf16*)(base + 35840) + er * LDT + eq * 16) = P_.p[0]; *(LAS u32x4*)((LAS bf16*)(base + 35840) + er * LDT + eq * 16 + 8) = P_.p[1]; \
        *(LAS u32x4*)((LAS bf16*)(base + 45056) + er * LDT + eq * 16) = P_.p[2]; *(LAS u32x4*)((LAS bf16*)(base + 45056) + er * LDT + eq * 16 + 8) = P_.p[3]; \
        if (d == 0) { *(LAS u32x4*)((LAS bf16*)(base + 17408) + er * LDT + eq * 16) = P_.b[0]; *(LAS u32x4*)((LAS bf16*)(base + 17408) + er * LDT + eq * 16 + 8) = P_.b[1]; \
            *(LAS u32x4*)((LAS bf16*)(base + 17408) + (64 + er) * LDT + eq * 16) = P_.b[2]; *(LAS u32x4*)((LAS bf16*)(base + 17408) + (64 + er) * LDT + eq * 16 + 8) = P_.b[3]; \
            *(LAS u32x4*)((LAS bf16*)(base + 54272) + er * LDT + eq * 16) = P_.v[0]; *(LAS u32x4*)((LAS bf16*)(base + 54272) + er * LDT + eq * 16 + 8) = P_.v[1]; \
            *(LAS u32x4*)((LAS bf16*)(base + 63488) + er * LDT + eq * 16) = P_.v[2]; *(LAS u32x4*)((LAS bf16*)(base + 63488) + er * LDT + eq * 16 + 8) = P_.v[3]; } \
        else { *(LAS u32x4*)((LAS bf16*)(base + 17408) + er * LDT + (3 - eq) * 16 + 8) = REV8(P_.b[0]); *(LAS u32x4*)((LAS bf16*)(base + 17408) + er * LDT + (3 - eq) * 16) = REV8(P_.b[1]); \
            *(LAS u32x4*)((LAS bf16*)(base + 17408) + (64 + er) * LDT + (3 - eq) * 16 + 8) = REV8(P_.b[2]); *(LAS u32x4*)((LAS bf16*)(base + 17408) + (64 + er) * LDT + (3 - eq) * 16) = REV8(P_.b[3]); \
            *(LAS u32x4*)((LAS bf16*)(base + 54272) + er * LDT + (3 - eq) * 16 + 8) = REV8(P_.v[0]); *(LAS u32x4*)((LAS bf16*)(base + 54272) + er * LDT + (3 - eq) * 16) = REV8(P_.v[1]); \
            *(LAS u32x4*)((LAS bf16*)(base + 63488) + er * LDT + (3 - eq) * 16 + 8) = REV8(P_.v[2]); *(LAS u32x4*)((LAS bf16*)(base + 63488) + er * LDT + (3 - eq) * 16) = REV8(P_.v[3]); } \
        if (e < 128) ((LAS float*)(base + 72704))[e] = P_.g; } while (0)
        SSD_ISSUE(0, PA); SSD_ISSUE(1, PB_);
#pragma unroll 1
        for (int ci = 0; ci < nch; ci += 2) {
            SSD_COMMIT(0, PA); LDSBAR(); if (ci + 2 < nch) SSD_ISSUE(ci + 2, PA);
            SSD_COMMIT(1, PB_); LDSBAR(); if (ci + 3 < nch) SSD_ISSUE(ci + 3, PB_); }
#undef SSD_ISSUE
#undef SSD_COMMIT
#undef REV8
    } else {
        const int pq = wave;
        f32x4 S[2][8];
        if (s >= 16) { int ln = lane_o; asm volatile("" : "+v"(ln)); const int l15 = ln & 15, q4 = ln >> 4;
#pragma unroll
            for (int x = 0; x < 2; ++x) { const float* sp = in[3] + ((size_t)((s - 16) * 2 + d) * 32 + head0 + x) * 8192;
#pragma unroll
                for (int t = 0; t < 8; ++t) S[x][t] = *(const f32x4*)(sp + (size_t)(16 * pq + l15) * 128 + 16 * t + 4 * q4); }
        } else {
#pragma unroll
            for (int x = 0; x < 2; ++x)
#pragma unroll
                for (int t = 0; t < 8; ++t) S[x][t] = (f32x4){0.f, 0.f, 0.f, 0.f}; }
#pragma unroll 1
        for (int ci = 0; ci < nch; ci += 2) { LDSBAR(); ssd_scan_step(F, S, 0, ci, d, len, row0, head0, OUT); LDSBAR(); ssd_scan_step(F, S, 1, ci + 1, d, len, row0, head0, OUT); }
        if (s < 16) { int ln = lane_o; asm volatile("" : "+v"(ln)); const int l15 = ln & 15, q4 = ln >> 4;
#pragma unroll
            for (int x = 0; x < 2; ++x) { float* sp = F.out + OUT_SS + ((size_t)(s * 2 + d) * 32 + head0 + x) * 8192;
#pragma unroll
                for (int t = 0; t < 8; ++t) *(f32x4*)(sp + (size_t)(16 * pq + l15) * 128 + 16 * t + 4 * q4) = S[x][t]; } }
    }
}

DI void phase_m0a(const Ctx& F, const float* const* in) {
    { int prev = -1; u32x4 rq_[6], rk_[6], rv_[6]; unsigned rgate = 0u; float gpar[2] = {0.f, 0.f};
      if (F.bid < 3072) gdn_prep_request(F, F.bid >> 4, F.bid & 15, rq_, rk_, rv_, rgate);
      for (int it = F.bid; it < 3072; it += F.G) { const int h = it & 15; const int nx = it + F.G;
          const int next_c64 = (nx < 3072 && (nx & 15) == h) ? (nx >> 4) : -1;
          gdn_prep_item(F, in, it >> 4, h, h != prev, rq_, rk_, rv_, rgate, gpar, next_c64);
          if (next_c64 < 0 && nx < 3072) gdn_prep_request(F, nx >> 4, nx & 15, rq_, rk_, rv_, rgate);
          prev = h; } }
    { int prev = -1; u32x4 rx0[6], rx1[6], rb_[6], rc_[6]; unsigned rdt = 0u; float spar[2] = {0.f, 0.f};
      if (F.bid < 1536) ssd_prep_request(F, F.bid >> 3, F.bid & 7, rx0, rx1, rb_, rc_, rdt);
#pragma unroll 1
      for (int it = F.bid; it < 1536; it += F.G) { const int g = it & 7; const int nx = it + F.G;
          ssd_prep_item(F, in, it >> 3, g, g != prev, rx0, rx1, rb_, rc_, rdt, spar, nx < 1536 ? (nx >> 3) : -1, nx & 7); prev = g; } }
}
DI int queue_grab(const Ctx& F, unsigned* head, int n) {
    volatile LAS int* slot = (volatile LAS int*)(F.lds + 163840 - 128);
    LDSBAR();
    if (F.tid == 0) *slot = (int)__hip_atomic_fetch_add(head, (unsigned)n, __ATOMIC_RELAXED, __HIP_MEMORY_SCOPE_AGENT);
    LDSBAR();
    return *slot;
}
DI void phase_m0(const Ctx& F, const float* const* in, int only = 0) {
    const int b = F.bid;
    const int nw = F.G > 128 ? F.G - 128 : F.G, w = F.G > 128 ? b - 128 : b;
    { int it = (F.G > 128 && b < 64) ? b : (F.G > 128 ? 64 + w : b); const int step = (F.G > 128 && b < 64) ? (1 << 20) : nw;
      if (!(F.G > 128 && b >= 64 && b < 128) && only != 2)
        for (; it < 64 + 512; it += step) { int s, h, d;
            if (it < 64) { s = 16 + (it >> 5); h = (it >> 1) & 15; d = it & 1; } else { const int k = it - 64; s = k >> 5; h = (k >> 1) & 15; d = k & 1; }
            gdn_scan_item(F, in, s, h, d); } }
    { int it = (F.G > 128 && b >= 64 && b < 128) ? b - 64 : (F.G > 128 ? 64 + w : b); const int step = (F.G > 128 && b >= 64 && b < 128) ? (1 << 20) : nw;
      if (!(F.G > 128 && b < 64) && only != 1)
        for (; it < 64 + 512; it += step) { int s, g, d, hp;
            if (it < 64) { s = 16 + (it >> 5); g = (it >> 2) & 7; d = (it >> 1) & 1; hp = it & 1; } else { const int k = it - 64; s = k >> 5; g = (k >> 2) & 7; d = (k >> 1) & 1; hp = k & 1; }
            ssd_scan_item(F, in, s, g, d, hp); } }
}
DI void phase_m0c(const Ctx& F, const float* const* in) {
    const int gw = F.bid * 8 + F.wave, NGW = F.G * 8, lane = F.lane;
    const bf16* U = (const bf16*)(F.ws + WS_U); bf16* MIX = (bf16*)(F.ws + WS_MIX);
    const bf16 *OFA = (const bf16*)(F.ws + WS_OFA), *OBA = (const bf16*)(F.ws + WS_OBA), *OFB = (const bf16*)(F.ws + WS_OFB), *OBB = (const bf16*)(F.ws + WS_OBB);
    for (int row = gw; row < NROWS; row += NGW) {
        const int len = row < 4096 ? 256 : 4096, t = row < 4096 ? (row & 255) : ((row - 4096) & 4095);
        const bf16* ur = U + (size_t)row * LD_EVEN;
        { const int hsub = lane >> 4, c8 = (lane & 15) * 8;
          const f32x4 gn0 = *(const f32x4*)(in[16] + c8), gn1 = *(const f32x4*)(in[16] + c8 + 4);
          u32x4 af[4], ab[4], az[4];
#pragma unroll
          for (int hq = 0; hq < 4; ++hq) { const size_t o = (size_t)row * 2048 + (hq * 4 + hsub) * 128 + c8;
              af[hq] = *(const u32x4*)(OFA + o); ab[hq] = *(const u32x4*)(OBA + o); az[hq] = *(const u32x4*)(ur + E_ZA + (hq * 4 + hsub) * 128 + c8); }
#pragma unroll
          for (int hq = 0; hq < 4; ++hq) { float x[8], y[8], z[8]; unpack8(af[hq], x); unpack8(ab[hq], y); unpack8(az[hq], z);
              float ss = 0.f;
#pragma unroll
              for (int e = 0; e < 8; ++e) { x[e] += y[e]; ss += x[e] * x[e]; }
              ss += __shfl_xor(ss, 1); ss += __shfl_xor(ss, 2); ss += __shfl_xor(ss, 4); ss += __shfl_xor(ss, 8);
              const float rn = __builtin_amdgcn_rsqf(ss * (1.0f / 128.0f) + EPS);
              u32x4 w; w.x = pk2(x[0] * rn * gn0[0] * siluf_(z[0]), x[1] * rn * gn0[1] * siluf_(z[1])); w.y = pk2(x[2] * rn * gn0[2] * siluf_(z[2]), x[3] * rn * gn0[3] * siluf_(z[3]));
              w.z = pk2(x[4] * rn * gn1[0] * siluf_(z[4]), x[5] * rn * gn1[1] * siluf_(z[5])); w.w = pk2(x[6] * rn * gn1[2] * siluf_(z[6]), x[7] * rn * gn1[3] * siluf_(z[7]));
              *(u32x4*)(MIX + (size_t)row * DM + (hq * 4 + hsub) * 128 + c8) = w; } }
        { const int gsub = lane >> 5, c8 = (lane & 31) * 8;
#pragma unroll 2
          for (int gq = 0; gq < 4; ++gq) { const int ch = (gq * 2 + gsub) * 256 + c8; const size_t o = (size_t)row * 2048 + ch;
              const u32x4 af = *(const u32x4*)(OFB + o), ab = *(const u32x4*)(OBB + o), x0 = *(const u32x4*)(ur + E_XBC + ch), zz = *(const u32x4*)(ur + E_ZB + ch);
              u32x4 xm = {0u, 0u, 0u, 0u}, xp = {0u, 0u, 0u, 0u};
              if (t > 0) xm = *(const u32x4*)(ur - LD_EVEN + E_XBC + ch);
              if (t + 1 < len) xp = *(const u32x4*)(ur + LD_EVEN + E_XBC + ch);
              const float dsk = in[20][ch >> 6];
              float a[8], bq[8], fm[8], f0[8], fp[8], zb[8], y[8]; unpack8(af, a); unpack8(ab, bq); unpack8(xm, fm); unpack8(x0, f0); unpack8(xp, fp); unpack8(zz, zb);
              float ss = 0.f;
#pragma unroll
              for (int e4 = 0; e4 < 2; ++e4) { const f32x4 w0 = *(const f32x4*)(in[17] + ch + 4 * e4), w1 = *(const f32x4*)(in[17] + 4096 + ch + 4 * e4), w2 = *(const f32x4*)(in[17] + 8192 + ch + 4 * e4);
#pragma unroll
                  for (int e = 0; e < 4; ++e) { const int k = 4 * e4 + e; const float xs = w0[e] * fm[k] + w1[e] * f0[k] + w2[e] * fp[k];
                      y[k] = (a[k] + bq[k] + dsk * siluf_(xs)) * siluf_(zb[k]); ss += y[k] * y[k]; } }
              ss += __shfl_xor(ss, 1); ss += __shfl_xor(ss, 2); ss += __shfl_xor(ss, 4); ss += __shfl_xor(ss, 8); ss += __shfl_xor(ss, 16);
              const float rn = __builtin_amdgcn_rsqf(ss * (1.0f / 256.0f) + EPS);
              const f32x4 g0 = *(const f32x4*)(in[21] + ch), g1 = *(const f32x4*)(in[21] + ch + 4);
              u32x4 w; w.x = pk2(y[0] * rn * g0[0], y[1] * rn * g0[1]); w.y = pk2(y[2] * rn * g0[2], y[3] * rn * g0[3]); w.z = pk2(y[4] * rn * g1[0], y[5] * rn * g1[1]); w.w = pk2(y[6] * rn * g1[2], y[7] * rn * g1[3]);
              *(u32x4*)(MIX + (size_t)row * DM + 2048 + ch) = w; } }
    }
}
DI void gla_prep_all(const Ctx& F, const float* const* in) {
    LAS bf16* QS = (LAS bf16*)(F.lds + 0);
    LAS bf16* KS = (LAS bf16*)(F.lds + 17408);
    LAS bf16* KST = (LAS bf16*)(F.lds + 34816);
    LAS bf16* VT = (LAS bf16*)(F.lds + 53248);
    LAS float* GL = (LAS float*)(F.lds + 71680);
    LAS float* PART = GL + 128;
    LAS bf16* RF0 = (LAS bf16*)(F.lds + 74240);
    LAS bf16* RF1 = (LAS bf16*)(F.lds + 91648);
    LAS bf16* RQ = (LAS bf16*)(F.lds + 109056);
    LAS bf16* RV = (LAS bf16*)(F.lds + 126464);
    const bf16* U = (const bf16*)(F.ws + WS_U);
    const int lane_o = F.lane, wave = F.wave;
    const int kch = F.tid & 127, qtr = F.tid >> 7;
    const int er = F.tid >> 3, ep = F.tid & 7;
    u32x4 pr[8];
#define GLA_PRE(it_) do { const bf16* ur_ = U + (size_t)(((it_) >> 4) * 64 + er) * IN_ODD + ((it_) & 15) * 128 + ep * 16; \
        const u32x4* a_ = (const u32x4*)(ur_ + O_Q); const u32x4* b_ = (const u32x4*)(ur_ + O_I); const u32x4* c_ = (const u32x4*)(ur_ + O_F); const u32x4* d_ = (const u32x4*)(ur_ + O_F + 2048); \
        pr[0] = a_[0]; pr[1] = a_[1]; pr[2] = b_[0]; pr[3] = b_[1]; pr[4] = c_[0]; pr[5] = c_[1]; pr[6] = d_[0]; pr[7] = d_[1]; } while (0)
    float lbv[2] = {0.f, 0.f}; int lb_h = -1;
    int it = F.bid;
    if (it < 3072) GLA_PRE(it);
#pragma unroll 1
  for (; it < 3072; it += F.G) {
    const int c64 = it >> 4, h = it & 15, r0 = c64 * 64;
    if (h != lb_h) { lb_h = h;
#pragma unroll
        for (int d = 0; d < 2; ++d) lbv[d] = 1.0f / (1.0f + expf(in[31][4096 + d * 2048 + h * 128 + kch] - in[31][d * 2048 + h * 128 + kch])); }
    LDSBAR();
    *(LAS u32x4*)(RQ + er * LDQ + ep * 16) = pr[0]; *(LAS u32x4*)(RQ + er * LDQ + ep * 16 + 8) = pr[1];
    *(LAS u32x4*)(RV + er * LDQ + ep * 16) = pr[2]; *(LAS u32x4*)(RV + er * LDQ + ep * 16 + 8) = pr[3];
    *(LAS u32x4*)(RF0 + er * LDQ + ep * 16) = pr[4]; *(LAS u32x4*)(RF0 + er * LDQ + ep * 16 + 8) = pr[5];
    *(LAS u32x4*)(RF1 + er * LDQ + ep * 16) = pr[6]; *(LAS u32x4*)(RF1 + er * LDQ + ep * 16 + 8) = pr[7];
    if (it + F.G < 3072) GLA_PRE(it + F.G);
    float sq[16];
#pragma unroll 1
    for (int d = 0; d < 2; ++d) {
        const size_t item = ((size_t)c64 * 16 + h) * 2 + d;
        LAS bf16* RF = d ? RF1 : RF0;
        int lane = lane_o; asm volatile("" : "+v"(lane)); const int l15 = lane & 15, q4 = lane >> 4;
        const float lb = d ? lbv[1] : lbv[0];
        LDSBAR();
#ifndef PROBE_GE
#define PROBE_GE 1
#endif
#pragma unroll 1
        for (int rp_ = 0; rp_ < PROBE_GE; ++rp_)
        { const int sqt = d ? 3 - qtr : qtr;
          float pr_[16], kk[16]; float run = 1.f;
#pragma unroll
          for (int ii = 0; ii < 16; ++ii) { const int i = 16 * sqt + ii, tok = d ? 63 - i : i;
              const float fr = bf2f(RF[tok * LDQ + kch]);
              const float f = lb + (1.0f - lb) * sigmoidf_(fr); kk[ii] = 1.0f - f; run *= f; pr_[ii] = run; }
          PART[sqt * 128 + kch] = run;
          if (d == 0) {
#pragma unroll
              for (int ii = 0; ii < 16; ++ii) { const int i = 16 * qtr + ii; sq[ii] = siluf_(bf2f(RQ[i * LDQ + kch])) * 0.08838834764831845f; } }
          LDSBAR();
          float off = 1.f, tot = 1.f;
#pragma unroll
          for (int qq = 0; qq < 4; ++qq) { const float pq = PART[qq * 128 + kch]; if (qq < sqt) off *= pq; tot *= pq; }
          if (qtr == 0) ((float*)(F.ws + WS_LGL))[item * 128 + kch] = __logf(tot);
          unsigned kp[8], vp[8];
          float kvs[16];
          { float inv = __builtin_amdgcn_rcpf(off * pr_[15]);
#pragma unroll
            for (int ii = 15; ii >= 0; --ii) { kvs[ii] = kk[ii] * inv; inv *= 1.0f - kk[ii]; } }
#pragma unroll
          for (int ii = 0; ii < 16; ++ii) { const int i = 16 * sqt + ii, tok = d ? 63 - i : i;
              const float eg = off * pr_[ii];
              const float qv = (d ? sq[15 - ii] : sq[ii]) * eg;
              const float kv = kvs[ii];
              QS[i * LDQ + kch] = f2bf(qv); const bf16 kb = f2bf(kv); KS[i * LDQ + kch] = kb;
              if (ii & 1) kp[ii >> 1] |= (unsigned)kb << 16; else kp[ii >> 1] = kb;
              if (d == 0) { const unsigned vb = RV[tok * LDQ + kch]; if (ii & 1) vp[ii >> 1] |= vb << 16; else vp[ii >> 1] = vb; } }
          *(LAS u32x4*)(KST + kch * LDT + 16 * sqt) = (u32x4){kp[0], kp[1], kp[2], kp[3]}; *(LAS u32x4*)(KST + kch * LDT + 16 * sqt + 8) = (u32x4){kp[4], kp[5], kp[6], kp[7]};
          if (d == 0) { *(LAS u32x4*)(VT + kch * LDT + 16 * qtr) = (u32x4){vp[0], vp[1], vp[2], vp[3]}; *(LAS u32x4*)(VT + kch * LDT + 16 * qtr + 8) = (u32x4){vp[4], vp[5], vp[6], vp[7]}; } }
        LDSBAR();
#ifndef PROBE_GA
#define PROBE_GA 1
#endif
#pragma unroll 1
        for (int rq_ = 0; rq_ < PROBE_GA; ++rq_) {
#pragma unroll
        for (int tt = 0; tt < 2; ++tt) { const int id = 2 * wave + tt, ti = id >> 2, tj = id & 3;
            f32x4 a = {0.f, 0.f, 0.f, 0.f};
#pragma unroll
            for (int ks = 0; ks < 4; ++ks) a = MFMA16(frag_nat(KS, LDQ, tj * 16, ks * 32, lane), frag_nat(QS, LDQ, ti * 16, ks * 32, lane), a);
            const int i = ti * 16 + l15; float pv[4];
#pragma unroll
            for (int r = 0; r < 4; ++r) { const int j = tj * 16 + 4 * q4 + r; pv[r] = (i >= j) ? a[r] : 0.f; }
            u32x2 w2; w2.x = pk2(pv[0], pv[1]); w2.y = pk2(pv[2], pv[3]);
            *(u32x2*)((bf16*)(F.ws + WS_LAT) + (item * 64 + i) * 64 + tj * 16 + 4 * q4) = w2; }
        { bf16* qg = (bf16*)(F.ws + WS_LQS) + item * 8192; bf16* kg = (bf16*)(F.ws + WS_LKS) + item * 8192;
#pragma unroll
          for (int k = 0; k < 2; ++k) { const int e = F.tid + 512 * k;
              { const int row = e >> 4, pc = e & 15; *(u32x4*)(qg + row * 128 + pc * 8) = *(const LAS u32x4*)(QS + row * LDQ + pc * 8); }
              { const int row = e >> 3, pc = e & 7; *(u32x4*)(kg + row * 64 + pc * 8) = *(const LAS u32x4*)(KST + row * LDT + pc * 8);
                if (d == 0) *(u32x4*)((bf16*)(F.ws + WS_LVT) + ((size_t)h * 128 + row) * NROWS + r0 + pc * 8) = *(const LAS u32x4*)(VT + row * LDT + pc * 8); } } }
        }
    }
  }
#undef GLA_PRE
}

#define GLA_SETB 64000
DI void gla_scan_step(const Ctx& F, f32x4 (&S)[2][8], int set, int ci, int d, int len, int row0, int h, bf16* OUT) {
    const int wave = F.wave;
    int lane = F.lane; asm volatile("" : "+v"(lane)); const int l15 = lane & 15, q4 = lane >> 4;
    LAS unsigned char* base = F.lds + set * GLA_SETB;
    LAS bf16* QS = (LAS bf16*)base; LAS bf16* KST = (LAS bf16*)(base + 17408); LAS bf16* ATT = (LAS bf16*)(base + 35840); LAS bf16* VT = (LAS bf16*)(base + 45056); LAS float* GL = (LAS float*)(base + 63488);
#define LQ(dst, it) do { _Pragma("unroll") for (int i_ = 0; i_ < 4; ++i_) dst[i_] = frag_perm(QS, LDQ, (it) * 16, i_ * 32, lane); SCHED_FENCE(); } while (0)
#define LT(dst, M, t0) do { _Pragma("unroll") for (int i_ = 0; i_ < 4; ++i_) dst[i_] = frag_nat(M, LDT, ((t0) + (i_ >> 1)) * 16, (i_ & 1) * 32, lane); SCHED_FENCE(); } while (0)
#define CO(X, j) do { _Pragma("unroll") for (int ks = 0; ks < 4; ++ks) { o[0][j] = MFMA16(Sp[0][ks], X[ks], o[0][j]); o[1][j] = MFMA16(Sp[1][ks], X[ks], o[1][j]); } SCHED_FENCE(); } while (0)
#define CA(X, it0) do { _Pragma("unroll") for (int ks = 0; ks < 2; ++ks) _Pragma("unroll") for (int j = 0; j < 2; ++j) { o[0][j] = MFMA16(VF[0][ks], X[j * 2 + ks], o[0][j]); o[1][j] = MFMA16(VF[1][ks], X[j * 2 + ks], o[1][j]); } \
        _Pragma("unroll") for (int j = 0; j < 2; ++j) { const int i = ((it0) + j) * 16 + l15; const int tl = ci * 64 + i, t = d ? (len - 1 - tl) : tl; bf16* op = OUT + (size_t)(row0 + t) * 2048 + h * 128 + 32 * wave + 4 * q4; \
            u32x2 w2; w2.x = pk2(o[0][j][0], o[0][j][1]); w2.y = pk2(o[0][j][2], o[0][j][3]); *(u32x2*)op = w2; w2.x = pk2(o[1][j][0], o[1][j][1]); w2.y = pk2(o[1][j][2], o[1][j][3]); *(u32x2*)(op + 16) = w2; \
            o[0][j] = (f32x4){0.f, 0.f, 0.f, 0.f}; o[1][j] = (f32x4){0.f, 0.f, 0.f, 0.f}; } SCHED_FENCE(); } while (0)
#define CS(X, t0) do { _Pragma("unroll") for (int ks = 0; ks < 2; ++ks) _Pragma("unroll") for (int j = 0; j < 2; ++j) { S[0][(t0) + j] = MFMA16(X[j * 2 + ks], VF[0][ks], S[0][(t0) + j]); S[1][(t0) + j] = MFMA16(X[j * 2 + ks], VF[1][ks], S[1][(t0) + j]); } SCHED_FENCE(); } while (0)
    bf16x8 X0[4], X1[4], X2[4];
    bf16x8 VF[2][2];
#pragma unroll
    for (int x = 0; x < 2; ++x)
#pragma unroll
        for (int ks = 0; ks < 2; ++ks) VF[x][ks] = frag_nat(VT, LDT, 16 * (2 * wave + x), ks * 32, lane);
    LQ(X0, 0); LQ(X1, 1);
    bf16x8 Sp[2][4];
#pragma unroll
    for (int x = 0; x < 2; ++x)
#pragma unroll
        for (int ks = 0; ks < 4; ++ks) Sp[x][ks] = pack2(S[x][2 * ks], S[x][2 * ks + 1]);
    f32x4 o[2][2];
#pragma unroll
    for (int x = 0; x < 2; ++x)
#pragma unroll
        for (int j = 0; j < 2; ++j) o[x][j] = (f32x4){0.f, 0.f, 0.f, 0.f};
    SCHED_FENCE();
    LT(X2, ATT, 0); CO(X0, 0);
    LQ(X0, 2); CO(X1, 1);
    LQ(X1, 3); CA(X2, 0);
    LT(X2, ATT, 2); CO(X0, 0);
    LT(X0, KST, 0); CO(X1, 1);
    LT(X1, KST, 2); CA(X2, 2);
    LT(X2, KST, 4); CS(X0, 0);
    LT(X0, KST, 6); CS(X1, 2);
    CS(X2, 4); CS(X0, 6);
#pragma unroll
    for (int t = 0; t < 8; ++t) { const f32x4 gl = *(const LAS f32x4*)(GL + 16 * t + 4 * q4);
#pragma unroll
        for (int r = 0; r < 4; ++r) { const float eg = __expf(gl[r]); S[0][t][r] *= eg; S[1][t][r] *= eg; } }
#undef LQ
#undef LT
#undef CO
#undef CA
#undef CS
}
DI void gla_scan_item(const Ctx& F, const float* const* in, int s, int h, int d) {
    constexpr int SETB = GLA_SETB;
    const int row0 = seq_row0(s), len = seq_len(s), nch = len >> 6, c640 = row0 >> 6;
    const int lane_o = F.lane, wave = F.wave;
    bf16* OUT = (bf16*)(F.ws + (d ? WS_OBA : WS_OFA));
    const bf16* LQS = (const bf16*)(F.ws + WS_LQS); const bf16* LKS = (const bf16*)(F.ws + WS_LKS); const bf16* LAT = (const bf16*)(F.ws + WS_LAT);
    const bf16* LVT = (const bf16*)(F.ws + WS_LVT) + (size_t)h * 128 * NROWS; const float* LGL = (const float*)(F.ws + WS_LGL);
    LDSBAR();
    if (wave >= 4) {
        struct Pre { u32x4 q[4], k[4], a[2], v[4]; float g; };
        Pre PA, PB_;
        const int e = F.tid - 256, er = e >> 2, eq = e & 3;
#define REV8(w_) ((u32x4){((w_).w >> 16) | ((w_).w << 16), ((w_).z >> 16) | ((w_).z << 16), ((w_).y >> 16) | ((w_).y << 16), ((w_).x >> 16) | ((w_).x << 16)})
#define GLA_ISSUE(ci_, P_) do { const int cc = c640 + (d ? nch - 1 - (ci_) : (ci_)); const size_t item = ((size_t)cc * 16 + h) * 2 + d; \
        const u32x4* qsrc = (const u32x4*)(LQS + item * 8192 + er * 128 + eq * 32); _Pragma("unroll") for (int m_ = 0; m_ < 4; ++m_) P_.q[m_] = qsrc[m_]; \
        const u32x4* k0src = (const u32x4*)(LKS + item * 8192 + er * 64 + eq * 16); const u32x4* k1src = (const u32x4*)(LKS + item * 8192 + (64 + er) * 64 + eq * 16); \
        P_.k[0] = k0src[0]; P_.k[1] = k0src[1]; P_.k[2] = k1src[0]; P_.k[3] = k1src[1]; \
        const u32x4* asrc = (const u32x4*)(LAT + item * 4096 + er * 64 + eq * 16); P_.a[0] = asrc[0]; P_.a[1] = asrc[1]; \
        const u32x4* v0src = (const u32x4*)(LVT + (size_t)er * NROWS + cc * 64 + eq * 16); const u32x4* v1src = (const u32x4*)(LVT + (size_t)(64 + er) * NROWS + cc * 64 + eq * 16); \
        P_.v[0] = v0src[0]; P_.v[1] = v0src[1]; P_.v[2] = v1src[0]; P_.v[3] = v1src[1]; \
        P_.g = 0.f; if (e < 128) P_.g = LGL[item * 128 + e]; } while (0)
#define GLA_COMMIT(set_, P_) do { LAS unsigned char* base = F.lds + (set_) * SETB; \
        _Pragma("unroll") for (int m_ = 0; m_ < 4; ++m_) *(LAS u32x4*)((LAS bf16*)base + er * LDQ + eq * 32 + m_ * 8) = P_.q[m_]; \
        *(LAS u32x4*)((LAS bf16*)(base + 17408) + er * LDT + eq * 16) = P_.k[0]; *(LAS u32x4*)((LAS bf16*)(base + 17408) + er * LDT + eq * 16 + 8) = P_.k[1]; \
        *(LAS u32x4*)((LAS bf16*)(base + 17408) + (64 + er) * LDT + eq * 16) = P_.k[2]; *(LAS u32x4*)((LAS bf16*)(base + 17408) + (64 + er) * LDT + eq * 16 + 8) = P_.k[3]; \
        *(LAS u32x4*)((LAS bf16*)(base + 35840) + er * LDT + eq * 16) = P_.a[0]; *(LAS u32x4*)((LAS bf16*)(base + 35840) + er * LDT + eq * 16 + 8) = P_.a[1]; \
        if (d == 0) { *(LAS u32x4*)((LAS bf16*)(base + 45056) + er * LDT + eq * 16) = P_.v[0]; *(LAS u32x4*)((LAS bf16*)(base + 45056) + er * LDT + eq * 16 + 8) = P_.v[1]; \
            *(LAS u32x4*)((LAS bf16*)(base + 45056) + (64 + er) * LDT + eq * 16) = P_.v[2]; *(LAS u32x4*)((LAS bf16*)(base + 45056) + (64 + er) * LDT + eq * 16 + 8) = P_.v[3]; } \
        else { *(LAS u32x4*)((LAS bf16*)(base + 45056) + er * LDT + (3 - eq) * 16 + 8) = REV8(P_.v[0]); *(LAS u32x4*)((LAS bf16*)(base + 45056) + er * LDT + (3 - eq) * 16) = REV8(P_.v[1]); \
            *(LAS u32x4*)((LAS bf16*)(base + 45056) + (64 + er) * LDT + (3 - eq) * 16 + 8) = REV8(P_.v[2]); *(LAS u32x4*)((LAS bf16*)(base + 45056) + (64 + er) * LDT + (3 - eq) * 16) = REV8(P_.v[3]); } \
        if (e < 128) ((LAS float*)(base + 63488))[e] = P_.g; } while (0)
        GLA_ISSUE(0, PA); GLA_ISSUE(1, PB_);
#pragma unroll 1
        for (int ci = 0; ci < nch; ci += 2) {
            GLA_COMMIT(0, PA); LDSBAR(); if (ci + 2 < nch) GLA_ISSUE(ci + 2, PA);
            GLA_COMMIT(1, PB_); LDSBAR(); if (ci + 3 < nch) GLA_ISSUE(ci + 3, PB_); }
#undef GLA_ISSUE
#undef GLA_COMMIT
#undef REV8
    } else {
        f32x4 S[2][8];
        if (s >= 16) { int ln = lane_o; asm volatile("" : "+v"(ln)); const int l15 = ln & 15, q4 = ln >> 4; const float* sp = in[4] + ((size_t)((s - 16) * 2 + d) * 16 + h) * 16384;
#pragma unroll
            for (int x = 0; x < 2; ++x)
#pragma unroll
                for (int t = 0; t < 8; ++t)
#pragma unroll
                    for (int r = 0; r < 4; ++r) S[x][t][r] = sp[(size_t)(16 * t + 4 * q4 + r) * 128 + 32 * wave + 16 * x + l15];
        } else {
#pragma unroll
            for (int x = 0; x < 2; ++x)
#pragma unroll
                for (int t = 0; t < 8; ++t) S[x][t] = (f32x4){0.f, 0.f, 0.f, 0.f}; }
#pragma unroll 1
        for (int ci = 0; ci < nch; ci += 2) { LDSBAR(); gla_scan_step(F, S, 0, ci, d, len, row0, h, OUT); LDSBAR(); gla_scan_step(F, S, 1, ci + 1, d, len, row0, h, OUT); }
        if (s < 16) { int ln = lane_o; asm volatile("" : "+v"(ln)); const int l15 = ln & 15, q4 = ln >> 4; float* sp = F.out + OUT_SH + ((size_t)(s * 2 + d) * 16 + h) * 16384;
#pragma unroll
            for (int x = 0; x < 2; ++x)
#pragma unroll
                for (int t = 0; t < 8; ++t)
#pragma unroll
                    for (int r = 0; r < 4; ++r) sp[(size_t)(16 * t + 4 * q4 + r) * 128 + 32 * wave + 16 * x + l15] = S[x][t][r]; }
    }
}

struct M1aRaw { u32x4 a[2], b[2], m[2], p[2]; };
DI void m1a_load(const Ctx& F, int item, M1aRaw& R) {
    const int tt = item >> 5, cb = item & 31, r0 = tt * 64, c0 = cb * 256;
    const bf16* U = (const bf16*)(F.ws + WS_U);
    const int cg = F.lane & 31;
    const int len = r0 < 4096 ? 256 : 4096, tbase = r0 < 4096 ? (r0 & 255) : ((r0 - 4096) & 4095);
    const int col = c0 + cg * 8;
#pragma unroll
    for (int itk = 0; itk < 2; ++itk) { const int tp = itk * 16 + F.wave * 2 + (F.lane >> 5);
        const int tl = 2 * tp, t = tbase + tl; const bf16* ur = U + (size_t)(r0 + tl) * IN_ODD + col;
        R.a[itk] = *(const u32x4*)ur; R.b[itk] = *(const u32x4*)(ur + IN_ODD);
        R.m[itk] = (u32x4){0u, 0u, 0u, 0u}; R.p[itk] = (u32x4){0u, 0u, 0u, 0u};
        if (col < 6144) { if (t > 0) R.m[itk] = *(const u32x4*)(ur - IN_ODD); if (t + 2 < len) R.p[itk] = *(const u32x4*)(ur + 2 * IN_ODD); } }
}
DI void m1a_item(const Ctx& F, const float* const* in, int item, M1aRaw& R, int next_item) {
    LAS unsigned* T = (LAS unsigned*)F.lds;
    const int tt = item >> 5, cb = item & 31, r0 = tt * 64, c0 = cb * 256;
    bf16* TB = (bf16*)(F.ws + WS_TB);
    const int cg = F.lane & 31;
    const int col = c0 + cg * 8;
#pragma unroll
    for (int itk = 0; itk < 2; ++itk) { const int tp = itk * 16 + F.wave * 2 + (F.lane >> 5);
        float xa[8], xb[8], oa[8], ob[8]; unpack8(R.a[itk], xa); unpack8(R.b[itk], xb);
        if (col < 6144) { float xm[8], xp[8]; unpack8(R.m[itk], xm); unpack8(R.p[itk], xp);
            const float* cw = in[23] + col;
#pragma unroll
            for (int e = 0; e < 8; ++e) { oa[e] = cw[e] * xm[e] + cw[6144 + e] * xa[e] + cw[12288 + e] * xb[e]; ob[e] = cw[e] * xa[e] + cw[6144 + e] * xb[e] + cw[12288 + e] * xp[e]; }
        } else {
#pragma unroll
            for (int e = 0; e < 8; ++e) { oa[e] = siluf_(xa[e]); ob[e] = siluf_(xb[e]); } }
#pragma unroll
        for (int e = 0; e < 8; ++e) T[(e * 32 + cg) * 33 + tp] = pk2(oa[e], ob[e]); }
    if (next_item >= 0) m1a_load(F, next_item, R);
    LDSBAR();
#pragma unroll
    for (int k = 0; k < 4; ++k) { const int e = F.tid + 512 * k, part = e & 7, chi = e >> 3;
        const int ch = (chi & 31) * 8 + (chi >> 5);
        const LAS unsigned* sp = T + chi * 33 + part * 4;
        u32x4 w; w.x = sp[0]; w.y = sp[1]; w.z = sp[2]; w.w = sp[3];
        *(u32x4*)(TB + (size_t)(c0 + ch) * NROWS + r0 + part * 8) = w; }
    LDSBAR();
}

DI f32x2 w16(int k) {
    switch (k & 7) {
        case 0: return (f32x2){1.0f, 0.0f};
        case 1: return (f32x2){0.9238795325112867f, -0.3826834323650898f};
        case 2: return (f32x2){0.7071067811865476f, -0.7071067811865476f};
        case 3: return (f32x2){0.3826834323650898f, -0.9238795325112867f};
        case 4: return (f32x2){0.0f, -1.0f};
        case 5: return (f32x2){-0.3826834323650898f, -0.9238795325112867f};
        case 6: return (f32x2){-0.7071067811865476f, -0.7071067811865476f};
        default: return (f32x2){-0.9238795325112867f, -0.3826834323650898f};
    }
}
DI f32x2 cmul(f32x2 a, f32x2 b) { return (f32x2){a[0] * b[0] - a[1] * b[1], a[0] * b[1] + a[1] * b[0]}; }
DI f32x2 cmulc(f32x2 a, f32x2 b) { return (f32x2){a[0] * b[0] + a[1] * b[1], a[1] * b[0] - a[0] * b[1]}; }
template <int LOGR, bool INV, bool UNIT = false> DI void fft_bfly(f32x2 (&x)[1 << LOGR], f32x2 w0) {
    constexpr int R = 1 << LOGR;
    f32x2 wj[LOGR];
    wj[0] = w0;
#pragma unroll
    for (int s = 1; s < LOGR; ++s) wj[s] = cmul(wj[s - 1], wj[s - 1]);
#pragma unroll
    for (int ss = 0; ss < LOGR; ++ss) { const int s = INV ? (LOGR - 1 - ss) : ss; const int hm = R >> (s + 1);
#pragma unroll
        for (int m = 0; m < R; ++m) { if (m & hm) continue; const int mm = m % hm;
            const int k16 = mm * (16 >> (LOGR - s));
            if (UNIT && k16 == 0) { const f32x2 a = x[m], b = x[m + hm]; x[m] = a + b; x[m + hm] = a - b; continue; }
            if (UNIT && k16 == 4) {
                if (!INV) { const f32x2 a = x[m], b = x[m + hm], d = a - b; x[m] = a + b; x[m + hm] = (f32x2){d[1], -d[0]}; }
                else { const f32x2 a = x[m], bb = x[m + hm], b = (f32x2){-bb[1], bb[0]}; x[m] = a + b; x[m + hm] = a - b; }
                continue; }
            f32x2 w;
            if (UNIT) w = w16(k16);
            else if (k16 == 0) w = wj[s];
            else if (k16 == 4) w = (f32x2){wj[s][1], -wj[s][0]};
            else w = cmul(wj[s], w16(k16));
            if (!INV) { const f32x2 a = x[m], b = x[m + hm]; x[m] = a + b; x[m + hm] = cmul(a - b, w); }
            else { const f32x2 a = x[m], b = cmulc(x[m + hm], w); x[m] = a + b; x[m + hm] = a - b; } } }
}
template <int LOGR, bool INV, int PADSH> DI void fft_group(LAS f32x2* buf, const LAS f32x2* TW, int B, int tws, int g) {
    constexpr int R = 1 << LOGR;
    const int stride = B >> LOGR, blk = g / stride, j = g - blk * stride;
    const int base = blk * B + j;
    LAS f32x2* p = buf + base + (base >> PADSH);
    const int pstride = stride >= (1 << PADSH) ? stride + (stride >> PADSH) : stride;
    f32x2 x[R];
#pragma unroll
    for (int m = 0; m < R; ++m) x[m] = p[m * pstride];
    fft_bfly<LOGR, INV>(x, TW[j * tws]);
#pragma unroll
    for (int m = 0; m < R; ++m) p[m * pstride] = x[m];
}
template <int LOGR, bool INV, int PADSH> DI void fft_group2(LAS f32x2* buf, const LAS f32x2* TW, int B, int tws, int g0, int g1) {
    constexpr int R = 1 << LOGR;
    const int stride = B >> LOGR, pstride = stride >= (1 << PADSH) ? stride + (stride >> PADSH) : stride;
    const int blk0 = g0 / stride, j0 = g0 - blk0 * stride, base0 = blk0 * B + j0;
    const int blk1 = g1 / stride, j1 = g1 - blk1 * stride, base1 = blk1 * B + j1;
    LAS f32x2* p0 = buf + base0 + (base0 >> PADSH); LAS f32x2* p1 = buf + base1 + (base1 >> PADSH);
    f32x2 xa[R], xb[R];
#pragma unroll
    for (int m = 0; m < R; ++m) xa[m] = p0[m * pstride];
#pragma unroll
    for (int m = 0; m < R; ++m) xb[m] = p1[m * pstride];
    const f32x2 wa = TW[j0 * tws], wb = TW[j1 * tws];
    SCHED_FENCE();
    fft_bfly<LOGR, INV>(xa, wa);
#pragma unroll
    for (int m = 0; m < R; ++m) p0[m * pstride] = xa[m];
    fft_bfly<LOGR, INV>(xb, wb);
#pragma unroll
    for (int m = 0; m < R; ++m) p1[m * pstride] = xb[m];
}
template <int PADSH> DI void fft_first8(LAS f32x2* buf, f32x2 w0, int N, int j, f32x2 i0, f32x2 i1, f32x2 i2, f32x2 i3) {
    const int stride = N >> 3, pstride = stride + (stride >> PADSH);
    f32x2 x[8] = {i0, i1, i2, i3, (f32x2){0.f, 0.f}, (f32x2){0.f, 0.f}, (f32x2){0.f, 0.f}, (f32x2){0.f, 0.f}};
    fft_bfly<3, false>(x, w0);
    LAS f32x2* p = buf + j + (j >> PADSH);
#pragma unroll
    for (int m = 0; m < 8; ++m) p[m * pstride] = x[m];
}
template <int PADSH> DI void fft_last8(const LAS f32x2* buf, f32x2 w0, int N, int j, f32x2& o0, f32x2& o1, f32x2& o2, f32x2& o3) {
    const int stride = N >> 3, pstride = stride + (stride >> PADSH);
    const LAS f32x2* p = buf + j + (j >> PADSH);
    f32x2 x[8];
#pragma unroll
    for (int m = 0; m < 8; ++m) x[m] = p[m * pstride];
    fft_bfly<3, true>(x, w0);
    o0 = x[0]; o1 = x[1]; o2 = x[2]; o3 = x[3];
}
#define PD4(i_) ((i_) + ((i_) >> 4))
#define PD3(i_) ((i_) + ((i_) >> 3))
template <bool INV> DI void fft8192(LAS f32x2* buf, const LAS f32x2* TW, int tid) {
    if (!INV) {
        fft_group2<3, false, 4>(buf, TW, 8192, 1, tid, tid + 512); LDSBAR();
        fft_group2<3, false, 4>(buf, TW, 1024, 8, tid, tid + 512); LDSBAR();
        fft_group2<3, false, 4>(buf, TW, 128, 64, tid, tid + 512); LDSBAR();
        fft_group<4, false, 4>(buf, TW, 16, 0, tid); LDSBAR();
    } else {
        fft_group<4, true, 4>(buf, TW, 16, 0, tid); LDSBAR();
        fft_group2<3, true, 4>(buf, TW, 128, 64, tid, tid + 512); LDSBAR();
        fft_group2<3, true, 4>(buf, TW, 1024, 8, tid, tid + 512); LDSBAR();
        fft_group2<3, true, 4>(buf, TW, 8192, 1, tid, tid + 512); LDSBAR();
    }
}
#define WSYNC() asm volatile("s_waitcnt lgkmcnt(0)" ::: "memory")
template <bool INV> DI void fft512(LAS f32x2* buf, const LAS f32x2* TW, int lane) {
    if (!INV) { fft_group<3, false, 3>(buf, TW, 512, 16, lane); WSYNC(); fft_group<3, false, 3>(buf, TW, 64, 128, lane); WSYNC(); fft_group<3, false, 3>(buf, TW, 8, 0, lane); WSYNC(); }
    else { fft_group<3, true, 3>(buf, TW, 8, 0, lane); WSYNC(); fft_group<3, true, 3>(buf, TW, 64, 128, lane); WSYNC(); fft_group<3, true, 3>(buf, TW, 512, 16, lane); WSYNC(); }
}
constexpr int LDS_TW = 139264;
DI void fft_table_init(const Ctx& F) { LAS f32x2* TW = (LAS f32x2*)(F.lds + LDS_TW);
    for (int j = F.tid; j < 1024; j += 512) { float sn, cs; sincospif(-2.0f * (float)j / 8192.0f, &sn, &cs); TW[j] = (f32x2){cs, sn}; }
    LDSBAR(); }
DI f32x2 filt_spec(f32x2 z1, f32x2 z2, int ord) { const float sg = ord ? -0.5f : 0.5f; const float ar = 0.5f * z1[0] + sg * z2[0], ai = 0.5f * z1[1] - sg * z2[1];
    return ord ? (f32x2){ai, -ar} : (f32x2){ar, ai}; }

template <int LOGR, int PADSH, int LOGN> DI void fft_mid(LAS f32x2* D, const LAS f32x2* HZ, int ord, int g) {
    constexpr int R = 1 << LOGR, N = 1 << LOGN;
    LAS f32x2* p = D + g * R + ((g * R) >> PADSH);
    f32x2 x[R];
#pragma unroll
    for (int m = 0; m < R; ++m) x[m] = p[m];
    fft_bfly<LOGR, false, true>(x, (f32x2){1.f, 0.f});
#pragma unroll
    for (int m = 0; m < R; ++m) { const int t = g * R + m; const int fq = (int)(__brev((unsigned)t) >> (32 - LOGN)), t2 = (int)(__brev((unsigned)((N - fq) & (N - 1))) >> (32 - LOGN));
        x[m] = cmul(x[m], filt_spec(HZ[t + (t >> PADSH)], HZ[t2 + (t2 >> PADSH)], ord)) * (1.0f / (float)N); }
    fft_bfly<LOGR, true, true>(x, (f32x2){1.f, 0.f});
#pragma unroll
    for (int m = 0; m < R; ++m) p[m] = x[m];
}
DI void hyena_dec_item(const Ctx& F, const float* const* in, int c) {
    LAS f32x2* HB = (LAS f32x2*)F.lds;
    LAS f32x2* DB = HB + 8704;
    const LAS f32x2* TW = (const LAS f32x2*)(F.lds + LDS_TW);
    const bf16* TB = (const bf16*)(F.ws + WS_TB); bf16* YT = (bf16*)(F.ws + WS_YT);
    const float* HF = (const float*)(F.ws + WS_HF4096); const float* HN = (const float*)(F.ws + WS_HNRM) + 4096;
    const int tid_o = F.tid;
    float va[8], vb[8];
#pragma unroll
    for (int k = 0; k < 8; ++k) { const int t = tid_o + 512 * k; va[k] = bf2f(TB[(size_t)c * NROWS + 4096 + t]); vb[k] = bf2f(TB[(size_t)c * NROWS + 8192 + t]); }
    { const float n0 = HN[c], n1 = HN[2048 + c]; const float* h0 = HF + (size_t)c * 8192; const float* h1 = HF + ((size_t)2048 + c) * 8192;
#pragma unroll 8
      for (int k = 0; k < 16; ++k) { const int t = tid_o + 512 * k; HB[PD4(t)] = (f32x2){h0[t] * n0, h1[t] * n1}; } }
    LDSBAR();
    fft8192<false>(HB, TW, tid_o);
#pragma unroll 1
    for (int ord = 0; ord < 2; ++ord) {
        int tid = tid_o; asm volatile("" : "+v"(tid));
        const size_t xoff = (size_t)((ord + 1) * 2048 + c) * NROWS, zoff = (size_t)(6144 + c) * NROWS;
        bf16 rxa[8], rxb[8], rza[8], rzb[8];
#pragma unroll
        for (int k = 0; k < 8; ++k) { const int t = tid + 512 * k; rxa[k] = TB[xoff + 4096 + t]; rxb[k] = TB[xoff + 8192 + t];
            if (ord == 1) { rza[k] = TB[zoff + 4096 + t]; rzb[k] = TB[zoff + 8192 + t]; } else { rza[k] = 0; rzb[k] = 0; } }
        fft_first8<4>(DB, TW[tid], 8192, tid, (f32x2){va[0], vb[0]}, (f32x2){va[2], vb[2]}, (f32x2){va[4], vb[4]}, (f32x2){va[6], vb[6]});
        fft_first8<4>(DB, TW[tid + 512], 8192, tid + 512, (f32x2){va[1], vb[1]}, (f32x2){va[3], vb[3]}, (f32x2){va[5], vb[5]}, (f32x2){va[7], vb[7]});
        LDSBAR();
        fft_group2<3, false, 4>(DB, TW, 1024, 8, tid, tid + 512); LDSBAR();
        fft_group2<3, false, 4>(DB, TW, 128, 64, tid, tid + 512); LDSBAR();
        fft_mid<4, 4, 13>(DB, HB, ord, tid); LDSBAR();
        fft_group2<3, true, 4>(DB, TW, 128, 64, tid, tid + 512); LDSBAR();
        fft_group2<3, true, 4>(DB, TW, 1024, 8, tid, tid + 512); LDSBAR();
        f32x2 y[8];
        fft_last8<4>(DB, TW[tid], 8192, tid, y[0], y[2], y[4], y[6]);
        fft_last8<4>(DB, TW[tid + 512], 8192, tid + 512, y[1], y[3], y[5], y[7]);
        const float bias = in[30][ord * 2048 + c];
#pragma unroll
        for (int k = 0; k < 8; ++k) { const int t = tid + 512 * k;
            va[k] = bf2f(rxa[k]) * (y[k][0] + bias * va[k]); vb[k] = bf2f(rxb[k]) * (y[k][1] + bias * vb[k]);
            if (ord == 1) { YT[(size_t)c * NROWS + 4096 + t] = f2bf(va[k] * bf2f(rza[k])); YT[(size_t)c * NROWS + 8192 + t] = f2bf(vb[k] * bf2f(rzb[k])); } }
    }
    LDSBAR();
}
DI void hyena_ctx_item(const Ctx& F, const float* const* in, int c, int p0) {
    LAS f32x2* HZ = (LAS f32x2*)F.lds + F.wave * 1152;
    LAS f32x2* D = HZ + 576;
    const LAS f32x2* TW = (const LAS f32x2*)(F.lds + LDS_TW);
    const bf16* TB = (const bf16*)(F.ws + WS_TB); bf16* YT = (bf16*)(F.ws + WS_YT);
    const float* HF = (const float*)(F.ws + WS_HF256); const float* HN = (const float*)(F.ws + WS_HNRM);
    const int lane = F.lane;
    { const float n0 = HN[c], n1 = HN[2048 + c]; const float* h0 = HF + (size_t)c * 512; const float* h1 = HF + ((size_t)2048 + c) * 512;
#pragma unroll
      for (int k = 0; k < 8; ++k) { const int t = lane + 64 * k; HZ[PD3(t)] = (f32x2){h0[t] * n0, h1[t] * n1}; } }
    WSYNC();
    fft512<false>(HZ, TW, lane);
#pragma unroll 1
    for (int pp = p0; pp < p0 + 4; ++pp) { const int ra = (2 * pp) * 256, rb = (2 * pp + 1) * 256;
    float va[4], vb[4];
#pragma unroll
    for (int k = 0; k < 4; ++k) { const int t = lane + 64 * k; va[k] = bf2f(TB[(size_t)c * NROWS + ra + t]); vb[k] = bf2f(TB[(size_t)c * NROWS + rb + t]); }
#pragma unroll 1
    for (int ord = 0; ord < 2; ++ord) {
        const size_t xoff = (size_t)((ord + 1) * 2048 + c) * NROWS, zoff = (size_t)(6144 + c) * NROWS;
        bf16 rxa[4], rxb[4], rza[4], rzb[4];
#pragma unroll
        for (int k = 0; k < 4; ++k) { const int t = lane + 64 * k; rxa[k] = TB[xoff + ra + t]; rxb[k] = TB[xoff + rb + t];
            if (ord == 1) { rza[k] = TB[zoff + ra + t]; rzb[k] = TB[zoff + rb + t]; } else { rza[k] = 0; rzb[k] = 0; } }
        fft_first8<3>(D, TW[lane * 16], 512, lane, (f32x2){va[0], vb[0]}, (f32x2){va[1], vb[1]}, (f32x2){va[2], vb[2]}, (f32x2){va[3], vb[3]}); WSYNC();
        fft_group<3, false, 3>(D, TW, 64, 128, lane); WSYNC();
        fft_mid<3, 3, 9>(D, HZ, ord, lane); WSYNC();
        fft_group<3, true, 3>(D, TW, 64, 128, lane); WSYNC();
        f32x2 y[4];
        fft_last8<3>(D, TW[lane * 16], 512, lane, y[0], y[1], y[2], y[3]);
        const float bias = in[30][ord * 2048 + c];
#pragma unroll
        for (int k = 0; k < 4; ++k) { const int t = lane + 64 * k;
            va[k] = bf2f(rxa[k]) * (y[k][0] + bias * va[k]); vb[k] = bf2f(rxb[k]) * (y[k][1] + bias * vb[k]);
            if (ord == 1) { YT[(size_t)c * NROWS + ra + t] = f2bf(va[k] * bf2f(rza[k])); YT[(size_t)c * NROWS + rb + t] = f2bf(vb[k] * bf2f(rzb[k])); } }
        WSYNC();
    }
    }
}
DI void phase_m1a(const Ctx& F, const float* const* in) {
    { M1aRaw R; int it = F.bid; if (it < 192 * 32) m1a_load(F, it, R);
#pragma unroll 1
      for (; it < 192 * 32; it += F.G) m1a_item(F, in, it, R, it + F.G < 192 * 32 ? it + F.G : -1); }
    gla_prep_all(F, in);
}
DI void phase_m1b(const Ctx& F, const float* const* in, int pass = 0) {
    const int b = F.bid; unsigned* ctl = (unsigned*)(F.ws + WS_CTL) + pass * 1024;
    fft_table_init(F);
#ifndef P11_ONLY
#define P11_ONLY 0
#endif
    const int only = pass ? P11_ONLY : 0;
    if (b < 64 && (only == 0 || only == 1)) gla_scan_item(F, in, 16 + (b >> 5), (b >> 1) & 15, b & 1);
    if (only == 0 || only == 2) for (;;) { const int it = queue_grab(F, ctl + CW_Q0, 1); if (it >= 2048) break; hyena_dec_item(F, in, it); }
    if (only == 0 || only == 3) for (;;) { const int it = queue_grab(F, ctl + CW_Q1, 1); if (it >= 512) break; gla_scan_item(F, in, it >> 5, (it >> 1) & 15, it & 1); }
    if (only == 0 || only == 4) for (;;) { const int g = queue_grab(F, ctl + CW_Q2, 1); if (g >= 512) break;
        hyena_ctx_item(F, in, (g >> 1) * 8 + F.wave, (g & 1) * 4); }
}
DI void phase_m1c(const Ctx& F, const float* const* in) {
    const int gw = F.bid * 8 + F.wave, NGW = F.G * 8, lane = F.lane;
    const bf16* U = (const bf16*)(F.ws + WS_U); bf16* MIX = (bf16*)(F.ws + WS_MIX);
    const bf16 *OFA = (const bf16*)(F.ws + WS_OFA), *OBA = (const bf16*)(F.ws + WS_OBA);
    const int hsub = lane >> 4, c8 = (lane & 15) * 8;
    const f32x4 gn0 = *(const f32x4*)(in[32] + c8), gn1 = *(const f32x4*)(in[32] + c8 + 4);
    for (int row = gw; row < NROWS; row += NGW) { const bf16* ur = U + (size_t)row * IN_ODD;
        u32x4 af[4], ab[4], az[4];
#pragma unroll
        for (int hq = 0; hq < 4; ++hq) { const size_t o = (size_t)row * 2048 + (hq * 4 + hsub) * 128 + c8;
            af[hq] = *(const u32x4*)(OFA + o); ab[hq] = *(const u32x4*)(OBA + o); az[hq] = *(const u32x4*)(ur + O_ZD + (hq * 4 + hsub) * 128 + c8); }
#pragma unroll
        for (int hq = 0; hq < 4; ++hq) { float x[8], y[8], z[8]; unpack8(af[hq], x); unpack8(ab[hq], y); unpack8(az[hq], z);
            float ss = 0.f;
#pragma unroll
            for (int e = 0; e < 8; ++e) { x[e] += y[e]; ss += x[e] * x[e]; }
            ss += __shfl_xor(ss, 1); ss += __shfl_xor(ss, 2); ss += __shfl_xor(ss, 4); ss += __shfl_xor(ss, 8);
            const float rn = __builtin_amdgcn_rsqf(ss * (1.0f / 128.0f) + EPS);
            u32x4 w; w.x = pk2(x[0] * rn * gn0[0] * siluf_(z[0]), x[1] * rn * gn0[1] * siluf_(z[1])); w.y = pk2(x[2] * rn * gn0[2] * siluf_(z[2]), x[3] * rn * gn0[3] * siluf_(z[3]));
            w.z = pk2(x[4] * rn * gn1[0] * siluf_(z[4]), x[5] * rn * gn1[1] * siluf_(z[5])); w.w = pk2(x[6] * rn * gn1[2] * siluf_(z[6]), x[7] * rn * gn1[3] * siluf_(z[7]));
            *(u32x4*)(MIX + (size_t)row * DM + 2048 + (hq * 4 + hsub) * 128 + c8) = w; } }
    const bf16* YT = (const bf16*)(F.ws + WS_YT);
    LAS bf16* T = (LAS bf16*)(F.lds + F.wave * 8448);
    for (int it = gw; it < 32 * 192; it += NGW) { const int cb = it & 31, rbk = it >> 5, c0 = cb * 64, r0 = rbk * 64;
#pragma unroll
        for (int k = 0; k < 8; ++k) { const int ch = 8 * k + (lane >> 3); const u32x4 w = *(const u32x4*)(YT + (size_t)(c0 + ch) * NROWS + r0 + (lane & 7) * 8);
            LAS bf16* dp = T + ch * 66 + (lane & 7) * 8;
            dp[0] = (bf16)(w.x & 0xffffu); dp[1] = (bf16)(w.x >> 16); dp[2] = (bf16)(w.y & 0xffffu); dp[3] = (bf16)(w.y >> 16); dp[4] = (bf16)(w.z & 0xffffu); dp[5] = (bf16)(w.z >> 16); dp[6] = (bf16)(w.w & 0xffffu); dp[7] = (bf16)(w.w >> 16); }
        asm volatile("s_waitcnt lgkmcnt(0)" ::: "memory");
#pragma unroll
        for (int k = 0; k < 8; ++k) { const int rr = 8 * k + (lane >> 3), cc = (lane & 7) * 8;
            u32x4 w; w.x = (unsigned)T[(cc + 0) * 66 + rr] | ((unsigned)T[(cc + 1) * 66 + rr] << 16); w.y = (unsigned)T[(cc + 2) * 66 + rr] | ((unsigned)T[(cc + 3) * 66 + rr] << 16);
            w.z = (unsigned)T[(cc + 4) * 66 + rr] | ((unsigned)T[(cc + 5) * 66 + rr] << 16); w.w = (unsigned)T[(cc + 6) * 66 + rr] | ((unsigned)T[(cc + 7) * 66 + rr] << 16);
            *(u32x4*)(MIX + (size_t)(r0 + rr) * DM + c0 + cc) = w; }
        asm volatile("s_waitcnt lgkmcnt(0)" ::: "memory"); }
}
constexpr int NWAVES = 8, NTHREADS = 512;
constexpr int LDS_BYTES = 163840;
constexpr int LDS_MISC = LDS_BYTES - 64;
constexpr int N_PHASES = 14;
struct Args { const float* in[33]; float* out; unsigned char* ws; int ph_lo, ph_hi; };

__global__ void __launch_bounds__(NTHREADS, 2) mk_fwd(Args args) {
    extern __shared__ __attribute__((aligned(16))) unsigned char lds_raw[];
    Ctx F;
    F.lds = (LAS unsigned char*)lds_raw; F.in = nullptr; F.ws = args.ws; F.out = args.out;
    F.tid = threadIdx.x; F.lane = F.tid & 63; F.wave = __builtin_amdgcn_readfirstlane(F.tid >> 6); F.bid = blockIdx.x; F.G = gridDim.x;
    const float* const* in = args.in;
    volatile LAS unsigned* xbw = (volatile LAS unsigned*)(F.lds + LDS_MISC);
    if (F.tid < 4) xbw[F.tid] = 0u;
    __syncthreads();
    unsigned* ctl = (unsigned*)(args.ws + WS_CTL);
    XcdBarrier bar = xcd_barrier_post(ctl + CW_BAR, xbw);
    const int lo = args.ph_lo, hi = args.ph_hi;
#ifndef PHASE_MASK
#define PHASE_MASK 0xffffffffu
#endif
#define IN(k) (((PHASE_MASK >> (k)) & 1u) && lo <= (k) && (k) < hi)
#define SEAM(k) do { if (IN(k) && IN((k) + 1)) xcd_barrier(bar); } while (0)
#ifndef DUP_MASK
#define DUP_MASK 0u
#endif
#define DUP(k) (((DUP_MASK >> (k)) & 1u) != 0u)
    if (IN(0)) { phase_p0(F, in); if (DUP(0)) { xcd_barrier(bar); phase_p0(F, in); } }
    SEAM(0);
    if (IN(1)) { phase_p0c(F, in); if (DUP(1)) { xcd_barrier(bar); phase_p0c(F, in); } }
    SEAM(1);
    if (IN(2)) { phase_norm<0>(F, in); if (DUP(2)) { xcd_barrier(bar); phase_norm<0>(F, in); } }
    SEAM(2);
    if (IN(3)) { pg8::Gemm g{(const pg8::bf16_t*)(F.ws + WS_H), (const pg8::bf16_t*)(F.ws + WS_WTE), NROWS, LD_EVEN, DM}; pg8::StaticOrder S; S.init(NROWS, LD_EVEN, F.G, F.bid);
        pg8::EpiStoreBf16 E{(pg8::bf16_t*)(F.ws + WS_U), LD_EVEN};
        pg8::gemm_phase<pg8::EpiStoreBf16, pg8::StaticOrder, true, true>(F.lds, g, S, E);
        if (DUP(3)) { xcd_barrier(bar); pg8::gemm_phase<pg8::EpiStoreBf16, pg8::StaticOrder, true, true>(F.lds, g, S, E); }
        { constexpr int NU = (NROWS / 256) * (LD_EVEN / 256); const int nfull = NU % F.G;
          if (nfull > 0 && F.bid >= nfull) { convert_wout(F, in, F.bid - nfull, F.G - nfull, 0); convert_wodd(F, in, F.bid - nfull, F.G - nfull); } else if (nfull == 0) { convert_wout(F, in, F.bid, F.G, 0); convert_wodd(F, in, F.bid, F.G); } } }
    SEAM(3);
    if (IN(4)) { phase_m0a(F, in); if (DUP(4)) { xcd_barrier(bar); phase_m0a(F, in); } }
    SEAM(4);
#ifndef P5_ONLY
#define P5_ONLY 0
#endif
    if (IN(5)) { phase_m0(F, in); if (DUP(5)) { xcd_barrier(bar); phase_m0(F, in, P5_ONLY); } }
    SEAM(5);
    if (IN(6)) { phase_m0c(F, in); if (DUP(6)) { xcd_barrier(bar); phase_m0c(F, in); } }
    SEAM(6);
    if (IN(7)) { pg8::Gemm g{(const pg8::bf16_t*)(F.ws + WS_MIX), (const pg8::bf16_t*)(F.ws + WS_WTOUT), NROWS, DM, DM}; pg8::StaticOrder S; S.init(NROWS, DM, F.G, F.bid);
        pg8::EpiResGateBf16 E{(pg8::bf16_t*)xr_base(F), LDX, (const float*)(F.ws + WS_MODF) + (size_t)6 * 4096};
        pg8::gemm_phase<pg8::EpiResGateBf16, pg8::StaticOrder, true, true>(F.lds, g, S, E); }
    SEAM(7);
    if (IN(8)) { phase_norm<1>(F, in); if (DUP(8)) { xcd_barrier(bar); phase_norm<1>(F, in); } }
    SEAM(8);
    if (IN(9)) { pg8::Gemm g{(const pg8::bf16_t*)(F.ws + WS_H), (const pg8::bf16_t*)(F.ws + WS_WTO), NROWS, IN_ODD, DM}; pg8::StaticOrder S; S.init(NROWS, IN_ODD, F.G, F.bid);
        pg8::EpiStoreBf16 E{(pg8::bf16_t*)(F.ws + WS_U), IN_ODD};
        pg8::gemm_phase<pg8::EpiStoreBf16, pg8::StaticOrder, true, true>(F.lds, g, S, E);
        if (DUP(9)) { xcd_barrier(bar); pg8::gemm_phase<pg8::EpiStoreBf16, pg8::StaticOrder, true, true>(F.lds, g, S, E); }
        { constexpr int NU = (NROWS / 256) * (IN_ODD / 256); const int nfull = NU % F.G;
          if (nfull > 0 && F.bid >= nfull) { phase_filters(F, in, F.bid - nfull, F.G - nfull); convert_wout(F, in, F.bid - nfull, F.G - nfull, 1); } else if (nfull == 0) { phase_filters(F, in, F.bid, F.G); convert_wout(F, in, F.bid, F.G, 1); } } }
    SEAM(9);
    if (IN(10)) { phase_m1a(F, in); if (DUP(10)) { xcd_barrier(bar); phase_m1a(F, in); } }
    SEAM(10);
    if (IN(11)) { phase_m1b(F, in); if (DUP(11)) { xcd_barrier(bar); phase_m1b(F, in, 1); } }
    SEAM(11);
    if (IN(12)) { phase_m1c(F, in); if (DUP(12)) { xcd_barrier(bar); phase_m1c(F, in); } }
    SEAM(12);
    if (IN(13)) { pg8::Gemm g{(const pg8::bf16_t*)(F.ws + WS_MIX), (const pg8::bf16_t*)(F.ws + WS_WTOUT) + (size_t)DM * DM, NROWS, DM, DM}; pg8::StaticOrder S; S.init(NROWS, DM, F.G, F.bid);
        pg8::EpiResGateBf16 E{(pg8::bf16_t*)xr_base(F), LDX, (const float*)(F.ws + WS_MODF) + (size_t)(9 + 6) * 4096};
        pg8::gemm_phase<pg8::EpiResGateBf16, pg8::StaticOrder, true, true>(F.lds, g, S, E); }
    SEAM(13);
    if (IN(14)) phase_norm<2>(F, in);
#ifdef DBG_DUMP
    xcd_barrier(bar);
#define DUMP_ONE(OOFF, ONEXT, PTR, NB, ISBF) do { const size_t no = (size_t)(ONEXT) - (size_t)(OOFF), nb = (NB); float* op = F.out + (OOFF); \
        for (size_t i = (size_t)F.bid * 512 + F.tid; i < no; i += (size_t)F.G * 512) { float acc = 0.f; \
            for (size_t j = i; j < nb; j += no) acc += (ISBF) ? bf2f(((const bf16*)(PTR))[j]) : ((const float*)(PTR))[j]; \
            op[i] = acc; } } while (0)
#if DBG_DUMP == 1
    DUMP_ONE(0, 16777216, F.ws + WS_H, (size_t)NROWS * DM, 1);
    DUMP_ONE(16777216, 50331648, F.ws + WS_U, (size_t)NROWS * LD_EVEN, 1);
    DUMP_ONE(50331648, 58720256, F.ws + WS_OFA, (size_t)2 * NROWS * 2048, 0);
    DUMP_ONE(58720256, 67108864, F.ws + WS_OFB, (size_t)2 * NROWS * 2048, 0);
    DUMP_ONE(67108864, 75497472, F.ws + WS_MIX, (size_t)NROWS * DM, 1);
#elif DBG_DUMP == 4
    DUMP_ONE(0, 16777216, F.ws + WS_OFA, (size_t)NROWS * 2048, 0);
    DUMP_ONE(16777216, 50331648, F.ws + WS_OBA, (size_t)NROWS * 2048, 0);
    DUMP_ONE(58720256, 67108864, F.ws + WS_H, (size_t)NROWS * DM, 1);
    DUMP_ONE(67108864, 75497472, F.ws + WS_H, (size_t)NROWS * DM, 1);
#elif DBG_DUMP == 7
    { unsigned fl = 0u; const float* pa = (const float*)(F.ws + WS_OFA); const float* pb = (const float*)(F.ws + WS_OBA); const float* ps = F.out + OUT_SG;
      for (size_t i = (size_t)F.bid * 512 + F.tid; i < (size_t)NROWS * 2048; i += (size_t)F.G * 512) { const size_t row = i >> 11; const float va = pa[i], vb = pb[i];
          if (!(fabsf(va) <= 3.0e38f)) { fl |= row < 4096 ? 1u : 2u; if (row >= 4096 && ((row - 4096) & 4095) < 64) fl |= 32u; }
          if (!(fabsf(vb) <= 3.0e38f)) fl |= row < 4096 ? 4u : 8u; }
      for (size_t i = (size_t)F.bid * 512 + F.tid; i < (size_t)8388608; i += (size_t)F.G * 512) { const float v = ps[i]; if (!(fabsf(v) <= 3.0e38f)) fl |= 16u; }
      if (fl) atomicOr(ctl + 64, fl); }
    xcd_barrier(bar);
    { const unsigned fl = __hip_atomic_load(ctl + 64, __ATOMIC_RELAXED, __HIP_MEMORY_SCOPE_AGENT);
      const unsigned d1 = 1u + (fl & 1u) + ((fl >> 1) & 1u) * 2u + ((fl >> 2) & 1u) * 4u, d2 = 1u + ((fl >> 3) & 1u) + ((fl >> 4) & 1u) * 2u + ((fl >> 5) & 1u) * 4u;
      const unsigned total = d1 * 1000000u + d2 * 100000u;
      for (size_t i = (size_t)F.bid * 512 + F.tid; i < (size_t)75497472; i += (size_t)F.G * 512) F.out[i] = (i < total) ? __uint_as_float(0xAAAAAAAAu) : 1.0f; }
#elif DBG_DUMP == 6
    { unsigned cnt = 0u; const float* pa = (const float*)(F.ws + WS_OFA); const float* ps = F.out + OUT_SG;
      for (size_t i = (size_t)F.bid * 512 + F.tid; i < (size_t)2 * NROWS * 2048; i += (size_t)F.G * 512) { const float v = pa[i]; if (!(fabsf(v) <= 3.0e38f)) ++cnt; }
      for (size_t i = (size_t)F.bid * 512 + F.tid; i < (size_t)8388608; i += (size_t)F.G * 512) { const float v = ps[i]; if (!(fabsf(v) <= 3.0e38f)) ++cnt; }
      if (cnt) atomicAdd(ctl + 64, cnt); }
    xcd_barrier(bar);
    { const unsigned total = __hip_atomic_load(ctl + 64, __ATOMIC_RELAXED, __HIP_MEMORY_SCOPE_AGENT);
      const float* pa = (const float*)(F.ws + WS_OFA);
      for (size_t i = (size_t)F.bid * 512 + F.tid; i < (size_t)75497472; i += (size_t)F.G * 512) {
          float v = 1.0f;
          if (i < 16777216) { if (i < total) v = __uint_as_float(0xAAAAAAAAu); }
          else if (i < 50331648) { const size_t k = i - 16777216; float a = pa[k]; if (!(fabsf(a) <= 3.0e38f)) a = 7.0f; v = a; }
          F.out[i] = v; } }
#elif DBG_DUMP == 5
    DUMP_ONE(0, 16777216, F.ws + WS_OFB, (size_t)NROWS * 2048, 0);
    DUMP_ONE(16777216, 50331648, F.ws + WS_OBB, (size_t)NROWS * 2048, 0);
    DUMP_ONE(50331648, 58720256, F.ws + WS_H, (size_t)NROWS * DM, 1);
    DUMP_ONE(67108864, 75497472, F.ws + WS_H, (size_t)NROWS * DM, 1);
#elif DBG_DUMP == 3
    DUMP_ONE(0, 16777216, F.ws + WS_H, (size_t)NROWS * DM, 1);
    DUMP_ONE(16777216, 50331648, F.ws + WS_U, (size_t)NROWS * LD_EVEN, 1);
    DUMP_ONE(50331648, 58720256, F.ws + WS_WTE, (size_t)LD_EVEN * DM, 1);
    DUMP_ONE(58720256, 67108864, F.ws + WS_MODF, (size_t)(1 * MiB + 512 * 1024) / 4, 0);
    DUMP_ONE(67108864, 75497472, F.ws + WS_HF256, (size_t)2 * 2048 * 512, 0);
#else
    DUMP_ONE(0, 16777216, F.ws + WS_H, (size_t)NROWS * DM, 1);
    DUMP_ONE(16777216, 50331648, F.ws + WS_U, (size_t)NROWS * IN_ODD, 1);
    DUMP_ONE(50331648, 58720256, F.ws + WS_TB, (size_t)8192 * NROWS, 1);
    DUMP_ONE(58720256, 67108864, F.ws + WS_OFA, (size_t)2 * NROWS * 2048, 0);
    DUMP_ONE(67108864, 75497472, F.ws + WS_YT, (size_t)2048 * NROWS, 1);
#endif
#endif
#undef IN
#undef SEAM
}

extern "C" void kernel_launch(void* const* d_in, const int* in_sizes, int n_in, void* d_out, int out_size, void* d_ws, size_t ws_size, hipStream_t stream) {
    static int grid = 0;
    if (grid == 0) {
        if (n_in != 33 || out_size != 75497472 || ws_size < WS_END2) { fprintf(stderr, "kernel_launch: unexpected problem (n_in %d, out %d, ws %zu)\n", n_in, out_size, ws_size); grid = -1; return; }
        int dev = 0, cus = 0, per_cu = 0;
        if (hipGetDevice(&dev) != hipSuccess || hipDeviceGetAttribute(&cus, hipDeviceAttributeMultiprocessorCount, dev) != hipSuccess) { grid = -1; return; }
        if (hipFuncSetAttribute((const void*)mk_fwd, hipFuncAttributeMaxDynamicSharedMemorySize, LDS_BYTES) != hipSuccess) { fprintf(stderr, "kernel_launch: hipFuncSetAttribute failed\n"); grid = -1; return; }
        if (hipOccupancyMaxActiveBlocksPerMultiprocessor(&per_cu, (const void*)mk_fwd, NTHREADS, LDS_BYTES) != hipSuccess || per_cu < 1) { fprintf(stderr, "kernel_launch: occupancy query says %d\n", per_cu); }
        (void)hipGetLastError();
        grid = cus;
        if (grid < 128) { grid = -1; return; }
    }
    if (grid < 0) return;
    (void)hipMemsetAsync((char*)d_ws + WS_CTL, 0, CTL_ZERO_BYTES, stream);
    Args a{};
    for (int i = 0; i < 33; ++i) a.in[i] = (const float*)d_in[i];
    a.out = (float*)d_out; a.ws = (unsigned char*)d_ws;
#ifndef MK_SPLIT
    a.ph_lo = 0; a.ph_hi = N_PHASES + 1;
#ifdef DBG_STOP
    a.ph_hi = DBG_STOP + 1;
#endif
    hipLaunchKernelGGL(mk_fwd, dim3(grid), dim3(NTHREADS), LDS_BYTES, stream, a);
#else
    for (int p = 0; p <= N_PHASES; ++p) { a.ph_lo = p; a.ph_hi = p + 1; hipLaunchKernelGGL(mk_fwd, dim3(grid), dim3(NTHREADS), LDS_BYTES, stream, a); }
#endif
}
```

```cpp
#include <hip/hip_runtime.h>
#include <cstdio>
#include <cstdint>
namespace pg8 {
#define PG8_LAS __attribute__((address_space(3)))
typedef unsigned short bf16_t;
typedef short bf16x8 __attribute__((ext_vector_type(8)));
typedef float f32x4 __attribute__((ext_vector_type(4)));
typedef unsigned u32x4 __attribute__((ext_vector_type(4)));
constexpr int BM = 256, BK = 64, HALF = 128, HTB = HALF * BK * 2  , STAGE_BYTES = 8 * HTB, NXCD = 8, WGM = 8;

__host__ __device__ __forceinline__ int lds_byte(int r, int c) { const int st = (r >> 4) * 2 + (c >> 5), rr = r & 15, cc = c & 31, ob = rr * 64 + cc * 2; return st * 1024 + (ob ^ (((ob >> 9) & 1) << 5)); }
__host__ __device__ __forceinline__ void stage_rc(int b, int& R, int& C) { const int st = b / 1024, sb = b % 1024, swz = sb ^ (((sb >> 9) & 1) << 5); R = (st >> 1) * 16 + swz / 64; C = (st & 1) * 32 + (swz % 64) / 2; }
__host__ __device__ __forceinline__ int perm32(int rho) { const int n = rho >> 4, i = rho & 15; return 8 * (i >> 2) + 4 * n + (i & 3); }

struct Unit { int pm, pn; };
struct Gemm { const bf16_t* A; const bf16_t* Bt; int M, N, K; };

struct StaticOrder {
    int nM, nN, nwg, G, c;
    __host__ __device__ void init(int M, int N, int G_, int c_) { nM = M / BM; nN = N / BM; nwg = nM * nN; G = G_; c = c_; }
    __host__ __device__ bool next(int i, Unit& u) const {
        const long L = (long)i * G + c; if (L >= nwg) return false;
        int wgid = (int)L; { const int q = nwg / NXCD, r = nwg % NXCD, xcd = wgid % NXCD, off = wgid / NXCD; wgid = (xcd < r ? xcd * (q + 1) : r * (q + 1) + (xcd - r) * q) + off; }
        const int nig = WGM * nN, gid = wgid / nig, fm = gid * WGM, gsz = (nM - fm) < WGM ? (nM - fm) : WGM;
        u.pm = fm + ((wgid % nig) % gsz); u.pn = (wgid % nig) / gsz; return true;
    }
    __device__ __forceinline__ void a_ready(const Unit&) const {}
    __device__ __forceinline__ void done(const Unit&) const {}
};
__device__ __forceinline__ unsigned cvt_pk_bf16(float lo, float hi) { unsigned r; asm volatile("v_cvt_pk_bf16_f32 %0, %1, %2" : "=v"(r) : "v"(lo), "v"(hi)); return r; }
typedef __bf16 bf16x2v __attribute__((ext_vector_type(2)));
typedef float f32x2v_ __attribute__((ext_vector_type(2)));
__device__ __forceinline__ unsigned pk_bf16(float lo, float hi) { f32x2v_ v = {lo, hi}; return __builtin_bit_cast(unsigned, __builtin_convertvector(v, bf16x2v)); }
struct EpiStoreBf16 {
    static constexpr bool PERM = true, AFTER_DRAIN = false;
    bf16_t* O; int ldc;
    __device__ __forceinline__ void operator()(const f32x4 (&acc)[2][2][4][2], const Unit& u, int wr, int wc, int fr, int fq) const {
        const int row0 = u.pm * BM + wr * 64 + fr, col0 = u.pn * BM + wc * 32 + 8 * fq;
#pragma unroll
        for (int ai = 0; ai < 2; ++ai)
#pragma unroll
            for (int m = 0; m < 4; ++m) { bf16_t* rowp = O + (size_t)(row0 + ai * HALF + m * 16) * ldc + col0;
#pragma unroll
                for (int bj = 0; bj < 2; ++bj) { const f32x4 v0 = acc[ai][bj][m][0], v1 = acc[ai][bj][m][1];
                    u32x4 w; w.x = pk_bf16(v0[0], v0[1]); w.y = pk_bf16(v0[2], v0[3]); w.z = pk_bf16(v1[0], v1[1]); w.w = pk_bf16(v1[2], v1[3]);
                    *(u32x4*)(rowp + bj * HALF) = w; } }
    }
};
struct EpiResGate {
    static constexpr bool PERM = false, AFTER_DRAIN = false;
    float* io; int ldc; const float* gate;
    __device__ __forceinline__ void operator()(const f32x4 (&acc)[2][2][4][2], const Unit& u, int wr, int wc, int fr, int fq) const {
        const int row0 = u.pm * BM + wr * 64 + fr, col0 = u.pn * BM + wc * 32 + 4 * fq;
        const int rb = u.pm * BM; const int r = rb < 4096 ? 0 : 1 + ((rb - 4096) >> 12);
        const float* g = gate + r * 4096 + col0;
        f32x4 gv[2][2];
#pragma unroll
        for (int bj = 0; bj < 2; ++bj)
#pragma unroll
            for (int n = 0; n < 2; ++n) gv[bj][n] = *(const f32x4*)(g + bj * HALF + n * 16);
#pragma unroll
        for (int ai = 0; ai < 2; ++ai)
#pragma unroll
            for (int m = 0; m < 4; ++m) { float* rowp = io + (size_t)(row0 + ai * HALF + m * 16) * ldc + col0;
#pragma unroll
                for (int bj = 0; bj < 2; ++bj)
#pragma unroll
                    for (int n = 0; n < 2; ++n) { f32x4* p = (f32x4*)(rowp + bj * HALF + n * 16); const f32x4 b = *p; *p = b + gv[bj][n] * acc[ai][bj][m][n]; }
                if (m == 3) asm volatile("" ::: "memory"); }
    }
};

struct EpiResGateBf16 {
    static constexpr bool PERM = true, AFTER_DRAIN = false;
    bf16_t* io; int ldc; const float* gate;
    __device__ __forceinline__ void operator()(const f32x4 (&acc)[2][2][4][2], const Unit& u, int wr, int wc, int fr, int fq) const {
        const int row0 = u.pm * BM + wr * 64 + fr, col0 = u.pn * BM + wc * 32 + 8 * fq;
        const int rb = u.pm * BM; const int r = rb < 4096 ? 0 : 1 + ((rb - 4096) >> 12);
        const float* g = gate + r * 4096 + col0;
        f32x4 gv[2][2];
#pragma unroll
        for (int bj = 0; bj < 2; ++bj)
#pragma unroll
            for (int n = 0; n < 2; ++n) gv[bj][n] = *(const f32x4*)(g + bj * HALF + 4 * n);
#pragma unroll
        for (int ai = 0; ai < 2; ++ai)
#pragma unroll
            for (int m = 0; m < 4; ++m) { bf16_t* rowp = io + (size_t)(row0 + ai * HALF + m * 16) * ldc + col0;
#pragma unroll
                for (int bj = 0; bj < 2; ++bj) { u32x4* p = (u32x4*)(rowp + bj * HALF); const u32x4 b = *p;
                    const f32x4 a0 = acc[ai][bj][m][0] * gv[bj][0], a1 = acc[ai][bj][m][1] * gv[bj][1];
                    u32x4 w;
                    w.x = pk_bf16(__uint_as_float(b.x << 16) + a0[0], __uint_as_float(b.x & 0xffff0000u) + a0[1]); w.y = pk_bf16(__uint_as_float(b.y << 16) + a0[2], __uint_as_float(b.y & 0xffff0000u) + a0[3]);
                    w.z = pk_bf16(__uint_as_float(b.z << 16) + a1[0], __uint_as_float(b.z & 0xffff0000u) + a1[1]); w.w = pk_bf16(__uint_as_float(b.w << 16) + a1[2], __uint_as_float(b.w & 0xffff0000u) + a1[3]);
                    *p = w; }
                if (m == 3) asm volatile("" ::: "memory"); }
    }
};
template <class Epi, class Sched, bool ALIGN_EPI = false, bool SP2 = false>
__device__ __forceinline__ void gemm_phase(PG8_LAS unsigned char* lds, const Gemm g, const Sched& S, const Epi& E) {
    const int tid = threadIdx.x, wid = __builtin_amdgcn_readfirstlane(tid >> 6), lane = tid & 63, wr = wid >> 2, wc = wid & 3, fr = lane & 15, fq = lane >> 4;
    const int K = g.K, nt = K / BK;
    unsigned voffA[2], voffB[2];
#pragma unroll
    for (int i = 0; i < 2; ++i) { int R, C; stage_rc(tid * 16 + i * 8192, R, C); const int Rb = Epi::PERM ? ((R & ~31) + perm32(R & 31)) : R;
        voffA[i] = (unsigned)(R * K + C) * 2u; voffB[i] = (unsigned)(Rb * K + C) * 2u; }
    const size_t kstep = (size_t)(BK * 2);
    const size_t hstep = (size_t)HALF * K * 2;
    const size_t tstep = 2 * hstep;
    const unsigned ldsw = (unsigned)wid * 1024u;
    const int aoff = lds_byte(wr * 64 + fr, fq * 8), boff = lds_byte(wc * 32 + fr, fq * 8);
#define PG8_SA(b, h) (((b) * 2 + (h)) * HTB)
#define PG8_SB(b, h) ((4 + (b) * 2 + (h)) * HTB)
#define PG8_STAGE(bufoff, gbase, voff) do { _Pragma("unroll") for (int _i = 0; _i < 2; ++_i) \
        __builtin_amdgcn_global_load_lds((const unsigned*)((const char*)(gbase) + (voff)[_i]), (PG8_LAS unsigned*)(lds + (bufoff) + ldsw + _i * 8192), 16, 0, 0); } while (0)
#define PG8_LDA(dst, b, h) do { _Pragma("unroll") for (int m = 0; m < 4; ++m) _Pragma("unroll") for (int k = 0; k < 2; ++k) dst[m][k] = *(const PG8_LAS bf16x8*)(lds + PG8_SA(b, h) + aoff + m * 2048 + k * 1024); } while (0)
#define PG8_LDB(dst, b, h) do { _Pragma("unroll") for (int n = 0; n < 2; ++n) _Pragma("unroll") for (int k = 0; k < 2; ++k) dst[n][k] = *(const PG8_LAS bf16x8*)(lds + PG8_SB(b, h) + boff + n * 2048 + k * 1024); } while (0)
#define PG8_MMA(ai, bj, At, Bt) do { __builtin_amdgcn_s_setprio(1); _Pragma("unroll") for (int m = 0; m < 4; ++m) _Pragma("unroll") for (int n = 0; n < 2; ++n) _Pragma("unroll") for (int k = 0; k < 2; ++k) \
        acc[ai][bj][m][n] = __builtin_amdgcn_mfma_f32_16x16x32_bf16(Bt[n][k], At[m][k], acc[ai][bj][m][n], 0, 0, 0); __builtin_amdgcn_s_setprio(0); } while (0)
#define PG8_WAIT_V(n) asm volatile("s_waitcnt vmcnt(" #n ")" ::: "memory")
#define PG8_WAIT_L(n) asm volatile("s_waitcnt lgkmcnt(" #n ")" ::: "memory")
#define PG8_BAR __builtin_amdgcn_s_barrier()
#define PG8_SCHED __builtin_amdgcn_sched_barrier(0)
    Unit cur, nxt; int ui = 0;
    if (!S.next(0, cur)) return;
    f32x4 acc[2][2][4][2];
#pragma unroll
    for (int a = 0; a < 2; ++a)
#pragma unroll
        for (int b = 0; b < 2; ++b)
#pragma unroll
            for (int m = 0; m < 4; ++m)
#pragma unroll
                for (int n = 0; n < 2; ++n) acc[a][b][m][n] = (f32x4){0.f, 0.f, 0.f, 0.f};
    bf16x8 At[4][2], B0[2][2], B1[2][2];
    const char* cA = (const char*)g.A + (size_t)cur.pm * tstep; const char* cB = (const char*)g.Bt + (size_t)cur.pn * tstep;
    S.a_ready(cur);
    if constexpr (SP2) {
        PG8_STAGE(PG8_SB(0, 0), cB, voffB); PG8_STAGE(PG8_SB(0, 1), cB + hstep, voffB); PG8_STAGE(PG8_SA(0, 0), cA, voffA); PG8_STAGE(PG8_SA(0, 1), cA + hstep, voffA);
        if (wr == 1) PG8_BAR;
        PG8_WAIT_V(2); PG8_BAR;
        PG8_STAGE(PG8_SB(1, 0), cB + kstep, voffB); PG8_STAGE(PG8_SA(1, 0), cA + kstep, voffA); PG8_STAGE(PG8_SB(1, 1), cB + hstep + kstep, voffB);
        PG8_WAIT_V(6); PG8_BAR;
    } else {
        PG8_STAGE(PG8_SB(0, 0), cB, voffB); PG8_STAGE(PG8_SA(0, 0), cA, voffA); PG8_STAGE(PG8_SB(0, 1), cB + hstep, voffB); PG8_STAGE(PG8_SA(0, 1), cA + hstep, voffA);
        if (wr == 1) PG8_BAR;
        PG8_WAIT_V(4); PG8_BAR;
        PG8_STAGE(PG8_SB(1, 0), cB + kstep, voffB); PG8_STAGE(PG8_SA(1, 0), cA + kstep, voffA); PG8_STAGE(PG8_SB(1, 1), cB + hstep + kstep, voffB);
        PG8_WAIT_V(6); PG8_BAR;
    }
    for (;;) {
        const bool has_next = S.next(ui + 1, nxt);
        const char* nA = has_next ? (const char*)g.A + (size_t)nxt.pm * tstep : cA; const char* nB = has_next ? (const char*)g.Bt + (size_t)nxt.pn * tstep : cB;
        for (int t = 0; t < nt; t += 2) {
            const bool last = (t == nt - 2);
            const char* a1 = cA + (size_t)(t + 1) * kstep;
            const char* a2 = last ? nA : cA + (size_t)(t + 2) * kstep; const char* b2 = last ? nB : cB + (size_t)(t + 2) * kstep;
            const char* a3 = a2 + kstep; const char* b3 = b2 + kstep;
            if (last && has_next) S.a_ready(nxt);
            if constexpr (SP2) {
            PG8_LDB(B0, 0, 0); PG8_LDB(B1, 0, 1); PG8_SCHED; PG8_LDA(At, 0, 0); PG8_STAGE(PG8_SA(1, 1), a1 + hstep, voffA);
            PG8_WAIT_V(8); PG8_WAIT_L(0); PG8_BAR; PG8_MMA(0, 0, At, B0); PG8_MMA(0, 1, At, B1); PG8_BAR; PG8_SCHED;
            PG8_LDA(At, 0, 1); PG8_STAGE(PG8_SB(0, 0), b2, voffB); PG8_STAGE(PG8_SB(0, 1), b2 + hstep, voffB); PG8_STAGE(PG8_SA(0, 0), a2, voffA);
            PG8_WAIT_V(8); PG8_WAIT_L(0); PG8_BAR; PG8_MMA(1, 0, At, B0); PG8_MMA(1, 1, At, B1); PG8_BAR; PG8_SCHED;
            PG8_LDB(B0, 1, 0); PG8_LDB(B1, 1, 1); PG8_SCHED; PG8_LDA(At, 1, 0); PG8_STAGE(PG8_SA(0, 1), a2 + hstep, voffA);
            PG8_WAIT_V(8); PG8_WAIT_L(0); PG8_BAR; PG8_MMA(0, 0, At, B0); PG8_MMA(0, 1, At, B1); PG8_BAR; PG8_SCHED;
            PG8_LDA(At, 1, 1); PG8_STAGE(PG8_SB(1, 0), b3, voffB); PG8_STAGE(PG8_SB(1, 1), b3 + hstep, voffB); PG8_STAGE(PG8_SA(1, 0), a3, voffA);
            PG8_WAIT_V(8); PG8_WAIT_L(0); PG8_BAR; PG8_MMA(1, 0, At, B0); PG8_MMA(1, 1, At, B1); PG8_BAR; PG8_SCHED;
            } else {
            PG8_LDB(B0, 0, 0); PG8_SCHED; PG8_LDA(At, 0, 0); PG8_STAGE(PG8_SA(1, 1), a1 + hstep, voffA);
            PG8_WAIT_L(8); PG8_BAR; PG8_WAIT_L(0); PG8_MMA(0, 0, At, B0); PG8_BAR; PG8_SCHED;
            PG8_LDB(B1, 0, 1); PG8_STAGE(PG8_SB(0, 0), b2, voffB);
            PG8_BAR; PG8_WAIT_L(0); PG8_MMA(0, 1, At, B1); PG8_BAR;
            PG8_LDA(At, 0, 1); PG8_STAGE(PG8_SA(0, 0), a2, voffA);
            PG8_BAR; PG8_WAIT_L(0); PG8_MMA(1, 0, At, B0); PG8_BAR; PG8_SCHED;
            PG8_STAGE(PG8_SB(0, 1), b2 + hstep, voffB);
            PG8_WAIT_V(6); PG8_BAR; PG8_MMA(1, 1, At, B1); PG8_BAR;
            PG8_LDB(B0, 1, 0); PG8_SCHED; PG8_LDA(At, 1, 0); PG8_STAGE(PG8_SA(0, 1), a2 + hstep, voffA);
            PG8_WAIT_L(8); PG8_BAR; PG8_WAIT_L(0); PG8_MMA(0, 0, At, B0); PG8_BAR; PG8_SCHED;
            PG8_LDB(B1, 1, 1); PG8_STAGE(PG8_SB(1, 0), b3, voffB);
            PG8_BAR; PG8_WAIT_L(0); PG8_MMA(0, 1, At, B1); PG8_BAR;
            PG8_LDA(At, 1, 1); PG8_STAGE(PG8_SA(1, 0), a3, voffA);
            PG8_BAR; PG8_WAIT_L(0); PG8_MMA(1, 0, At, B0); PG8_BAR; PG8_SCHED;
            PG8_STAGE(PG8_SB(1, 1), b3 + hstep, voffB);
            PG8_WAIT_V(6); PG8_BAR; PG8_MMA(1, 1, At, B1); PG8_BAR;
            }
        }
        if constexpr (ALIGN_EPI) { if (wr == 0) PG8_BAR; }
        if constexpr (!Epi::AFTER_DRAIN) { E(acc, cur, wr, wc, fr, fq); S.done(cur); }
        if (!has_next) break;
#pragma unroll
        for (int a = 0; a < 2; ++a)
#pragma unroll
            for (int b = 0; b < 2; ++b)
#pragma unroll
                for (int m = 0; m < 4; ++m)
#pragma unroll
                    for (int n = 0; n < 2; ++n) acc[a][b][m][n] = (f32x4){0.f, 0.f, 0.f, 0.f};
        cur = nxt; cA = nA; cB = nB; ++ui;
        if constexpr (ALIGN_EPI) { if (wr == 1) PG8_BAR; }
    }
    PG8_WAIT_V(0);
    if constexpr (!ALIGN_EPI) { if (wr == 0) PG8_BAR; }
    PG8_BAR;
    if constexpr (Epi::AFTER_DRAIN) { E.fused(acc, cur, wr, wc, fr, fq, lds, wid, lane); S.done(cur); }
#undef PG8_SA
#undef PG8_SB
#undef PG8_STAGE
#undef PG8_LDA
#undef PG8_LDB
#undef PG8_MMA
#undef PG8_WAIT_V
#undef PG8_WAIT_L
#undef PG8_BAR
#undef PG8_SCHED
}
}
#define XB_TMO      128
#define XB_XCNT(j)  (256  + 64 * (j))
#define XB_XSUB(j)  (1280 + 64 * (j))
#define XB_XGEN(j)  (2304 + 64 * (j))
#define XB_TOP      3328
#define XB_TOPGEN   3392
#define XCD_BAR_WORDS 3456
#define XB_SPIN_CAP (1u << 18)
#define LAS __attribute__((address_space(3)))

__device__ __forceinline__ unsigned xb_ld(unsigned* p)              { return __hip_atomic_load(p, __ATOMIC_RELAXED, __HIP_MEMORY_SCOPE_AGENT); }
__device__ __forceinline__ unsigned xb_add(unsigned* p, unsigned v) { return __hip_atomic_fetch_add(p, v, __ATOMIC_RELAXED, __HIP_MEMORY_SCOPE_AGENT); }
__device__ __forceinline__ unsigned xb_xcc_id() { return (unsigned)__builtin_amdgcn_s_getreg((3 << 11) | 20) & 0xFu; }
#define XB_SPIN(cond, bar) do { unsigned _sp = 0; while (cond) { __builtin_amdgcn_s_sleep(1); \
    if ((++_sp & 255u) == 0u) { if (xb_ld(&(bar)[XB_TMO])) break; if (_sp > XB_SPIN_CAP) { atomicAdd(&(bar)[XB_TMO], 1u); break; } } } } while (0)

struct XcdBarrier {
    unsigned* bar; unsigned x;
    volatile LAS unsigned* st;
};

__device__ __forceinline__ XcdBarrier xcd_barrier_post(unsigned* bar, volatile LAS unsigned* st) {
    XcdBarrier b; b.bar = bar; b.x = xb_xcc_id(); b.st = st;
    if (threadIdx.x == 0) (void)xb_add(&bar[XB_XCNT(b.x)], 1u);
    return b;
}
__device__ __forceinline__ void xcd_barrier_complete(unsigned* bar, unsigned x, unsigned& nloc, unsigned& nx) {
    const unsigned G = gridDim.x * gridDim.y * gridDim.z;
    unsigned sum, cnt, mine, sp = 0u;
    for (;;) {
        sum = 0u; cnt = 0u; mine = 0u;
#pragma unroll
        for (unsigned j = 0; j < 16; ++j) { const unsigned c = xb_ld(&bar[XB_XCNT(j)]); sum += c; cnt += (c > 0u) ? 1u : 0u; mine = (j == x) ? c : mine; }
        if (sum == G) break;
        __builtin_amdgcn_s_sleep(1);
        if ((++sp & 255u) == 0u) { if (xb_ld(&bar[XB_TMO])) break; if (sp > XB_SPIN_CAP) { atomicAdd(&bar[XB_TMO], 1u); break; } }
    }
    nloc = mine > 0u ? mine : 1u; nx = cnt > 0u ? cnt : 1u;
}

__device__ __forceinline__ void xcd_barrier(const XcdBarrier& b) {
    asm volatile("s_waitcnt vmcnt(0)" ::: "memory");
    __syncthreads();
    if (threadIdx.x == 0) {
        unsigned* bar = b.bar;
        __builtin_amdgcn_s_waitcnt(0);
        unsigned nloc = b.st[0], nx = b.st[1];
        if (nloc == 0u) { xcd_barrier_complete(bar, b.x, nloc, nx); b.st[0] = nloc; b.st[1] = nx; }
        const unsigned old = xb_add(&bar[XB_XSUB(b.x)], 1u);
        const unsigned gen = old / nloc;
        if (old + 1u == (gen + 1u) * nloc) {
            __builtin_amdgcn_fence(__ATOMIC_RELEASE, "agent");
            asm volatile("s_waitcnt vmcnt(0)" ::: "memory");
            const unsigned og = xb_add(&bar[XB_TOP], 1u);
            const unsigned tg = og / nx;
            if (og + 1u == (tg + 1u) * nx) xb_add(&bar[XB_TOPGEN], 1u);
            else XB_SPIN(xb_ld(&bar[XB_TOPGEN]) == tg, bar);
            __builtin_amdgcn_fence(__ATOMIC_ACQUIRE, "agent");
            xb_add(&bar[XB_XGEN(b.x)], 1u);
            asm volatile("s_waitcnt vmcnt(0)" ::: "memory");
        } else {
            XB_SPIN(xb_ld(&bar[XB_XGEN(b.x)]) == gen, bar);
            __builtin_amdgcn_fence(__ATOMIC_ACQUIRE, "agent");
            asm volatile("s_waitcnt vmcnt(0)" ::: "memory");
        }
    }
    __syncthreads();
}
#define DI __device__ __forceinline__
typedef unsigned short bf16;
typedef short bf16x8 __attribute__((ext_vector_type(8)));
typedef short bf16x4 __attribute__((ext_vector_type(4)));
typedef float f32x4 __attribute__((ext_vector_type(4)));
typedef float f32x2 __attribute__((ext_vector_type(2)));
typedef unsigned u32x4 __attribute__((ext_vector_type(4)));
typedef unsigned u32x2 __attribute__((ext_vector_type(2)));
typedef __bf16 bf16x2n __attribute__((ext_vector_type(2)));
#define MFMA16(a, b, c) __builtin_amdgcn_mfma_f32_16x16x32_bf16((a), (b), (c), 0, 0, 0)

constexpr int DM = 4096, NROWS = 12288;
constexpr int IN_EVEN = 14464, LD_EVEN = 14592, IN_ODD = 18432;
constexpr int E_QKV = 0, E_BETA = 6144, E_A = 6176, E_ZA = 6208, E_XBC = 8256, E_DT = 12352, E_ZB = 12416;
constexpr int O_VX = 0, O_ZC = 6144, O_Q = 8192, O_F = 10240, O_I = 14336, O_ZD = 16384;
constexpr float EPS = 1e-6f;
constexpr int NSEQ = 18;
DI int seq_row0(int s) { return s < 16 ? s * 256 : 4096 + (s - 16) * 4096; }
DI int seq_len(int s) { return s < 16 ? 256 : 4096; }
constexpr size_t OUT_SG = 50331648, OUT_SS = 58720256, OUT_SH = 67108864;

constexpr size_t MiB = 1u << 20;
constexpr size_t WS_CTL = 0, CTL_ZERO_BYTES = 1 * MiB;
constexpr size_t WS_MODP = 1 * MiB;
constexpr size_t WS_MODF = 4 * MiB;
constexpr size_t WS_PE = 5 * MiB;
constexpr size_t WS_HDN = 6 * MiB;
constexpr size_t WS_HNRM = 8 * MiB;
constexpr size_t WS_HF256 = 16 * MiB;
constexpr size_t WS_HF4096 = 32 * MiB;
constexpr size_t WS_WTE = 160 * MiB;
constexpr size_t WS_WTO = 274 * MiB;
constexpr size_t WS_WTOUT = 418 * MiB;
constexpr size_t WS_H = 482 * MiB;
constexpr size_t WS_U = 578 * MiB;
constexpr size_t WS_MIX = 1010 * MiB;
constexpr size_t WS_OFA = 1106 * MiB;
constexpr size_t WS_OBA = 1154 * MiB;
constexpr size_t WS_OFB = 1202 * MiB;
constexpr size_t WS_OBB = 1250 * MiB;
constexpr size_t WS_TB = 1298 * MiB;
constexpr size_t WS_END = 1490 * MiB;
constexpr size_t WS_YT = WS_WTE;
constexpr size_t WS_GWN = 1298 * MiB;
constexpr size_t WS_GUF = 1394 * MiB;
constexpr size_t WS_GPP = 920 * MiB;
constexpr size_t WS_GGC = 968 * MiB;
constexpr size_t WS_GQN = WS_WTE;
constexpr size_t WS_GKT = WS_WTE + 48 * MiB;
constexpr size_t WS_SSP = 32 * MiB;
constexpr size_t WS_SCN = 128 * MiB;
constexpr size_t WS_SSG = 152 * MiB;
constexpr size_t WS_SBT = 1490 * MiB;
constexpr size_t WS_SVT = WS_H;
constexpr size_t WS_END2 = 1514 * MiB;
constexpr size_t WS_LQS = WS_H;
constexpr size_t WS_LKS = WS_WTO;
constexpr size_t WS_LAT = WS_WTO + 96 * MiB;
constexpr size_t WS_LVT = WS_OFB;
constexpr size_t WS_LGL = WS_OBB;
constexpr int CW_Q0 = 8192, CW_Q1 = 8256, CW_Q2 = 8320, CW_Q3 = 8384, CW_Q4 = 8448;
constexpr int CW_BAR = 4096;

DI float bf2f(bf16 b) { return __uint_as_float(((unsigned)b) << 16); }
DI unsigned pk2(float lo, float hi) { f32x2 v = {lo, hi}; return __builtin_bit_cast(unsigned, __builtin_convertvector(v, bf16x2n)); }
DI bf16 f2bf(float f) { return (bf16)(pk2(f, 0.f) & 0xffffu); }
DI float wave_sum(float v) {
#pragma unroll
    for (int o = 1; o < 64; o <<= 1) v += __shfl_xor(v, o);
    return v;
}
DI float sigmoidf_(float x) { return __builtin_amdgcn_rcpf(1.0f + __expf(-x)); }
DI float siluf_(float x) { return x * __builtin_amdgcn_rcpf(1.0f + __expf(-x)); }
DI float softplusf_(float x) { return x > 20.f ? x : log1pf(__expf(x)); }
DI void unpack8(const u32x4 w, float* o) {
    o[0] = __uint_as_float(w.x << 16); o[1] = __uint_as_float(w.x & 0xffff0000u); o[2] = __uint_as_float(w.y << 16); o[3] = __uint_as_float(w.y & 0xffff0000u);
    o[4] = __uint_as_float(w.z << 16); o[5] = __uint_as_float(w.z & 0xffff0000u); o[6] = __uint_as_float(w.w << 16); o[7] = __uint_as_float(w.w & 0xffff0000u);
}
DI bf16x8 frag_nat(const LAS bf16* M, int ld, int r0, int k0, int lane) { return *(const LAS bf16x8*)(M + (r0 + (lane & 15)) * ld + k0 + 8 * (lane >> 4)); }
DI bf16x8 frag_perm(const LAS bf16* M, int ld, int r0, int k0, int lane) {
    const LAS bf16* p = M + (r0 + (lane & 15)) * ld + k0 + 4 * (lane >> 4);
    const bf16x4 lo = *(const LAS bf16x4*)p, hi = *(const LAS bf16x4*)(p + 16);
    return __builtin_shufflevector(lo, hi, 0, 1, 2, 3, 4, 5, 6, 7);
}
DI bf16x8 pack2(const f32x4 a, const f32x4 b) {
    u32x4 w; w.x = pk2(a[0], a[1]); w.y = pk2(a[2], a[3]); w.z = pk2(b[0], b[1]); w.w = pk2(b[2], b[3]);
    return __builtin_bit_cast(bf16x8, w);
}
DI void st_bf16x4(LAS bf16* p, float a, float b, float c, float d) { u32x2 w; w.x = pk2(a, b); w.y = pk2(c, d); *(LAS u32x2*)p = w; }
constexpr int LDQ = 136, LDT = 72;
DI int swz_idx(int row, int col) { return row * LDT + (((((col >> 3) ^ (row >> 4)) & 7) << 3) | (col & 7)); }
DI bf16x8 frag_nat_sw(const LAS bf16* M, int r0, int k0, int lane) { const int q = lane >> 4; return *(const LAS bf16x8*)(M + (r0 + (lane & 15)) * LDT + ((((k0 >> 3) + q) ^ (r0 >> 4)) & 7) * 8); }
DI bf16x8 frag_perm_sw(const LAS bf16* M, int r0, int k0, int lane) { const int q = lane >> 4, sw = r0 >> 4; const LAS bf16* p = M + (r0 + (lane & 15)) * LDT + 4 * (q & 1);
    const bf16x4 lo = *(const LAS bf16x4*)(p + ((((k0 >> 3) + (q >> 1)) ^ sw) & 7) * 8), hi = *(const LAS bf16x4*)(p + ((((k0 >> 3) + 2 + (q >> 1)) ^ sw) & 7) * 8);
    return __builtin_shufflevector(lo, hi, 0, 1, 2, 3, 4, 5, 6, 7); }
#define LDSBAR() do { asm volatile("s_waitcnt lgkmcnt(0)" ::: "memory"); __builtin_amdgcn_s_barrier(); asm volatile("" ::: "memory"); } while (0)
#ifndef WODD_KEEP
#define WODD_KEEP 288
#endif
constexpr int WODD_P0 = 64 * WODD_KEEP;
struct Ctx {
    LAS unsigned char* lds;
    const float* const* in;
    unsigned char* ws;
    float* out;
    int tid, lane, wave, bid, G;
};
DI void p0_transpose_pair(const float* W, int K, int N, bf16* WT, LAS float* scr, int item0, int item1, int lane) {
    const int nblk = N / 32;
    float va[32], vb[32];
    { const int kb = item0 / nblk, nb = item0 % nblk; const float* src = W + (size_t)(64 * kb + (lane >> 5)) * N + 32 * nb + (lane & 31);
#pragma unroll
      for (int i = 0; i < 32; ++i) va[i] = __builtin_nontemporal_load(src + (size_t)(2 * i) * N); }
    if (item1 >= 0) { const int kb = item1 / nblk, nb = item1 % nblk; const float* src = W + (size_t)(64 * kb + (lane >> 5)) * N + 32 * nb + (lane & 31);
#pragma unroll
      for (int i = 0; i < 32; ++i) vb[i] = __builtin_nontemporal_load(src + (size_t)(2 * i) * N); }
#pragma unroll
    for (int half = 0; half < 2; ++half) { const int item = half ? item1 : item0; if (item < 0) break;
        const int kb = item / nblk, nb = item % nblk, k0 = 64 * kb, n0 = 32 * nb;
#pragma unroll
        for (int i = 0; i < 32; ++i) scr[(2 * i + (lane >> 5)) * 33 + (lane & 31)] = half ? vb[i] : va[i];
        asm volatile("s_waitcnt lgkmcnt(0)" ::: "memory");
        const int c = lane & 7;
#pragma unroll
        for (int j = 0; j < 4; ++j) { const int n = (lane >> 3) + 8 * j; const LAS float* s = scr + (8 * c) * 33 + n;
            u32x4 o; o.x = pk2(s[0 * 33], s[1 * 33]); o.y = pk2(s[2 * 33], s[3 * 33]); o.z = pk2(s[4 * 33], s[5 * 33]); o.w = pk2(s[6 * 33], s[7 * 33]);
            *(u32x4*)(WT + (size_t)(n0 + n) * K + k0 + 8 * c) = o; }
        asm volatile("s_waitcnt lgkmcnt(0)" ::: "memory"); }
}
DI void p0_transpose_range(const float* W, int K, int N, bf16* WT, LAS float* scr, int first, int stride, int total, int lane) {
    for (int it = first; it < total; it += 2 * stride) p0_transpose_pair(W, K, N, WT, scr, it, it + stride < total ? it + stride : -1, lane);
}
DI void p0_adaln_item(const Ctx& F, const float* w_ada, const float* c, const float* c_ctx, int item) {
    const int li = item / 384, rem = item % 384, strip = rem >> 3, kseg = rem & 7;
    const float* W = w_ada + (size_t)li * 4096 * 12288 + strip * 256 + F.lane * 4;
    const int k0 = kseg * 512 + F.wave * 64;
    f32x4 a0 = {0.f, 0.f, 0.f, 0.f}, a1 = a0, a2 = a0;
#pragma unroll 8
    for (int kk = 0; kk < 64; ++kk) { const int k = k0 + kk;
        const float s0 = siluf_(c_ctx[k]), s1 = siluf_(c[k]), s2 = siluf_(c[4096 + k]);
        const f32x4 w = __builtin_nontemporal_load((const f32x4*)(W + (size_t)k * 12288));
        a0 += s0 * w; a1 += s1 * w; a2 += s2 * w; }
    LAS float* scr = (LAS float*)F.lds;
    *(LAS f32x4*)(scr + F.wave * 768 + 0 * 256 + F.lane * 4) = a0;
    *(LAS f32x4*)(scr + F.wave * 768 + 1 * 256 + F.lane * 4) = a1;
    *(LAS f32x4*)(scr + F.wave * 768 + 2 * 256 + F.lane * 4) = a2;
    __syncthreads();
    float* modp = (float*)(F.ws + WS_MODP);
    for (int o = F.tid; o < 768; o += 512) { float s = 0.f;
#pragma unroll
        for (int w = 0; w < 8; ++w) s += scr[w * 768 + o];
        const int r = o >> 8, ci = o & 255;
        modp[((size_t)(kseg * 2 + li) * 3 + r) * 12288 + strip * 256 + ci] = s; }
    __syncthreads();
}
DI void p0_hdn_item(const float* w1, const float* b1, const float* freq, const float* w2, const float* b2, int L, int p, float* out, int lane) {
    const float t = (float)p / (float)(L - 1);
    float zk = 0.f;
    if (lane == 0) zk = t;
    else if (lane <= 32) { const int b = (lane - 1) & 15; const float band = 1e-4f + (float)b * ((15.0f - 1e-4f) / 15.0f);
        const float ang = (6.283185307179586f / (float)L) * (float)p * band; zk = (lane <= 16) ? cosf(ang) : -sinf(ang); }
    float a = b1[lane];
#pragma unroll
    for (int k = 0; k < 33; ++k) a += __shfl(zk, k) * w1[k * 64 + lane];
    const float h1 = sinf(freq[lane] * a);
    float a2 = b2[lane];
#pragma unroll 16
    for (int k = 0; k < 64; ++k) a2 += __shfl(h1, k) * w2[k * 64 + lane];
    out[lane] = sinf(freq[64 + lane] * a2);
}
DI void p0_filter_item(const Ctx& F, const float* hdn, const float* w3, float* HF, float* HNRM, int L, int cg) {
    LAS float* wl = (LAS float*)F.lds;
    LAS float* red = wl + 2048;
    for (int e = F.tid; e < 2048; e += 512) { const int k = e >> 5, x = e & 31, dir = x >> 4, ord = (x >> 3) & 1, cc = x & 7;
        wl[e] = w3[(size_t)k * 8192 + dir * 4096 + ord * 2048 + cg * 8 + cc]; }
    __syncthreads();
    float asum[16];
#pragma unroll
    for (int i = 0; i < 16; ++i) asum[i] = 0.f;
    const float tinv = 1.0f / (float)(L - 1);
    float dl2[8];
#pragma unroll
    for (int cc = 0; cc < 8; ++cc) dl2[cc] = 1.4426950408889634f * fabsf(-3.0701134573253945f + (-15.350567286626972f + 3.0701134573253945f) * ((float)(cg * 8 + cc) * (1.0f / 2047.0f)));
    const int half = L > 512 ? L / 2 : L;
    for (int p = F.tid; p < half; p += 512) { const bool two = (L > 512); const int p1 = two ? p + half : p;
        float acc0[32], acc1[32];
#pragma unroll
        for (int i = 0; i < 32; ++i) { acc0[i] = 0.f; acc1[i] = 0.f; }
        const f32x4* hp0 = (const f32x4*)(hdn + (size_t)p * 64); const f32x4* hp1 = (const f32x4*)(hdn + (size_t)p1 * 64);
#pragma unroll 2
        for (int k4 = 0; k4 < 16; ++k4) { const f32x4 hv0 = hp0[k4], hv1 = hp1[k4];
#pragma unroll
            for (int kk = 0; kk < 4; ++kk) { const float h0 = hv0[kk], h1 = hv1[kk]; const LAS f32x4* wr = (const LAS f32x4*)(wl + (k4 * 4 + kk) * 32);
#pragma unroll
                for (int x4 = 0; x4 < 8; ++x4) { const f32x4 w = wr[x4];
                    acc0[x4 * 4 + 0] += h0 * w[0]; acc0[x4 * 4 + 1] += h0 * w[1]; acc0[x4 * 4 + 2] += h0 * w[2]; acc0[x4 * 4 + 3] += h0 * w[3];
                    acc1[x4 * 4 + 0] += h1 * w[0]; acc1[x4 * 4 + 1] += h1 * w[1]; acc1[x4 * 4 + 2] += h1 * w[2]; acc1[x4 * 4 + 3] += h1 * w[3]; } } }
#pragma unroll
        for (int pp = 0; pp < 2; ++pp) { if (pp == 1 && !two) break; const int q = pp ? p1 : p; const float t = (float)q * tinv;
            float win[8];
#pragma unroll
            for (int cc = 0; cc < 8; ++cc) win[cc] = __builtin_amdgcn_exp2f(-t * dl2[cc]);
#pragma unroll
            for (int x = 0; x < 32; ++x) { const int dir = x >> 4, ord = (x >> 3) & 1, cc = x & 7, c = cg * 8 + cc;
                const float val = (pp ? acc1[x] : acc0[x]) * win[cc];
                float* row = HF + ((size_t)ord * 2048 + c) * (size_t)(2 * L);
                if (dir == 0) { row[q] = val; asum[ord * 8 + cc] += fabsf(val); if (q == 0) row[L] = 0.f; }
                else if (q >= 1) { row[2 * L - q] = val; asum[ord * 8 + cc] += fabsf(val); } } }
    }
#pragma unroll
    for (int i = 0; i < 16; ++i) { const float s = wave_sum(asum[i]); if (F.lane == 0) red[F.wave * 16 + i] = s; }
    __syncthreads();
    if (F.tid < 16) { float s = 0.f;
#pragma unroll
        for (int w = 0; w < 8; ++w) s += red[w * 16 + F.tid];
        const int ord = F.tid >> 3, cc = F.tid & 7; HNRM[ord * 2048 + cg * 8 + cc] = 1.0f / s; }
    __syncthreads();
}
DI void phase_p0(const Ctx& F, const float* const* in) {
    const int gw = F.bid * 8 + F.wave, NGW = F.G * 8;
    for (int it = F.bid; it < 768; it += F.G) p0_adaln_item(F, in[8], in[5], in[6], it);
    LAS float* scr = (LAS float*)(F.lds + F.wave * 16384);
    constexpr int I_E = 64 * (IN_EVEN / 32);
    p0_transpose_range(in[12], 4096, IN_EVEN, (bf16*)(F.ws + WS_WTE), scr, gw, NGW, I_E, F.lane);
    p0_transpose_range(in[22], 4096, IN_ODD, (bf16*)(F.ws + WS_WTO), scr, gw, NGW, WODD_P0, F.lane);
    { u32x4* z = (u32x4*)((bf16*)(F.ws + WS_WTE) + (size_t)IN_EVEN * 4096); const u32x4 zero = {0u, 0u, 0u, 0u};
      for (int i = F.bid * 512 + F.tid; i < (LD_EVEN - IN_EVEN) * 4096 / 8; i += F.G * 512) z[i] = zero; }
    { float* pe = (float*)(F.ws + WS_PE);
      for (int i = F.bid * 512 + F.tid; i < 65536; i += F.G * 512) { const int v = i >> 10, j = i & 1023;
          const float omega = 1.0f / powf(10000.0f, (float)j / 1024.0f); const float ang = (float)v * omega;
          pe[2 * i] = sinf(ang); pe[2 * i + 1] = cosf(ang); } }
    { float* hdn = (float*)(F.ws + WS_HDN);
      for (int it = gw; it < 256 + 4096; it += NGW) { const int L = it < 256 ? 256 : 4096, p = it < 256 ? it : it - 256;
          p0_hdn_item(in[24], in[25], in[26], in[27], in[28], L, p, hdn + (size_t)it * 64, F.lane); } }
}
DI void phase_p0c(const Ctx& F, const float* const* in) {
    { const float* modp = (const float*)(F.ws + WS_MODP); float* modf = (float*)(F.ws + WS_MODF);
      for (int i = F.bid * 512 + F.tid; i < 2 * 3 * 4096; i += F.G * 512) { const int li = i / 12288, r = (i / 4096) % 3, cc = i & 4095;
          float sh = in[9][li * 12288 + cc], sc = in[9][li * 12288 + 4096 + cc], gt = in[9][li * 12288 + 8192 + cc];
#pragma unroll
          for (int ks = 0; ks < 8; ++ks) { const float* m = modp + ((size_t)(ks * 2 + li) * 3 + r) * 12288; sh += m[cc]; sc += m[4096 + cc]; gt += m[8192 + cc]; }
          float* o = modf + (size_t)(li * 9 + r) * 4096;
          o[cc] = in[7][li * 4096 + cc] * (1.0f + sc); o[3 * 4096 + cc] = sh; o[6 * 4096 + cc] = gt; } }
}
DI void phase_filters(const Ctx& F, const float* const* in, int w, int nw) {
    __syncthreads();
    for (int it = w; it < 512; it += nw) { const int cg = it & 255, li = it >> 8;
        const float* hdn = (const float*)(F.ws + WS_HDN) + (li ? (size_t)256 * 64 : 0);
        p0_filter_item(F, hdn, in[29], (float*)(F.ws + (li ? WS_HF4096 : WS_HF256)), (float*)(F.ws + WS_HNRM) + li * 4096, li ? 4096 : 256, cg); }
}
DI void convert_wout(const Ctx& F, const float* const* in, int w, int nw, int li) {
    __syncthreads();
    LAS float* scr = (LAS float*)(F.lds + F.wave * 16384);
    p0_transpose_range(in[10] + (size_t)li * 4096 * 4096, 4096, 4096, (bf16*)(F.ws + WS_WTOUT) + (size_t)li * 4096 * 4096, scr, w * 8 + F.wave, nw * 8, 8192, F.lane);
}
DI void convert_wodd(const Ctx& F, const float* const* in, int w, int nw) {
    __syncthreads();
    LAS float* scr = (LAS float*)(F.lds + F.wave * 16384);
    p0_transpose_range(in[22], 4096, IN_ODD, (bf16*)(F.ws + WS_WTO), scr, WODD_P0 + w * 8 + F.wave, nw * 8, 64 * (IN_ODD / 32), F.lane);
}
constexpr int LDX = 8192;
DI bf16* xr_base(const Ctx& F) { return (bf16*)F.out + 4096; }
template <int MODE> DI void phase_norm(const Ctx& F, const float* const* in) {
    const int gw = F.bid * 8 + F.wave, NGW = F.G * 8;
    bf16* H = (bf16*)(F.ws + WS_H); const float* pe = (const float*)(F.ws + WS_PE); bf16* XR = xr_base(F);
    f32x4 ra[MODE == 0 ? 8 : 1], rb[MODE == 0 ? 8 : 1]; u32x4 rw[MODE == 0 ? 1 : 8];
#define NORM_LOAD(row_) do { if (MODE == 0) { const float* src_ = (row_) < 4096 ? in[0] + (size_t)(row_) * DM : in[1] + (size_t)((row_) - 4096) * DM; \
            _Pragma("unroll") for (int j_ = 0; j_ < 8; ++j_) { ra[MODE == 0 ? j_ : 0] = __builtin_nontemporal_load((const f32x4*)(src_ + j_ * 512 + F.lane * 8)); rb[MODE == 0 ? j_ : 0] = __builtin_nontemporal_load((const f32x4*)(src_ + j_ * 512 + F.lane * 8 + 4)); } } \
        else { _Pragma("unroll") for (int j_ = 0; j_ < 8; ++j_) rw[MODE == 0 ? 0 : j_] = *(const u32x4*)(XR + (size_t)(row_) * LDX + j_ * 512 + F.lane * 8); } } while (0)
    if (gw < NROWS) NORM_LOAD(gw);
#pragma unroll 1
    for (int row = gw; row < NROWS; row += NGW) {
        const int r = row < 4096 ? 0 : 1 + ((row - 4096) >> 12);
        const int t = (row - 4096) & 4095, gr = t >> 6, gc = t & 63;
        float v[8][8]; float ss = 0.f;
        if (MODE == 0) {
#pragma unroll
            for (int j = 0; j < 8; ++j) { const int col = j * 512 + F.lane * 8; const f32x4 a = ra[MODE == 0 ? j : 0], b = rb[MODE == 0 ? j : 0];
                v[j][0] = a[0]; v[j][1] = a[1]; v[j][2] = a[2]; v[j][3] = a[3]; v[j][4] = b[0]; v[j][5] = b[1]; v[j][6] = b[2]; v[j][7] = b[3];
                if (row >= 4096) { const int q4 = j >> 1, jj = col & 1023, vv = (q4 < 2) ? gr : gc, comp = q4 & 1;
                    const f32x4* pp = (const f32x4*)(pe + ((size_t)vv * 1024 + jj) * 2);
#pragma unroll
                    for (int e2 = 0; e2 < 4; ++e2) { const f32x4 p = pp[e2]; v[j][2 * e2] += comp ? p[1] : p[0]; v[j][2 * e2 + 1] += comp ? p[3] : p[2]; } } }
        } else {
#pragma unroll
            for (int j = 0; j < 8; ++j) unpack8(rw[MODE == 0 ? 0 : j], v[j]); }
        if (row + NGW < NROWS) NORM_LOAD(row + NGW);
#pragma unroll
        for (int j = 0; j < 8; ++j)
#pragma unroll
            for (int e = 0; e < 8; ++e) ss += v[j][e] * v[j][e];
        const float rstd = __builtin_amdgcn_rsqf(wave_sum(ss) * (1.0f / DM) + EPS);
        if (MODE == 2) { float* yo = F.out + (size_t)row * DM;
#pragma unroll
            for (int j = 0; j < 8; ++j) { const int col = j * 512 + F.lane * 8; const f32x4 g0 = *(const f32x4*)(in[11] + col), g1 = *(const f32x4*)(in[11] + col + 4);
                __builtin_nontemporal_store((f32x4){v[j][0] * rstd * g0[0], v[j][1] * rstd * g0[1], v[j][2] * rstd * g0[2], v[j][3] * rstd * g0[3]}, (f32x4*)(yo + col));
                __builtin_nontemporal_store((f32x4){v[j][4] * rstd * g1[0], v[j][5] * rstd * g1[1], v[j][6] * rstd * g1[2], v[j][7] * rstd * g1[3]}, (f32x4*)(yo + col + 4)); }
        } else {
            const float* A = (const float*)(F.ws + WS_MODF) + (size_t)((MODE == 1 ? 9 : 0) + r) * 4096;
#pragma unroll
            for (int j = 0; j < 8; ++j) { const int col = j * 512 + F.lane * 8;
                const f32x4 a0 = *(const f32x4*)(A + col), a1 = *(const f32x4*)(A + col + 4), b0 = *(const f32x4*)(A + 3 * 4096 + col), b1 = *(const f32x4*)(A + 3 * 4096 + col + 4);
                u32x4 w; w.x = pk2(v[j][0] * rstd * a0[0] + b0[0], v[j][1] * rstd * a0[1] + b0[1]); w.y = pk2(v[j][2] * rstd * a0[2] + b0[2], v[j][3] * rstd * a0[3] + b0[3]);
                w.z = pk2(v[j][4] * rstd * a1[0] + b1[0], v[j][5] * rstd * a1[1] + b1[1]); w.w = pk2(v[j][6] * rstd * a1[2] + b1[2], v[j][7] * rstd * a1[3] + b1[3]);
                *(u32x4*)(H + (size_t)row * DM + col) = w;
                if (MODE == 0) { u32x4 x; x.x = pk2(v[j][0], v[j][1]); x.y = pk2(v[j][2], v[j][3]); x.z = pk2(v[j][4], v[j][5]); x.w = pk2(v[j][6], v[j][7]);
                    *(u32x4*)(XR + (size_t)row * LDX + col) = x; } }
        }
    }
}
#undef NORM_LOAD

DI void conv3_load(const bf16* Urow, size_t ld, int t, int len, u32x4* r) {
    const u32x4 z = {0u, 0u, 0u, 0u};
    const u32x4* p0 = (const u32x4*)Urow; r[2] = p0[0]; r[3] = p0[1];
    if (t > 0) { const u32x4* p = (const u32x4*)(Urow - ld); r[0] = p[0]; r[1] = p[1]; } else { r[0] = z; r[1] = z; }
    if (t + 1 < len) { const u32x4* p = (const u32x4*)(Urow + ld); r[4] = p[0]; r[5] = p[1]; } else { r[4] = z; r[5] = z; }
}
DI void conv3_calc(const u32x4* r, const LAS float* cw, int cstride, float* o) {
#pragma unroll
    for (int hf = 0; hf < 2; ++hf) { float xm[8], x0[8], xp[8]; unpack8(r[hf], xm); unpack8(r[2 + hf], x0); unpack8(r[4 + hf], xp);
#pragma unroll
        for (int e4 = 0; e4 < 2; ++e4) { const int c = hf * 8 + e4 * 4; const f32x4 w0 = *(const LAS f32x4*)(cw + c), w1 = *(const LAS f32x4*)(cw + cstride + c), w2 = *(const LAS f32x4*)(cw + 2 * cstride + c);
#pragma unroll
            for (int e = 0; e < 4; ++e) o[c + e] = w0[e] * xm[e4 * 4 + e] + w1[e] * x0[e4 * 4 + e] + w2[e] * xp[e4 * 4 + e]; } }
}
#define SCHED_FENCE() __builtin_amdgcn_sched_barrier(0)
DI float wave_scan_incl(float v, int lane) {
#pragma unroll
    for (int o = 1; o < 64; o <<= 1) { const float u = __shfl_up(v, o); if (lane >= o) v += u; }
    return v;
}

DI void gdn_prep_request(const Ctx& F, int c64, int h, u32x4 (&rq_)[6], u32x4 (&rk_)[6], u32x4 (&rv_)[6], unsigned& rgate) {
    const bf16* U = (const bf16*)(F.ws + WS_U);
    const int r0 = c64 * 64, len = r0 < 4096 ? 256 : 4096, t0 = r0 < 4096 ? (r0 & 255) : ((r0 - 4096) & 4095);
    const int i = F.tid >> 3, sub = F.tid & 7, t = t0 + i;
    const bf16* ur = U + (size_t)(r0 + i) * LD_EVEN;
    conv3_load(ur + E_QKV + h * 128 + sub * 16, LD_EVEN, t, len, rq_);
    conv3_load(ur + E_QKV + 2048 + h * 128 + sub * 16, LD_EVEN, t, len, rk_);
    conv3_load(ur + E_QKV + 4096 + h * 128 + sub * 16, LD_EVEN, t, len, rv_);
    rgate = (unsigned)ur[E_BETA + (sub & 1) * 16 + h] | ((unsigned)ur[E_A + (sub & 1) * 16 + h] << 16);
}
DI void gdn_prep_item(const Ctx& F, const float* const* in, int c64, int h, bool stage_cw, u32x4 (&rq_)[6], u32x4 (&rk_)[6], u32x4 (&rv_)[6], unsigned& rgate, float (&gpar)[2], int next_c64) {
    LAS bf16* Q = (LAS bf16*)(F.lds + 0);
    LAS bf16* K = (LAS bf16*)(F.lds + 17408);
    LAS bf16* KT = (LAS bf16*)(F.lds + 34816);
    LAS bf16* VT = (LAS bf16*)(F.lds + 53248);
    LAS float* KKR = (LAS float*)(F.lds + 71680);
    LAS float* QKR = (LAS float*)(F.lds + 89088);
    LAS bf16* NN = (LAS bf16*)(F.lds + 106496);
    LAS float* NDG = (LAS float*)(F.lds + 115712);
    LAS bf16* DBK = (LAS bf16*)(F.lds + 119808);
    LAS bf16* W = (LAS bf16*)(F.lds + 124928);
    LAS float* TBL = (LAS float*)(F.lds + 142336);
    LAS float* CW = TBL + 384;
    constexpr int LDD = 40, LDR = 68;
    const bf16* U = (const bf16*)(F.ws + WS_U);
    const int r0 = c64 * 64, len = r0 < 4096 ? 256 : 4096, t0 = r0 < 4096 ? (r0 & 255) : ((r0 - 4096) & 4095);
    const int lane_o = F.lane, wave = F.wave;
    LDSBAR();
    if (stage_cw) { const int sd = (F.tid & 1); gpar[0] = -expf(in[14][sd * 16 + h]); gpar[1] = in[15][sd * 16 + h]; }
    if (stage_cw) {
        for (int e = F.tid; e < 3 * 384; e += 512) { const int tap = e / 384, c = e % 384; CW[e] = in[13][tap * 6144 + (c >> 7) * 2048 + h * 128 + (c & 127)]; }
        for (int e = F.tid; e < 4 * 16 * LDD / 2; e += 512) ((LAS unsigned*)DBK)[e] = 0u;
        LDSBAR(); }
    int lane = lane_o; asm volatile("" : "+v"(lane)); const int l15 = lane & 15, q4 = lane >> 4;
    { const int i = F.tid >> 3, sub = F.tid & 7;
      const bf16* ur = U + (size_t)(r0 + i) * LD_EVEN;
      SCHED_FENCE();
      { float qv[16]; conv3_calc(rq_, CW + sub * 16, 384, qv); float sq = 0.f;
#pragma unroll
        for (int e = 0; e < 16; ++e) { qv[e] = siluf_(qv[e]); sq += qv[e] * qv[e]; }
        sq += __shfl_xor(sq, 1); sq += __shfl_xor(sq, 2); sq += __shfl_xor(sq, 4);
        const float rq = 0.08838834764831845f * __builtin_amdgcn_rsqf(sq + EPS);
        u32x4 g0, g1; g0.x = pk2(qv[0] * rq, qv[1] * rq); g0.y = pk2(qv[2] * rq, qv[3] * rq); g0.z = pk2(qv[4] * rq, qv[5] * rq); g0.w = pk2(qv[6] * rq, qv[7] * rq);
        g1.x = pk2(qv[8] * rq, qv[9] * rq); g1.y = pk2(qv[10] * rq, qv[11] * rq); g1.z = pk2(qv[12] * rq, qv[13] * rq); g1.w = pk2(qv[14] * rq, qv[15] * rq);
        *(LAS u32x4*)(Q + i * LDQ + sub * 16) = g0; *(LAS u32x4*)(Q + i * LDQ + sub * 16 + 8) = g1;
        u32x4* gq = (u32x4*)((bf16*)(F.ws + WS_GQN) + (size_t)(r0 + i) * 2048 + h * 128 + sub * 16); gq[0] = g0; gq[1] = g1; }
      SCHED_FENCE();
      { float kv[16]; conv3_calc(rk_, CW + 128 + sub * 16, 384, kv); float sk = 0.f;
#pragma unroll
        for (int e = 0; e < 16; ++e) { kv[e] = siluf_(kv[e]); sk += kv[e] * kv[e]; }
        sk += __shfl_xor(sk, 1); sk += __shfl_xor(sk, 2); sk += __shfl_xor(sk, 4);
        const float rk = __builtin_amdgcn_rsqf(sk + EPS);
#pragma unroll
        for (int e = 0; e < 16; ++e) kv[e] *= rk;
#pragma unroll
        for (int e = 0; e < 16; e += 4) st_bf16x4(K + i * LDQ + sub * 16 + e, kv[e], kv[e + 1], kv[e + 2], kv[e + 3]);
#pragma unroll
        for (int e = 0; e < 16; ++e) KT[swz_idx(sub * 16 + e, i)] = f2bf(kv[e]); }
      SCHED_FENCE();
      { float vv[16]; conv3_calc(rv_, CW + 256 + sub * 16, 384, vv);
#pragma unroll
        for (int e = 0; e < 16; ++e) VT[swz_idx(sub * 16 + e, i)] = f2bf(siluf_(vv[e])); }
      SCHED_FENCE();
      if (sub < 2) { const int d = sub; const float braw = bf2f((bf16)(rgate & 0xffffu)), araw = bf2f((bf16)(rgate >> 16));
          const int ii = d ? 63 - i : i;
          TBL[d * 192 + ii] = gpar[0] * softplusf_(araw + gpar[1]); TBL[d * 192 + 64 + ii] = sigmoidf_(braw); } }
    LDSBAR();
    if (wave < 2) TBL[wave * 192 + 128 + lane] = wave_scan_incl(TBL[wave * 192 + lane], lane);
    { bf16* ktg = (bf16*)(F.ws + WS_GKT) + (size_t)h * 128 * NROWS + r0;
#pragma unroll
      for (int k = 0; k < 2; ++k) { const int e = F.tid + 512 * k, row = e >> 3, pc = e & 7;
          *(u32x4*)(ktg + (size_t)row * NROWS + pc * 8) = *(const LAS u32x4*)(KT + row * LDT + ((pc ^ (row >> 4)) & 7) * 8); } }
#pragma unroll
    for (int tt = 0; tt < 2; ++tt) { const int id = 2 * wave + tt, ti = id >> 2, tj = id & 3;
        f32x4 akk = {0.f, 0.f, 0.f, 0.f}, aqk = akk;
#pragma unroll
        for (int ks = 0; ks < 4; ++ks) { const bf16x8 bk = frag_nat(K, LDQ, tj * 16, ks * 32, lane);
            akk = MFMA16(bk, frag_nat(K, LDQ, ti * 16, ks * 32, lane), akk);
            aqk = MFMA16(bk, frag_nat(Q, LDQ, ti * 16, ks * 32, lane), aqk); }
        *(LAS f32x4*)(KKR + (ti * 16 + l15) * LDR + tj * 16 + 4 * q4) = akk; *(LAS f32x4*)(QKR + (ti * 16 + l15) * LDR + tj * 16 + 4 * q4) = aqk; }
    LDSBAR();
#pragma unroll
    for (int d = 0; d < 2; ++d) {
        const size_t item = ((size_t)c64 * 16 + h) * 2 + d;
        const LAS float* TB_ = TBL + d * 192;
        if (d == 1 && next_c64 >= 0) { gdn_prep_request(F, next_c64, h, rq_, rk_, rv_, rgate); }
#pragma unroll
        for (int tt = 0; tt < 2; ++tt) { const int id = 2 * wave + tt, ti = id >> 2, tj = id & 3;
            const int i = ti * 16 + l15, j0 = tj * 16 + 4 * q4;
            f32x4 kk, qk;
            if (d == 0) { kk = *(const LAS f32x4*)(KKR + i * LDR + j0); qk = *(const LAS f32x4*)(QKR + i * LDR + j0); }
            else { const f32x4 a = *(const LAS f32x4*)(KKR + (63 - i) * LDR + 60 - j0), b = *(const LAS f32x4*)(QKR + (63 - i) * LDR + 60 - j0);
                kk = (f32x4){a[3], a[2], a[1], a[0]}; qk = (f32x4){b[3], b[2], b[1], b[0]}; }
            const float gi = TB_[128 + i], bi = TB_[64 + i];
            float nv[4], pv[4];
#pragma unroll
            for (int r = 0; r < 4; ++r) { const int j = j0 + r; const float dec = (i >= j) ? __expf(gi - TB_[128 + j]) : 0.f;
                nv[r] = (i > j) ? bi * kk[r] * dec : 0.f; pv[r] = qk[r] * dec; }
            st_bf16x4(NN + i * LDT + j0, -nv[0], -nv[1], -nv[2], -nv[3]);
            { u32x2 w2; w2.x = pk2(pv[0], pv[1]); w2.y = pk2(pv[2], pv[3]); *(u32x2*)((bf16*)(F.ws + WS_GPP) + (item * 64 + i) * 64 + j0) = w2; }
            if (ti == tj) *(LAS f32x4*)(NDG + (ti * 16 + l15) * 16 + 4 * q4) = (f32x4){nv[0], nv[1], nv[2], nv[3]}; }
        if (wave == 1) ((float*)(F.ws + WS_GGC))[item * 64 + lane] = TB_[128 + lane];
        LDSBAR();
        if (wave == 0) { float x[16];
#pragma unroll
            for (int i = 0; i < 16; ++i) { float sa[4] = {0.f, 0.f, 0.f, 0.f};
                const LAS f32x4* nr = (const LAS f32x4*)(NDG + (q4 * 16 + i) * 16);
#pragma unroll
                for (int k4 = 0; k4 < 4; ++k4) { if (4 * k4 < i) { const f32x4 nvv = nr[k4];
#pragma unroll
                        for (int e = 0; e < 4; ++e) if (4 * k4 + e < i) sa[e] += nvv[e] * x[4 * k4 + e]; } }
                const float a = ((i == l15) ? 1.f : 0.f) - ((sa[0] + sa[1]) + (sa[2] + sa[3]));
                x[i] = a; DBK[(q4 * 16 + i) * LDD + l15] = f2bf(a); } }
        LDSBAR();
        { f32x4 u[4], xw[4]; const f32x4 z4 = {0.f, 0.f, 0.f, 0.f};
#pragma unroll
          for (int b = 0; b < 4; ++b) {
              const f32x4 be = *(const LAS f32x4*)(TB_ + 64 + 16 * b + 4 * q4), gcv = *(const LAS f32x4*)(TB_ + 128 + 16 * b + 4 * q4);
              const int c0 = d ? 60 - 16 * b - 4 * q4 : 16 * b + 4 * q4;
              const bf16x4 vraw = *(const LAS bf16x4*)(VT + swz_idx(16 * wave + l15, c0)), kraw = *(const LAS bf16x4*)(KT + swz_idx(16 * wave + l15, c0));
              f32x4 au, aw;
#pragma unroll
              for (int r = 0; r < 4; ++r) { const int rr = d ? 3 - r : r; au[r] = be[r] * bf2f((bf16)vraw[rr]); aw[r] = be[r] * __expf(gcv[r]) * bf2f((bf16)kraw[rr]); }
              if (b >= 1) { const bf16x8 nf = frag_perm(NN, LDT, 16 * b, 0, lane);
                  au = MFMA16(nf, pack2(u[0], b >= 2 ? u[1] : z4), au); aw = MFMA16(nf, pack2(xw[0], b >= 2 ? xw[1] : z4), aw); }
              if (b == 3) { const bf16x8 nf = frag_perm(NN, LDT, 48, 32, lane);
                  au = MFMA16(nf, pack2(u[2], z4), au); aw = MFMA16(nf, pack2(xw[2], z4), aw); }
              const bf16x8 df = frag_perm(DBK + b * 16 * LDD, LDD, 0, 0, lane);
              u[b] = MFMA16(df, pack2(au, z4), z4); xw[b] = MFMA16(df, pack2(aw, z4), z4);
              { u32x2 w2; w2.x = pk2(u[b][0], u[b][1]); w2.y = pk2(u[b][2], u[b][3]);
                *(u32x2*)((bf16*)(F.ws + WS_GUF) + (((item * 8 + wave) * 4 + b) * 64 + lane) * 4) = w2; }
#pragma unroll
              for (int r = 0; r < 4; ++r) W[(16 * b + 4 * q4 + r) * LDQ + 16 * wave + l15] = f2bf(-xw[b][r]); } }
        LDSBAR();
        { bf16* wg = (bf16*)(F.ws + WS_GWN) + item * 8192;
#pragma unroll
          for (int k = 0; k < 2; ++k) { const int e = F.tid + 512 * k, row = e >> 4, pc = e & 15;
              *(u32x4*)(wg + row * 128 + pc * 8) = *(const LAS u32x4*)(W + row * LDQ + pc * 8); } }
    }
}

#define GDN_SETB 79872
DI void gdn_scan_step(const Ctx& F, f32x4 (&S)[2][8], int set, int ci, int d, int len, int row0, int h, bf16* OUT) {
    const int wave = F.wave;
    int lane = F.lane; asm volatile("" : "+v"(lane)); const int l15 = lane & 15, q4 = lane >> 4;
    LAS bf16* W = (LAS bf16*)(F.lds + set * GDN_SETB); LAS bf16* Q = (LAS bf16*)(F.lds + set * GDN_SETB + 17408); LAS bf16* PB = (LAS bf16*)(F.lds + set * GDN_SETB + 34816);
    LAS bf16* KT = (LAS bf16*)(F.lds + set * GDN_SETB + 44032); LAS float* GC = (LAS float*)(F.lds + set * GDN_SETB + 62464); const LAS bf16* UL = (const LAS bf16*)(F.lds + set * GDN_SETB + 63488);
#define LQ(dst, M, it) do { _Pragma("unroll") for (int i_ = 0; i_ < 4; ++i_) dst[i_] = frag_perm(M, LDQ, (it) * 16, i_ * 32, lane); SCHED_FENCE(); } while (0)
#define LT(dst, M, t0) do { _Pragma("unroll") for (int i_ = 0; i_ < 4; ++i_) dst[i_] = frag_perm(M, LDT, ((t0) + (i_ >> 1)) * 16, (i_ & 1) * 32, lane); SCHED_FENCE(); } while (0)
#define CVN(X, it) do { _Pragma("unroll") for (int ks = 0; ks < 4; ++ks) { vn[0][it] = MFMA16(X[ks], Sp[0][ks], vn[0][it]); vn[1][it] = MFMA16(X[ks], Sp[1][ks], vn[1][it]); } SCHED_FENCE(); } while (0)
#define CO(X, j) do { _Pragma("unroll") for (int ks = 0; ks < 4; ++ks) { o[0][j] = MFMA16(Sp[0][ks], X[ks], o[0][j]); o[1][j] = MFMA16(Sp[1][ks], X[ks], o[1][j]); } SCHED_FENCE(); } while (0)
#define CS(X, t0) do { _Pragma("unroll") for (int ks = 0; ks < 2; ++ks) _Pragma("unroll") for (int j = 0; j < 2; ++j) { S[0][(t0) + j] = MFMA16(X[j * 2 + ks], V2p[0][ks], S[0][(t0) + j]); S[1][(t0) + j] = MFMA16(X[j * 2 + ks], V2p[1][ks], S[1][(t0) + j]); } SCHED_FENCE(); } while (0)
#define CPV(X, it0) do { _Pragma("unroll") for (int j = 0; j < 2; ++j) { const float eg = __expf(GC[((it0) + j) * 16 + l15]); o[0][j] = o[0][j] * eg; o[1][j] = o[1][j] * eg; } \
        _Pragma("unroll") for (int ks = 0; ks < 2; ++ks) _Pragma("unroll") for (int j = 0; j < 2; ++j) { o[0][j] = MFMA16(Vp[0][ks], X[j * 2 + ks], o[0][j]); o[1][j] = MFMA16(Vp[1][ks], X[j * 2 + ks], o[1][j]); } \
        _Pragma("unroll") for (int j = 0; j < 2; ++j) { const int i = ((it0) + j) * 16 + l15; const int tl = ci * 64 + i, t = d ? (len - 1 - tl) : tl; bf16* op = OUT + (size_t)(row0 + t) * 2048 + h * 128 + 32 * wave + 4 * q4; \
            u32x2 w2; w2.x = pk2(o[0][j][0], o[0][j][1]); w2.y = pk2(o[0][j][2], o[0][j][3]); *(u32x2*)op = w2; w2.x = pk2(o[1][j][0], o[1][j][1]); w2.y = pk2(o[1][j][2], o[1][j][3]); *(u32x2*)(op + 16) = w2; \
            o[0][j] = (f32x4){0.f, 0.f, 0.f, 0.f}; o[1][j] = (f32x4){0.f, 0.f, 0.f, 0.f}; } SCHED_FENCE(); } while (0)
    bf16x8 X0[4], X1[4], X2[4];
    f32x4 vn[2][4];
#pragma unroll
    for (int x = 0; x < 2; ++x)
#pragma unroll
        for (int b = 0; b < 4; ++b) { const u32x2 ur = *(const LAS u32x2*)(UL + (((2 * wave + x) * 4 + b) * 64 + lane) * 4);
            vn[x][b][0] = __uint_as_float(ur.x << 16); vn[x][b][1] = __uint_as_float(ur.x & 0xffff0000u); vn[x][b][2] = __uint_as_float(ur.y << 16); vn[x][b][3] = __uint_as_float(ur.y & 0xffff0000u); }
    const float gl = GC[63];
    LQ(X0, W, 0); LQ(X1, W, 1);
    bf16x8 Sp[2][4];
#pragma unroll
    for (int x = 0; x < 2; ++x)
#pragma unroll
        for (int ks = 0; ks < 4; ++ks) Sp[x][ks] = pack2(S[x][2 * ks], S[x][2 * ks + 1]);
    SCHED_FENCE();
    LQ(X2, W, 2); CVN(X0, 0);
    LQ(X0, W, 3); CVN(X1, 1);
    LQ(X1, Q, 0); CVN(X2, 2);
    LQ(X2, Q, 1); CVN(X0, 3);
    bf16x8 Vp[2][2], V2p[2][2];
#pragma unroll
    for (int ks = 0; ks < 2; ++ks) { float e0[4], e1[4];
#pragma unroll
        for (int r = 0; r < 4; ++r) { e0[r] = __expf(gl - GC[(2 * ks) * 16 + 4 * q4 + r]); e1[r] = __expf(gl - GC[(2 * ks + 1) * 16 + 4 * q4 + r]); }
#pragma unroll
        for (int x = 0; x < 2; ++x) { Vp[x][ks] = pack2(vn[x][2 * ks], vn[x][2 * ks + 1]);
            f32x4 a, b;
#pragma unroll
            for (int r = 0; r < 4; ++r) { a[r] = vn[x][2 * ks][r] * e0[r]; b[r] = vn[x][2 * ks + 1][r] * e1[r]; }
            V2p[x][ks] = pack2(a, b); } }
    const float egl = __expf(gl);
    SCHED_FENCE();
    f32x4 o[2][2];
#pragma unroll
    for (int x = 0; x < 2; ++x)
#pragma unroll
        for (int j = 0; j < 2; ++j) o[x][j] = (f32x4){0.f, 0.f, 0.f, 0.f};
    LT(X0, PB, 0); CO(X1, 0);
    LQ(X1, Q, 2); CO(X2, 1);
    LQ(X2, Q, 3); CPV(X0, 0);
    LT(X0, PB, 2); CO(X1, 0);
    LT(X1, KT, 0); CO(X2, 1);
    LT(X2, KT, 2); CPV(X0, 2);
#pragma unroll
    for (int x = 0; x < 2; ++x)
#pragma unroll
        for (int t = 0; t < 8; ++t) S[x][t] = S[x][t] * egl;
    SCHED_FENCE();
    LT(X0, KT, 4); CS(X1, 0);
    LT(X1, KT, 6); CS(X2, 2);
    CS(X0, 4); CS(X1, 6);
#undef LQ
#undef LT
#undef CVN
#undef CO
#undef CS
#undef CPV
}
DI void gdn_scan_item(const Ctx& F, const float* const* in, int s, int h, int d) {
    constexpr int SETB = GDN_SETB;
    const int row0 = seq_row0(s), len = seq_len(s), nch = len >> 6, c640 = row0 >> 6;
    const int lane_o = F.lane, wave = F.wave;
    bf16* OUT = (bf16*)(F.ws + (d ? WS_OBA : WS_OFA));
    const bf16* GWN = (const bf16*)(F.ws + WS_GWN); const bf16* GUF = (const bf16*)(F.ws + WS_GUF); const bf16* GPP = (const bf16*)(F.ws + WS_GPP);
    const float* GGC = (const float*)(F.ws + WS_GGC); const bf16* GQN = (const bf16*)(F.ws + WS_GQN); const bf16* GKT = (const bf16*)(F.ws + WS_GKT) + (size_t)h * 128 * NROWS;
    LDSBAR();
    if (wave >= 4) {
        struct Pre { u32x4 w[4], q[4], p[2], k[4], u[4]; float g; };
        Pre PA, PB_;
        const int e = F.tid - 256, er = e >> 2, eq = e & 3;
#define GDN_ISSUE(ci_, P_) do { const int cc = c640 + (d ? nch - 1 - (ci_) : (ci_)); const size_t item = ((size_t)cc * 16 + h) * 2 + d; \
        const u32x4* wsrc = (const u32x4*)(GWN + item * 8192 + er * 128 + eq * 32); \
        const int qrow = cc * 64 + (d ? 63 - er : er); const u32x4* qsrc = (const u32x4*)(GQN + (size_t)qrow * 2048 + h * 128 + eq * 32); \
        _Pragma("unroll") for (int m_ = 0; m_ < 4; ++m_) { P_.w[m_] = wsrc[m_]; P_.q[m_] = qsrc[m_]; } \
        const u32x4* psrc = (const u32x4*)(GPP + item * 4096 + er * 64 + eq * 16); P_.p[0] = psrc[0]; P_.p[1] = psrc[1]; \
        const u32x4* k0src = (const u32x4*)(GKT + (size_t)er * NROWS + cc * 64 + eq * 16); const u32x4* k1src = (const u32x4*)(GKT + (size_t)(64 + er) * NROWS + cc * 64 + eq * 16); \
        P_.k[0] = k0src[0]; P_.k[1] = k0src[1]; P_.k[2] = k1src[0]; P_.k[3] = k1src[1]; \
        const u32x4* usrc = (const u32x4*)(GUF + item * 8192) + e; _Pragma("unroll") for (int m_ = 0; m_ < 4; ++m_) P_.u[m_] = usrc[m_ * 256]; \
        P_.g = (e < 64) ? GGC[item * 64 + e] : 0.f; } while (0)
#define REV8(w_) ((u32x4){((w_).w >> 16) | ((w_).w << 16), ((w_).z >> 16) | ((w_).z << 16), ((w_).y >> 16) | ((w_).y << 16), ((w_).x >> 16) | ((w_).x << 16)})
#define GDN_COMMIT(set_, P_) do { LAS unsigned char* base = F.lds + (set_) * SETB; \
        _Pragma("unroll") for (int m_ = 0; m_ < 4; ++m_) { *(LAS u32x4*)((LAS bf16*)base + er * LDQ + eq * 32 + m_ * 8) = P_.w[m_]; *(LAS u32x4*)((LAS bf16*)(base + 17408) + er * LDQ + eq * 32 + m_ * 8) = P_.q[m_]; } \
        *(LAS u32x4*)((LAS bf16*)(base + 34816) + er * LDT + eq * 16) = P_.p[0]; *(LAS u32x4*)((LAS bf16*)(base + 34816) + er * LDT + eq * 16 + 8) = P_.p[1]; \
        if (d == 0) { *(LAS u32x4*)((LAS bf16*)(base + 44032) + er * LDT + eq * 16) = P_.k[0]; *(LAS u32x4*)((LAS bf16*)(base + 44032) + er * LDT + eq * 16 + 8) = P_.k[1]; \
            *(LAS u32x4*)((LAS bf16*)(base + 44032) + (64 + er) * LDT + eq * 16) = P_.k[2]; *(LAS u32x4*)((LAS bf16*)(base + 44032) + (64 + er) * LDT + eq * 16 + 8) = P_.k[3]; } \
        else { *(LAS u32x4*)((LAS bf16*)(base + 44032) + er * LDT + (3 - eq) * 16 + 8) = REV8(P_.k[0]); *(LAS u32x4*)((LAS bf16*)(base + 44032) + er * LDT + (3 - eq) * 16) = REV8(P_.k[1]); \
            *(LAS u32x4*)((LAS bf16*)(base + 44032) + (64 + er) * LDT + (3 - eq) * 16 + 8) = REV8(P_.k[2]); *(LAS u32x4*)((LAS bf16*)(base + 44032) + (64 + er) * LDT + (3 - eq) * 16) = REV8(P_.k[3]); } \
        _Pragma("unroll") for (int m_ = 0; m_ < 4; ++m_) *((LAS u32x4*)(base + 63488) + e + m_ * 256) = P_.u[m_]; \
        if (e < 64) ((LAS float*)(base + 62464))[e] = P_.g; } while (0)
        GDN_ISSUE(0, PA); GDN_ISSUE(1, PB_);
#pragma unroll 1
        for (int ci = 0; ci < nch; ci += 2) {
            GDN_COMMIT(0, PA); LDSBAR(); if (ci + 2 < nch) GDN_ISSUE(ci + 2, PA);
            GDN_COMMIT(1, PB_); LDSBAR(); if (ci + 3 < nch) GDN_ISSUE(ci + 3, PB_); }
#undef GDN_ISSUE
#undef GDN_COMMIT
#undef REV8
    } else {
        f32x4 S[2][8];
        if (s >= 16) { int ln = lane_o; asm volatile("" : "+v"(ln)); const int l15 = ln & 15, q4 = ln >> 4; const float* sp = in[2] + ((size_t)((s - 16) * 2 + d) * 16 + h) * 16384;
#pragma unroll
            for (int x = 0; x < 2; ++x)
#pragma unroll
                for (int t = 0; t < 8; ++t)
#pragma unroll
                    for (int r = 0; r < 4; ++r) S[x][t][r] = sp[(size_t)(16 * t + 4 * q4 + r) * 128 + 32 * wave + 16 * x + l15];
        } else {
#pragma unroll
            for (int x = 0; x < 2; ++x)
#pragma unroll
                for (int t = 0; t < 8; ++t) S[x][t] = (f32x4){0.f, 0.f, 0.f, 0.f}; }
#pragma unroll 1
        for (int ci = 0; ci < nch; ci += 2) { LDSBAR(); gdn_scan_step(F, S, 0, ci, d, len, row0, h, OUT); LDSBAR(); gdn_scan_step(F, S, 1, ci + 1, d, len, row0, h, OUT); }
        if (s < 16) { int ln = lane_o; asm volatile("" : "+v"(ln)); const int l15 = ln & 15, q4 = ln >> 4; float* sp = F.out + OUT_SG + ((size_t)(s * 2 + d) * 16 + h) * 16384;
#pragma unroll
            for (int x = 0; x < 2; ++x)
#pragma unroll
                for (int t = 0; t < 8; ++t)
#pragma unroll
                    for (int r = 0; r < 4; ++r) sp[(size_t)(16 * t + 4 * q4 + r) * 128 + 32 * wave + 16 * x + l15] = S[x][t][r]; }
    }
}

DI void ssd_prep_request(const Ctx& F, int c64, int g, u32x4 (&rx0)[6], u32x4 (&rx1)[6], u32x4 (&rb_)[6], u32x4 (&rc_)[6], unsigned& rdt) {
    const bf16* U = (const bf16*)(F.ws + WS_U);
    const int r0 = c64 * 64, len = r0 < 4096 ? 256 : 4096, t0 = r0 < 4096 ? (r0 & 255) : ((r0 - 4096) & 4095);
    const int i = F.tid >> 3, sub = F.tid & 7, t = t0 + i;
    const bf16* ur = U + (size_t)(r0 + i) * LD_EVEN;
    conv3_load(ur + E_XBC + g * 256 + sub * 32, LD_EVEN, t, len, rx0);
    conv3_load(ur + E_XBC + g * 256 + sub * 32 + 16, LD_EVEN, t, len, rx1);
    conv3_load(ur + E_XBC + 2048 + g * 128 + sub * 16, LD_EVEN, t, len, rb_);
    conv3_load(ur + E_XBC + 3072 + g * 128 + sub * 16, LD_EVEN, t, len, rc_);
    rdt = (unsigned)ur[E_DT + (sub >> 2) * 32 + g * 4 + (sub & 3)];
}
DI void ssd_prep_item(const Ctx& F, const float* const* in, int c64, int g, bool stage_cw, u32x4 (&rx0)[6], u32x4 (&rx1)[6], u32x4 (&rb_)[6], u32x4 (&rc_)[6], unsigned& rdt, float (&spar)[2], int next_c64, int next_g) {
    LAS bf16* C = (LAS bf16*)(F.lds + 0);
    LAS bf16* B = (LAS bf16*)(F.lds + 17408);
    LAS bf16* BT = (LAS bf16*)(F.lds + 34816);
    LAS bf16* XT = (LAS bf16*)(F.lds + 53248);
    LAS float* CBR = (LAS float*)(F.lds + 90112);
    LAS float* TBL = (LAS float*)(F.lds + 107520);
    LAS float* CW = TBL + 8 * 192;
    constexpr int LDR = 68;
    const bf16* U = (const bf16*)(F.ws + WS_U);
    const int r0 = c64 * 64, len = r0 < 4096 ? 256 : 4096, t0 = r0 < 4096 ? (r0 & 255) : ((r0 - 4096) & 4095);
    const int lane_o = F.lane, wave = F.wave;
    LDSBAR();
    if (stage_cw) { const int sd = (F.tid & 7) >> 2, shd = g * 4 + (F.tid & 3); spar[0] = -expf(in[18][sd * 32 + shd]); spar[1] = in[19][sd * 32 + shd]; }
    if (stage_cw) {
        for (int e = F.tid; e < 3 * 512; e += 512) { const int tap = e >> 9, c = e & 511; const int col = c < 256 ? g * 256 + c : (c < 384 ? 2048 + g * 128 + (c - 256) : 3072 + g * 128 + (c - 384)); CW[e] = in[17][tap * 4096 + col]; }
        LDSBAR(); }
    int lane = lane_o; asm volatile("" : "+v"(lane)); const int l15 = lane & 15, q4 = lane >> 4;
    { const int i = F.tid >> 3, sub = F.tid & 7; const int t = t0 + i;
      const bf16* ur = U + (size_t)(r0 + i) * LD_EVEN;
      SCHED_FENCE();
      { float xv[16]; conv3_calc(rx0, CW + sub * 32, 512, xv);
#pragma unroll
        for (int e = 0; e < 16; ++e) XT[swz_idx((sub >> 1) * 64 + (sub & 1) * 32 + e, i)] = f2bf(siluf_(xv[e])); }
      SCHED_FENCE();
      { float xv[16]; conv3_calc(rx1, CW + sub * 32 + 16, 512, xv);
#pragma unroll
        for (int e = 0; e < 16; ++e) XT[swz_idx((sub >> 1) * 64 + (sub & 1) * 32 + 16 + e, i)] = f2bf(siluf_(xv[e])); }
      SCHED_FENCE();
      { float bv[16]; conv3_calc(rb_, CW + 256 + sub * 16, 512, bv);
#pragma unroll
        for (int e = 0; e < 16; ++e) bv[e] = siluf_(bv[e]);
#pragma unroll
        for (int e = 0; e < 16; e += 4) st_bf16x4(B + i * LDQ + sub * 16 + e, bv[e], bv[e + 1], bv[e + 2], bv[e + 3]);
#pragma unroll
        for (int e = 0; e < 16; ++e) BT[swz_idx(sub * 16 + e, i)] = f2bf(bv[e]); }
      SCHED_FENCE();
      { float cv[16]; conv3_calc(rc_, CW + 384 + sub * 16, 512, cv);
        u32x4 g0, g1; g0.x = pk2(siluf_(cv[0]), siluf_(cv[1])); g0.y = pk2(siluf_(cv[2]), siluf_(cv[3])); g0.z = pk2(siluf_(cv[4]), siluf_(cv[5])); g0.w = pk2(siluf_(cv[6]), siluf_(cv[7]));
        g1.x = pk2(siluf_(cv[8]), siluf_(cv[9])); g1.y = pk2(siluf_(cv[10]), siluf_(cv[11])); g1.z = pk2(siluf_(cv[12]), siluf_(cv[13])); g1.w = pk2(siluf_(cv[14]), siluf_(cv[15]));
        *(LAS u32x4*)(C + i * LDQ + sub * 16) = g0; *(LAS u32x4*)(C + i * LDQ + sub * 16 + 8) = g1;
        u32x4* gc_ = (u32x4*)((bf16*)(F.ws + WS_SCN) + (size_t)(r0 + i) * 1024 + g * 128 + sub * 16); gc_[0] = g0; gc_[1] = g1; }
      SCHED_FENCE();
      { const int d = sub >> 2, hx = sub & 3, hd = g * 4 + hx, ii = d ? 63 - i : i;
        const float dt = softplusf_(bf2f((bf16)(rdt & 0xffffu)) + spar[1]);
        TBL[sub * 192 + ii] = spar[0] * dt; TBL[sub * 192 + 128 + ii] = dt; } }
    if (next_c64 >= 0) ssd_prep_request(F, next_c64, next_g, rx0, rx1, rb_, rc_, rdt);
    LDSBAR();
    TBL[wave * 192 + 64 + lane] = wave_scan_incl(TBL[wave * 192 + lane], lane);
    { bf16* btg = (bf16*)(F.ws + WS_SBT) + (size_t)g * 128 * NROWS + r0;
#pragma unroll
      for (int k = 0; k < 2; ++k) { const int e = F.tid + 512 * k, row = e >> 3, pc = e & 7;
          *(u32x4*)(btg + (size_t)row * NROWS + pc * 8) = *(const LAS u32x4*)(BT + row * LDT + ((pc ^ (row >> 4)) & 7) * 8); } }
#pragma unroll
    for (int k = 0; k < 8; ++k) { const int e = F.tid + 512 * k, pc = e & 7, row = (e >> 3) & 63, hx = (e >> 9) & 3, d = e >> 11;
        const u32x4 raw = *(const LAS u32x4*)(XT + (hx * 64 + row) * LDT + ((pc ^ ((hx * 64 + row) >> 4)) & 7) * 8); float f[8]; unpack8(raw, f);
        const LAS float* dtp = TBL + (d * 4 + hx) * 192 + 128;
        u32x4 o;
        if (d == 0) { const f32x4 d0 = *(const LAS f32x4*)(dtp + pc * 8), d1 = *(const LAS f32x4*)(dtp + pc * 8 + 4);
            o.x = pk2(f[0] * d0[0], f[1] * d0[1]); o.y = pk2(f[2] * d0[2], f[3] * d0[3]); o.z = pk2(f[4] * d1[0], f[5] * d1[1]); o.w = pk2(f[6] * d1[2], f[7] * d1[3]); }
        else { const f32x4 d0 = *(const LAS f32x4*)(dtp + 56 - pc * 8), d1 = *(const LAS f32x4*)(dtp + 60 - pc * 8);
            o.x = pk2(f[0] * d1[3], f[1] * d1[2]); o.y = pk2(f[2] * d1[1], f[3] * d1[0]); o.z = pk2(f[4] * d0[3], f[5] * d0[2]); o.w = pk2(f[6] * d0[1], f[7] * d0[0]); }
        *(u32x4*)((bf16*)(F.ws + WS_SVT) + ((size_t)((g * 4 + hx) * 2 + d) * 64 + row) * NROWS + r0 + pc * 8) = o; }
#pragma unroll
    for (int tt = 0; tt < 2; ++tt) { const int id = 2 * wave + tt, ti = id >> 2, tj = id & 3;
        f32x4 cb = {0.f, 0.f, 0.f, 0.f};
#pragma unroll
        for (int ks = 0; ks < 4; ++ks) cb = MFMA16(frag_nat(B, LDQ, tj * 16, ks * 32, lane), frag_nat(C, LDQ, ti * 16, ks * 32, lane), cb);
        *(LAS f32x4*)(CBR + (ti * 16 + l15) * LDR + tj * 16 + 4 * q4) = cb; }
    LDSBAR();
    { const int d = wave >> 2, hx = wave & 3; const size_t item = ((size_t)c64 * 32 + g * 4 + hx) * 2 + d;
      const LAS float* gcp = TBL + wave * 192 + 64; const float gi = gcp[lane];
      ((float*)(F.ws + WS_SSG))[item * 64 + lane] = gi;
      const LAS float* crow = CBR + (d ? 63 - lane : lane) * LDR;
      bf16* pg = (bf16*)(F.ws + WS_SSP) + (item * 64 + lane) * 64;
#pragma unroll
      for (int j8 = 0; j8 < 8; ++j8) { float pv[8];
          f32x4 c0, c1;
          if (d == 0) { c0 = *(const LAS f32x4*)(crow + j8 * 8); c1 = *(const LAS f32x4*)(crow + j8 * 8 + 4); }
          else { const f32x4 a0 = *(const LAS f32x4*)(crow + 60 - j8 * 8), a1 = *(const LAS f32x4*)(crow + 56 - j8 * 8); c0 = (f32x4){a0[3], a0[2], a0[1], a0[0]}; c1 = (f32x4){a1[3], a1[2], a1[1], a1[0]}; }
          const f32x4 g0 = *(const LAS f32x4*)(gcp + j8 * 8), g1 = *(const LAS f32x4*)(gcp + j8 * 8 + 4);
#pragma unroll
          for (int e = 0; e < 4; ++e) { const int j = j8 * 8 + e; pv[e] = (lane >= j) ? c0[e] * __expf(gi - g0[e]) : 0.f; pv[4 + e] = (lane >= j + 4) ? c1[e] * __expf(gi - g1[e]) : 0.f; }
          u32x4 o; o.x = pk2(pv[0], pv[1]); o.y = pk2(pv[2], pv[3]); o.z = pk2(pv[4], pv[5]); o.w = pk2(pv[6], pv[7]);
          *(u32x4*)(pg + j8 * 8) = o; } }
}

#define SSD_SETB 73728
DI void ssd_scan_step(const Ctx& F, f32x4 (&S)[2][8], int set, int ci, int d, int len, int row0, int head0, bf16* OUT) {
    const int pq = F.wave;
    int lane = F.lane; asm volatile("" : "+v"(lane)); const int l15 = lane & 15, q4 = lane >> 4;
    LAS unsigned char* base = F.lds + set * SSD_SETB;
    LAS bf16* C = (LAS bf16*)base; LAS bf16* BT = (LAS bf16*)(base + 17408); LAS bf16* PH = (LAS bf16*)(base + 35840); LAS bf16* VT = (LAS bf16*)(base + 54272);
    LAS float* GC = (LAS float*)(base + 72704);
#define LC(dst, it) do { _Pragma("unroll") for (int i_ = 0; i_ < 4; ++i_) dst[i_] = frag_perm(C, LDQ, (it) * 16, i_ * 32, lane); SCHED_FENCE(); } while (0)
#define LP(dst, it) do { _Pragma("unroll") for (int i_ = 0; i_ < 4; ++i_) dst[i_] = frag_nat(PH + (i_ >> 1) * 4608, LDT, (it) * 16, (i_ & 1) * 32, lane); SCHED_FENCE(); } while (0)
#define LB(dst, t0) do { _Pragma("unroll") for (int i_ = 0; i_ < 4; ++i_) dst[i_] = frag_nat(BT, LDT, ((t0) + (i_ >> 1)) * 16, (i_ & 1) * 32, lane); SCHED_FENCE(); } while (0)
#define CY(X, it) do { y[0] = (f32x4){0.f, 0.f, 0.f, 0.f}; y[1] = y[0]; _Pragma("unroll") for (int ks = 0; ks < 4; ++ks) { y[0] = MFMA16(Sp[0][ks], X[ks], y[0]); y[1] = MFMA16(Sp[1][ks], X[ks], y[1]); } \
        y[0] = y[0] * __expf(GC[(it) * 16 + l15]); y[1] = y[1] * __expf(GC[64 + (it) * 16 + l15]); SCHED_FENCE(); } while (0)
#define CP(X, it) do { _Pragma("unroll") for (int ks = 0; ks < 2; ++ks) { y[0] = MFMA16(VF[0][ks], X[ks], y[0]); y[1] = MFMA16(VF[1][ks], X[2 + ks], y[1]); } \
        { const int i = (it) * 16 + l15; const int tl = ci * 64 + i, t = d ? (len - 1 - tl) : tl; bf16* op = OUT + (size_t)(row0 + t) * 2048 + head0 * 64 + 16 * pq + 4 * q4; \
          u32x2 w2; w2.x = pk2(y[0][0], y[0][1]); w2.y = pk2(y[0][2], y[0][3]); *(u32x2*)op = w2; w2.x = pk2(y[1][0], y[1][1]); w2.y = pk2(y[1][2], y[1][3]); *(u32x2*)(op + 64) = w2; } SCHED_FENCE(); } while (0)
#define CS(X, t0) do { _Pragma("unroll") for (int ks = 0; ks < 2; ++ks) _Pragma("unroll") for (int j = 0; j < 2; ++j) { S[0][(t0) + j] = MFMA16(X[j * 2 + ks], V2[0][ks], S[0][(t0) + j]); S[1][(t0) + j] = MFMA16(X[j * 2 + ks], V2[1][ks], S[1][(t0) + j]); } SCHED_FENCE(); } while (0)
    bf16x8 X0[4], X1[4], X2[4];
    bf16x8 VF[2][2];
#pragma unroll
    for (int x = 0; x < 2; ++x)
#pragma unroll
        for (int ks = 0; ks < 2; ++ks) VF[x][ks] = frag_nat(VT + x * 4608, LDT, 16 * pq, ks * 32, lane);
    const float gl0 = GC[63], gl1 = GC[127];
    LC(X0, 0); LP(X1, 0);
    bf16x8 Sp[2][4];
#pragma unroll
    for (int x = 0; x < 2; ++x)
#pragma unroll
        for (int ks = 0; ks < 4; ++ks) Sp[x][ks] = pack2(S[x][2 * ks], S[x][2 * ks + 1]);
    bf16x8 V2[2][2];
#pragma unroll
    for (int x = 0; x < 2; ++x) { const float gl = x ? gl1 : gl0;
#pragma unroll
        for (int ks = 0; ks < 2; ++ks) { float f[8]; unpack8(__builtin_bit_cast(u32x4, VF[x][ks]), f);
            const f32x4 g0 = *(const LAS f32x4*)(GC + x * 64 + ks * 32 + 8 * q4), g1 = *(const LAS f32x4*)(GC + x * 64 + ks * 32 + 8 * q4 + 4);
            u32x4 w; w.x = pk2(f[0] * __expf(gl - g0[0]), f[1] * __expf(gl - g0[1])); w.y = pk2(f[2] * __expf(gl - g0[2]), f[3] * __expf(gl - g0[3]));
            w.z = pk2(f[4] * __expf(gl - g1[0]), f[5] * __expf(gl - g1[1])); w.w = pk2(f[6] * __expf(gl - g1[2]), f[7] * __expf(gl - g1[3]));
            V2[x][ks] = __builtin_bit_cast(bf16x8, w); } }
    const float egl0 = __expf(gl0), egl1 = __expf(gl1);
    SCHED_FENCE();
    f32x4 y[2];
    LC(X2, 1); CY(X0, 0);
    LP(X0, 1); CP(X1, 0);
    LC(X1, 2); CY(X2, 1);
    LP(X2, 2); CP(X0, 1);
    LC(X0, 3); CY(X1, 2);
    LP(X1, 3); CP(X2, 2);
    LB(X2, 0); CY(X0, 3);
    LB(X0, 2); CP(X1, 3);
#pragma unroll
    for (int t = 0; t < 8; ++t) { S[0][t] = S[0][t] * egl0; S[1][t] = S[1][t] * egl1; }
    SCHED_FENCE();
    LB(X1, 4); CS(X2, 0);
    LB(X2, 6); CS(X0, 2);
    CS(X1, 4); CS(X2, 6);
#undef LC
#undef LP
#undef LB
#undef CY
#undef CP
#undef CS
}
DI void ssd_scan_item(const Ctx& F, const float* const* in, int s, int g, int d, int hp) {
    constexpr int SETB = SSD_SETB;
    const int row0 = seq_row0(s), len = seq_len(s), nch = len >> 6, c640 = row0 >> 6;
    const int lane_o = F.lane, wave = F.wave;
    const int head0 = g * 4 + hp * 2;
    bf16* OUT = (bf16*)(F.ws + (d ? WS_OBB : WS_OFB));
    const bf16* SCN = (const bf16*)(F.ws + WS_SCN); const bf16* SBT = (const bf16*)(F.ws + WS_SBT) + (size_t)g * 128 * NROWS;
    const bf16* SVT = (const bf16*)(F.ws + WS_SVT); const bf16* SSP = (const bf16*)(F.ws + WS_SSP); const float* SSG = (const float*)(F.ws + WS_SSG);
    LDSBAR();
    if (wave >= 4) {
        struct Pre { u32x4 c[4], b[4], p[4], v[4]; float g; };
        Pre PA, PB_;
        const int e = F.tid - 256, er = e >> 2, eq = e & 3;
#define REV8(w_) ((u32x4){((w_).w >> 16) | ((w_).w << 16), ((w_).z >> 16) | ((w_).z << 16), ((w_).y >> 16) | ((w_).y << 16), ((w_).x >> 16) | ((w_).x << 16)})
#define SSD_ISSUE(ci_, P_) do { const int cc = c640 + (d ? nch - 1 - (ci_) : (ci_)); \
        const int crow = cc * 64 + (d ? 63 - er : er); const u32x4* csrc = (const u32x4*)(SCN + (size_t)crow * 1024 + g * 128 + eq * 32); \
        _Pragma("unroll") for (int m_ = 0; m_ < 4; ++m_) P_.c[m_] = csrc[m_]; \
        const u32x4* b0src = (const u32x4*)(SBT + (size_t)er * NROWS + cc * 64 + eq * 16); const u32x4* b1src = (const u32x4*)(SBT + (size_t)(64 + er) * NROWS + cc * 64 + eq * 16); \
        P_.b[0] = b0src[0]; P_.b[1] = b0src[1]; P_.b[2] = b1src[0]; P_.b[3] = b1src[1]; \
        const size_t it0 = ((size_t)cc * 32 + head0) * 2 + d, it1 = it0 + 2; \
        const u32x4* p0src = (const u32x4*)(SSP + (it0 * 64 + er) * 64 + eq * 16); const u32x4* p1src = (const u32x4*)(SSP + (it1 * 64 + er) * 64 + eq * 16); \
        P_.p[0] = p0src[0]; P_.p[1] = p0src[1]; P_.p[2] = p1src[0]; P_.p[3] = p1src[1]; \
        const u32x4* v0src = (const u32x4*)(SVT + ((size_t)(head0 * 2 + d) * 64 + er) * NROWS + cc * 64 + eq * 16); const u32x4* v1src = (const u32x4*)(SVT + ((size_t)((head0 + 1) * 2 + d) * 64 + er) * NROWS + cc * 64 + eq * 16); \
        P_.v[0] = v0src[0]; P_.v[1] = v0src[1]; P_.v[2] = v1src[0]; P_.v[3] = v1src[1]; \
        P_.g = 0.f; if (e < 128) P_.g = SSG[((e < 64) ? it0 : it1) * 64 + (e & 63)]; } while (0)
#define SSD_COMMIT(set_, P_) do { LAS unsigned char* base = F.lds + (set_) * SETB; \
        _Pragma("unroll") for (int m_ = 0; m_ < 4; ++m_) *(LAS u32x4*)((LAS bf16*)base + er * LDQ + eq * 32 + m_ * 8) = P_.c[m_]; \
        *(LAS u32x4*)((LAS bf16*)(base + 35840) + er * LDT + eq * 16) = P_.p[0]; *(LAS u32x4*)((LAS bf16*)(base + 35840) + er * LDT + eq * 16 + 8) = P_.p[1]; \
        *(LAS u32x4*)((LAS bf16*)(base + 45056) + er * LDT + eq * 16) = P_.p[2]; *(LAS u32x4*)((LAS bf16*)(base + 45056) + er * LDT + eq * 16 + 8) = P_.p[3]; \
        if (d == 0) { *(LAS u32x4*)((LAS bf16*)(base + 17408) + er * LDT + eq * 16) = P_.b[0]; *(LAS u32x4*)((LAS bf16*)(base + 17408) + er * LDT + eq * 16 + 8) = P_.b[1]; \
            *(LAS u32x4*)((LAS bf16*)(base + 17408) + (64 + er) * LDT + eq * 16) = P_.b[2]; *(LAS u32x4*)((LAS bf16*)(base + 17408) + (64 + er) * LDT + eq * 16 + 8) = P_.b[3]; \
            *(LAS u32x4*)((LAS bf16*)(base + 54272) + er * LDT + eq * 16) = P_.v[0]; *(LAS u32x4*)((LAS bf16*)(base + 54272) + er * LDT + eq * 16 + 8) = P_.v[1]; \
            *(LAS u32x4*)((LAS bf16*)(base + 63488) + er * LDT + eq * 16) = P_.v[2]; *(LAS u32x4*)((LAS bf16*)(base + 63488) + er * LDT + eq * 16 + 8) = P_.v[3]; } \
        else { *(LAS u32x4*)((LAS bf16*)(base + 17408) + er * LDT + (3 - eq) * 16 + 8) = REV8(P_.b[0]); *(LAS u32x4*)((LAS bf16*)(base + 17408) + er * LDT + (3 - eq) * 16) = REV8(P_.b[1]); \
            *(LAS u32x4*)((LAS bf16*)(base + 17408) + (64 + er) * LDT + (3 - eq) * 16 + 8) = REV8(P_.b[2]); *(LAS u32x4*)((LAS bf16*)(base + 17408) + (64 + er) * LDT + (3 - eq) * 16) = REV8(P_.b[3]); \
            *(LAS u32x4*)((LAS bf16*)(base + 54272) + er * LDT + (3 - eq) * 16 + 8) = REV8(P_.v[0]); *(LAS u32x4*)((LAS bf16*)(base + 54272) + er * LDT + (3 - eq) * 16) = REV8(P_.v[1]); \
            *(LAS u32x4*)((LAS bf16*)(base + 63488) + er * LDT + (3 - eq) * 16 + 8) = REV8(P_.v[2]); *(LAS u32x4*)((LAS bf16*)(base + 63488) + er * LDT + (3 - eq) * 16) = REV8(P_.v[3]); } \
        if (e < 128) ((LAS float*)(base + 72704))[e] = P_.g; } while (0)
        SSD_ISSUE(0, PA); SSD_ISSUE(1, PB_);
#pragma unroll 1
        for (int ci = 0; ci < nch; ci += 2) {
            SSD_COMMIT(0, PA); LDSBAR(); if (ci + 2 < nch) SSD_ISSUE(ci + 2, PA);
            SSD_COMMIT(1, PB_); LDSBAR(); if (ci + 3 < nch) SSD_ISSUE(ci + 3, PB_); }
#undef SSD_ISSUE
#undef SSD_COMMIT
#undef REV8
    } else {
        const int pq = wave;
        f32x4 S[2][8];
        if (s >= 16) { int ln = lane_o; asm volatile("" : "+v"(ln)); const int l15 = ln & 15, q4 = ln >> 4;
#pragma unroll
            for (int x = 0; x < 2; ++x) { const float* sp = in[3] + ((size_t)((s - 16) * 2 + d) * 32 + head0 + x) * 8192;
#pragma unroll
                for (int t = 0; t < 8; ++t) S[x][t] = *(const f32x4*)(sp + (size_t)(16 * pq + l15) * 128 + 16 * t + 4 * q4); }
        } else {
#pragma unroll
            for (int x = 0; x < 2; ++x)
#pragma unroll
                for (int t = 0; t < 8; ++t) S[x][t] = (f32x4){0.f, 0.f, 0.f, 0.f}; }
#pragma unroll 1
        for (int ci = 0; ci < nch; ci += 2) { LDSBAR(); ssd_scan_step(F, S, 0, ci, d, len, row0, head0, OUT); LDSBAR(); ssd_scan_step(F, S, 1, ci + 1, d, len, row0, head0, OUT); }
        if (s < 16) { int ln = lane_o; asm volatile("" : "+v"(ln)); const int l15 = ln & 15, q4 = ln >> 4;
#pragma unroll
            for (int x = 0; x < 2; ++x) { float* sp = F.out + OUT_SS + ((size_t)(s * 2 + d) * 32 + head0 + x) * 8192;
#pragma unroll
                for (int t = 0; t < 8; ++t) *(f32x4*)(sp + (size_t)(16 * pq + l15) * 128 + 16 * t + 4 * q4) = S[x][t]; } }
    }
}

DI void phase_m0a(const Ctx& F, const float* const* in) {
    { int prev = -1; u32x4 rq_[6], rk_[6], rv_[6]; unsigned rgate = 0u; float gpar[2] = {0.f, 0.f};
      if (F.bid < 3072) gdn_prep_request(F, F.bid >> 4, F.bid & 15, rq_, rk_, rv_, rgate);
      for (int it = F.bid; it < 3072; it += F.G) { const int h = it & 15; const int nx = it + F.G;
          const int next_c64 = (nx < 3072 && (nx & 15) == h) ? (nx >> 4) : -1;
          gdn_prep_item(F, in, it >> 4, h, h != prev, rq_, rk_, rv_, rgate, gpar, next_c64);
          if (next_c64 < 0 && nx < 3072) gdn_prep_request(F, nx >> 4, nx & 15, rq_, rk_, rv_, rgate);
          prev = h; } }
    { int prev = -1; u32x4 rx0[6], rx1[6], rb_[6], rc_[6]; unsigned rdt = 0u; float spar[2] = {0.f, 0.f};
      if (F.bid < 1536) ssd_prep_request(F, F.bid >> 3, F.bid & 7, rx0, rx1, rb_, rc_, rdt);
#pragma unroll 1
      for (int it = F.bid; it < 1536; it += F.G) { const int g = it & 7; const int nx = it + F.G;
          ssd_prep_item(F, in, it >> 3, g, g != prev, rx0, rx1, rb_, rc_, rdt, spar, nx < 1536 ? (nx >> 3) : -1, nx & 7); prev = g; } }
}
DI int queue_grab(const Ctx& F, unsigned* head, int n) {
    volatile LAS int* slot = (volatile LAS int*)(F.lds + 163840 - 128);
    LDSBAR();
    if (F.tid == 0) *slot = (int)__hip_atomic_fetch_add(head, (unsigned)n, __ATOMIC_RELAXED, __HIP_MEMORY_SCOPE_AGENT);
    LDSBAR();
    return *slot;
}
DI void phase_m0(const Ctx& F, const float* const* in, int only = 0) {
    const int b = F.bid;
    const int nw = F.G > 128 ? F.G - 128 : F.G, w = F.G > 128 ? b - 128 : b;
    { int it = (F.G > 128 && b < 64) ? b : (F.G > 128 ? 64 + w : b); const int step = (F.G > 128 && b < 64) ? (1 << 20) : nw;
      if (!(F.G > 128 && b >= 64 && b < 128) && only != 2)
        for (; it < 64 + 512; it += step) { int s, h, d;
            if (it < 64) { s = 16 + (it >> 5); h = (it >> 1) & 15; d = it & 1; } else { const int k = it - 64; s = k >> 5; h = (k >> 1) & 15; d = k & 1; }
            gdn_scan_item(F, in, s, h, d); } }
    { int it = (F.G > 128 && b >= 64 && b < 128) ? b - 64 : (F.G > 128 ? 64 + w : b); const int step = (F.G > 128 && b >= 64 && b < 128) ? (1 << 20) : nw;
      if (!(F.G > 128 && b < 64) && only != 1)
        for (; it < 64 + 512; it += step) { int s, g, d, hp;
            if (it < 64) { s = 16 + (it >> 5); g = (it >> 2) & 7; d = (it >> 1) & 1; hp = it & 1; } else { const int k = it - 64; s = k >> 5; g = (k >> 2) & 7; d = (k >> 1) & 1; hp = k & 1; }
            ssd_scan_item(F, in, s, g, d, hp); } }
}
DI void phase_m0c(const Ctx& F, const float* const* in) {
    const int gw = F.bid * 8 + F.wave, NGW = F.G * 8, lane = F.lane;
    const bf16* U = (const bf16*)(F.ws + WS_U); bf16* MIX = (bf16*)(F.ws + WS_MIX);
    const bf16 *OFA = (const bf16*)(F.ws + WS_OFA), *OBA = (const bf16*)(F.ws + WS_OBA), *OFB = (const bf16*)(F.ws + WS_OFB), *OBB = (const bf16*)(F.ws + WS_OBB);
    for (int row = gw; row < NROWS; row += NGW) {
        const int len = row < 4096 ? 256 : 4096, t = row < 4096 ? (row & 255) : ((row - 4096) & 4095);
        const bf16* ur = U + (size_t)row * LD_EVEN;
        { const int hsub = lane >> 4, c8 = (lane & 15) * 8;
          const f32x4 gn0 = *(const f32x4*)(in[16] + c8), gn1 = *(const f32x4*)(in[16] + c8 + 4);
          u32x4 af[4], ab[4], az[4];
#pragma unroll
          for (int hq = 0; hq < 4; ++hq) { const size_t o = (size_t)row * 2048 + (hq * 4 + hsub) * 128 + c8;
              af[hq] = *(const u32x4*)(OFA + o); ab[hq] = *(const u32x4*)(OBA + o); az[hq] = *(const u32x4*)(ur + E_ZA + (hq * 4 + hsub) * 128 + c8); }
#pragma unroll
          for (int hq = 0; hq < 4; ++hq) { float x[8], y[8], z[8]; unpack8(af[hq], x); unpack8(ab[hq], y); unpack8(az[hq], z);
              float ss = 0.f;
#pragma unroll
              for (int e = 0; e < 8; ++e) { x[e] += y[e]; ss += x[e] * x[e]; }
              ss += __shfl_xor(ss, 1); ss += __shfl_xor(ss, 2); ss += __shfl_xor(ss, 4); ss += __shfl_xor(ss, 8);
              const float rn = __builtin_amdgcn_rsqf(ss * (1.0f / 128.0f) + EPS);
              u32x4 w; w.x = pk2(x[0] * rn * gn0[0] * siluf_(z[0]), x[1] * rn * gn0[1] * siluf_(z[1])); w.y = pk2(x[2] * rn * gn0[2] * siluf_(z[2]), x[3] * rn * gn0[3] * siluf_(z[3]));
              w.z = pk2(x[4] * rn * gn1[0] * siluf_(z[4]), x[5] * rn * gn1[1] * siluf_(z[5])); w.w = pk2(x[6] * rn * gn1[2] * siluf_(z[6]), x[7] * rn * gn1[3] * siluf_(z[7]));
              *(u32x4*)(MIX + (size_t)row * DM + (hq * 4 + hsub) * 128 + c8) = w; } }
        { const int gsub = lane >> 5, c8 = (lane & 31) * 8;
#pragma unroll 2
          for (int gq = 0; gq < 4; ++gq) { const int ch = (gq * 2 + gsub) * 256 + c8; const size_t o = (size_t)row * 2048 + ch;
              const u32x4 af = *(const u32x4*)(OFB + o), ab = *(const u32x4*)(OBB + o), x0 = *(const u32x4*)(ur + E_XBC + ch), zz = *(const u32x4*)(ur + E_ZB + ch);
              u32x4 xm = {0u, 0u, 0u, 0u}, xp = {0u, 0u, 0u, 0u};
              if (t > 0) xm = *(const u32x4*)(ur - LD_EVEN + E_XBC + ch);
              if (t + 1 < len) xp = *(const u32x4*)(ur + LD_EVEN + E_XBC + ch);
              const float dsk = in[20][ch >> 6];
              float a[8], bq[8], fm[8], f0[8], fp[8], zb[8], y[8]; unpack8(af, a); unpack8(ab, bq); unpack8(xm, fm); unpack8(x0, f0); unpack8(xp, fp); unpack8(zz, zb);
              float ss = 0.f;
#pragma unroll
              for (int e4 = 0; e4 < 2; ++e4) { const f32x4 w0 = *(const f32x4*)(in[17] + ch + 4 * e4), w1 = *(const f32x4*)(in[17] + 4096 + ch + 4 * e4), w2 = *(const f32x4*)(in[17] + 8192 + ch + 4 * e4);
#pragma unroll
                  for (int e = 0; e < 4; ++e) { const int k = 4 * e4 + e; const float xs = w0[e] * fm[k] + w1[e] * f0[k] + w2[e] * fp[k];
                      y[k] = (a[k] + bq[k] + dsk * siluf_(xs)) * siluf_(zb[k]); ss += y[k] * y[k]; } }
              ss += __shfl_xor(ss, 1); ss += __shfl_xor(ss, 2); ss += __shfl_xor(ss, 4); ss += __shfl_xor(ss, 8); ss += __shfl_xor(ss, 16);
              const float rn = __builtin_amdgcn_rsqf(ss * (1.0f / 256.0f) + EPS);
              const f32x4 g0 = *(const f32x4*)(in[21] + ch), g1 = *(const f32x4*)(in[21] + ch + 4);
              u32x4 w; w.x = pk2(y[0] * rn * g0[0], y[1] * rn * g0[1]); w.y = pk2(y[2] * rn * g0[2], y[3] * rn * g0[3]); w.z = pk2(y[4] * rn * g1[0], y[5] * rn * g1[1]); w.w = pk2(y[6] * rn * g1[2], y[7] * rn * g1[3]);
              *(u32x4*)(MIX + (size_t)row * DM + 2048 + ch) = w; } }
    }
}
DI void gla_prep_all(const Ctx& F, const float* const* in) {
    LAS bf16* QS = (LAS bf16*)(F.lds + 0);
    LAS bf16* KS = (LAS bf16*)(F.lds + 17408);
    LAS bf16* KST = (LAS bf16*)(F.lds + 34816);
    LAS bf16* VT = (LAS bf16*)(F.lds + 53248);
    LAS float* GL = (LAS float*)(F.lds + 71680);
    LAS float* PART = GL + 128;
    LAS bf16* RF0 = (LAS bf16*)(F.lds + 74240);
    LAS bf16* RF1 = (LAS bf16*)(F.lds + 91648);
    LAS bf16* RQ = (LAS bf16*)(F.lds + 109056);
    LAS bf16* RV = (LAS bf16*)(F.lds + 126464);
    const bf16* U = (const bf16*)(F.ws + WS_U);
    const int lane_o = F.lane, wave = F.wave;
    const int kch = F.tid & 127, qtr = F.tid >> 7;
    const int er = F.tid >> 3, ep = F.tid & 7;
    u32x4 pr[8];
#define GLA_PRE(it_) do { const bf16* ur_ = U + (size_t)(((it_) >> 4) * 64 + er) * IN_ODD + ((it_) & 15) * 128 + ep * 16; \
        const u32x4* a_ = (const u32x4*)(ur_ + O_Q); const u32x4* b_ = (const u32x4*)(ur_ + O_I); const u32x4* c_ = (const u32x4*)(ur_ + O_F); const u32x4* d_ = (const u32x4*)(ur_ + O_F + 2048); \
        pr[0] = a_[0]; pr[1] = a_[1]; pr[2] = b_[0]; pr[3] = b_[1]; pr[4] = c_[0]; pr[5] = c_[1]; pr[6] = d_[0]; pr[7] = d_[1]; } while (0)
    float lbv[2] = {0.f, 0.f}; int lb_h = -1;
    int it = F.bid;
    if (it < 3072) GLA_PRE(it);
#pragma unroll 1
  for (; it < 3072; it += F.G) {
    const int c64 = it >> 4, h = it & 15, r0 = c64 * 64;
    if (h != lb_h) { lb_h = h;
#pragma unroll
        for (int d = 0; d < 2; ++d) lbv[d] = 1.0f / (1.0f + expf(in[31][4096 + d * 2048 + h * 128 + kch] - in[31][d * 2048 + h * 128 + kch])); }
    LDSBAR();
    *(LAS u32x4*)(RQ + er * LDQ + ep * 16) = pr[0]; *(LAS u32x4*)(RQ + er * LDQ + ep * 16 + 8) = pr[1];
    *(LAS u32x4*)(RV + er * LDQ + ep * 16) = pr[2]; *(LAS u32x4*)(RV + er * LDQ + ep * 16 + 8) = pr[3];
    *(LAS u32x4*)(RF0 + er * LDQ + ep * 16) = pr[4]; *(LAS u32x4*)(RF0 + er * LDQ + ep * 16 + 8) = pr[5];
    *(LAS u32x4*)(RF1 + er * LDQ + ep * 16) = pr[6]; *(LAS u32x4*)(RF1 + er * LDQ + ep * 16 + 8) = pr[7];
    if (it + F.G < 3072) GLA_PRE(it + F.G);
    float sq[16];
#pragma unroll 1
    for (int d = 0; d < 2; ++d) {
        const size_t item = ((size_t)c64 * 16 + h) * 2 + d;
        LAS bf16* RF = d ? RF1 : RF0;
        int lane = lane_o; asm volatile("" : "+v"(lane)); const int l15 = lane & 15, q4 = lane >> 4;
        const float lb = d ? lbv[1] : lbv[0];
        LDSBAR();
#ifndef PROBE_GE
#define PROBE_GE 1
#endif
#pragma unroll 1
        for (int rp_ = 0; rp_ < PROBE_GE; ++rp_)
        { const int sqt = d ? 3 - qtr : qtr;
          float pr_[16], kk[16]; float run = 1.f;
#pragma unroll
          for (int ii = 0; ii < 16; ++ii) { const int i = 16 * sqt + ii, tok = d ? 63 - i : i;
              const float fr = bf2f(RF[tok * LDQ + kch]);
              const float f = lb + (1.0f - lb) * sigmoidf_(fr); kk[ii] = 1.0f - f; run *= f; pr_[ii] = run; }
          PART[sqt * 128 + kch] = run;
          if (d == 0) {
#pragma unroll
              for (int ii = 0; ii < 16; ++ii) { const int i = 16 * qtr + ii; sq[ii] = siluf_(bf2f(RQ[i * LDQ + kch])) * 0.08838834764831845f; } }
          LDSBAR();
          float off = 1.f, tot = 1.f;
#pragma unroll
          for (int qq = 0; qq < 4; ++qq) { const float pq = PART[qq * 128 + kch]; if (qq < sqt) off *= pq; tot *= pq; }
          if (qtr == 0) ((float*)(F.ws + WS_LGL))[item * 128 + kch] = __logf(tot);
          unsigned kp[8], vp[8];
          float kvs[16];
          { float inv = __builtin_amdgcn_rcpf(off * pr_[15]);
#pragma unroll
            for (int ii = 15; ii >= 0; --ii) { kvs[ii] = kk[ii] * inv; inv *= 1.0f - kk[ii]; } }
#pragma unroll
          for (int ii = 0; ii < 16; ++ii) { const int i = 16 * sqt + ii, tok = d ? 63 - i : i;
              const float eg = off * pr_[ii];
              const float qv = (d ? sq[15 - ii] : sq[ii]) * eg;
              const float kv = kvs[ii];
              QS[i * LDQ + kch] = f2bf(qv); const bf16 kb = f2bf(kv); KS[i * LDQ + kch] = kb;
              if (ii & 1) kp[ii >> 1] |= (unsigned)kb << 16; else kp[ii >> 1] = kb;
              if (d == 0) { const unsigned vb = RV[tok * LDQ + kch]; if (ii & 1) vp[ii >> 1] |= vb << 16; else vp[ii >> 1] = vb; } }
          *(LAS u32x4*)(KST + kch * LDT + 16 * sqt) = (u32x4){kp[0], kp[1], kp[2], kp[3]}; *(LAS u32x4*)(KST + kch * LDT + 16 * sqt + 8) = (u32x4){kp[4], kp[5], kp[6], kp[7]};
          if (d == 0) { *(LAS u32x4*)(VT + kch * LDT + 16 * qtr) = (u32x4){vp[0], vp[1], vp[2], vp[3]}; *(LAS u32x4*)(VT + kch * LDT + 16 * qtr + 8) = (u32x4){vp[4], vp[5], vp[6], vp[7]}; } }
        LDSBAR();
#ifndef PROBE_GA
#define PROBE_GA 1
#endif
#pragma unroll 1
        for (int rq_ = 0; rq_ < PROBE_GA; ++rq_) {
#pragma unroll
        for (int tt = 0; tt < 2; ++tt) { const int id = 2 * wave + tt, ti = id >> 2, tj = id & 3;
            f32x4 a = {0.f, 0.f, 0.f, 0.f};
#pragma unroll
            for (int ks = 0; ks < 4; ++ks) a = MFMA16(frag_nat(KS, LDQ, tj * 16, ks * 32, lane), frag_nat(QS, LDQ, ti * 16, ks * 32, lane), a);
            const int i = ti * 16 + l15; float pv[4];
#pragma unroll
            for (int r = 0; r < 4; ++r) { const int j = tj * 16 + 4 * q4 + r; pv[r] = (i >= j) ? a[r] : 0.f; }
            u32x2 w2; w2.x = pk2(pv[0], pv[1]); w2.y = pk2(pv[2], pv[3]);
            *(u32x2*)((bf16*)(F.ws + WS_LAT) + (item * 64 + i) * 64 + tj * 16 + 4 * q4) = w2; }
        { bf16* qg = (bf16*)(F.ws + WS_LQS) + item * 8192; bf16* kg = (bf16*)(F.ws + WS_LKS) + item * 8192;
#pragma unroll
          for (int k = 0; k < 2; ++k) { const int e = F.tid + 512 * k;
              { const int row = e >> 4, pc = e & 15; *(u32x4*)(qg + row * 128 + pc * 8) = *(const LAS u32x4*)(QS + row * LDQ + pc * 8); }
              { const int row = e >> 3, pc = e & 7; *(u32x4*)(kg + row * 64 + pc * 8) = *(const LAS u32x4*)(KST + row * LDT + pc * 8);
                if (d == 0) *(u32x4*)((bf16*)(F.ws + WS_LVT) + ((size_t)h * 128 + row) * NROWS + r0 + pc * 8) = *(const LAS u32x4*)(VT + row * LDT + pc * 8); } } }
        }
    }
  }
#undef GLA_PRE
}

#define GLA_SETB 64000
DI void gla_scan_step(const Ctx& F, f32x4 (&S)[2][8], int set, int ci, int d, int len, int row0, int h, bf16* OUT) {
    const int wave = F.wave;
    int lane = F.lane; asm volatile("" : "+v"(lane)); const int l15 = lane & 15, q4 = lane >> 4;
    LAS unsigned char* base = F.lds + set * GLA_SETB;
    LAS bf16* QS = (LAS bf16*)base; LAS bf16* KST = (LAS bf16*)(base + 17408); LAS bf16* ATT = (LAS bf16*)(base + 35840); LAS bf16* VT = (LAS bf16*)(base + 45056); LAS float* GL = (LAS float*)(base + 63488);
#define LQ(dst, it) do { _Pragma("unroll") for (int i_ = 0; i_ < 4; ++i_) dst[i_] = frag_perm(QS, LDQ, (it) * 16, i_ * 32, lane); SCHED_FENCE(); } while (0)
#define LT(dst, M, t0) do { _Pragma("unroll") for (int i_ = 0; i_ < 4; ++i_) dst[i_] = frag_nat(M, LDT, ((t0) + (i_ >> 1)) * 16, (i_ & 1) * 32, lane); SCHED_FENCE(); } while (0)
#define CO(X, j) do { _Pragma("unroll") for (int ks = 0; ks < 4; ++ks) { o[0][j] = MFMA16(Sp[0][ks], X[ks], o[0][j]); o[1][j] = MFMA16(Sp[1][ks], X[ks], o[1][j]); } SCHED_FENCE(); } while (0)
#define CA(X, it0) do { _Pragma("unroll") for (int ks = 0; ks < 2; ++ks) _Pragma("unroll") for (int j = 0; j < 2; ++j) { o[0][j] = MFMA16(VF[0][ks], X[j * 2 + ks], o[0][j]); o[1][j] = MFMA16(VF[1][ks], X[j * 2 + ks], o[1][j]); } \
        _Pragma("unroll") for (int j = 0; j < 2; ++j) { const int i = ((it0) + j) * 16 + l15; const int tl = ci * 64 + i, t = d ? (len - 1 - tl) : tl; bf16* op = OUT + (size_t)(row0 + t) * 2048 + h * 128 + 32 * wave + 4 * q4; \
            u32x2 w2; w2.x = pk2(o[0][j][0], o[0][j][1]); w2.y = pk2(o[0][j][2], o[0][j][3]); *(u32x2*)op = w2; w2.x = pk2(o[1][j][0], o[1][j][1]); w2.y = pk2(o[1][j][2], o[1][j][3]); *(u32x2*)(op + 16) = w2; \
            o[0][j] = (f32x4){0.f, 0.f, 0.f, 0.f}; o[1][j] = (f32x4){0.f, 0.f, 0.f, 0.f}; } SCHED_FENCE(); } while (0)
#define CS(X, t0) do { _Pragma("unroll") for (int ks = 0; ks < 2; ++ks) _Pragma("unroll") for (int j = 0; j < 2; ++j) { S[0][(t0) + j] = MFMA16(X[j * 2 + ks], VF[0][ks], S[0][(t0) + j]); S[1][(t0) + j] = MFMA16(X[j * 2 + ks], VF[1][ks], S[1][(t0) + j]); } SCHED_FENCE(); } while (0)
    bf16x8 X0[4], X1[4], X2[4];
    bf16x8 VF[2][2];
#pragma unroll
    for (int x = 0; x < 2; ++x)
#pragma unroll
        for (int ks = 0; ks < 2; ++ks) VF[x][ks] = frag_nat(VT, LDT, 16 * (2 * wave + x), ks * 32, lane);
    LQ(X0, 0); LQ(X1, 1);
    bf16x8 Sp[2][4];
#pragma unroll
    for (int x = 0; x < 2; ++x)
#pragma unroll
        for (int ks = 0; ks < 4; ++ks) Sp[x][ks] = pack2(S[x][2 * ks], S[x][2 * ks + 1]);
    f32x4 o[2][2];
#pragma unroll
    for (int x = 0; x < 2; ++x)
#pragma unroll
        for (int j = 0; j < 2; ++j) o[x][j] = (f32x4){0.f, 0.f, 0.f, 0.f};
    SCHED_FENCE();
    LT(X2, ATT, 0); CO(X0, 0);
    LQ(X0, 2); CO(X1, 1);
    LQ(X1, 3); CA(X2, 0);
    LT(X2, ATT, 2); CO(X0, 0);
    LT(X0, KST, 0); CO(X1, 1);
    LT(X1, KST, 2); CA(X2, 2);
    LT(X2, KST, 4); CS(X0, 0);
    LT(X0, KST, 6); CS(X1, 2);
    CS(X2, 4); CS(X0, 6);
#pragma unroll
    for (int t = 0; t < 8; ++t) { const f32x4 gl = *(const LAS f32x4*)(GL + 16 * t + 4 * q4);
#pragma unroll
        for (int r = 0; r < 4; ++r) { const float eg = __expf(gl[r]); S[0][t][r] *= eg; S[1][t][r] *= eg; } }
#undef LQ
#undef LT
#undef CO
#undef CA
#undef CS
}
DI void gla_scan_item(const Ctx& F, const float* const* in, int s, int h, int d) {
    constexpr int SETB = GLA_SETB;
    const int row0 = seq_row0(s), len = seq_len(s), nch = len >> 6, c640 = row0 >> 6;
    const int lane_o = F.lane, wave = F.wave;
    bf16* OUT = (bf16*)(F.ws + (d ? WS_OBA : WS_OFA));
    const bf16* LQS = (const bf16*)(F.ws + WS_LQS); const bf16* LKS = (const bf16*)(F.ws + WS_LKS); const bf16* LAT = (const bf16*)(F.ws + WS_LAT);
    const bf16* LVT = (const bf16*)(F.ws + WS_LVT) + (size_t)h * 128 * NROWS; const float* LGL = (const float*)(F.ws + WS_LGL);
    LDSBAR();
    if (wave >= 4) {
        struct Pre { u32x4 q[4], k[4], a[2], v[4]; float g; };
        Pre PA, PB_;
        const int e = F.tid - 256, er = e >> 2, eq = e & 3;
#define REV8(w_) ((u32x4){((w_).w >> 16) | ((w_).w << 16), ((w_).z >> 16) | ((w_).z << 16), ((w_).y >> 16) | ((w_).y << 16), ((w_).x >> 16) | ((w_).x << 16)})
#define GLA_ISSUE(ci_, P_) do { const int cc = c640 + (d ? nch - 1 - (ci_) : (ci_)); const size_t item = ((size_t)cc * 16 + h) * 2 + d; \
        const u32x4* qsrc = (const u32x4*)(LQS + item * 8192 + er * 128 + eq * 32); _Pragma("unroll") for (int m_ = 0; m_ < 4; ++m_) P_.q[m_] = qsrc[m_]; \
        const u32x4* k0src = (const u32x4*)(LKS + item * 8192 + er * 64 + eq * 16); const u32x4* k1src = (const u32x4*)(LKS + item * 8192 + (64 + er) * 64 + eq * 16); \
        P_.k[0] = k0src[0]; P_.k[1] = k0src[1]; P_.k[2] = k1src[0]; P_.k[3] = k1src[1]; \
        const u32x4* asrc = (const u32x4*)(LAT + item * 4096 + er * 64 + eq * 16); P_.a[0] = asrc[0]; P_.a[1] = asrc[1]; \
        const u32x4* v0src = (const u32x4*)(LVT + (size_t)er * NROWS + cc * 64 + eq * 16); const u32x4* v1src = (const u32x4*)(LVT + (size_t)(64 + er) * NROWS + cc * 64 + eq * 16); \
        P_.v[0] = v0src[0]; P_.v[1] = v0src[1]; P_.v[2] = v1src[0]; P_.v[3] = v1src[1]; \
        P_.g = 0.f; if (e < 128) P_.g = LGL[item * 128 + e]; } while (0)
#define GLA_COMMIT(set_, P_) do { LAS unsigned char* base = F.lds + (set_) * SETB; \
        _Pragma("unroll") for (int m_ = 0; m_ < 4; ++m_) *(LAS u32x4*)((LAS bf16*)base + er * LDQ + eq * 32 + m_ * 8) = P_.q[m_]; \
        *(LAS u32x4*)((LAS bf16*)(base + 17408) + er * LDT + eq * 16) = P_.k[0]; *(LAS u32x4*)((LAS bf16*)(base + 17408) + er * LDT + eq * 16 + 8) = P_.k[1]; \
        *(LAS u32x4*)((LAS bf16*)(base + 17408) + (64 + er) * LDT + eq * 16) = P_.k[2]; *(LAS u32x4*)((LAS bf16*)(base + 17408) + (64 + er) * LDT + eq * 16 + 8) = P_.k[3]; \
        *(LAS u32x4*)((LAS bf16*)(base + 35840) + er * LDT + eq * 16) = P_.a[0]; *(LAS u32x4*)((LAS bf16*)(base + 35840) + er * LDT + eq * 16 + 8) = P_.a[1]; \
        if (d == 0) { *(LAS u32x4*)((LAS bf16*)(base + 45056) + er * LDT + eq * 16) = P_.v[0]; *(LAS u32x4*)((LAS bf16*)(base + 45056) + er * LDT + eq * 16 + 8) = P_.v[1]; \
            *(LAS u32x4*)((LAS bf16*)(base + 45056) + (64 + er) * LDT + eq * 16) = P_.v[2]; *(LAS u32x4*)((LAS bf16*)(base + 45056) + (64 + er) * LDT + eq * 16 + 8) = P_.v[3]; } \
        else { *(LAS u32x4*)((LAS bf16*)(base + 45056) + er * LDT + (3 - eq) * 16 + 8) = REV8(P_.v[0]); *(LAS u32x4*)((LAS bf16*)(base + 45056) + er * LDT + (3 - eq) * 16) = REV8(P_.v[1]); \
            *(LAS u32x4*)((LAS bf16*)(base + 45056) + (64 + er) * LDT + (3 - eq) * 16 + 8) = REV8(P_.v[2]); *(LAS u32x4*)((LAS bf16*)(base + 45056) + (64 + er) * LDT + (3 - eq) * 16) = REV8(P_.v[3]); } \
        if (e < 128) ((LAS float*)(base + 63488))[e] = P_.g; } while (0)
        GLA_ISSUE(0, PA); GLA_ISSUE(1, PB_);
#pragma unroll 1
        for (int ci = 0; ci < nch; ci += 2) {
            GLA_COMMIT(0, PA); LDSBAR(); if (ci + 2 < nch) GLA_ISSUE(ci + 2, PA);
            GLA_COMMIT(1, PB_); LDSBAR(); if (ci + 3 < nch) GLA_ISSUE(ci + 3, PB_); }
#undef GLA_ISSUE
#undef GLA_COMMIT
#undef REV8
    } else {
        f32x4 S[2][8];
        if (s >= 16) { int ln = lane_o; asm volatile("" : "+v"(ln)); const int l15 = ln & 15, q4 = ln >> 4; const float* sp = in[4] + ((size_t)((s - 16) * 2 + d) * 16 + h) * 16384;
#pragma unroll
            for (int x = 0; x < 2; ++x)
#pragma unroll
                for (int t = 0; t < 8; ++t)
#pragma unroll
                    for (int r = 0; r < 4; ++r) S[x][t][r] = sp[(size_t)(16 * t + 4 * q4 + r) * 128 + 32 * wave + 16 * x + l15];
        } else {
#pragma unroll
            for (int x = 0; x < 2; ++x)
#pragma unroll
                for (int t = 0; t < 8; ++t) S[x][t] = (f32x4){0.f, 0.f, 0.f, 0.f}; }
#pragma unroll 1
        for (int ci = 0; ci < nch; ci += 2) { LDSBAR(); gla_scan_step(F, S, 0, ci, d, len, row0, h, OUT); LDSBAR(); gla_scan_step(F, S, 1, ci + 1, d, len, row0, h, OUT); }
        if (s < 16) { int ln = lane_o; asm volatile("" : "+v"(ln)); const int l15 = ln & 15, q4 = ln >> 4; float* sp = F.out + OUT_SH + ((size_t)(s * 2 + d) * 16 + h) * 16384;
#pragma unroll
            for (int x = 0; x < 2; ++x)
#pragma unroll
                for (int t = 0; t < 8; ++t)
#pragma unroll
                    for (int r = 0; r < 4; ++r) sp[(size_t)(16 * t + 4 * q4 + r) * 128 + 32 * wave + 16 * x + l15] = S[x][t][r]; }
    }
}

struct M1aRaw { u32x4 a[2], b[2], m[2], p[2]; };
DI void m1a_load(const Ctx& F, int item, M1aRaw& R) {
    const int tt = item >> 5, cb = item & 31, r0 = tt * 64, c0 = cb * 256;
    const bf16* U = (const bf16*)(F.ws + WS_U);
    const int cg = F.lane & 31;
    const int len = r0 < 4096 ? 256 : 4096, tbase = r0 < 4096 ? (r0 & 255) : ((r0 - 4096) & 4095);
    const int col = c0 + cg * 8;
#pragma unroll
    for (int itk = 0; itk < 2; ++itk) { const int tp = itk * 16 + F.wave * 2 + (F.lane >> 5);
        const int tl = 2 * tp, t = tbase + tl; const bf16* ur = U + (size_t)(r0 + tl) * IN_ODD + col;
        R.a[itk] = *(const u32x4*)ur; R.b[itk] = *(const u32x4*)(ur + IN_ODD);
        R.m[itk] = (u32x4){0u, 0u, 0u, 0u}; R.p[itk] = (u32x4){0u, 0u, 0u, 0u};
        if (col < 6144) { if (t > 0) R.m[itk] = *(const u32x4*)(ur - IN_ODD); if (t + 2 < len) R.p[itk] = *(const u32x4*)(ur + 2 * IN_ODD); } }
}
DI void m1a_item(const Ctx& F, const float* const* in, int item, M1aRaw& R, int next_item) {
    LAS unsigned* T = (LAS unsigned*)F.lds;
    const int tt = item >> 5, cb = item & 31, r0 = tt * 64, c0 = cb * 256;
    bf16* TB = (bf16*)(F.ws + WS_TB);
    const int cg = F.lane & 31;
    const int col = c0 + cg * 8;
#pragma unroll
    for (int itk = 0; itk < 2; ++itk) { const int tp = itk * 16 + F.wave * 2 + (F.lane >> 5);
        float xa[8], xb[8], oa[8], ob[8]; unpack8(R.a[itk], xa); unpack8(R.b[itk], xb);
        if (col < 6144) { float xm[8], xp[8]; unpack8(R.m[itk], xm); unpack8(R.p[itk], xp);
            const float* cw = in[23] + col;
#pragma unroll
            for (int e = 0; e < 8; ++e) { oa[e] = cw[e] * xm[e] + cw[6144 + e] * xa[e] + cw[12288 + e] * xb[e]; ob[e] = cw[e] * xa[e] + cw[6144 + e] * xb[e] + cw[12288 + e] * xp[e]; }
        } else {
#pragma unroll
            for (int e = 0; e < 8; ++e) { oa[e] = siluf_(xa[e]); ob[e] = siluf_(xb[e]); } }
#pragma unroll
        for (int e = 0; e < 8; ++e) T[(e * 32 + cg) * 33 + tp] = pk2(oa[e], ob[e]); }
    if (next_item >= 0) m1a_load(F, next_item, R);
    LDSBAR();
#pragma unroll
    for (int k = 0; k < 4; ++k) { const int e = F.tid + 512 * k, part = e & 7, chi = e >> 3;
        const int ch = (chi & 31) * 8 + (chi >> 5);
        const LAS unsigned* sp = T + chi * 33 + part * 4;
        u32x4 w; w.x = sp[0]; w.y = sp[1]; w.z = sp[2]; w.w = sp[3];
        *(u32x4*)(TB + (size_t)(c0 + ch) * NROWS + r0 + part * 8) = w; }
    LDSBAR();
}

DI f32x2 w16(int k) {
    switch (k & 7) {
        case 0: return (f32x2){1.0f, 0.0f};
        case 1: return (f32x2){0.9238795325112867f, -0.3826834323650898f};
        case 2: return (f32x2){0.7071067811865476f, -0.7071067811865476f};
        case 3: return (f32x2){0.3826834323650898f, -0.9238795325112867f};
        case 4: return (f32x2){0.0f, -1.0f};
        case 5: return (f32x2){-0.3826834323650898f, -0.9238795325112867f};
        case 6: return (f32x2){-0.7071067811865476f, -0.7071067811865476f};
        default: return (f32x2){-0.9238795325112867f, -0.3826834323650898f};
    }
}
DI f32x2 cmul(f32x2 a, f32x2 b) { return (f32x2){a[0] * b[0] - a[1] * b[1], a[0] * b[1] + a[1] * b[0]}; }
DI f32x2 cmulc(f32x2 a, f32x2 b) { return (f32x2){a[0] * b[0] + a[1] * b[1], a[1] * b[0] - a[0] * b[1]}; }
template <int LOGR, bool INV, bool UNIT = false> DI void fft_bfly(f32x2 (&x)[1 << LOGR], f32x2 w0) {
    constexpr int R = 1 << LOGR;
    f32x2 wj[LOGR];
    wj[0] = w0;
#pragma unroll
    for (int s = 1; s < LOGR; ++s) wj[s] = cmul(wj[s - 1], wj[s - 1]);
#pragma unroll
    for (int ss = 0; ss < LOGR; ++ss) { const int s = INV ? (LOGR - 1 - ss) : ss; const int hm = R >> (s + 1);
#pragma unroll
        for (int m = 0; m < R; ++m) { if (m & hm) continue; const int mm = m % hm;
            const int k16 = mm * (16 >> (LOGR - s));
            if (UNIT && k16 == 0) { const f32x2 a = x[m], b = x[m + hm]; x[m] = a + b; x[m + hm] = a - b; continue; }
            if (UNIT && k16 == 4) {
                if (!INV) { const f32x2 a = x[m], b = x[m + hm], d = a - b; x[m] = a + b; x[m + hm] = (f32x2){d[1], -d[0]}; }
                else { const f32x2 a = x[m], bb = x[m + hm], b = (f32x2){-bb[1], bb[0]}; x[m] = a + b; x[m + hm] = a - b; }
                continue; }
            f32x2 w;
            if (UNIT) w = w16(k16);
            else if (k16 == 0) w = wj[s];
            else if (k16 == 4) w = (f32x2){wj[s][1], -wj[s][0]};
            else w = cmul(wj[s], w16(k16));
            if (!INV) { const f32x2 a = x[m], b = x[m + hm]; x[m] = a + b; x[m + hm] = cmul(a - b, w); }
            else { const f32x2 a = x[m], b = cmulc(x[m + hm], w); x[m] = a + b; x[m + hm] = a - b; } } }
}
template <int LOGR, bool INV, int PADSH> DI void fft_group(LAS f32x2* buf, const LAS f32x2* TW, int B, int tws, int g) {
    constexpr int R = 1 << LOGR;
    const int stride = B >> LOGR, blk = g / stride, j = g - blk * stride;
    const int base = blk * B + j;
    LAS f32x2* p = buf + base + (base >> PADSH);
    const int pstride = stride >= (1 << PADSH) ? stride + (stride >> PADSH) : stride;
    f32x2 x[R];
#pragma unroll
    for (int m = 0; m < R; ++m) x[m] = p[m * pstride];
    fft_bfly<LOGR, INV>(x, TW[j * tws]);
#pragma unroll
    for (int m = 0; m < R; ++m) p[m * pstride] = x[m];
}
template <int LOGR, bool INV, int PADSH> DI void fft_group2(LAS f32x2* buf, const LAS f32x2* TW, int B, int tws, int g0, int g1) {
    constexpr int R = 1 << LOGR;
    const int stride = B >> LOGR, pstride = stride >= (1 << PADSH) ? stride + (stride >> PADSH) : stride;
    const int blk0 = g0 / stride, j0 = g0 - blk0 * stride, base0 = blk0 * B + j0;
    const int blk1 = g1 / stride, j1 = g1 - blk1 * stride, base1 = blk1 * B + j1;
    LAS f32x2* p0 = buf + base0 + (base0 >> PADSH); LAS f32x2* p1 = buf + base1 + (base1 >> PADSH);
    f32x2 xa[R], xb[R];
#pragma unroll
    for (int m = 0; m < R; ++m) xa[m] = p0[m * pstride];
#pragma unroll
    for (int m = 0; m < R; ++m) xb[m] = p1[m * pstride];
    const f32x2 wa = TW[j0 * tws], wb = TW[j1 * tws];
    SCHED_FENCE();
    fft_bfly<LOGR, INV>(xa, wa);
#pragma unroll
    for (int m = 0; m < R; ++m) p0[m * pstride] = xa[m];
    fft_bfly<LOGR, INV>(xb, wb);
#pragma unroll
    for (int m = 0; m < R; ++m) p1[m * pstride] = xb[m];
}
template <int PADSH> DI void fft_first8(LAS f32x2* buf, f32x2 w0, int N, int j, f32x2 i0, f32x2 i1, f32x2 i2, f32x2 i3) {
    const int stride = N >> 3, pstride = stride + (stride >> PADSH);
    f32x2 x[8] = {i0, i1, i2, i3, (f32x2){0.f, 0.f}, (f32x2){0.f, 0.f}, (f32x2){0.f, 0.f}, (f32x2){0.f, 0.f}};
    fft_bfly<3, false>(x, w0);
    LAS f32x2* p = buf + j + (j >> PADSH);
#pragma unroll
    for (int m = 0; m < 8; ++m) p[m * pstride] = x[m];
}
template <int PADSH> DI void fft_last8(const LAS f32x2* buf, f32x2 w0, int N, int j, f32x2& o0, f32x2& o1, f32x2& o2, f32x2& o3) {
    const int stride = N >> 3, pstride = stride + (stride >> PADSH);
    const LAS f32x2* p = buf + j + (j >> PADSH);
    f32x2 x[8];
#pragma unroll
    for (int m = 0; m < 8; ++m) x[m] = p[m * pstride];
    fft_bfly<3, true>(x, w0);
    o0 = x[0]; o1 = x[1]; o2 = x[2]; o3 = x[3];
}
#define PD4(i_) ((i_) + ((i_) >> 4))
#define PD3(i_) ((i_) + ((i_) >> 3))
template <bool INV> DI void fft8192(LAS f32x2* buf, const LAS f32x2* TW, int tid) {
    if (!INV) {
        fft_group2<3, false, 4>(buf, TW, 8192, 1, tid, tid + 512); LDSBAR();
        fft_group2<3, false, 4>(buf, TW, 1024, 8, tid, tid + 512); LDSBAR();
        fft_group2<3, false, 4>(buf, TW, 128, 64, tid, tid + 512); LDSBAR();
        fft_group<4, false, 4>(buf, TW, 16, 0, tid); LDSBAR();
    } else {
        fft_group<4, true, 4>(buf, TW, 16, 0, tid); LDSBAR();
        fft_group2<3, true, 4>(buf, TW, 128, 64, tid, tid + 512); LDSBAR();
        fft_group2<3, true, 4>(buf, TW, 1024, 8, tid, tid + 512); LDSBAR();
        fft_group2<3, true, 4>(buf, TW, 8192, 1, tid, tid + 512); LDSBAR();
    }
}
#define WSYNC() asm volatile("s_waitcnt lgkmcnt(0)" ::: "memory")
template <bool INV> DI void fft512(LAS f32x2* buf, const LAS f32x2* TW, int lane) {
    if (!INV) { fft_group<3, false, 3>(buf, TW, 512, 16, lane); WSYNC(); fft_group<3, false, 3>(buf, TW, 64, 128, lane); WSYNC(); fft_group<3, false, 3>(buf, TW, 8, 0, lane); WSYNC(); }
    else { fft_group<3, true, 3>(buf, TW, 8, 0, lane); WSYNC(); fft_group<3, true, 3>(buf, TW, 64, 128, lane); WSYNC(); fft_group<3, true, 3>(buf, TW, 512, 16, lane); WSYNC(); }
}
constexpr int LDS_TW = 139264;
DI void fft_table_init(const Ctx& F) { LAS f32x2* TW = (LAS f32x2*)(F.lds + LDS_TW);
    for (int j = F.tid; j < 1024; j += 512) { float sn, cs; sincospif(-2.0f * (float)j / 8192.0f, &sn, &cs); TW[j] = (f32x2){cs, sn}; }
    LDSBAR(); }
DI f32x2 filt_spec(f32x2 z1, f32x2 z2, int ord) { const float sg = ord ? -0.5f : 0.5f; const float ar = 0.5f * z1[0] + sg * z2[0], ai = 0.5f * z1[1] - sg * z2[1];
    return ord ? (f32x2){ai, -ar} : (f32x2){ar, ai}; }

template <int LOGR, int PADSH, int LOGN> DI void fft_mid(LAS f32x2* D, const LAS f32x2* HZ, int ord, int g) {
    constexpr int R = 1 << LOGR, N = 1 << LOGN;
    LAS f32x2* p = D + g * R + ((g * R) >> PADSH);
    f32x2 x[R];
#pragma unroll
    for (int m = 0; m < R; ++m) x[m] = p[m];
    fft_bfly<LOGR, false, true>(x, (f32x2){1.f, 0.f});
#pragma unroll
    for (int m = 0; m < R; ++m) { const int t = g * R + m; const int fq = (int)(__brev((unsigned)t) >> (32 - LOGN)), t2 = (int)(__brev((unsigned)((N - fq) & (N - 1))) >> (32 - LOGN));
        x[m] = cmul(x[m], filt_spec(HZ[t + (t >> PADSH)], HZ[t2 + (t2 >> PADSH)], ord)) * (1.0f / (float)N); }
    fft_bfly<LOGR, true, true>(x, (f32x2){1.f, 0.f});
#pragma unroll
    for (int m = 0; m < R; ++m) p[m] = x[m];
}
DI void hyena_dec_item(const Ctx& F, const float* const* in, int c) {
    LAS f32x2* HB = (LAS f32x2*)F.lds;
    LAS f32x2* DB = HB + 8704;
    const LAS f32x2* TW = (const LAS f32x2*)(F.lds + LDS_TW);
    const bf16* TB = (const bf16*)(F.ws + WS_TB); bf16* YT = (bf16*)(F.ws + WS_YT);
    const float* HF = (const float*)(F.ws + WS_HF4096); const float* HN = (const float*)(F.ws + WS_HNRM) + 4096;
    const int tid_o = F.tid;
    float va[8], vb[8];
#pragma unroll
    for (int k = 0; k < 8; ++k) { const int t = tid_o + 512 * k; va[k] = bf2f(TB[(size_t)c * NROWS + 4096 + t]); vb[k] = bf2f(TB[(size_t)c * NROWS + 8192 + t]); }
    { const float n0 = HN[c], n1 = HN[2048 + c]; const float* h0 = HF + (size_t)c * 8192; const float* h1 = HF + ((size_t)2048 + c) * 8192;
#pragma unroll 8
      for (int k = 0; k < 16; ++k) { const int t = tid_o + 512 * k; HB[PD4(t)] = (f32x2){h0[t] * n0, h1[t] * n1}; } }
    LDSBAR();
    fft8192<false>(HB, TW, tid_o);
#pragma unroll 1
    for (int ord = 0; ord < 2; ++ord) {
        int tid = tid_o; asm volatile("" : "+v"(tid));
        const size_t xoff = (size_t)((ord + 1) * 2048 + c) * NROWS, zoff = (size_t)(6144 + c) * NROWS;
        const float bias = in[30][ord * 2048 + c];
        bf16 rxa[8], rxb[8], rza[8], rzb[8];
#pragma unroll
        for (int k = 0; k < 8; ++k) { const int t = tid + 512 * k; rxa[k] = TB[xoff + 4096 + t]; rxb[k] = TB[xoff + 8192 + t];
            if (ord == 1) { rza[k] = TB[zoff + 4096 + t]; rzb[k] = TB[zoff + 8192 + t]; } else { rza[k] = 0; rzb[k] = 0; } }
        fft_first8<4>(DB, TW[tid], 8192, tid, (f32x2){va[0], vb[0]}, (f32x2){va[2], vb[2]}, (f32x2){va[4], vb[4]}, (f32x2){va[6], vb[6]});
        fft_first8<4>(DB, TW[tid + 512], 8192, tid + 512, (f32x2){va[1], vb[1]}, (f32x2){va[3], vb[3]}, (f32x2){va[5], vb[5]}, (f32x2){va[7], vb[7]});
        LDSBAR();
        fft_group2<3, false, 4>(DB, TW, 1024, 8, tid, tid + 512); LDSBAR();
        fft_group2<3, false, 4>(DB, TW, 128, 64, tid, tid + 512); LDSBAR();
        fft_mid<4, 4, 13>(DB, HB, ord, tid); LDSBAR();
        fft_group2<3, true, 4>(DB, TW, 128, 64, tid, tid + 512); LDSBAR();
        fft_group2<3, true, 4>(DB, TW, 1024, 8, tid, tid + 512); LDSBAR();
        f32x2 y[8];
        fft_last8<4>(DB, TW[tid], 8192, tid, y[0], y[2], y[4], y[6]);
        fft_last8<4>(DB, TW[tid + 512], 8192, tid + 512, y[1], y[3], y[5], y[7]);
#pragma unroll
        for (int k = 0; k < 8; ++k) { const int t = tid + 512 * k;
            va[k] = bf2f(rxa[k]) * (y[k][0] + bias * va[k]); vb[k] = bf2f(rxb[k]) * (y[k][1] + bias * vb[k]);
            if (ord == 1) { YT[(size_t)c * NROWS + 4096 + t] = f2bf(va[k] * bf2f(rza[k])); YT[(size_t)c * NROWS + 8192 + t] = f2bf(vb[k] * bf2f(rzb[k])); } }
    }
    LDSBAR();
}
DI void hyena_ctx_item(const Ctx& F, const float* const* in, int c, int p0) {
    LAS f32x2* HZ = (LAS f32x2*)F.lds + F.wave * 1152;
    LAS f32x2* D = HZ + 576;
    const LAS f32x2* TW = (const LAS f32x2*)(F.lds + LDS_TW);
    const bf16* TB = (const bf16*)(F.ws + WS_TB); bf16* YT = (bf16*)(F.ws + WS_YT);
    const float* HF = (const float*)(F.ws + WS_HF256); const float* HN = (const float*)(F.ws + WS_HNRM);
    const int lane = F.lane;
    { const float n0 = HN[c], n1 = HN[2048 + c]; const float* h0 = HF + (size_t)c * 512; const float* h1 = HF + ((size_t)2048 + c) * 512;
#pragma unroll
      for (int k = 0; k < 8; ++k) { const int t = lane + 64 * k; HZ[PD3(t)] = (f32x2){h0[t] * n0, h1[t] * n1}; } }
    WSYNC();
    fft512<false>(HZ, TW, lane);
#pragma unroll 1
    for (int pp = p0; pp < p0 + 4; ++pp) { const int ra = (2 * pp) * 256, rb = (2 * pp + 1) * 256;
    float va[4], vb[4];
#pragma unroll
    for (int k = 0; k < 4; ++k) { const int t = lane + 64 * k; va[k] = bf2f(TB[(size_t)c * NROWS + ra + t]); vb[k] = bf2f(TB[(size_t)c * NROWS + rb + t]); }
#pragma unroll 1
    for (int ord = 0; ord < 2; ++ord) {
        const size_t xoff = (size_t)((ord + 1) * 2048 + c) * NROWS, zoff = (size_t)(6144 + c) * NROWS;
        const float bias = in[30][ord * 2048 + c];
        bf16 rxa[4], rxb[4], rza[4], rzb[4];
#pragma unroll
        for (int k = 0; k < 4; ++k) { const int t = lane + 64 * k; rxa[k] = TB[xoff + ra + t]; rxb[k] = TB[xoff + rb + t];
            if (ord == 1) { rza[k] = TB[zoff + ra + t]; rzb[k] = TB[zoff + rb + t]; } else { rza[k] = 0; rzb[k] = 0; } }
        fft_first8<3>(D, TW[lane * 16], 512, lane, (f32x2){va[0], vb[0]}, (f32x2){va[1], vb[1]}, (f32x2){va[2], vb[2]}, (f32x2){va[3], vb[3]}); WSYNC();
        fft_group<3, false, 3>(D, TW, 64, 128, lane); WSYNC();
        fft_mid<3, 3, 9>(D, HZ, ord, lane); WSYNC();
        fft_group<3, true, 3>(D, TW, 64, 128, lane); WSYNC();
        f32x2 y[4];
        fft_last8<3>(D, TW[lane * 16], 512, lane, y[0], y[1], y[2], y[3]);
#pragma unroll
        for (int k = 0; k < 4; ++k) { const int t = lane + 64 * k;
            va[k] = bf2f(rxa[k]) * (y[k][0] + bias * va[k]); vb[k] = bf2f(rxb[k]) * (y[k][1] + bias * vb[k]);
            if (ord == 1) { YT[(size_t)c * NROWS + ra + t] = f2bf(va[k] * bf2f(rza[k])); YT[(size_t)c * NROWS + rb + t] = f2bf(vb[k] * bf2f(rzb[k])); } }
        WSYNC();
    }
    }
}
DI void phase_m1a(const Ctx& F, const float* const* in) {
    { M1aRaw R; int it = F.bid; if (it < 192 * 32) m1a_load(F, it, R);
#pragma unroll 1
      for (; it < 192 * 32; it += F.G) m1a_item(F, in, it, R, it + F.G < 192 * 32 ? it + F.G : -1); }
    gla_prep_all(F, in);
}
DI void phase_m1b(const Ctx& F, const float* const* in, int pass = 0) {
    const int b = F.bid; unsigned* ctl = (unsigned*)(F.ws + WS_CTL) + pass * 1024;
    fft_table_init(F);
#ifndef P11_ONLY
#define P11_ONLY 0
#endif
    const int only = pass ? P11_ONLY : 0;
    if (b < 64 && (only == 0 || only == 1)) gla_scan_item(F, in, 16 + (b >> 5), (b >> 1) & 15, b & 1);
    if (only == 0 || only == 2) for (;;) { const int it = queue_grab(F, ctl + CW_Q0, 1); if (it >= 2048) break; hyena_dec_item(F, in, it); }
    if (only == 0 || only == 3) for (;;) { const int it = queue_grab(F, ctl + CW_Q1, 1); if (it >= 512) break; gla_scan_item(F, in, it >> 5, (it >> 1) & 15, it & 1); }
    if (only == 0 || only == 4) for (;;) { const int g = queue_grab(F, ctl + CW_Q2, 1); if (g >= 512) break;
        hyena_ctx_item(F, in, (g >> 1) * 8 + F.wave, (g & 1) * 4); }
}
DI void phase_m1c(const Ctx& F, const float* const* in) {
    const int gw = F.bid * 8 + F.wave, NGW = F.G * 8, lane = F.lane;
    const bf16* U = (const bf16*)(F.ws + WS_U); bf16* MIX = (bf16*)(F.ws + WS_MIX);
    const bf16 *OFA = (const bf16*)(F.ws + WS_OFA), *OBA = (const bf16*)(F.ws + WS_OBA);
    const int hsub = lane >> 4, c8 = (lane & 15) * 8;
    const f32x4 gn0 = *(const f32x4*)(in[32] + c8), gn1 = *(const f32x4*)(in[32] + c8 + 4);
    for (int row = gw; row < NROWS; row += NGW) { const bf16* ur = U + (size_t)row * IN_ODD;
        u32x4 af[4], ab[4], az[4];
#pragma unroll
        for (int hq = 0; hq < 4; ++hq) { const size_t o = (size_t)row * 2048 + (hq * 4 + hsub) * 128 + c8;
            af[hq] = *(const u32x4*)(OFA + o); ab[hq] = *(const u32x4*)(OBA + o); az[hq] = *(const u32x4*)(ur + O_ZD + (hq * 4 + hsub) * 128 + c8); }
#pragma unroll
        for (int hq = 0; hq < 4; ++hq) { float x[8], y[8], z[8]; unpack8(af[hq], x); unpack8(ab[hq], y); unpack8(az[hq], z);
            float ss = 0.f;
#pragma unroll
            for (int e = 0; e < 8; ++e) { x[e] += y[e]; ss += x[e] * x[e]; }
            ss += __shfl_xor(ss, 1); ss += __shfl_xor(ss, 2); ss += __shfl_xor(ss, 4); ss += __shfl_xor(ss, 8);
            const float rn = __builtin_amdgcn_rsqf(ss * (1.0f / 128.0f) + EPS);
            u32x4 w; w.x = pk2(x[0] * rn * gn0[0] * siluf_(z[0]), x[1] * rn * gn0[1] * siluf_(z[1])); w.y = pk2(x[2] * rn * gn0[2] * siluf_(z[2]), x[3] * rn * gn0[3] * siluf_(z[3]));
            w.z = pk2(x[4] * rn * gn1[0] * siluf_(z[4]), x[5] * rn * gn1[1] * siluf_(z[5])); w.w = pk2(x[6] * rn * gn1[2] * siluf_(z[6]), x[7] * rn * gn1[3] * siluf_(z[7]));
            *(u32x4*)(MIX + (size_t)row * DM + 2048 + (hq * 4 + hsub) * 128 + c8) = w; } }
    const bf16* YT = (const bf16*)(F.ws + WS_YT);
    LAS bf16* T = (LAS bf16*)(F.lds + F.wave * 8448);
    for (int it = gw; it < 32 * 192; it += NGW) { const int cb = it & 31, rbk = it >> 5, c0 = cb * 64, r0 = rbk * 64;
#pragma unroll
        for (int k = 0; k < 8; ++k) { const int ch = 8 * k + (lane >> 3); const u32x4 w = *(const u32x4*)(YT + (size_t)(c0 + ch) * NROWS + r0 + (lane & 7) * 8);
            LAS bf16* dp = T + ch * 66 + (lane & 7) * 8;
            dp[0] = (bf16)(w.x & 0xffffu); dp[1] = (bf16)(w.x >> 16); dp[2] = (bf16)(w.y & 0xffffu); dp[3] = (bf16)(w.y >> 16); dp[4] = (bf16)(w.z & 0xffffu); dp[5] = (bf16)(w.z >> 16); dp[6] = (bf16)(w.w & 0xffffu); dp[7] = (bf16)(w.w >> 16); }
        asm volatile("s_waitcnt lgkmcnt(0)" ::: "memory");
#pragma unroll
        for (int k = 0; k < 8; ++k) { const int rr = 8 * k + (lane >> 3), cc = (lane & 7) * 8;
            u32x4 w; w.x = (unsigned)T[(cc + 0) * 66 + rr] | ((unsigned)T[(cc + 1) * 66 + rr] << 16); w.y = (unsigned)T[(cc + 2) * 66 + rr] | ((unsigned)T[(cc + 3) * 66 + rr] << 16);
            w.z = (unsigned)T[(cc + 4) * 66 + rr] | ((unsigned)T[(cc + 5) * 66 + rr] << 16); w.w = (unsigned)T[(cc + 6) * 66 + rr] | ((unsigned)T[(cc + 7) * 66 + rr] << 16);
            *(u32x4*)(MIX + (size_t)(r0 + rr) * DM + c0 + cc) = w; }
        asm volatile("s_waitcnt lgkmcnt(0)" ::: "memory"); }
}
constexpr int NWAVES = 8, NTHREADS = 512;
constexpr int LDS_BYTES = 163840;
constexpr int LDS_MISC = LDS_BYTES - 64;
constexpr int N_PHASES = 14;
struct Args { const float* in[33]; float* out; unsigned char* ws; int ph_lo, ph_hi; };

__global__ void __launch_bounds__(NTHREADS, 2) mk_fwd(Args args) {
    extern __shared__ __attribute__((aligned(16))) unsigned char lds_raw[];
    Ctx F;
    F.lds = (LAS unsigned char*)lds_raw; F.in = nullptr; F.ws = args.ws; F.out = args.out;
    F.tid = threadIdx.x; F.lane = F.tid & 63; F.wave = __builtin_amdgcn_readfirstlane(F.tid >> 6); F.bid = blockIdx.x; F.G = gridDim.x;
    const float* const* in = args.in;
    volatile LAS unsigned* xbw = (volatile LAS unsigned*)(F.lds + LDS_MISC);
    if (F.tid < 4) xbw[F.tid] = 0u;
    __syncthreads();
    unsigned* ctl = (unsigned*)(args.ws + WS_CTL);
    XcdBarrier bar = xcd_barrier_post(ctl + CW_BAR, xbw);
    const int lo = args.ph_lo, hi = args.ph_hi;
#ifndef PHASE_MASK
#define PHASE_MASK 0xffffffffu
#endif
#define IN(k) (((PHASE_MASK >> (k)) & 1u) && lo <= (k) && (k) < hi)
#define SEAM(k) do { if (IN(k) && IN((k) + 1)) xcd_barrier(bar); } while (0)
#ifndef DUP_MASK
#define DUP_MASK 0u
#endif
#define DUP(k) (((DUP_MASK >> (k)) & 1u) != 0u)
    if (IN(0)) { phase_p0(F, in); if (DUP(0)) { xcd_barrier(bar); phase_p0(F, in); } }
    SEAM(0);
    if (IN(1)) { phase_p0c(F, in); if (DUP(1)) { xcd_barrier(bar); phase_p0c(F, in); } }
    SEAM(1);
    if (IN(2)) { phase_norm<0>(F, in); if (DUP(2)) { xcd_barrier(bar); phase_norm<0>(F, in); } }
    SEAM(2);
    if (IN(3)) { pg8::Gemm g{(const pg8::bf16_t*)(F.ws + WS_H), (const pg8::bf16_t*)(F.ws + WS_WTE), NROWS, LD_EVEN, DM}; pg8::StaticOrder S; S.init(NROWS, LD_EVEN, F.G, F.bid);
        pg8::EpiStoreBf16 E{(pg8::bf16_t*)(F.ws + WS_U), LD_EVEN};
        pg8::gemm_phase<pg8::EpiStoreBf16, pg8::StaticOrder, true, true>(F.lds, g, S, E);
        if (DUP(3)) { xcd_barrier(bar); pg8::gemm_phase<pg8::EpiStoreBf16, pg8::StaticOrder, true, true>(F.lds, g, S, E); }
        { constexpr int NU = (NROWS / 256) * (LD_EVEN / 256); const int nfull = NU % F.G;
          if (nfull > 0 && F.bid >= nfull) { convert_wout(F, in, F.bid - nfull, F.G - nfull, 0); convert_wodd(F, in, F.bid - nfull, F.G - nfull); } else if (nfull == 0) { convert_wout(F, in, F.bid, F.G, 0); convert_wodd(F, in, F.bid, F.G); } } }
    SEAM(3);
    if (IN(4)) { phase_m0a(F, in); if (DUP(4)) { xcd_barrier(bar); phase_m0a(F, in); } }
    SEAM(4);
#ifndef P5_ONLY
#define P5_ONLY 0
#endif
    if (IN(5)) { phase_m0(F, in); if (DUP(5)) { xcd_barrier(bar); phase_m0(F, in, P5_ONLY); } }
    SEAM(5);
    if (IN(6)) { phase_m0c(F, in); if (DUP(6)) { xcd_barrier(bar); phase_m0c(F, in); } }
    SEAM(6);
    if (IN(7)) { pg8::Gemm g{(const pg8::bf16_t*)(F.ws + WS_MIX), (const pg8::bf16_t*)(F.ws + WS_WTOUT), NROWS, DM, DM}; pg8::StaticOrder S; S.init(NROWS, DM, F.G, F.bid);
        pg8::EpiResGateBf16 E{(pg8::bf16_t*)xr_base(F), LDX, (const float*)(F.ws + WS_MODF) + (size_t)6 * 4096};
        pg8::gemm_phase<pg8::EpiResGateBf16, pg8::StaticOrder, true, true>(F.lds, g, S, E); }
    SEAM(7);
    if (IN(8)) { phase_norm<1>(F, in); if (DUP(8)) { xcd_barrier(bar); phase_norm<1>(F, in); } }
    SEAM(8);
    if (IN(9)) { pg8::Gemm g{(const pg8::bf16_t*)(F.ws + WS_H), (const pg8::bf16_t*)(F.ws + WS_WTO), NROWS, IN_ODD, DM}; pg8::StaticOrder S; S.init(NROWS, IN_ODD, F.G, F.bid);
        pg8::EpiStoreBf16 E{(pg8::bf16_t*)(F.ws + WS_U), IN_ODD};
        pg8::gemm_phase<pg8::EpiStoreBf16, pg8::StaticOrder, true, true>(F.lds, g, S, E);
        if (DUP(9)) { xcd_barrier(bar); pg8::gemm_phase<pg8::EpiStoreBf16, pg8::StaticOrder, true, true>(F.lds, g, S, E); }
        { constexpr int NU = (NROWS / 256) * (IN_ODD / 256); const int nfull = NU % F.G;
          if (nfull > 0 && F.bid >= nfull) { phase_filters(F, in, F.bid - nfull, F.G - nfull); convert_wout(F, in, F.bid - nfull, F.G - nfull, 1); } else if (nfull == 0) { phase_filters(F, in, F.bid, F.G); convert_wout(F, in, F.bid, F.G, 1); } } }
    SEAM(9);
    if (IN(10)) { phase_m1a(F, in); if (DUP(10)) { xcd_barrier(bar); phase_m1a(F, in); } }
    SEAM(10);
    if (IN(11)) { phase_m1b(F, in); if (DUP(11)) { xcd_barrier(bar); phase_m1b(F, in, 1); } }
    SEAM(11);
    if (IN(12)) { phase_m1c(F, in); if (DUP(12)) { xcd_barrier(bar); phase_m1c(F, in); } }
    SEAM(12);
    if (IN(13)) { pg8::Gemm g{(const pg8::bf16_t*)(F.ws + WS_MIX), (const pg8::bf16_t*)(F.ws + WS_WTOUT) + (size_t)DM * DM, NROWS, DM, DM}; pg8::StaticOrder S; S.init(NROWS, DM, F.G, F.bid);
        pg8::EpiResGateBf16 E{(pg8::bf16_t*)xr_base(F), LDX, (const float*)(F.ws + WS_MODF) + (size_t)(9 + 6) * 4096};
        pg8::gemm_phase<pg8::EpiResGateBf16, pg8::StaticOrder, true, true>(F.lds, g, S, E); }
    SEAM(13);
    if (IN(14)) phase_norm<2>(F, in);
#ifdef DBG_DUMP
    xcd_barrier(bar);
#define DUMP_ONE(OOFF, ONEXT, PTR, NB, ISBF) do { const size_t no = (size_t)(ONEXT) - (size_t)(OOFF), nb = (NB); float* op = F.out + (OOFF); \
        for (size_t i = (size_t)F.bid * 512 + F.tid; i < no; i += (size_t)F.G * 512) { float acc = 0.f; \
            for (size_t j = i; j < nb; j += no) acc += (ISBF) ? bf2f(((const bf16*)(PTR))[j]) : ((const float*)(PTR))[j]; \
            op[i] = acc; } } while (0)
#if DBG_DUMP == 1
    DUMP_ONE(0, 16777216, F.ws + WS_H, (size_t)NROWS * DM, 1);
    DUMP_ONE(16777216, 50331648, F.ws + WS_U, (size_t)NROWS * LD_EVEN, 1);
    DUMP_ONE(50331648, 58720256, F.ws + WS_OFA, (size_t)2 * NROWS * 2048, 0);
    DUMP_ONE(58720256, 67108864, F.ws + WS_OFB, (size_t)2 * NROWS * 2048, 0);
    DUMP_ONE(67108864, 75497472, F.ws + WS_MIX, (size_t)NROWS * DM, 1);
#elif DBG_DUMP == 4
    DUMP_ONE(0, 16777216, F.ws + WS_OFA, (size_t)NROWS * 2048, 0);
    DUMP_ONE(16777216, 50331648, F.ws + WS_OBA, (size_t)NROWS * 2048, 0);
    DUMP_ONE(58720256, 67108864, F.ws + WS_H, (size_t)NROWS * DM, 1);
    DUMP_ONE(67108864, 75497472, F.ws + WS_H, (size_t)NROWS * DM, 1);
#elif DBG_DUMP == 7
    { unsigned fl = 0u; const float* pa = (const float*)(F.ws + WS_OFA); const float* pb = (const float*)(F.ws + WS_OBA); const float* ps = F.out + OUT_SG;
      for (size_t i = (size_t)F.bid * 512 + F.tid; i < (size_t)NROWS * 2048; i += (size_t)F.G * 512) { const size_t row = i >> 11; const float va = pa[i], vb = pb[i];
          if (!(fabsf(va) <= 3.0e38f)) { fl |= row < 4096 ? 1u : 2u; if (row >= 4096 && ((row - 4096) & 4095) < 64) fl |= 32u; }
          if (!(fabsf(vb) <= 3.0e38f)) fl |= row < 4096 ? 4u : 8u; }
      for (size_t i = (size_t)F.bid * 512 + F.tid; i < (size_t)8388608; i += (size_t)F.G * 512) { const float v = ps[i]; if (!(fabsf(v) <= 3.0e38f)) fl |= 16u; }
      if (fl) atomicOr(ctl + 64, fl); }
    xcd_barrier(bar);
    { const unsigned fl = __hip_atomic_load(ctl + 64, __ATOMIC_RELAXED, __HIP_MEMORY_SCOPE_AGENT);
      const unsigned d1 = 1u + (fl & 1u) + ((fl >> 1) & 1u) * 2u + ((fl >> 2) & 1u) * 4u, d2 = 1u + ((fl >> 3) & 1u) + ((fl >> 4) & 1u) * 2u + ((fl >> 5) & 1u) * 4u;
      const unsigned total = d1 * 1000000u + d2 * 100000u;
      for (size_t i = (size_t)F.bid * 512 + F.tid; i < (size_t)75497472; i += (size_t)F.G * 512) F.out[i] = (i < total) ? __uint_as_float(0xAAAAAAAAu) : 1.0f; }
#elif DBG_DUMP == 6
    { unsigned cnt = 0u; const float* pa = (const float*)(F.ws + WS_OFA); const float* ps = F.out + OUT_SG;
      for (size_t i = (size_t)F.bid * 512 + F.tid; i < (size_t)2 * NROWS * 2048; i += (size_t)F.G * 512) { const float v = pa[i]; if (!(fabsf(v) <= 3.0e38f)) ++cnt; }
      for (size_t i = (size_t)F.bid * 512 + F.tid; i < (size_t)8388608; i += (size_t)F.G * 512) { const float v = ps[i]; if (!(fabsf(v) <= 3.0e38f)) ++cnt; }
      if (cnt) atomicAdd(ctl + 64, cnt); }
    xcd_barrier(bar);
    { const unsigned total = __hip_atomic_load(ctl + 64, __ATOMIC_RELAXED, __HIP_MEMORY_SCOPE_AGENT);
      const float* pa = (const float*)(F.ws + WS_OFA);
      for (size_t i = (size_t)F.bid * 512 + F.tid; i < (size_t)75497472; i += (size_t)F.G * 512) {
          float v = 1.0f;
          if (i < 16777216) { if (i < total) v = __uint_as_float(0xAAAAAAAAu); }
          else if (i < 50331648) { const size_t k = i - 16777216; float a = pa[k]; if (!(fabsf(a) <= 3.0e38f)) a = 7.0f; v = a; }
          F.out[i] = v; } }
#elif DBG_DUMP == 5
    DUMP_ONE(0, 16777216, F.ws + WS_OFB, (size_t)NROWS * 2048, 0);
    DUMP_ONE(16777216, 50331648, F.ws + WS_OBB, (size_t)NROWS * 2048, 0);
    DUMP_ONE(50331648, 58720256, F.ws + WS_H, (size_t)NROWS * DM, 1);
    DUMP_ONE(67108864, 75497472, F.ws + WS_H, (size_t)NROWS * DM, 1);
#elif DBG_DUMP == 3
    DUMP_ONE(0, 16777216, F.ws + WS_H, (size_t)NROWS * DM, 1);
    DUMP_ONE(16777216, 50331648, F.ws + WS_U, (size_t)NROWS * LD_EVEN, 1);
    DUMP_ONE(50331648, 58720256, F.ws + WS_WTE, (size_t)LD_EVEN * DM, 1);
    DUMP_ONE(58720256, 67108864, F.ws + WS_MODF, (size_t)(1 * MiB + 512 * 1024) / 4, 0);
    DUMP_ONE(67108864, 75497472, F.ws + WS_HF256, (size_t)2 * 2048 * 512, 0);
#else
    DUMP_ONE(0, 16777216, F.ws + WS_H, (size_t)NROWS * DM, 1);
    DUMP_ONE(16777216, 50331648, F.ws + WS_U, (size_t)NROWS * IN_ODD, 1);
    DUMP_ONE(50331648, 58720256, F.ws + WS_TB, (size_t)8192 * NROWS, 1);
    DUMP_ONE(58720256, 67108864, F.ws + WS_OFA, (size_t)2 * NROWS * 2048, 0);
    DUMP_ONE(67108864, 75497472, F.ws + WS_YT, (size_t)2048 * NROWS, 1);
#endif
#endif
#undef IN
#undef SEAM
}

extern "C" void kernel_launch(void* const* d_in, const int* in_sizes, int n_in, void* d_out, int out_size, void* d_ws, size_t ws_size, hipStream_t stream) {
    static int grid = 0;
    if (grid == 0) {
        if (n_in != 33 || out_size != 75497472 || ws_size < WS_END2) { fprintf(stderr, "kernel_launch: unexpected problem (n_in %d, out %d, ws %zu)\n", n_in, out_size, ws_size); grid = -1; return; }
        int dev = 0, cus = 0, per_cu = 0;
        if (hipGetDevice(&dev) != hipSuccess || hipDeviceGetAttribute(&cus, hipDeviceAttributeMultiprocessorCount, dev) != hipSuccess) { grid = -1; return; }
        if (hipFuncSetAttribute((const void*)mk_fwd, hipFuncAttributeMaxDynamicSharedMemorySize, LDS_BYTES) != hipSuccess) { fprintf(stderr, "kernel_launch: hipFuncSetAttribute failed\n"); grid = -1; return; }
        if (hipOccupancyMaxActiveBlocksPerMultiprocessor(&per_cu, (const void*)mk_fwd, NTHREADS, LDS_BYTES) != hipSuccess || per_cu < 1) { fprintf(stderr, "kernel_launch: occupancy query says %d\n", per_cu); }
        (void)hipGetLastError();
        grid = cus;
        if (grid < 128) { grid = -1; return; }
    }
    if (grid < 0) return;
    (void)hipMemsetAsync((char*)d_ws + WS_CTL, 0, CTL_ZERO_BYTES, stream);
    Args a{};
    for (int i = 0; i < 33; ++i) a.in[i] = (const float*)d_in[i];
    a.out = (float*)d_out; a.ws = (unsigned char*)d_ws;
#ifndef MK_SPLIT
    a.ph_lo = 0; a.ph_hi = N_PHASES + 1;
#ifdef DBG_STOP
    a.ph_hi = DBG_STOP + 1;
#endif
    hipLaunchKernelGGL(mk_fwd, dim3(grid), dim3(NTHREADS), LDS_BYTES, stream, a);
#else
    for (int p = 0; p <= N_PHASES; ++p) { a.ph_lo = p; a.ph_hi = p + 1; hipLaunchKernelGGL(mk_fwd, dim3(grid), dim3(NTHREADS), LDS_BYTES, stream, a); }
#endif
}
```

```cpp
#include <hip/hip_runtime.h>
#include <cstdio>
#include <cstdint>
namespace pg8 {
#define PG8_LAS __attribute__((address_space(3)))
typedef unsigned short bf16_t;
typedef short bf16x8 __attribute__((ext_vector_type(8)));
typedef float f32x4 __attribute__((ext_vector_type(4)));
typedef unsigned u32x4 __attribute__((ext_vector_type(4)));
constexpr int BM = 256, BK = 64, HALF = 128, HTB = HALF * BK * 2  , STAGE_BYTES = 8 * HTB, NXCD = 8, WGM = 8;

__host__ __device__ __forceinline__ int lds_byte(int r, int c) { const int st = (r >> 4) * 2 + (c >> 5), rr = r & 15, cc = c & 31, ob = rr * 64 + cc * 2; return st * 1024 + (ob ^ (((ob >> 9) & 1) << 5)); }
__host__ __device__ __forceinline__ void stage_rc(int b, int& R, int& C) { const int st = b / 1024, sb = b % 1024, swz = sb ^ (((sb >> 9) & 1) << 5); R = (st >> 1) * 16 + swz / 64; C = (st & 1) * 32 + (swz % 64) / 2; }
__host__ __device__ __forceinline__ int perm32(int rho) { const int n = rho >> 4, i = rho & 15; return 8 * (i >> 2) + 4 * n + (i & 3); }

struct Unit { int pm, pn; };
struct Gemm { const bf16_t* A; const bf16_t* Bt; int M, N, K; };

struct StaticOrder {
    int nM, nN, nwg, G, c;
    __host__ __device__ void init(int M, int N, int G_, int c_) { nM = M / BM; nN = N / BM; nwg = nM * nN; G = G_; c = c_; }
    __host__ __device__ bool next(int i, Unit& u) const {
        const long L = (long)i * G + c; if (L >= nwg) return false;
        int wgid = (int)L; { const int q = nwg / NXCD, r = nwg % NXCD, xcd = wgid % NXCD, off = wgid / NXCD; wgid = (xcd < r ? xcd * (q + 1) : r * (q + 1) + (xcd - r) * q) + off; }
        const int nig = WGM * nN, gid = wgid / nig, fm = gid * WGM, gsz = (nM - fm) < WGM ? (nM - fm) : WGM;
        u.pm = fm + ((wgid % nig) % gsz); u.pn = (wgid % nig) / gsz; return true;
    }
    __device__ __forceinline__ void a_ready(const Unit&) const {}
    __device__ __forceinline__ void done(const Unit&) const {}
};
__device__ __forceinline__ unsigned cvt_pk_bf16(float lo, float hi) { unsigned r; asm volatile("v_cvt_pk_bf16_f32 %0, %1, %2" : "=v"(r) : "v"(lo), "v"(hi)); return r; }
typedef __bf16 bf16x2v __attribute__((ext_vector_type(2)));
typedef float f32x2v_ __attribute__((ext_vector_type(2)));
__device__ __forceinline__ unsigned pk_bf16(float lo, float hi) { f32x2v_ v = {lo, hi}; return __builtin_bit_cast(unsigned, __builtin_convertvector(v, bf16x2v)); }
struct EpiStoreBf16 {
    static constexpr bool PERM = true, AFTER_DRAIN = false;
    bf16_t* O; int ldc;
    __device__ __forceinline__ void operator()(const f32x4 (&acc)[2][2][4][2], const Unit& u, int wr, int wc, int fr, int fq) const {
        const int row0 = u.pm * BM + wr * 64 + fr, col0 = u.pn * BM + wc * 32 + 8 * fq;
#pragma unroll
        for (int ai = 0; ai < 2; ++ai)
#pragma unroll
            for (int m = 0; m < 4; ++m) { bf16_t* rowp = O + (size_t)(row0 + ai * HALF + m * 16) * ldc + col0;
#pragma unroll
                for (int bj = 0; bj < 2; ++bj) { const f32x4 v0 = acc[ai][bj][m][0], v1 = acc[ai][bj][m][1];
                    u32x4 w; w.x = pk_bf16(v0[0], v0[1]); w.y = pk_bf16(v0[2], v0[3]); w.z = pk_bf16(v1[0], v1[1]); w.w = pk_bf16(v1[2], v1[3]);
                    *(u32x4*)(rowp + bj * HALF) = w; } }
    }
};
struct EpiResGate {
    static constexpr bool PERM = false, AFTER_DRAIN = false;
    float* io; int ldc; const float* gate;
    __device__ __forceinline__ void operator()(const f32x4 (&acc)[2][2][4][2], const Unit& u, int wr, int wc, int fr, int fq) const {
        const int row0 = u.pm * BM + wr * 64 + fr, col0 = u.pn * BM + wc * 32 + 4 * fq;
        const int rb = u.pm * BM; const int r = rb < 4096 ? 0 : 1 + ((rb - 4096) >> 12);
        const float* g = gate + r * 4096 + col0;
        f32x4 gv[2][2];
#pragma unroll
        for (int bj = 0; bj < 2; ++bj)
#pragma unroll
            for (int n = 0; n < 2; ++n) gv[bj][n] = *(const f32x4*)(g + bj * HALF + n * 16);
#pragma unroll
        for (int ai = 0; ai < 2; ++ai)
#pragma unroll
            for (int m = 0; m < 4; ++m) { float* rowp = io + (size_t)(row0 + ai * HALF + m * 16) * ldc + col0;
#pragma unroll
                for (int bj = 0; bj < 2; ++bj)
#pragma unroll
                    for (int n = 0; n < 2; ++n) { f32x4* p = (f32x4*)(rowp + bj * HALF + n * 16); const f32x4 b = *p; *p = b + gv[bj][n] * acc[ai][bj][m][n]; }
                if (m == 3) asm volatile("" ::: "memory"); }
    }
};

struct EpiResGateBf16 {
    static constexpr bool PERM = true, AFTER_DRAIN = false;
    bf16_t* io; int ldc; const float* gate;
    __device__ __forceinline__ void operator()(const f32x4 (&acc)[2][2][4][2], const Unit& u, int wr, int wc, int fr, int fq) const {
        const int row0 = u.pm * BM + wr * 64 + fr, col0 = u.pn * BM + wc * 32 + 8 * fq;
        const int rb = u.pm * BM; const int r = rb < 4096 ? 0 : 1 + ((rb - 4096) >> 12);
        const float* g = gate + r * 4096 + col0;
        f32x4 gv[2][2];
#pragma unroll
        for (int bj = 0; bj < 2; ++bj)
#pragma unroll
            for (int n = 0; n < 2; ++n) gv[bj][n] = *(const f32x4*)(g + bj * HALF + 4 * n);
#pragma unroll
        for (int ai = 0; ai < 2; ++ai)
#pragma unroll
            for (int m = 0; m < 4; ++m) { bf16_t* rowp = io + (size_t)(row0 + ai * HALF + m * 16) * ldc + col0;
#pragma unroll
                for (int bj = 0; bj < 2; ++bj) { u32x4* p = (u32x4*)(rowp + bj * HALF); const u32x4 b = *p;
                    const f32x4 a0 = acc[ai][bj][m][0] * gv[bj][0], a1 = acc[ai][bj][m][1] * gv[bj][1];
                    u32x4 w;
                    w.x = pk_bf16(__uint_as_float(b.x << 16) + a0[0], __uint_as_float(b.x & 0xffff0000u) + a0[1]); w.y = pk_bf16(__uint_as_float(b.y << 16) + a0[2], __uint_as_float(b.y & 0xffff0000u) + a0[3]);
                    w.z = pk_bf16(__uint_as_float(b.z << 16) + a1[0], __uint_as_float(b.z & 0xffff0000u) + a1[1]); w.w = pk_bf16(__uint_as_float(b.w << 16) + a1[2], __uint_as_float(b.w & 0xffff0000u) + a1[3]);
                    *p = w; }
                if (m == 3) asm volatile("" ::: "memory"); }
    }
};
template <class Epi, class Sched, bool ALIGN_EPI = false, bool SP2 = false>
__device__ __forceinline__ void gemm_phase(PG8_LAS unsigned char* lds, const Gemm g, const Sched& S, const Epi& E) {
    const int tid = threadIdx.x, wid = __builtin_amdgcn_readfirstlane(tid >> 6), lane = tid & 63, wr = wid >> 2, wc = wid & 3, fr = lane & 15, fq = lane >> 4;
    const int K = g.K, nt = K / BK;
    unsigned voffA[2], voffB[2];
#pragma unroll
    for (int i = 0; i < 2; ++i) { int R, C; stage_rc(tid * 16 + i * 8192, R, C); const int Rb = Epi::PERM ? ((R & ~31) + perm32(R & 31)) : R;
        voffA[i] = (unsigned)(R * K + C) * 2u; voffB[i] = (unsigned)(Rb * K + C) * 2u; }
    const size_t kstep = (size_t)(BK * 2);
    const size_t hstep = (size_t)HALF * K * 2;
    const size_t tstep = 2 * hstep;
    const unsigned ldsw = (unsigned)wid * 1024u;
    const int aoff = lds_byte(wr * 64 + fr, fq * 8), boff = lds_byte(wc * 32 + fr, fq * 8);
#define PG8_SA(b, h) (((b) * 2 + (h)) * HTB)
#define PG8_SB(b, h) ((4 + (b) * 2 + (h)) * HTB)
#define PG8_STAGE(bufoff, gbase, voff) do { _Pragma("unroll") for (int _i = 0; _i < 2; ++_i) \
        __builtin_amdgcn_global_load_lds((const unsigned*)((const char*)(gbase) + (voff)[_i]), (PG8_LAS unsigned*)(lds + (bufoff) + ldsw + _i * 8192), 16, 0, 0); } while (0)
#define PG8_LDA(dst, b, h) do { _Pragma("unroll") for (int m = 0; m < 4; ++m) _Pragma("unroll") for (int k = 0; k < 2; ++k) dst[m][k] = *(const PG8_LAS bf16x8*)(lds + PG8_SA(b, h) + aoff + m * 2048 + k * 1024); } while (0)
#define PG8_LDB(dst, b, h) do { _Pragma("unroll") for (int n = 0; n < 2; ++n) _Pragma("unroll") for (int k = 0; k < 2; ++k) dst[n][k] = *(const PG8_LAS bf16x8*)(lds + PG8_SB(b, h) + boff + n * 2048 + k * 1024); } while (0)
#define PG8_MMA(ai, bj, At, Bt) do { __builtin_amdgcn_s_setprio(1); _Pragma("unroll") for (int m = 0; m < 4; ++m) _Pragma("unroll") for (int n = 0; n < 2; ++n) _Pragma("unroll") for (int k = 0; k < 2; ++k) \
        acc[ai][bj][m][n] = __builtin_amdgcn_mfma_f32_16x16x32_bf16(Bt[n][k], At[m][k], acc[ai][bj][m][n], 0, 0, 0); __builtin_amdgcn_s_setprio(0); } while (0)
#define PG8_WAIT_V(n) asm volatile("s_waitcnt vmcnt(" #n ")" ::: "memory")
#define PG8_WAIT_L(n) asm volatile("s_waitcnt lgkmcnt(" #n ")" ::: "memory")
#define PG8_BAR __builtin_amdgcn_s_barrier()
#define PG8_SCHED __builtin_amdgcn_sched_barrier(0)
    Unit cur, nxt; int ui = 0;
    if (!S.next(0, cur)) return;
    f32x4 acc[2][2][4][2];
#pragma unroll
    for (int a = 0; a < 2; ++a)
#pragma unroll
        for (int b = 0; b < 2; ++b)
#pragma unroll
            for (int m = 0; m < 4; ++m)
#pragma unroll
                for (int n = 0; n < 2; ++n) acc[a][b][m][n] = (f32x4){0.f, 0.f, 0.f, 0.f};
    bf16x8 At[4][2], B0[2][2], B1[2][2];
    const char* cA = (const char*)g.A + (size_t)cur.pm * tstep; const char* cB = (const char*)g.Bt + (size_t)cur.pn * tstep;
    S.a_ready(cur);
    if constexpr (SP2) {
        PG8_STAGE(PG8_SB(0, 0), cB, voffB); PG8_STAGE(PG8_SB(0, 1), cB + hstep, voffB); PG8_STAGE(PG8_SA(0, 0), cA, voffA); PG8_STAGE(PG8_SA(0, 1), cA + hstep, voffA);
        if (wr == 1) PG8_BAR;
        PG8_WAIT_V(2); PG8_BAR;
        PG8_STAGE(PG8_SB(1, 0), cB + kstep, voffB); PG8_STAGE(PG8_SA(1, 0), cA + kstep, voffA); PG8_STAGE(PG8_SB(1, 1), cB + hstep + kstep, voffB);
        PG8_WAIT_V(6); PG8_BAR;
    } else {
        PG8_STAGE(PG8_SB(0, 0), cB, voffB); PG8_STAGE(PG8_SA(0, 0), cA, voffA); PG8_STAGE(PG8_SB(0, 1), cB + hstep, voffB); PG8_STAGE(PG8_SA(0, 1), cA + hstep, voffA);
        if (wr == 1) PG8_BAR;
        PG8_WAIT_V(4); PG8_BAR;
        PG8_STAGE(PG8_SB(1, 0), cB + kstep, voffB); PG8_STAGE(PG8_SA(1, 0), cA + kstep, voffA); PG8_STAGE(PG8_SB(1, 1), cB + hstep + kstep, voffB);
        PG8_WAIT_V(6); PG8_BAR;
    }
    for (;;) {
        const bool has_next = S.next(ui + 1, nxt);
        const char* nA = has_next ? (const char*)g.A + (size_t)nxt.pm * tstep : cA; const char* nB = has_next ? (const char*)g.Bt + (size_t)nxt.pn * tstep : cB;
        for (int t = 0; t < nt; t += 2) {
            const bool last = (t == nt - 2);
            const char* a1 = cA + (size_t)(t + 1) * kstep;
            const char* a2 = last ? nA : cA + (size_t)(t + 2) * kstep; const char* b2 = last ? nB : cB + (size_t)(t + 2) * kstep;
            const char* a3 = a2 + kstep; const char* b3 = b2 + kstep;
            if (last && has_next) S.a_ready(nxt);
            if constexpr (SP2) {
            PG8_LDB(B0, 0, 0); PG8_LDB(B1, 0, 1); PG8_SCHED; PG8_LDA(At, 0, 0); PG8_STAGE(PG8_SA(1, 1), a1 + hstep, voffA);
            PG8_WAIT_V(8); PG8_WAIT_L(0); PG8_BAR; PG8_MMA(0, 0, At, B0); PG8_MMA(0, 1, At, B1); PG8_BAR; PG8_SCHED;
            PG8_LDA(At, 0, 1); PG8_STAGE(PG8_SB(0, 0), b2, voffB); PG8_STAGE(PG8_SB(0, 1), b2 + hstep, voffB); PG8_STAGE(PG8_SA(0, 0), a2, voffA);
            PG8_WAIT_V(8); PG8_WAIT_L(0); PG8_BAR; PG8_MMA(1, 0, At, B0); PG8_MMA(1, 1, At, B1); PG8_BAR; PG8_SCHED;
            PG8_LDB(B0, 1, 0); PG8_LDB(B1, 1, 1); PG8_SCHED; PG8_LDA(At, 1, 0); PG8_STAGE(PG8_SA(0, 1), a2 + hstep, voffA);
            PG8_WAIT_V(8); PG8_WAIT_L(0); PG8_BAR; PG8_MMA(0, 0, At, B0); PG8_MMA(0, 1, At, B1); PG8_BAR; PG8_SCHED;
            PG8_LDA(At, 1, 1); PG8_STAGE(PG8_SB(1, 0), b3, voffB); PG8_STAGE(PG8_SB(1, 1), b3 + hstep, voffB); PG8_STAGE(PG8_SA(1, 0), a3, voffA);
            PG8_WAIT_V(8); PG8_WAIT_L(0); PG8_BAR; PG8_MMA(1, 0, At, B0); PG8_MMA(1, 1, At, B1); PG8_BAR; PG8_SCHED;
            } else {
            PG8_LDB(B0, 0, 0); PG8_SCHED; PG8_LDA(At, 0, 0); PG8_STAGE(PG8_SA(1, 1), a1 + hstep, voffA);
            PG8_WAIT_L(8); PG8_BAR; PG8_WAIT_L(0); PG8_MMA(0, 0, At, B0); PG8_BAR; PG8_SCHED;
            PG8_LDB(B1, 0, 1); PG8_STAGE(PG8_SB(0, 0), b2, voffB);
            PG8_BAR; PG8_WAIT_L(0); PG8_MMA(0, 1, At, B1); PG8_BAR;
            PG8_LDA(At, 0, 1); PG8_STAGE(PG8_SA(0, 0), a2, voffA);
            PG8_BAR; PG8_WAIT_L(0); PG8_MMA(1, 0, At, B0); PG8_BAR; PG8_SCHED;
            PG8_STAGE(PG8_SB(0, 1), b2 + hstep, voffB);
            PG8_WAIT_V(6); PG8_BAR; PG8_MMA(1, 1, At, B1); PG8_BAR;
            PG8_LDB(B0, 1, 0); PG8_SCHED; PG8_LDA(At, 1, 0); PG8_STAGE(PG8_SA(0, 1), a2 + hstep, voffA);
            PG8_WAIT_L(8); PG8_BAR; PG8_WAIT_L(0); PG8_MMA(0, 0, At, B0); PG8_BAR; PG8_SCHED;
            PG8_LDB(B1, 1, 1); PG8_STAGE(PG8_SB(1, 0), b3, voffB);
            PG8_BAR; PG8_WAIT_L(0); PG8_MMA(0, 1, At, B1); PG8_BAR;
            PG8_LDA(At, 1, 1); PG8_STAGE(PG8_SA(1, 0), a3, voffA);
            PG8_BAR; PG8_WAIT_L(0); PG8_MMA(1, 0, At, B0); PG8_BAR; PG8_SCHED;
            PG8_STAGE(PG8_SB(1, 1), b3 + hstep, voffB);
            PG8_WAIT_V(6); PG8_BAR; PG8_MMA(1, 1, At, B1); PG8_BAR;
            }
        }
        if constexpr (ALIGN_EPI) { if (wr == 0) PG8_BAR; }
        if constexpr (!Epi::AFTER_DRAIN) { E(acc, cur, wr, wc, fr, fq); S.done(cur); }
        if (!has_next) break;
#pragma unroll
        for (int a = 0; a < 2; ++a)
#pragma unroll
            for (int b = 0; b < 2; ++b)
#pragma unroll
                for (int m = 0; m < 4; ++m)
#pragma unroll
                    for (int n = 0; n < 2; ++n) acc[a][b][m][n] = (f32x4){0.f, 0.f, 0.f, 0.f};
        cur = nxt; cA = nA; cB = nB; ++ui;
        if constexpr (ALIGN_EPI) { if (wr == 1) PG8_BAR; }
    }
    PG8_WAIT_V(0);
    if constexpr (!ALIGN_EPI) { if (wr == 0) PG8_BAR; }
    PG8_BAR;
    if constexpr (Epi::AFTER_DRAIN) { E.fused(acc, cur, wr, wc, fr, fq, lds, wid, lane); S.done(cur); }
#undef PG8_SA
#undef PG8_SB
#undef PG8_STAGE
#undef PG8_LDA
#undef PG8_LDB
#undef PG8_MMA
#undef PG8_WAIT_V
#undef PG8_WAIT_L
#undef PG8_BAR
#undef PG8_SCHED
}
}
#define XB_TMO      128
#define XB_XCNT(j)  (256  + 64 * (j))
#define XB_XSUB(j)  (1280 + 64 * (j))
#define XB_XGEN(j)  (2304 + 64 * (j))
#define XB_TOP      3328
#define XB_TOPGEN   3392
#define XCD_BAR_WORDS 3456
#define XB_SPIN_CAP (1u << 18)
#define LAS __attribute__((address_space(3)))

__device__ __forceinline__ unsigned xb_ld(unsigned* p)              { return __hip_atomic_load(p, __ATOMIC_RELAXED, __HIP_MEMORY_SCOPE_AGENT); }
__device__ __forceinline__ unsigned xb_add(unsigned* p, unsigned v) { return __hip_atomic_fetch_add(p, v, __ATOMIC_RELAXED, __HIP_MEMORY_SCOPE_AGENT); }
__device__ __forceinline__ unsigned xb_xcc_id() { return (unsigned)__builtin_amdgcn_s_getreg((3 << 11) | 20) & 0xFu; }
#define XB_SPIN(cond, bar) do { unsigned _sp = 0; while (cond) { __builtin_amdgcn_s_sleep(1); \
    if ((++_sp & 255u) == 0u) { if (xb_ld(&(bar)[XB_TMO])) break; if (_sp > XB_SPIN_CAP) { atomicAdd(&(bar)[XB_TMO], 1u); break; } } } } while (0)

struct XcdBarrier {
    unsigned* bar; unsigned x;
    volatile LAS unsigned* st;
};

__device__ __forceinline__ XcdBarrier xcd_barrier_post(unsigned* bar, volatile LAS unsigned* st) {
    XcdBarrier b; b.bar = bar; b.x = xb_xcc_id(); b.st = st;
    if (threadIdx.x == 0) (void)xb_add(&bar[XB_XCNT(b.x)], 1u);
    return b;
}
__device__ __forceinline__ void xcd_barrier_complete(unsigned* bar, unsigned x, unsigned& nloc, unsigned& nx) {
    const unsigned G = gridDim.x * gridDim.y * gridDim.z;
    unsigned sum, cnt, mine, sp = 0u;
    for (;;) {
        sum = 0u; cnt = 0u; mine = 0u;
#pragma unroll
        for (unsigned j = 0; j < 16; ++j) { const unsigned c = xb_ld(&bar[XB_XCNT(j)]); sum += c; cnt += (c > 0u) ? 1u : 0u; mine = (j == x) ? c : mine; }
        if (sum == G) break;
        __builtin_amdgcn_s_sleep(1);
        if ((++sp & 255u) == 0u) { if (xb_ld(&bar[XB_TMO])) break; if (sp > XB_SPIN_CAP) { atomicAdd(&bar[XB_TMO], 1u); break; } }
    }
    nloc = mine > 0u ? mine : 1u; nx = cnt > 0u ? cnt : 1u;
}

__device__ __forceinline__ void xcd_barrier(const XcdBarrier& b) {
    asm volatile("s_waitcnt vmcnt(0)" ::: "memory");
    __syncthreads();
    if (threadIdx.x == 0) {
        unsigned* bar = b.bar;
        __builtin_amdgcn_s_waitcnt(0);
        unsigned nloc = b.st[0], nx = b.st[1];
        if (nloc == 0u) { xcd_barrier_complete(bar, b.x, nloc, nx); b.st[0] = nloc; b.st[1] = nx; }
        const unsigned old = xb_add(&bar[XB_XSUB(b.x)], 1u);
        const unsigned gen = old / nloc;
        if (old + 1u == (gen + 1u) * nloc) {
            __builtin_amdgcn_fence(__ATOMIC_RELEASE, "agent");
            asm volatile("s_waitcnt vmcnt(0)" ::: "memory");
            const unsigned og = xb_add(&bar[XB_TOP], 1u);
            const unsigned tg = og / nx;
            if (og + 1u == (tg + 1u) * nx) xb_add(&bar[XB_TOPGEN], 1u);
            else XB_SPIN(xb_ld(&bar[XB_TOPGEN]) == tg, bar);
            __builtin_amdgcn_fence(__ATOMIC_ACQUIRE, "agent");
            xb_add(&bar[XB_XGEN(b.x)], 1u);
            asm volatile("s_waitcnt vmcnt(0)" ::: "memory");
        } else {
            XB_SPIN(xb_ld(&bar[XB_XGEN(b.x)]) == gen, bar);
            __builtin_amdgcn_fence(__ATOMIC_ACQUIRE, "agent");
            asm volatile("s_waitcnt vmcnt(0)" ::: "memory");
        }
    }
    __syncthreads();
}
#define DI __device__ __forceinline__
typedef unsigned short bf16;
typedef short bf16x8 __attribute__((ext_vector_type(8)));
typedef short bf16x4 __attribute__((ext_vector_type(4)));
typedef float f32x4 __attribute__((ext_vector_type(4)));
typedef float f32x2 __attribute__((ext_vector_type(2)));
typedef unsigned u32x4 __attribute__((ext_vector_type(4)));
typedef unsigned u32x2 __attribute__((ext_vector_type(2)));
typedef __bf16 bf16x2n __attribute__((ext_vector_type(2)));
#define MFMA16(a, b, c) __builtin_amdgcn_mfma_f32_16x16x32_bf16((a), (b), (c), 0, 0, 0)

constexpr int DM = 4096, NROWS = 12288;
constexpr int IN_EVEN = 14464, LD_EVEN = 14592, IN_ODD = 18432;
constexpr int E_QKV = 0, E_BETA = 6144, E_A = 6176, E_ZA = 6208, E_XBC = 8256, E_DT = 12352, E_ZB = 12416;
constexpr int O_VX = 0, O_ZC = 6144, O_Q = 8192, O_F = 10240, O_I = 14336, O_ZD = 16384;
constexpr float EPS = 1e-6f;
constexpr int NSEQ = 18;
DI int seq_row0(int s) { return s < 16 ? s * 256 : 4096 + (s - 16) * 4096; }
DI int seq_len(int s) { return s < 16 ? 256 : 4096; }
constexpr size_t OUT_SG = 50331648, OUT_SS = 58720256, OUT_SH = 67108864;

constexpr size_t MiB = 1u << 20;
constexpr size_t WS_CTL = 0, CTL_ZERO_BYTES = 1 * MiB;
constexpr size_t WS_MODP = 1 * MiB;
constexpr size_t WS_MODF = 4 * MiB;
constexpr size_t WS_PE = 5 * MiB;
constexpr size_t WS_HDN = 6 * MiB;
constexpr size_t WS_HNRM = 8 * MiB;
constexpr size_t WS_HF256 = 16 * MiB;
constexpr size_t WS_HF4096 = 32 * MiB;
constexpr size_t WS_WTE = 160 * MiB;
constexpr size_t WS_WTO = 274 * MiB;
constexpr size_t WS_WTOUT = 418 * MiB;
constexpr size_t WS_H = 482 * MiB;
constexpr size_t WS_U = 578 * MiB;
constexpr size_t WS_MIX = 1010 * MiB;
constexpr size_t WS_OFA = 1106 * MiB;
constexpr size_t WS_OBA = 1154 * MiB;
constexpr size_t WS_OFB = 1202 * MiB;
constexpr size_t WS_OBB = 1250 * MiB;
constexpr size_t WS_TB = 1298 * MiB;
constexpr size_t WS_END = 1490 * MiB;
constexpr size_t WS_YT = WS_WTE;
constexpr size_t WS_GWN = 1298 * MiB;
constexpr size_t WS_GUF = 1394 * MiB;
constexpr size_t WS_GPP = 920 * MiB;
constexpr size_t WS_GGC = 968 * MiB;
constexpr size_t WS_GQN = WS_WTE;
constexpr size_t WS_GKT = WS_WTE + 48 * MiB;
constexpr size_t WS_SSP = 32 * MiB;
constexpr size_t WS_SCN = 128 * MiB;
constexpr size_t WS_SSG = 152 * MiB;
constexpr size_t WS_SBT = 1490 * MiB;
constexpr size_t WS_SVT = WS_H;
constexpr size_t WS_END2 = 1514 * MiB;
constexpr size_t WS_LQS = WS_H;
constexpr size_t WS_LKS = WS_WTO;
constexpr size_t WS_LAT = WS_WTO + 96 * MiB;
constexpr size_t WS_LVT = WS_OFB;
constexpr size_t WS_LGL = WS_OBB;
constexpr int CW_Q0 = 8192, CW_Q1 = 8256, CW_Q2 = 8320, CW_Q3 = 8384, CW_Q4 = 8448;
constexpr int CW_BAR = 4096;

DI float bf2f(bf16 b) { return __uint_as_float(((unsigned)b) << 16); }
DI unsigned pk2(float lo, float hi) { f32x2 v = {lo, hi}; return __builtin_bit_cast(unsigned, __builtin_convertvector(v, bf16x2n)); }
DI bf16 f2bf(float f) { return (bf16)(pk2(f, 0.f) & 0xffffu); }
DI float wave_sum(float v) {
#pragma unroll
    for (int o = 1; o < 64; o <<= 1) v += __shfl_xor(v, o);
    return v;
}
DI float sigmoidf_(float x) { return __builtin_amdgcn_rcpf(1.0f + __expf(-x)); }
DI float siluf_(float x) { return x * __builtin_amdgcn_rcpf(1.0f + __expf(-x)); }
DI float softplusf_(float x) { return x > 20.f ? x : log1pf(__expf(x)); }
DI void unpack8(const u32x4 w, float* o) {
    o[0] = __uint_as_float(w.x << 16); o[1] = __uint_as_float(w.x & 0xffff0000u); o[2] = __uint_as_float(w.y << 16); o[3] = __uint_as_float(w.y & 0xffff0000u);
    o[4] = __uint_as_float(w.z << 16); o[5] = __uint_as_float(w.z & 0xffff0000u); o[6] = __uint_as_float(w.w << 16); o[7] = __uint_as_float(w.w & 0xffff0000u);
}
DI bf16x8 frag_nat(const LAS bf16* M, int ld, int r0, int k0, int lane) { return *(const LAS bf16x8*)(M + (r0 + (lane & 15)) * ld + k0 + 8 * (lane >> 4)); }
DI bf16x8 frag_perm(const LAS bf16* M, int ld, int r0, int k0, int lane) {
    const LAS bf16* p = M + (r0 + (lane & 15)) * ld + k0 + 4 * (lane >> 4);
    const bf16x4 lo = *(const LAS bf16x4*)p, hi = *(const LAS bf16x4*)(p + 16);
    return __builtin_shufflevector(lo, hi, 0, 1, 2, 3, 4, 5, 6, 7);
}
DI bf16x8 pack2(const f32x4 a, const f32x4 b) {
    u32x4 w; w.x = pk2(a[0], a[1]); w.y = pk2(a[2], a[3]); w.z = pk2(b[0], b[1]); w.w = pk2(b[2], b[3]);
    return __builtin_bit_cast(bf16x8, w);
}
DI void st_bf16x4(LAS bf16* p, float a, float b, float c, float d) { u32x2 w; w.x = pk2(a, b); w.y = pk2(c, d); *(LAS u32x2*)p = w; }
constexpr int LDQ = 136, LDT = 72;
DI int swz_idx(int row, int col) { return row * LDT + (((((col >> 3) ^ (row >> 4)) & 7) << 3) | (col & 7)); }
DI bf16x8 frag_nat_sw(const LAS bf16* M, int r0, int k0, int lane) { const int q = lane >> 4; return *(const LAS bf16x8*)(M + (r0 + (lane & 15)) * LDT + ((((k0 >> 3) + q) ^ (r0 >> 4)) & 7) * 8); }
DI bf16x8 frag_perm_sw(const LAS bf16* M, int r0, int k0, int lane) { const int q = lane >> 4, sw = r0 >> 4; const LAS bf16* p = M + (r0 + (lane & 15)) * LDT + 4 * (q & 1);
    const bf16x4 lo = *(const LAS bf16x4*)(p + ((((k0 >> 3) + (q >> 1)) ^ sw) & 7) * 8), hi = *(const LAS bf16x4*)(p + ((((k0 >> 3) + 2 + (q >> 1)) ^ sw) & 7) * 8);
    return __builtin_shufflevector(lo, hi, 0, 1, 2, 3, 4, 5, 6, 7); }
#define LDSBAR() do { asm volatile("s_waitcnt lgkmcnt(0)" ::: "memory"); __builtin_amdgcn_s_barrier(); asm volatile("" ::: "memory"); } while (0)
#ifndef WODD_KEEP
#define WODD_KEEP 288
#endif
constexpr int WODD_P0 = 64 * WODD_KEEP;
struct Ctx {
    LAS unsigned char* lds;
    const float* const* in;
    unsigned char* ws;
    float* out;
    int tid, lane, wave, bid, G;
};
DI void p0_transpose_pair(const float* W, int K, int N, bf16* WT, LAS float* scr, int item0, int item1, int lane) {
    const int nblk = N / 32;
    float va[32], vb[32];
    { const int kb = item0 / nblk, nb = item0 % nblk; const float* src = W + (size_t)(64 * kb + (lane >> 5)) * N + 32 * nb + (lane & 31);
#pragma unroll
      for (int i = 0; i < 32; ++i) va[i] = __builtin_nontemporal_load(src + (size_t)(2 * i) * N); }
    if (item1 >= 0) { const int kb = item1 / nblk, nb = item1 % nblk; const float* src = W + (size_t)(64 * kb + (lane >> 5)) * N + 32 * nb + (lane & 31);
#pragma unroll
      for (int i = 0; i < 32; ++i) vb[i] = __builtin_nontemporal_load(src + (size_t)(2 * i) * N); }
#pragma unroll
    for (int half = 0; half < 2; ++half) { const int item = half ? item1 : item0; if (item < 0) break;
        const int kb = item / nblk, nb = item % nblk, k0 = 64 * kb, n0 = 32 * nb;
#pragma unroll
        for (int i = 0; i < 32; ++i) scr[(2 * i + (lane >> 5)) * 33 + (lane & 31)] = half ? vb[i] : va[i];
        asm volatile("s_waitcnt lgkmcnt(0)" ::: "memory");
        const int c = lane & 7;
#pragma unroll
        for (int j = 0; j < 4; ++j) { const int n = (lane >> 3) + 8 * j; const LAS float* s = scr + (8 * c) * 33 + n;
            u32x4 o; o.x = pk2(s[0 * 33], s[1 * 33]); o.y = pk2(s[2 * 33], s[3 * 33]); o.z = pk2(s[4 * 33], s[5 * 33]); o.w = pk2(s[6 * 33], s[7 * 33]);
            *(u32x4*)(WT + (size_t)(n0 + n) * K + k0 + 8 * c) = o; }
        asm volatile("s_waitcnt lgkmcnt(0)" ::: "memory"); }
}
DI void p0_transpose_range(const float* W, int K, int N, bf16* WT, LAS float* scr, int first, int stride, int total, int lane) {
    for (int it = first; it < total; it += 2 * stride) p0_transpose_pair(W, K, N, WT, scr, it, it + stride < total ? it + stride : -1, lane);
}
DI void p0_adaln_item(const Ctx& F, const float* w_ada, const float* c, const float* c_ctx, int item) {
    const int li = item / 384, rem = item % 384, strip = rem >> 3, kseg = rem & 7;
    const float* W = w_ada + (size_t)li * 4096 * 12288 + strip * 256 + F.lane * 4;
    const int k0 = kseg * 512 + F.wave * 64;
    f32x4 a0 = {0.f, 0.f, 0.f, 0.f}, a1 = a0, a2 = a0;
#pragma unroll 8
    for (int kk = 0; kk < 64; ++kk) { const int k = k0 + kk;
        const float s0 = siluf_(c_ctx[k]), s1 = siluf_(c[k]), s2 = siluf_(c[4096 + k]);
        const f32x4 w = __builtin_nontemporal_load((const f32x4*)(W + (size_t)k * 12288));
        a0 += s0 * w; a1 += s1 * w; a2 += s2 * w; }
    LAS float* scr = (LAS float*)F.lds;
    *(LAS f32x4*)(scr + F.wave * 768 + 0 * 256 + F.lane * 4) = a0;
    *(LAS f32x4*)(scr + F.wave * 768 + 1 * 256 + F.lane * 4) = a1;
    *(LAS f32x4*)(scr + F.wave * 768 + 2 * 256 + F.lane * 4) = a2;
    __syncthreads();
    float* modp = (float*)(F.ws + WS_MODP);
    for (int o = F.tid; o < 768; o += 512) { float s = 0.f;
#pragma unroll
        for (int w = 0; w < 8; ++w) s += scr[w * 768 + o];
        const int r = o >> 8, ci = o & 255;
        modp[((size_t)(kseg * 2 + li) * 3 + r) * 12288 + strip * 256 + ci] = s; }
    __syncthreads();
}
DI void p0_hdn_item(const float* w1, const float* b1, const float* freq, const float* w2, const float* b2, int L, int p, float* out, int lane) {
    const float t = (float)p / (float)(L - 1);
    float zk = 0.f;
    if (lane == 0) zk = t;
    else if (lane <= 32) { const int b = (lane - 1) & 15; const float band = 1e-4f + (float)b * ((15.0f - 1e-4f) / 15.0f);
        const float ang = (6.283185307179586f / (float)L) * (float)p * band; zk = (lane <= 16) ? cosf(ang) : -sinf(ang); }
    float a = b1[lane];
#pragma unroll
    for (int k = 0; k < 33; ++k) a += __shfl(zk, k) * w1[k * 64 + lane];
    const float h1 = sinf(freq[lane] * a);
    float a2 = b2[lane];
#pragma unroll 16
    for (int k = 0; k < 64; ++k) a2 += __shfl(h1, k) * w2[k * 64 + lane];
    out[lane] = sinf(freq[64 + lane] * a2);
}
DI void p0_filter_item(const Ctx& F, const float* hdn, const float* w3, float* HF, float* HNRM, int L, int cg) {
    LAS float* wl = (LAS float*)F.lds;
    LAS float* red = wl + 2048;
    for (int e = F.tid; e < 2048; e += 512) { const int k = e >> 5, x = e & 31, dir = x >> 4, ord = (x >> 3) & 1, cc = x & 7;
        wl[e] = w3[(size_t)k * 8192 + dir * 4096 + ord * 2048 + cg * 8 + cc]; }
    __syncthreads();
    float asum[16];
#pragma unroll
    for (int i = 0; i < 16; ++i) asum[i] = 0.f;
    const float tinv = 1.0f / (float)(L - 1);
    float dl2[8];
#pragma unroll
    for (int cc = 0; cc < 8; ++cc) dl2[cc] = 1.4426950408889634f * fabsf(-3.0701134573253945f + (-15.350567286626972f + 3.0701134573253945f) * ((float)(cg * 8 + cc) * (1.0f / 2047.0f)));
    const int half = L > 512 ? L / 2 : L;
    for (int p = F.tid; p < half; p += 512) { const bool two = (L > 512); const int p1 = two ? p + half : p;
        float acc0[32], acc1[32];
#pragma unroll
        for (int i = 0; i < 32; ++i) { acc0[i] = 0.f; acc1[i] = 0.f; }
        const f32x4* hp0 = (const f32x4*)(hdn + (size_t)p * 64); const f32x4* hp1 = (const f32x4*)(hdn + (size_t)p1 * 64);
#pragma unroll 2
        for (int k4 = 0; k4 < 16; ++k4) { const f32x4 hv0 = hp0[k4], hv1 = hp1[k4];
#pragma unroll
            for (int kk = 0; kk < 4; ++kk) { const float h0 = hv0[kk], h1 = hv1[kk]; const LAS f32x4* wr = (const LAS f32x4*)(wl + (k4 * 4 + kk) * 32);
#pragma unroll
                for (int x4 = 0; x4 < 8; ++x4) { const f32x4 w = wr[x4];
                    acc0[x4 * 4 + 0] += h0 * w[0]; acc0[x4 * 4 + 1] += h0 * w[1]; acc0[x4 * 4 + 2] += h0 * w[2]; acc0[x4 * 4 + 3] += h0 * w[3];
                    acc1[x4 * 4 + 0] += h1 * w[0]; acc1[x4 * 4 + 1] += h1 * w[1]; acc1[x4 * 4 + 2] += h1 * w[2]; acc1[x4 * 4 + 3] += h1 * w[3]; } } }
#pragma unroll
        for (int pp = 0; pp < 2; ++pp) { if (pp == 1 && !two) break; const int q = pp ? p1 : p; const float t = (float)q * tinv;
            float win[8];
#pragma unroll
            for (int cc = 0; cc < 8; ++cc) win[cc] = __builtin_amdgcn_exp2f(-t * dl2[cc]);
#pragma unroll
            for (int x = 0; x < 32; ++x) { const int dir = x >> 4, ord = (x >> 3) & 1, cc = x & 7, c = cg * 8 + cc;
                const float val = (pp ? acc1[x] : acc0[x]) * win[cc];
                float* row = HF + ((size_t)ord * 2048 + c) * (size_t)(2 * L);
                if (dir == 0) { row[q] = val; asum[ord * 8 + cc] += fabsf(val); if (q == 0) row[L] = 0.f; }
                else if (q >= 1) { row[2 * L - q] = val; asum[ord * 8 + cc] += fabsf(val); } } }
    }
#pragma unroll
    for (int i = 0; i < 16; ++i) { const float s = wave_sum(asum[i]); if (F.lane == 0) red[F.wave * 16 + i] = s; }
    __syncthreads();
    if (F.tid < 16) { float s = 0.f;
#pragma unroll
        for (int w = 0; w < 8; ++w) s += red[w * 16 + F.tid];
        const int ord = F.tid >> 3, cc = F.tid & 7; HNRM[ord * 2048 + cg * 8 + cc] = 1.0f / s; }
    __syncthreads();
}
DI void phase_p0(const Ctx& F, const float* const* in) {
    const int gw = F.bid * 8 + F.wave, NGW = F.G * 8;
    for (int it = F.bid; it < 768; it += F.G) p0_adaln_item(F, in[8], in[5], in[6], it);
    LAS float* scr = (LAS float*)(F.lds + F.wave * 16384);
    constexpr int I_E = 64 * (IN_EVEN / 32);
    p0_transpose_range(in[12], 4096, IN_EVEN, (bf16*)(F.ws + WS_WTE), scr, gw, NGW, I_E, F.lane);
    p0_transpose_range(in[22], 4096, IN_ODD, (bf16*)(F.ws + WS_WTO), scr, gw, NGW, WODD_P0, F.lane);
    { u32x4* z = (u32x4*)((bf16*)(F.ws + WS_WTE) + (size_t)IN_EVEN * 4096); const u32x4 zero = {0u, 0u, 0u, 0u};
      for (int i = F.bid * 512 + F.tid; i < (LD_EVEN - IN_EVEN) * 4096 / 8; i += F.G * 512) z[i] = zero; }
    { float* pe = (float*)(F.ws + WS_PE);
      for (int i = F.bid * 512 + F.tid; i < 65536; i += F.G * 512) { const int v = i >> 10, j = i & 1023;
          const float omega = 1.0f / powf(10000.0f, (float)j / 1024.0f); const float ang = (float)v * omega;
          pe[2 * i] = sinf(ang); pe[2 * i + 1] = cosf(ang); } }
    { float* hdn = (float*)(F.ws + WS_HDN);
      for (int it = gw; it < 256 + 4096; it += NGW) { const int L = it < 256 ? 256 : 4096, p = it < 256 ? it : it - 256;
          p0_hdn_item(in[24], in[25], in[26], in[27], in[28], L, p, hdn + (size_t)it * 64, F.lane); } }
}
DI void phase_p0c(const Ctx& F, const float* const* in) {
    { const float* modp = (const float*)(F.ws + WS_MODP); float* modf = (float*)(F.ws + WS_MODF);
      for (int i = F.bid * 512 + F.tid; i < 2 * 3 * 4096; i += F.G * 512) { const int li = i / 12288, r = (i / 4096) % 3, cc = i & 4095;
          float sh = in[9][li * 12288 + cc], sc = in[9][li * 12288 + 4096 + cc], gt = in[9][li * 12288 + 8192 + cc];
#pragma unroll
          for (int ks = 0; ks < 8; ++ks) { const float* m = modp + ((size_t)(ks * 2 + li) * 3 + r) * 12288; sh += m[cc]; sc += m[4096 + cc]; gt += m[8192 + cc]; }
          float* o = modf + (size_t)(li * 9 + r) * 4096;
          o[cc] = in[7][li * 4096 + cc] * (1.0f + sc); o[3 * 4096 + cc] = sh; o[6 * 4096 + cc] = gt; } }
}
DI void phase_filters(const Ctx& F, const float* const* in, int w, int nw) {
    __syncthreads();
    for (int it = w; it < 512; it += nw) { const int cg = it & 255, li = it >> 8;
        const float* hdn = (const float*)(F.ws + WS_HDN) + (li ? (size_t)256 * 64 : 0);
        p0_filter_item(F, hdn, in[29], (float*)(F.ws + (li ? WS_HF4096 : WS_HF256)), (float*)(F.ws + WS_HNRM) + li * 4096, li ? 4096 : 256, cg); }
}
DI void convert_wout(const Ctx& F, const float* const* in, int w, int nw, int li) {
    __syncthreads();
    LAS float* scr = (LAS float*)(F.lds + F.wave * 16384);
    p0_transpose_range(in[10] + (size_t)li * 4096 * 4096, 4096, 4096, (bf16*)(F.ws + WS_WTOUT) + (size_t)li * 4096 * 4096, scr, w * 8 + F.wave, nw * 8, 8192, F.lane);
}
DI void convert_wodd(const Ctx& F, const float* const* in, int w, int nw) {
    __syncthreads();
    LAS float* scr = (LAS float*)(F.lds + F.wave * 16384);
    p0_transpose_range(in[22], 4096, IN_ODD, (bf16*)(F.ws + WS_WTO), scr, WODD_P0 + w * 8 + F.wave, nw * 8, 64 * (IN_ODD / 32), F.lane);
}
constexpr int LDX = 8192;
DI bf16* xr_base(const Ctx& F) { return (bf16*)F.out + 4096; }
template <int MODE> DI void phase_norm(const Ctx& F, const float* const* in) {
    const int gw = F.bid * 8 + F.wave, NGW = F.G * 8;
    bf16* H = (bf16*)(F.ws + WS_H); const float* pe = (const float*)(F.ws + WS_PE); bf16* XR = xr_base(F);
    f32x4 ra[MODE == 0 ? 8 : 1], rb[MODE == 0 ? 8 : 1]; u32x4 rw[MODE == 0 ? 1 : 8];
#define NORM_LOAD(row_) do { if (MODE == 0) { const float* src_ = (row_) < 4096 ? in[0] + (size_t)(row_) * DM : in[1] + (size_t)((row_) - 4096) * DM; \
            _Pragma("unroll") for (int j_ = 0; j_ < 8; ++j_) { ra[MODE == 0 ? j_ : 0] = __builtin_nontemporal_load((const f32x4*)(src_ + j_ * 512 + F.lane * 8)); rb[MODE == 0 ? j_ : 0] = __builtin_nontemporal_load((const f32x4*)(src_ + j_ * 512 + F.lane * 8 + 4)); } } \
        else { _Pragma("unroll") for (int j_ = 0; j_ < 8; ++j_) rw[MODE == 0 ? 0 : j_] = *(const u32x4*)(XR + (size_t)(row_) * LDX + j_ * 512 + F.lane * 8); } } while (0)
    if (gw < NROWS) NORM_LOAD(gw);
#pragma unroll 1
    for (int row = gw; row < NROWS; row += NGW) {
        const int r = row < 4096 ? 0 : 1 + ((row - 4096) >> 12);
        const int t = (row - 4096) & 4095, gr = t >> 6, gc = t & 63;
        float v[8][8]; float ss = 0.f;
        if (MODE == 0) {
#pragma unroll
            for (int j = 0; j < 8; ++j) { const int col = j * 512 + F.lane * 8; const f32x4 a = ra[MODE == 0 ? j : 0], b = rb[MODE == 0 ? j : 0];
                v[j][0] = a[0]; v[j][1] = a[1]; v[j][2] = a[2]; v[j][3] = a[3]; v[j][4] = b[0]; v[j][5] = b[1]; v[j][6] = b[2]; v[j][7] = b[3];
                if (row >= 4096) { const int q4 = j >> 1, jj = col & 1023, vv = (q4 < 2) ? gr : gc, comp = q4 & 1;
                    const f32x4* pp = (const f32x4*)(pe + ((size_t)vv * 1024 + jj) * 2);
#pragma unroll
                    for (int e2 = 0; e2 < 4; ++e2) { const f32x4 p = pp[e2]; v[j][2 * e2] += comp ? p[1] : p[0]; v[j][2 * e2 + 1] += comp ? p[3] : p[2]; } } }
        } else {
#pragma unroll
            for (int j = 0; j < 8; ++j) unpack8(rw[MODE == 0 ? 0 : j], v[j]); }
        if (row + NGW < NROWS) NORM_LOAD(row + NGW);
#pragma unroll
        for (int j = 0; j < 8; ++j)
#pragma unroll
            for (int e = 0; e < 8; ++e) ss += v[j][e] * v[j][e];
        const float rstd = __builtin_amdgcn_rsqf(wave_sum(ss) * (1.0f / DM) + EPS);
        if (MODE == 2) { float* yo = F.out + (size_t)row * DM;
#pragma unroll
            for (int j = 0; j < 8; ++j) { const int col = j * 512 + F.lane * 8; const f32x4 g0 = *(const f32x4*)(in[11] + col), g1 = *(const f32x4*)(in[11] + col + 4);
                __builtin_nontemporal_store((f32x4){v[j][0] * rstd * g0[0], v[j][1] * rstd * g0[1], v[j][2] * rstd * g0[2], v[j][3] * rstd * g0[3]}, (f32x4*)(yo + col));
                __builtin_nontemporal_store((f32x4){v[j][4] * rstd * g1[0], v[j][5] * rstd * g1[1], v[j][6] * rstd * g1[2], v[j][7] * rstd * g1[3]}, (f32x4*)(yo + col + 4)); }
        } else {
            const float* A = (const float*)(F.ws + WS_MODF) + (size_t)((MODE == 1 ? 9 : 0) + r) * 4096;
#pragma unroll
            for (int j = 0; j < 8; ++j) { const int col = j * 512 + F.lane * 8;
                const f32x4 a0 = *(const f32x4*)(A + col), a1 = *(const f32x4*)(A + col + 4), b0 = *(const f32x4*)(A + 3 * 4096 + col), b1 = *(const f32x4*)(A + 3 * 4096 + col + 4);
                u32x4 w; w.x = pk2(v[j][0] * rstd * a0[0] + b0[0], v[j][1] * rstd * a0[1] + b0[1]); w.y = pk2(v[j][2] * rstd * a0[2] + b0[2], v[j][3] * rstd * a0[3] + b0[3]);
                w.z = pk2(v[j][4] * rstd * a1[0] + b1[0], v[j][5] * rstd * a1[1] + b1[1]); w.w = pk2(v[j][6] * rstd * a1[2] + b1[2], v[j][7] * rstd * a1[3] + b1[3]);
                *(u32x4*)(H + (size_t)row * DM + col) = w;
                if (MODE == 0) { u32x4 x; x.x = pk2(v[j][0], v[j][1]); x.y = pk2(v[j][2], v[j][3]); x.z = pk2(v[j][4], v[j][5]); x.w = pk2(v[j][6], v[j][7]);
                    *(u32x4*)(XR + (size_t)row * LDX + col) = x; } }
        }
    }
}
#undef NORM_LOAD

DI void conv3_load(const bf16* Urow, size_t ld, int t, int len, u32x4* r) {
    const u32x4 z = {0u, 0u, 0u, 0u};
    const u32x4* p0 = (const u32x4*)Urow; r[2] = p0[0]; r[3] = p0[1];
    if (t > 0) { const u32x4* p = (const u32x4*)(Urow - ld); r[0] = p[0]; r[1] = p[1]; } else { r[0] = z; r[1] = z; }
    if (t + 1 < len) { const u32x4* p = (const u32x4*)(Urow + ld); r[4] = p[0]; r[5] = p[1]; } else { r[4] = z; r[5] = z; }
}
DI void conv3_calc(const u32x4* r, const LAS float* cw, int cstride, float* o) {
#pragma unroll
    for (int hf = 0; hf < 2; ++hf) { float xm[8], x0[8], xp[8]; unpack8(r[hf], xm); unpack8(r[2 + hf], x0); unpack8(r[4 + hf], xp);
#pragma unroll
        for (int e4 = 0; e4 < 2; ++e4) { const int c = hf * 8 + e4 * 4; const f32x4 w0 = *(const LAS f32x4*)(cw + c), w1 = *(const LAS f32x4*)(cw + cstride + c), w2 = *(const LAS f32x4*)(cw + 2 * cstride + c);
#pragma unroll
            for (int e = 0; e < 4; ++e) o[c + e] = w0[e] * xm[e4 * 4 + e] + w1[e] * x0[e4 * 4 + e] + w2[e] * xp[e4 * 4 + e]; } }
}
#define SCHED_FENCE() __builtin_amdgcn_sched_barrier(0)
DI float wave_scan_incl(float v, int lane) {
#pragma unroll
    for (int o = 1; o < 64; o <<= 1) { const float u = __shfl_up(v, o); if (lane >= o) v += u; }
    return v;
}

DI void gdn_prep_request(const Ctx& F, int c64, int h, u32x4 (&rq_)[6], u32x4 (&rk_)[6], u32x4 (&rv_)[6], unsigned& rgate) {
    const bf16* U = (const bf16*)(F.ws + WS_U);
    const int r0 = c64 * 64, len = r0 < 4096 ? 256 : 4096, t0 = r0 < 4096 ? (r0 & 255) : ((r0 - 4096) & 4095);
    const int i = F.tid >> 3, sub = F.tid & 7, t = t0 + i;
    const bf16* ur = U + (size_t)(r0 + i) * LD_EVEN;
    conv3_load(ur + E_QKV + h * 128 + sub * 16, LD_EVEN, t, len, rq_);
    conv3_load(ur + E_QKV + 2048 + h * 128 + sub * 16, LD_EVEN, t, len, rk_);
    conv3_load(ur + E_QKV + 4096 + h * 128 + sub * 16, LD_EVEN, t, len, rv_);
    rgate = (unsigned)ur[E_BETA + (sub & 1) * 16 + h] | ((unsigned)ur[E_A + (sub & 1) * 16 + h] << 16);
}
DI void gdn_prep_item(const Ctx& F, const float* const* in, int c64, int h, bool stage_cw, u32x4 (&rq_)[6], u32x4 (&rk_)[6], u32x4 (&rv_)[6], unsigned& rgate, float (&gpar)[2], int next_c64) {
    LAS bf16* Q = (LAS bf16*)(F.lds + 0);
    LAS bf16* K = (LAS bf16*)(F.lds + 17408);
    LAS bf16* KT = (LAS bf16*)(F.lds + 34816);
    LAS bf16* VT = (LAS bf16*)(F.lds + 53248);
    LAS float* KKR = (LAS float*)(F.lds + 71680);
    LAS float* QKR = (LAS float*)(F.lds + 89088);
    LAS bf16* NN = (LAS bf16*)(F.lds + 106496);
    LAS float* NDG = (LAS float*)(F.lds + 115712);
    LAS bf16* DBK = (LAS bf16*)(F.lds + 119808);
    LAS bf16* W = (LAS bf16*)(F.lds + 124928);
    LAS float* TBL = (LAS float*)(F.lds + 142336);
    LAS float* CW = TBL + 384;
    constexpr int LDD = 40, LDR = 68;
    const bf16* U = (const bf16*)(F.ws + WS_U);
    const int r0 = c64 * 64, len = r0 < 4096 ? 256 : 4096, t0 = r0 < 4096 ? (r0 & 255) : ((r0 - 4096) & 4095);
    const int lane_o = F.lane, wave = F.wave;
    LDSBAR();
    if (stage_cw) { const int sd = (F.tid & 1); gpar[0] = -expf(in[14][sd * 16 + h]); gpar[1] = in[15][sd * 16 + h]; }
    if (stage_cw) {
        for (int e = F.tid; e < 3 * 384; e += 512) { const int tap = e / 384, c = e % 384; CW[e] = in[13][tap * 6144 + (c >> 7) * 2048 + h * 128 + (c & 127)]; }
        for (int e = F.tid; e < 4 * 16 * LDD / 2; e += 512) ((LAS unsigned*)DBK)[e] = 0u;
        LDSBAR(); }
    int lane = lane_o; asm volatile("" : "+v"(lane)); const int l15 = lane & 15, q4 = lane >> 4;
    { const int i = F.tid >> 3, sub = F.tid & 7;
      const bf16* ur = U + (size_t)(r0 + i) * LD_EVEN;
      SCHED_FENCE();
      { float qv[16]; conv3_calc(rq_, CW + sub * 16, 384, qv); float sq = 0.f;
#pragma unroll
        for (int e = 0; e < 16; ++e) { qv[e] = siluf_(qv[e]); sq += qv[e] * qv[e]; }
        sq += __shfl_xor(sq, 1); sq += __shfl_xor(sq, 2); sq += __shfl_xor(sq, 4);
        const float rq = 0.08838834764831845f * __builtin_amdgcn_rsqf(sq + EPS);
        u32x4 g0, g1; g0.x = pk2(qv[0] * rq, qv[1] * rq); g0.y = pk2(qv[2] * rq, qv[3] * rq); g0.z = pk2(qv[4] * rq, qv[5] * rq); g0.w = pk2(qv[6] * rq, qv[7] * rq);
        g1.x = pk2(qv[8] * rq, qv[9] * rq); g1.y = pk2(qv[10] * rq, qv[11] * rq); g1.z = pk2(qv[12] * rq, qv[13] * rq); g1.w = pk2(qv[14] * rq, qv[15] * rq);
        *(LAS u32x4*)(Q + i * LDQ + sub * 16) = g0; *(LAS u32x4*)(Q + i * LDQ + sub * 16 + 8) = g1;
        u32x4* gq = (u32x4*)((bf16*)(F.ws + WS_GQN) + (size_t)(r0 + i) * 2048 + h * 128 + sub * 16); gq[0] = g0; gq[1] = g1; }
      SCHED_FENCE();
      { float kv[16]; conv3_calc(rk_, CW + 128 + sub * 16, 384, kv); float sk = 0.f;
#pragma unroll
        for (int e = 0; e < 16; ++e) { kv[e] = siluf_(kv[e]); sk += kv[e] * kv[e]; }
        sk += __shfl_xor(sk, 1); sk += __shfl_xor(sk, 2); sk += __shfl_xor(sk, 4);
        const float rk = __builtin_amdgcn_rsqf(sk + EPS);
#pragma unroll
        for (int e = 0; e < 16; ++e) kv[e] *= rk;
#pragma unroll
        for (int e = 0; e < 16; e += 4) st_bf16x4(K + i * LDQ + sub * 16 + e, kv[e], kv[e + 1], kv[e + 2], kv[e + 3]);
#pragma unroll
        for (int e = 0; e < 16; ++e) KT[swz_idx(sub * 16 + e, i)] = f2bf(kv[e]); }
      SCHED_FENCE();
      { float vv[16]; conv3_calc(rv_, CW + 256 + sub * 16, 384, vv);
#pragma unroll
        for (int e = 0; e < 16; ++e) VT[swz_idx(sub * 16 + e, i)] = f2bf(siluf_(vv[e])); }
      SCHED_FENCE();
      if (sub < 2) { const int d = sub; const float braw = bf2f((bf16)(rgate & 0xffffu)), araw = bf2f((bf16)(rgate >> 16));
          const int ii = d ? 63 - i : i;
          TBL[d * 192 + ii] = gpar[0] * softplusf_(araw + gpar[1]); TBL[d * 192 + 64 + ii] = sigmoidf_(braw); } }
    LDSBAR();
    if (wave < 2) TBL[wave * 192 + 128 + lane] = wave_scan_incl(TBL[wave * 192 + lane], lane);
    { bf16* ktg = (bf16*)(F.ws + WS_GKT) + (size_t)h * 128 * NROWS + r0;
#pragma unroll
      for (int k = 0; k < 2; ++k) { const int e = F.tid + 512 * k, row = e >> 3, pc = e & 7;
          *(u32x4*)(ktg + (size_t)row * NROWS + pc * 8) = *(const LAS u32x4*)(KT + row * LDT + ((pc ^ (row >> 4)) & 7) * 8); } }
#pragma unroll
    for (int tt = 0; tt < 2; ++tt) { const int id = 2 * wave + tt, ti = id >> 2, tj = id & 3;
        f32x4 akk = {0.f, 0.f, 0.f, 0.f}, aqk = akk;
#pragma unroll
        for (int ks = 0; ks < 4; ++ks) { const bf16x8 bk = frag_nat(K, LDQ, tj * 16, ks * 32, lane);
            akk = MFMA16(bk, frag_nat(K, LDQ, ti * 16, ks * 32, lane), akk);
            aqk = MFMA16(bk, frag_nat(Q, LDQ, ti * 16, ks * 32, lane), aqk); }
        *(LAS f32x4*)(KKR + (ti * 16 + l15) * LDR + tj * 16 + 4 * q4) = akk; *(LAS f32x4*)(QKR + (ti * 16 + l15) * LDR + tj * 16 + 4 * q4) = aqk; }
    LDSBAR();
#pragma unroll
    for (int d = 0; d < 2; ++d) {
        const size_t item = ((size_t)c64 * 16 + h) * 2 + d;
        const LAS float* TB_ = TBL + d * 192;
        if (d == 1 && next_c64 >= 0) { gdn_prep_request(F, next_c64, h, rq_, rk_, rv_, rgate); }
#pragma unroll
        for (int tt = 0; tt < 2; ++tt) { const int id = 2 * wave + tt, ti = id >> 2, tj = id & 3;
            const int i = ti * 16 + l15, j0 = tj * 16 + 4 * q4;
            f32x4 kk, qk;
            if (d == 0) { kk = *(const LAS f32x4*)(KKR + i * LDR + j0); qk = *(const LAS f32x4*)(QKR + i * LDR + j0); }
            else { const f32x4 a = *(const LAS f32x4*)(KKR + (63 - i) * LDR + 60 - j0), b = *(const LAS f32x4*)(QKR + (63 - i) * LDR + 60 - j0);
                kk = (f32x4){a[3], a[2], a[1], a[0]}; qk = (f32x4){b[3], b[2], b[1], b[0]}; }
            const float gi = TB_[128 + i], bi = TB_[64 + i];
            float nv[4], pv[4];
#pragma unroll
            for (int r = 0; r < 4; ++r) { const int j = j0 + r; const float dec = (i >= j) ? __expf(gi - TB_[128 + j]) : 0.f;
                nv[r] = (i > j) ? bi * kk[r] * dec : 0.f; pv[r] = qk[r] * dec; }
            st_bf16x4(NN + i * LDT + j0, -nv[0], -nv[1], -nv[2], -nv[3]);
            { u32x2 w2; w2.x = pk2(pv[0], pv[1]); w2.y = pk2(pv[2], pv[3]); *(u32x2*)((bf16*)(F.ws + WS_GPP) + (item * 64 + i) * 64 + j0) = w2; }
            if (ti == tj) *(LAS f32x4*)(NDG + (ti * 16 + l15) * 16 + 4 * q4) = (f32x4){nv[0], nv[1], nv[2], nv[3]}; }
        if (wave == 1) ((float*)(F.ws + WS_GGC))[item * 64 + lane] = TB_[128 + lane];
        LDSBAR();
        if (wave == 0) { float x[16];
#pragma unroll
            for (int i = 0; i < 16; ++i) { float sa[4] = {0.f, 0.f, 0.f, 0.f};
                const LAS f32x4* nr = (const LAS f32x4*)(NDG + (q4 * 16 + i) * 16);
#pragma unroll
                for (int k4 = 0; k4 < 4; ++k4) { if (4 * k4 < i) { const f32x4 nvv = nr[k4];
#pragma unroll
                        for (int e = 0; e < 4; ++e) if (4 * k4 + e < i) sa[e] += nvv[e] * x[4 * k4 + e]; } }
                const float a = ((i == l15) ? 1.f : 0.f) - ((sa[0] + sa[1]) + (sa[2] + sa[3]));
                x[i] = a; DBK[(q4 * 16 + i) * LDD + l15] = f2bf(a); } }
        LDSBAR();
        { f32x4 u[4], xw[4]; const f32x4 z4 = {0.f, 0.f, 0.f, 0.f};
#pragma unroll
          for (int b = 0; b < 4; ++b) {
              const f32x4 be = *(const LAS f32x4*)(TB_ + 64 + 16 * b + 4 * q4), gcv = *(const LAS f32x4*)(TB_ + 128 + 16 * b + 4 * q4);
              const int c0 = d ? 60 - 16 * b - 4 * q4 : 16 * b + 4 * q4;
              const bf16x4 vraw = *(const LAS bf16x4*)(VT + swz_idx(16 * wave + l15, c0)), kraw = *(const LAS bf16x4*)(KT + swz_idx(16 * wave + l15, c0));
              f32x4 au, aw;
#pragma unroll
              for (int r = 0; r < 4; ++r) { const int rr = d ? 3 - r : r; au[r] = be[r] * bf2f((bf16)vraw[rr]); aw[r] = be[r] * __expf(gcv[r]) * bf2f((bf16)kraw[rr]); }
              if (b >= 1) { const bf16x8 nf = frag_perm(NN, LDT, 16 * b, 0, lane);
                  au = MFMA16(nf, pack2(u[0], b >= 2 ? u[1] : z4), au); aw = MFMA16(nf, pack2(xw[0], b >= 2 ? xw[1] : z4), aw); }
              if (b == 3) { const bf16x8 nf = frag_perm(NN, LDT, 48, 32, lane);
                  au = MFMA16(nf, pack2(u[2], z4), au); aw = MFMA16(nf, pack2(xw[2], z4), aw); }
              const bf16x8 df = frag_perm(DBK + b * 16 * LDD, LDD, 0, 0, lane);
              u[b] = MFMA16(df, pack2(au, z4), z4); xw[b] = MFMA16(df, pack2(aw, z4), z4);
              { u32x2 w2; w2.x = pk2(u[b][0], u[b][1]); w2.y = pk2(u[b][2], u[b][3]);
                *(u32x2*)((bf16*)(F.ws + WS_GUF) + (((item * 8 + wave) * 4 + b) * 64 + lane) * 4) = w2; }
#pragma unroll
              for (int r = 0; r < 4; ++r) W[(16 * b + 4 * q4 + r) * LDQ + 16 * wave + l15] = f2bf(-xw[b][r]); } }
        LDSBAR();
        { bf16* wg = (bf16*)(F.ws + WS_GWN) + item * 8192;
#pragma unroll
          for (int k = 0; k < 2; ++k) { const int e = F.tid + 512 * k, row = e >> 4, pc = e & 15;
              *(u32x4*)(wg + row * 128 + pc * 8) = *(const LAS u32x4*)(W + row * LDQ + pc * 8); } }
    }
}

#define GDN_SETB 79872
DI void gdn_scan_step(const Ctx& F, f32x4 (&S)[2][8], int set, int ci, int d, int len, int row0, int h, bf16* OUT) {
    const int wave = F.wave;
    int lane = F.lane; asm volatile("" : "+v"(lane)); const int l15 = lane & 15, q4 = lane >> 4;
    LAS bf16* W = (LAS bf16*)(F.lds + set * GDN_SETB); LAS bf16* Q = (LAS bf16*)(F.lds + set * GDN_SETB + 17408); LAS bf16* PB = (LAS bf16*)(F.lds + set * GDN_SETB + 34816);
    LAS bf16* KT = (LAS bf16*)(F.lds + set * GDN_SETB + 44032); LAS float* GC = (LAS float*)(F.lds + set * GDN_SETB + 62464); const LAS bf16* UL = (const LAS bf16*)(F.lds + set * GDN_SETB + 63488);
#define LQ(dst, M, it) do { _Pragma("unroll") for (int i_ = 0; i_ < 4; ++i_) dst[i_] = frag_perm(M, LDQ, (it) * 16, i_ * 32, lane); SCHED_FENCE(); } while (0)
#define LT(dst, M, t0) do { _Pragma("unroll") for (int i_ = 0; i_ < 4; ++i_) dst[i_] = frag_perm(M, LDT, ((t0) + (i_ >> 1)) * 16, (i_ & 1) * 32, lane); SCHED_FENCE(); } while (0)
#define CVN(X, it) do { _Pragma("unroll") for (int ks = 0; ks < 4; ++ks) { vn[0][it] = MFMA16(X[ks], Sp[0][ks], vn[0][it]); vn[1][it] = MFMA16(X[ks], Sp[1][ks], vn[1][it]); } SCHED_FENCE(); } while (0)
#define CO(X, j) do { _Pragma("unroll") for (int ks = 0; ks < 4; ++ks) { o[0][j] = MFMA16(Sp[0][ks], X[ks], o[0][j]); o[1][j] = MFMA16(Sp[1][ks], X[ks], o[1][j]); } SCHED_FENCE(); } while (0)
#define CS(X, t0) do { _Pragma("unroll") for (int ks = 0; ks < 2; ++ks) _Pragma("unroll") for (int j = 0; j < 2; ++j) { S[0][(t0) + j] = MFMA16(X[j * 2 + ks], V2p[0][ks], S[0][(t0) + j]); S[1][(t0) + j] = MFMA16(X[j * 2 + ks], V2p[1][ks], S[1][(t0) + j]); } SCHED_FENCE(); } while (0)
#define CPV(X, it0) do { _Pragma("unroll") for (int j = 0; j < 2; ++j) { const float eg = __expf(GC[((it0) + j) * 16 + l15]); o[0][j] = o[0][j] * eg; o[1][j] = o[1][j] * eg; } \
        _Pragma("unroll") for (int ks = 0; ks < 2; ++ks) _Pragma("unroll") for (int j = 0; j < 2; ++j) { o[0][j] = MFMA16(Vp[0][ks], X[j * 2 + ks], o[0][j]); o[1][j] = MFMA16(Vp[1][ks], X[j * 2 + ks], o[1][j]); } \
        _Pragma("unroll") for (int j = 0; j < 2; ++j) { const int i = ((it0) + j) * 16 + l15; const int tl = ci * 64 + i, t = d ? (len - 1 - tl) : tl; bf16* op = OUT + (size_t)(row0 + t) * 2048 + h * 128 + 32 * wave + 4 * q4; \
            u32x2 w2; w2.x = pk2(o[0][j][0], o[0][j][1]); w2.y = pk2(o[0][j][2], o[0][j][3]); *(u32x2*)op = w2; w2.x = pk2(o[1][j][0], o[1][j][1]); w2.y = pk2(o[1][j][2], o[1][j][3]); *(u32x2*)(op + 16) = w2; \
            o[0][j] = (f32x4){0.f, 0.f, 0.f, 0.f}; o[1][j] = (f32x4){0.f, 0.f, 0.f, 0.f}; } SCHED_FENCE(); } while (0)
    bf16x8 X0[4], X1[4], X2[4];
    f32x4 vn[2][4];
#pragma unroll
    for (int x = 0; x < 2; ++x)
#pragma unroll
        for (int b = 0; b < 4; ++b) { const u32x2 ur = *(const LAS u32x2*)(UL + (((2 * wave + x) * 4 + b) * 64 + lane) * 4);
            vn[x][b][0] = __uint_as_float(ur.x << 16); vn[x][b][1] = __uint_as_float(ur.x & 0xffff0000u); vn[x][b][2] = __uint_as_float(ur.y << 16); vn[x][b][3] = __uint_as_float(ur.y & 0xffff0000u); }
    const float gl = GC[63];
    LQ(X0, W, 0); LQ(X1, W, 1);
    bf16x8 Sp[2][4];
#pragma unroll
    for (int x = 0; x < 2; ++x)
#pragma unroll
        for (int ks = 0; ks < 4; ++ks) Sp[x][ks] = pack2(S[x][2 * ks], S[x][2 * ks + 1]);
    SCHED_FENCE();
    LQ(X2, W, 2); CVN(X0, 0);
    LQ(X0, W, 3); CVN(X1, 1);
    LQ(X1, Q, 0); CVN(X2, 2);
    LQ(X2, Q, 1); CVN(X0, 3);
    bf16x8 Vp[2][2], V2p[2][2];
#pragma unroll
    for (int ks = 0; ks < 2; ++ks) { float e0[4], e1[4];
#pragma unroll
        for (int r = 0; r < 4; ++r) { e0[r] = __expf(gl - GC[(2 * ks) * 16 + 4 * q4 + r]); e1[r] = __expf(gl - GC[(2 * ks + 1) * 16 + 4 * q4 + r]); }
#pragma unroll
        for (int x = 0; x < 2; ++x) { Vp[x][ks] = pack2(vn[x][2 * ks], vn[x][2 * ks + 1]);
            f32x4 a, b;
#pragma unroll
            for (int r = 0; r < 4; ++r) { a[r] = vn[x][2 * ks][r] * e0[r]; b[r] = vn[x][2 * ks + 1][r] * e1[r]; }
            V2p[x][ks] = pack2(a, b); } }
    const float egl = __expf(gl);
    SCHED_FENCE();
    f32x4 o[2][2];
#pragma unroll
    for (int x = 0; x < 2; ++x)
#pragma unroll
        for (int j = 0; j < 2; ++j) o[x][j] = (f32x4){0.f, 0.f, 0.f, 0.f};
    LT(X0, PB, 0); CO(X1, 0);
    LQ(X1, Q, 2); CO(X2, 1);
    LQ(X2, Q, 3); CPV(X0, 0);
    LT(X0, PB, 2); CO(X1, 0);
    LT(X1, KT, 0); CO(X2, 1);
    LT(X2, KT, 2); CPV(X0, 2);
#pragma unroll
    for (int x = 0; x < 2; ++x)
#pragma unroll
        for (int t = 0; t < 8; ++t) S[x][t] = S[x][t] * egl;
    SCHED_FENCE();
    LT(X0, KT, 4); CS(X1, 0);
    LT(X1, KT, 6); CS(X2, 2);
    CS(X0, 4); CS(X1, 6);
#undef LQ
#undef LT
#undef CVN
#undef CO
#undef CS
#undef CPV
}
DI void gdn_scan_item(const Ctx& F, const float* const* in, int s, int h, int d) {
    constexpr int SETB = GDN_SETB;
    const int row0 = seq_row0(s), len = seq_len(s), nch = len >> 6, c640 = row0 >> 6;
    const int lane_o = F.lane, wave = F.wave;
    bf16* OUT = (bf16*)(F.ws + (d ? WS_OBA : WS_OFA));
    const bf16* GWN = (const bf16*)(F.ws + WS_GWN); const bf16* GUF = (const bf16*)(F.ws + WS_GUF); const bf16* GPP = (const bf16*)(F.ws + WS_GPP);
    const float* GGC = (const float*)(F.ws + WS_GGC); const bf16* GQN = (const bf16*)(F.ws + WS_GQN); const bf16* GKT = (const bf16*)(F.ws + WS_GKT) + (size_t)h * 128 * NROWS;
    LDSBAR();
    if (wave >= 4) {
        struct Pre { u32x4 w[4], q[4], p[2], k[4], u[4]; float g; };
        Pre PA, PB_;
        const int e = F.tid - 256, er = e >> 2, eq = e & 3;
#define GDN_ISSUE(ci_, P_) do { const int cc = c640 + (d ? nch - 1 - (ci_) : (ci_)); const size_t item = ((size_t)cc * 16 + h) * 2 + d; \
        const u32x4* wsrc = (const u32x4*)(GWN + item * 8192 + er * 128 + eq * 32); \
        const int qrow = cc * 64 + (d ? 63 - er : er); const u32x4* qsrc = (const u32x4*)(GQN + (size_t)qrow * 2048 + h * 128 + eq * 32); \
        _Pragma("unroll") for (int m_ = 0; m_ < 4; ++m_) { P_.w[m_] = wsrc[m_]; P_.q[m_] = qsrc[m_]; } \
        const u32x4* psrc = (const u32x4*)(GPP + item * 4096 + er * 64 + eq * 16); P_.p[0] = psrc[0]; P_.p[1] = psrc[1]; \
        const u32x4* k0src = (const u32x4*)(GKT + (size_t)er * NROWS + cc * 64 + eq * 16); const u32x4* k1src = (const u32x4*)(GKT + (size_t)(64 + er) * NROWS + cc * 64 + eq * 16); \
        P_.k[0] = k0src[0]; P_.k[1] = k0src[1]; P_.k[2] = k1src[0]; P_.k[3] = k1src[1]; \
        const u32x4* usrc = (const u32x4*)(GUF + item * 8192) + e; _Pragma("unroll") for (int m_ = 0; m_ < 4; ++m_) P_.u[m_] = usrc[m_ * 256]; \
        P_.g = (e < 64) ? GGC[item * 64 + e] : 0.f; } while (0)
#define REV8(w_) ((u32x4){((w_).w >> 16) | ((w_).w << 16), ((w_).z >> 16) | ((w_).z << 16), ((w_).y >> 16) | ((w_).y << 16), ((w_).x >> 16) | ((w_).x << 16)})
#define GDN_COMMIT(set_, P_) do { LAS unsigned char* base = F.lds + (set_) * SETB; \
        _Pragma("unroll") for (int m_ = 0; m_ < 4; ++m_) { *(LAS u32x4*)((LAS bf16*)base + er * LDQ + eq * 32 + m_ * 8) = P_.w[m_]; *(LAS u32x4*)((LAS bf16*)(base + 17408) + er * LDQ + eq * 32 + m_ * 8) = P_.q[m_]; } \
        *(LAS u32x4*)((LAS bf16*)(base + 34816) + er * LDT + eq * 16) = P_.p[0]; *(LAS u32x4*)((LAS bf16*)(base + 34816) + er * LDT + eq * 16 + 8) = P_.p[1]; \
        if (d == 0) { *(LAS u32x4*)((LAS bf16*)(base + 44032) + er * LDT + eq * 16) = P_.k[0]; *(LAS u32x4*)((LAS bf16*)(base + 44032) + er * LDT + eq * 16 + 8) = P_.k[1]; \
            *(LAS u32x4*)((LAS bf16*)(base + 44032) + (64 + er) * LDT + eq * 16) = P_.k[2]; *(LAS u32x4*)((LAS bf16*)(base + 44032) + (64 + er) * LDT + eq * 16 + 8) = P_.k[3]; } \
        else { *(LAS u32x4*)((LAS bf16*)(base + 44032) + er * LDT + (3 - eq) * 16 + 8) = REV8(P_.k[0]); *(LAS u32x4*)((LAS bf16*)(base + 44032) + er * LDT + (3 - eq) * 16) = REV8(P_.k[1]); \
            *(LAS u32x4*)((LAS bf16*)(base + 44032) + (64 + er) * LDT + (3 - eq) * 16 + 8) = REV8(P_.k[2]); *(LAS u32x4*)((LAS bf16*)(base + 44032) + (64 + er) * LDT + (3 - eq) * 16) = REV8(P_.k[3]); } \
        _Pragma("unroll") for (int m_ = 0; m_ < 4; ++m_) *((LAS u32x4*)(base + 63488) + e + m_ * 256) = P_.u[m_]; \
        if (e < 64) ((LAS float*)(base + 62464))[e] = P_.g; } while (0)
        GDN_ISSUE(0, PA); GDN_ISSUE(1, PB_);
#pragma unroll 1
        for (int ci = 0; ci < nch; ci += 2) {
            GDN_COMMIT(0, PA); LDSBAR(); if (ci + 2 < nch) GDN_ISSUE(ci + 2, PA);
            GDN_COMMIT(1, PB_); LDSBAR(); if (ci + 3 < nch) GDN_ISSUE(ci + 3, PB_); }
#undef GDN_ISSUE
#undef GDN_COMMIT
#undef REV8
    } else {
        f32x4 S[2][8];
        if (s >= 16) { int ln = lane_o; asm volatile("" : "+v"(ln)); const int l15 = ln & 15, q4 = ln >> 4; const float* sp = in[2] + ((size_t)((s - 16) * 2 + d) * 16 + h) * 16384;
#pragma unroll
            for (int x = 0; x < 2; ++x)
#pragma unroll
                for (int t = 0; t < 8; ++t)
#pragma unroll
                    for (int r = 0; r < 4; ++r) S[x][t][r] = sp[(size_t)(16 * t + 4 * q4 + r) * 128 + 32 * wave + 16 * x + l15];
        } else {
#pragma unroll
            for (int x = 0; x < 2; ++x)
#pragma unroll
                for (int t = 0; t < 8; ++t) S[x][t] = (f32x4){0.f, 0.f, 0.f, 0.f}; }
#pragma unroll 1
        for (int ci = 0; ci < nch; ci += 2) { LDSBAR(); gdn_scan_step(F, S, 0, ci, d, len, row0, h, OUT); LDSBAR(); gdn_scan_step(F, S, 1, ci + 1, d, len, row0, h, OUT); }
        if (s < 16) { int ln = lane_o; asm volatile("" : "+v"(ln)); const int l15 = ln & 15, q4 = ln >> 4; float* sp = F.out + OUT_SG + ((size_t)(s * 2 + d) * 16 + h) * 16384;
#pragma unroll
            for (int x = 0; x < 2; ++x)
#pragma unroll
                for (int t = 0; t < 8; ++t)
#pragma unroll
                    for (int r = 0; r < 4; ++r) sp[(size_t)(16 * t + 4 * q4 + r) * 128 + 32 * wave + 16 * x + l15] = S[x][t][r]; }
    }
}

DI void ssd_prep_request(const Ctx& F, int c64, int g, u32x4 (&rx0)[6], u32x4 (&rx1)[6], u32x4 (&rb_)[6], u32x4 (&rc_)[6], unsigned& rdt) {
    const bf16* U = (const bf16*)(F.ws + WS_U);
    const int r0 = c64 * 64, len = r0 < 4096 ? 256 : 4096, t0 = r0 < 4096 ? (r0 & 255) : ((r0 - 4096) & 4095);
    const int i = F.tid >> 3, sub = F.tid & 7, t = t0 + i;
    const bf16* ur = U + (size_t)(r0 + i) * LD_EVEN;
    conv3_load(ur + E_XBC + g * 256 + sub * 32, LD_EVEN, t, len, rx0);
    conv3_load(ur + E_XBC + g * 256 + sub * 32 + 16, LD_EVEN, t, len, rx1);
    conv3_load(ur + E_XBC + 2048 + g * 128 + sub * 16, LD_EVEN, t, len, rb_);
    conv3_load(ur + E_XBC + 3072 + g * 128 + sub * 16, LD_EVEN, t, len, rc_);
    rdt = (unsigned)ur[E_DT + (sub >> 2) * 32 + g * 4 + (sub & 3)];
}
DI void ssd_prep_item(const Ctx& F, const float* const* in, int c64, int g, bool stage_cw, u32x4 (&rx0)[6], u32x4 (&rx1)[6], u32x4 (&rb_)[6], u32x4 (&rc_)[6], unsigned& rdt, float (&spar)[2], int next_c64, int next_g) {
    LAS bf16* C = (LAS bf16*)(F.lds + 0);
    LAS bf16* B = (LAS bf16*)(F.lds + 17408);
    LAS bf16* BT = (LAS bf16*)(F.lds + 34816);
    LAS bf16* XT = (LAS bf16*)(F.lds + 53248);
    LAS float* CBR = (LAS float*)(F.lds + 90112);
    LAS float* TBL = (LAS float*)(F.lds + 107520);
    LAS float* CW = TBL + 8 * 192;
    constexpr int LDR = 68;
    const bf16* U = (const bf16*)(F.ws + WS_U);
    const int r0 = c64 * 64, len = r0 < 4096 ? 256 : 4096, t0 = r0 < 4096 ? (r0 & 255) : ((r0 - 4096) & 4095);
    const int lane_o = F.lane, wave = F.wave;
    LDSBAR();
    if (stage_cw) { const int sd = (F.tid & 7) >> 2, shd = g * 4 + (F.tid & 3); spar[0] = -expf(in[18][sd * 32 + shd]); spar[1] = in[19][sd * 32 + shd]; }
    if (stage_cw) {
        for (int e = F.tid; e < 3 * 512; e += 512) { const int tap = e >> 9, c = e & 511; const int col = c < 256 ? g * 256 + c : (c < 384 ? 2048 + g * 128 + (c - 256) : 3072 + g * 128 + (c - 384)); CW[e] = in[17][tap * 4096 + col]; }
        LDSBAR(); }
    int lane = lane_o; asm volatile("" : "+v"(lane)); const int l15 = lane & 15, q4 = lane >> 4;
    { const int i = F.tid >> 3, sub = F.tid & 7; const int t = t0 + i;
      const bf16* ur = U + (size_t)(r0 + i) * LD_EVEN;
      SCHED_FENCE();
      { float xv[16]; conv3_calc(rx0, CW + sub * 32, 512, xv);
#pragma unroll
        for (int e = 0; e < 16; ++e) XT[swz_idx((sub >> 1) * 64 + (sub & 1) * 32 + e, i)] = f2bf(siluf_(xv[e])); }
      SCHED_FENCE();
      { float xv[16]; conv3_calc(rx1, CW + sub * 32 + 16, 512, xv);
#pragma unroll
        for (int e = 0; e < 16; ++e) XT[swz_idx((sub >> 1) * 64 + (sub & 1) * 32 + 16 + e, i)] = f2bf(siluf_(xv[e])); }
      SCHED_FENCE();
      { float bv[16]; conv3_calc(rb_, CW + 256 + sub * 16, 512, bv);
#pragma unroll
        for (int e = 0; e < 16; ++e) bv[e] = siluf_(bv[e]);
#pragma unroll
        for (int e = 0; e < 16; e += 4) st_bf16x4(B + i * LDQ + sub * 16 + e, bv[e], bv[e + 1], bv[e + 2], bv[e + 3]);
#pragma unroll
        for (int e = 0; e < 16; ++e) BT[swz_idx(sub * 16 + e, i)] = f2bf(bv[e]); }
      SCHED_FENCE();
      { float cv[16]; conv3_calc(rc_, CW + 384 + sub * 16, 512, cv);
        u32x4 g0, g1; g0.x = pk2(siluf_(cv[0]), siluf_(cv[1])); g0.y = pk2(siluf_(cv[2]), siluf_(cv[3])); g0.z = pk2(siluf_(cv[4]), siluf_(cv[5])); g0.w = pk2(siluf_(cv[6]), siluf_(cv[7]));
        g1.x = pk2(siluf_(cv[8]), siluf_(cv[9])); g1.y = pk2(siluf_(cv[10]), siluf_(cv[11])); g1.z = pk2(siluf_(cv[12]), siluf_(cv[13])); g1.w = pk2(siluf_(cv[14]), siluf_(cv[15]));
        *(LAS u32x4*)(C + i * LDQ + sub * 16) = g0; *(LAS u32x4*)(C + i * LDQ + sub * 16 + 8) = g1;
        u32x4* gc_ = (u32x4*)((bf16*)(F.ws + WS_SCN) + (size_t)(r0 + i) * 1024 + g * 128 + sub * 16); gc_[0] = g0; gc_[1] = g1; }
      SCHED_FENCE();
      { const int d = sub >> 2, hx = sub & 3, hd = g * 4 + hx, ii = d ? 63 - i : i;
        const float dt = softplusf_(bf2f((bf16)(rdt & 0xffffu)) + spar[1]);
        TBL[sub * 192 + ii] = spar[0] * dt; TBL[sub * 192 + 128 + ii] = dt; } }
    if (next_c64 >= 0) ssd_prep_request(F, next_c64, next_g, rx0, rx1, rb_, rc_, rdt);
    LDSBAR();
    TBL[wave * 192 + 64 + lane] = wave_scan_incl(TBL[wave * 192 + lane], lane);
    { bf16* btg = (bf16*)(F.ws + WS_SBT) + (size_t)g * 128 * NROWS + r0;
#pragma unroll
      for (int k = 0; k < 2; ++k) { const int e = F.tid + 512 * k, row = e >> 3, pc = e & 7;
          *(u32x4*)(btg + (size_t)row * NROWS + pc * 8) = *(const LAS u32x4*)(BT + row * LDT + ((pc ^ (row >> 4)) & 7) * 8); } }
#pragma unroll
    for (int k = 0; k < 8; ++k) { const int e = F.tid + 512 * k, pc = e & 7, row = (e >> 3) & 63, hx = (e >> 9) & 3, d = e >> 11;
        const u32x4 raw = *(const LAS u32x4*)(XT + (hx * 64 + row) * LDT + ((pc ^ ((hx * 64 + row) >> 4)) & 7) * 8); float f[8]; unpack8(raw, f);
        const LAS float* dtp = TBL + (d * 4 + hx) * 192 + 128;
        u32x4 o;
        if (d == 0) { const f32x4 d0 = *(const LAS f32x4*)(dtp + pc * 8), d1 = *(const LAS f32x4*)(dtp + pc * 8 + 4);
            o.x = pk2(f[0] * d0[0], f[1] * d0[1]); o.y = pk2(f[2] * d0[2], f[3] * d0[3]); o.z = pk2(f[4] * d1[0], f[5] * d1[1]); o.w = pk2(f[6] * d1[2], f[7] * d1[3]); }
        else { const f32x4 d0 = *(const LAS f32x4*)(dtp + 56 - pc * 8), d1 = *(const LAS f32x4*)(dtp + 60 - pc * 8);
            o.x = pk2(f[0] * d1[3], f[1] * d1[2]); o.y = pk2(f[2] * d1[1], f[3] * d1[0]); o.z = pk2(f[4] * d0[3], f[5] * d0[2]); o.w = pk2(f[6] * d0[1], f[7] * d0[0]); }
        *(u32x4*)((bf16*)(F.ws + WS_SVT) + ((size_t)((g * 4 + hx) * 2 + d) * 64 + row) * NROWS + r0 + pc * 8) = o; }
#pragma unroll
    for (int tt = 0; tt < 2; ++tt) { const int id = 2 * wave + tt, ti = id >> 2, tj = id & 3;
        f32x4 cb = {0.f, 0.f, 0.f, 0.f};
#pragma unroll
        for (int ks = 0; ks < 4; ++ks) cb = MFMA16(frag_nat(B, LDQ, tj * 16, ks * 32, lane), frag_nat(C, LDQ, ti * 16, ks * 32, lane), cb);
        *(LAS f32x4*)(CBR + (ti * 16 + l15) * LDR + tj * 16 + 4 * q4) = cb; }
    LDSBAR();
    { const int d = wave >> 2, hx = wave & 3; const size_t item = ((size_t)c64 * 32 + g * 4 + hx) * 2 + d;
      const LAS float* gcp = TBL + wave * 192 + 64; const float gi = gcp[lane];
      ((float*)(F.ws + WS_SSG))[item * 64 + lane] = gi;
      const LAS float* crow = CBR + (d ? 63 - lane : lane) * LDR;
      bf16* pg = (bf16*)(F.ws + WS_SSP) + (item * 64 + lane) * 64;
#pragma unroll
      for (int j8 = 0; j8 < 8; ++j8) { float pv[8];
          f32x4 c0, c1;
          if (d == 0) { c0 = *(const LAS f32x4*)(crow + j8 * 8); c1 = *(const LAS f32x4*)(crow + j8 * 8 + 4); }
          else { const f32x4 a0 = *(const LAS f32x4*)(crow + 60 - j8 * 8), a1 = *(const LAS f32x4*)(crow + 56 - j8 * 8); c0 = (f32x4){a0[3], a0[2], a0[1], a0[0]}; c1 = (f32x4){a1[3], a1[2], a1[1], a1[0]}; }
          const f32x4 g0 = *(const LAS f32x4*)(gcp + j8 * 8), g1 = *(const LAS f32x4*)(gcp + j8 * 8 + 4);
#pragma unroll
          for (int e = 0; e < 4; ++e) { const int j = j8 * 8 + e; pv[e] = (lane >= j) ? c0[e] * __expf(gi - g0[e]) : 0.f; pv[4 + e] = (lane >= j + 4) ? c1[e] * __expf(gi - g1[e]) : 0.f; }
          u32x4 o; o.x = pk2(pv[0], pv[1]); o.y = pk2(pv[2], pv[3]); o.z = pk2(pv[4], pv[5]); o.w = pk2(pv[6], pv[7]);
          *(u32x4*)(pg + j8 * 8) = o; } }
}

#define SSD_SETB 73728
DI void ssd_scan_step(const Ctx& F, f32x4 (&S)[2][8], int set, int ci, int d, int len, int row0, int head0, bf16* OUT) {
    const int pq = F.wave;
    int lane = F.lane; asm volatile("" : "+v"(lane)); const int l15 = lane & 15, q4 = lane >> 4;
    LAS unsigned char* base = F.lds + set * SSD_SETB;
    LAS bf16* C = (LAS bf16*)base; LAS bf16* BT = (LAS bf16*)(base + 17408); LAS bf16* PH = (LAS bf16*)(base + 35840); LAS bf16* VT = (LAS bf16*)(base + 54272);
    LAS float* GC = (LAS float*)(base + 72704);
#define LC(dst, it) do { _Pragma("unroll") for (int i_ = 0; i_ < 4; ++i_) dst[i_] = frag_perm(C, LDQ, (it) * 16, i_ * 32, lane); SCHED_FENCE(); } while (0)
#define LP(dst, it) do { _Pragma("unroll") for (int i_ = 0; i_ < 4; ++i_) dst[i_] = frag_nat(PH + (i_ >> 1) * 4608, LDT, (it) * 16, (i_ & 1) * 32, lane); SCHED_FENCE(); } while (0)
#define LB(dst, t0) do { _Pragma("unroll") for (int i_ = 0; i_ < 4; ++i_) dst[i_] = frag_nat(BT, LDT, ((t0) + (i_ >> 1)) * 16, (i_ & 1) * 32, lane); SCHED_FENCE(); } while (0)
#define CY(X, it) do { y[0] = (f32x4){0.f, 0.f, 0.f, 0.f}; y[1] = y[0]; _Pragma("unroll") for (int ks = 0; ks < 4; ++ks) { y[0] = MFMA16(Sp[0][ks], X[ks], y[0]); y[1] = MFMA16(Sp[1][ks], X[ks], y[1]); } \
        y[0] = y[0] * __expf(GC[(it) * 16 + l15]); y[1] = y[1] * __expf(GC[64 + (it) * 16 + l15]); SCHED_FENCE(); } while (0)
#define CP(X, it) do { _Pragma("unroll") for (int ks = 0; ks < 2; ++ks) { y[0] = MFMA16(VF[0][ks], X[ks], y[0]); y[1] = MFMA16(VF[1][ks], X[2 + ks], y[1]); } \
        { const int i = (it) * 16 + l15; const int tl = ci * 64 + i, t = d ? (len - 1 - tl) : tl; bf16* op = OUT + (size_t)(row0 + t) * 2048 + head0 * 64 + 16 * pq + 4 * q4; \
          u32x2 w2; w2.x = pk2(y[0][0], y[0][1]); w2.y = pk2(y[0][2], y[0][3]); *(u32x2*)op = w2; w2.x = pk2(y[1][0], y[1][1]); w2.y = pk2(y[1][2], y[1][3]); *(u32x2*)(op + 64) = w2; } SCHED_FENCE(); } while (0)
#define CS(X, t0) do { _Pragma("unroll") for (int ks = 0; ks < 2; ++ks) _Pragma("unroll") for (int j = 0; j < 2; ++j) { S[0][(t0) + j] = MFMA16(X[j * 2 + ks], V2[0][ks], S[0][(t0) + j]); S[1][(t0) + j] = MFMA16(X[j * 2 + ks], V2[1][ks], S[1][(t0) + j]); } SCHED_FENCE(); } while (0)
    bf16x8 X0[4], X1[4], X2[4];
    bf16x8 VF[2][2];
#pragma unroll
    for (int x = 0; x < 2; ++x)
#pragma unroll
        for (int ks = 0; ks < 2; ++ks) VF[x][ks] = frag_nat(VT + x * 4608, LDT, 16 * pq, ks * 32, lane);
    const float gl0 = GC[63], gl1 = GC[127];
    LC(X0, 0); LP(X1, 0);
    bf16x8 Sp[2][4];
#pragma unroll
    for (int x = 0; x < 2; ++x)
#pragma unroll
        for (int ks = 0; ks < 4; ++ks) Sp[x][ks] = pack2(S[x][2 * ks], S[x][2 * ks + 1]);
    bf16x8 V2[2][2];
#pragma unroll
    for (int x = 0; x < 2; ++x) { const float gl = x ? gl1 : gl0;
#pragma unroll
        for (int ks = 0; ks < 2; ++ks) { float f[8]; unpack8(__builtin_bit_cast(u32x4, VF[x][ks]), f);
            const f32x4 g0 = *(const LAS f32x4*)(GC + x * 64 + ks * 32 + 8 * q4), g1 = *(const LAS f32x4*)(GC + x * 64 + ks * 32 + 8 * q4 + 4);
            u32x4 w; w.x = pk2(f[0] * __expf(gl - g0[0]), f[1] * __expf(gl - g0[1])); w.y = pk2(f[2] * __expf(gl - g0[2]), f[3] * __expf(gl - g0[3]));
            w.z = pk2(f[4] * __expf(gl - g1[0]), f[5] * __expf(gl - g1[1])); w.w = pk2(f[6] * __expf(gl - g1[2]), f[7] * __expf(gl - g1[3]));
            V2[x][ks] = __builtin_bit_cast(bf16x8, w); } }
    const float egl0 = __expf(gl0), egl1 = __expf(gl1);
    SCHED_FENCE();
    f32x4 y[2];
    LC(X2, 1); CY(X0, 0);
    LP(X0, 1); CP(X1, 0);
    LC(X1, 2); CY(X2, 1);
    LP(X2, 2); CP(X0, 1);
    LC(X0, 3); CY(X1, 2);
    LP(X1, 3); CP(X2, 2);
    LB(X2, 0); CY(X0, 3);
    LB(X0, 2); CP(X1, 3);
#pragma unroll
    for (int t = 0; t < 8; ++t) { S[0][t] = S[0][t] * egl0; S[1][t] = S[1][t] * egl1; }
    SCHED_FENCE();
    LB(X1, 4); CS(X2, 0);
    LB(X2, 6); CS(X0, 2);
    CS(X1, 4); CS(X2, 6);
#undef LC
#undef LP
#undef LB
#undef CY
#undef CP
#undef CS
}
DI void ssd_scan_item(const Ctx& F, const float* const* in, int s, int g, int d, int hp) {
    constexpr int SETB = SSD_SETB;
    const int row0 = seq_row0(s), len = seq_len(s), nch = len >> 6, c640 = row0 >> 6;
    const int lane_o = F.lane, wave = F.wave;
    const int head0 = g * 4 + hp * 2;
    bf16* OUT = (bf16*)(F.ws + (d ? WS_OBB : WS_OFB));
    const bf16* SCN = (const bf16*)(F.ws + WS_SCN); const bf16* SBT = (const bf16*)(F.ws + WS_SBT) + (size_t)g * 128 * NROWS;
    const bf16* SVT = (const bf16*)(F.ws + WS_SVT); const bf16* SSP = (const bf16*)(F.ws + WS_SSP); const float* SSG = (const float*)(F.ws + WS_SSG);
    LDSBAR();
    if (wave >= 4) {
        struct Pre { u32x4 c[4], b[4], p[4], v[4]; float g; };
        Pre PA, PB_;
        const int e = F.tid - 256, er = e >> 2, eq = e & 3;
#define REV8(w_) ((u32x4){((w_).w >> 16) | ((w_).w << 16), ((w_).z >> 16) | ((w_).z << 16), ((w_).y >> 16) | ((w_).y << 16), ((w_).x >> 16) | ((w_).x << 16)})
#define SSD_ISSUE(ci_, P_) do { const int cc = c640 + (d ? nch - 1 - (ci_) : (ci_)); \
        const int crow = cc * 64 + (d ? 63 - er : er); const u32x4* csrc = (const u32x4*)(SCN + (size_t)crow * 1024 + g * 128 + eq * 32); \
        _Pragma("unroll") for (int m_ = 0; m_ < 4; ++m_) P_.c[m_] = csrc[m_]; \
        const u32x4* b0src = (const u32x4*)(SBT + (size_t)er * NROWS + cc * 64 + eq * 16); const u32x4* b1src = (const u32x4*)(SBT + (size_t)(64 + er) * NROWS + cc * 64 + eq * 16); \
        P_.b[0] = b0src[0]; P_.b[1] = b0src[1]; P_.b[2] = b1src[0]; P_.b[3] = b1src[1]; \
        const size_t it0 = ((size_t)cc * 32 + head0) * 2 + d, it1 = it0 + 2; \
        const u32x4* p0src = (const u32x4*)(SSP + (it0 * 64 + er) * 64 + eq * 16); const u32x4* p1src = (const u32x4*)(SSP + (it1 * 64 + er) * 64 + eq * 16); \
        P_.p[0] = p0src[0]; P_.p[1] = p0src[1]; P_.p[2] = p1src[0]; P_.p[3] = p1src[1]; \
        const u32x4* v0src = (const u32x4*)(SVT + ((size_t)(head0 * 2 + d) * 64 + er) * NROWS + cc * 64 + eq * 16); const u32x4* v1src = (const u32x4*)(SVT + ((size_t)((head0 + 1) * 2 + d) * 64 + er) * NROWS + cc * 64 + eq * 16); \
        P_.v[0] = v0src[0]; P_.v[1] = v0src[1]; P_.v[2] = v1src[0]; P_.v[3] = v1src[1]; \
        P_.g = 0.f; if (e < 128) P_.g = SSG[((e < 64) ? it0 : it1) * 64 + (e & 63)]; } while (0)
#define SSD_COMMIT(set_, P_) do { LAS unsigned char* base = F.lds + (set_) * SETB; \
        _Pragma("unroll") for (int m_ = 0; m_ < 4; ++m_) *(LAS u32x4*)((LAS bf16*)base + er * LDQ + eq * 32 + m_ * 8) = P_.c[m_]; \
        *(LAS u32x4*)((LAS bf16*)(base + 35840) + er * LDT + eq * 16) = P_.p[0]; *(LAS u32x4*)((LAS bf16*)(base + 35840) + er * LDT + eq * 16 + 8) = P_.p[1]; \
        *(LAS u32x4*)((LAS bf16*)(base + 45056) + er * LDT + eq * 16) = P_.p[2]; *(LAS u32x4*)((LAS bf16*)(base + 45056) + er * LDT + eq * 16 + 8) = P_.p[3]; \
        if (d == 0) { *(LAS u32x4*)((LAS bf16*)(base + 17408) + er * LDT + eq * 16) = P_.b[0]; *(LAS u32x4*)((LAS bf16*)(base + 17408) + er * LDT + eq * 16 + 8) = P_.b[1]; \
            *(LAS u32x4*)((LAS bf16*)(base + 17408) + (64 + er) * LDT + eq * 16) = P_.b[2]; *(LAS u32x4*)((LAS bf16*)(base + 17408) + (64 + er) * LDT + eq * 16 + 8) = P_.b[3]; \
            *(LAS u32x4*)((LAS bf16*)(base + 54272) + er * LDT + eq * 16) = P_.v[0]; *(LAS u32x4*)((LAS bf16*)(base + 54272) + er * LDT + eq * 16 + 8) = P_.v[1]; \
            *(LAS u32x4*)((LAS bf16*)(base + 63488) + er * LDT + eq * 16) = P_.v[2]; *(LAS u32x4*)((LAS bf16*)(base + 63488) + er * LDT + eq * 16 + 8) = P_.v[3]; } \
        else { *(LAS u32x4*)((LAS bf16*)(base + 17408) + er * LDT + (3 - eq) * 16 + 8) = REV8(P_.b[0]); *(LAS u32x4*)((LAS bf16*)(base + 17408) + er * LDT + (3 - eq) * 16) = REV8(P_.b[1]); \
            *(LAS u32x4*)((LAS bf16*)(base + 17408) + (64 + er) * LDT + (3 - eq) * 16 + 8) = REV8(P_.b[2]); *(LAS u32x4*)((LAS bf16*)(base + 17408) + (64 + er) * LDT + (3 - eq) * 16) = REV8(P_.b[3]); \
            *(LAS u32x4*)((LAS bf16*)(base + 54272) + er * LDT + (3 - eq) * 16 + 8) = REV8(P_.v[0]); *(LAS u32x4*)((LAS bf16*)(base + 54272) + er * LDT + (3 - eq) * 16) = REV8(P_.v[1]); \
            *(LAS u32x4*)((LAS bf16*)(base + 63488) + er * LDT + (3 - eq) * 16 + 8) = REV8(P_.v[2]); *(LAS u32x4*)((LAS bf16*)(base + 63488) + er * LDT + (3 - eq) * 16) = REV8(P_.v[3]); } \
        if (e < 128) ((LAS float*)(base + 72704))[e] = P_.g; } while (0)
        SSD_ISSUE(0, PA); SSD_ISSUE(1, PB_);
#pragma unroll 1
        for (int ci = 0; ci < nch; ci += 2) {
            SSD_COMMIT(0, PA); LDSBAR(); if (ci + 2 < nch) SSD_ISSUE(ci + 2, PA);
            SSD_COMMIT(1, PB_); LDSBAR(); if (ci + 3 < nch) SSD_ISSUE(ci + 3, PB_); }
#undef SSD_ISSUE
#undef SSD_COMMIT
#undef REV8
    } else {
        const int pq = wave;
        f32x4 S[2][8];
        if (s >= 16) { int ln = lane_o; asm volatile("" : "+v"(ln)); const int l15 = ln & 15, q4 = ln >> 4;
#pragma unroll
            for (int x = 0; x < 2; ++x) { const float* sp = in[3] + ((size_t)((s - 16) * 2 + d) * 32 + head0 + x) * 8192;
#pragma unroll
                for (int t = 0; t < 8; ++t) S[x][t] = *(const f32x4*)(sp + (size_t)(16 * pq + l15) * 128 + 16 * t + 4 * q4); }
        } else {
#pragma unroll
            for (int x = 0; x < 2; ++x)
#pragma unroll
                for (int t = 0; t < 8; ++t) S[x][t] = (f32x4){0.f, 0.f, 0.f, 0.f}; }
#pragma unroll 1
        for (int ci = 0; ci < nch; ci += 2) { LDSBAR(); ssd_scan_step(F, S, 0, ci, d, len, row0, head0, OUT); LDSBAR(); ssd_scan_step(F, S, 1, ci + 1, d, len, row0, head0, OUT); }
        if (s < 16) { int ln = lane_o; asm volatile("" : "+v"(ln)); const int l15 = ln & 15, q4 = ln >> 4;
#pragma unroll
            for (int x = 0; x < 2; ++x) { float* sp = F.out + OUT_SS + ((size_t)(s * 2 + d) * 32 + head0 + x) * 8192;
#pragma unroll
                for (int t = 0; t < 8; ++t) *(f32x4*)(sp + (size_t)(16 * pq + l15) * 128 + 16 * t + 4 * q4) = S[x][t]; } }
    }
}

DI void phase_m0a(const Ctx& F, const float* const* in) {
    { int prev = -1; u32x4 rq_[6], rk_[6], rv_[6]; unsigned rgate = 0u; float gpar[2] = {0.f, 0.f};
      if (F.bid < 3072) gdn_prep_request(F, F.bid >> 4, F.bid & 15, rq_, rk_, rv_, rgate);
      for (int it = F.bid; it < 3072; it += F.G) { const int h = it & 15; const int nx = it + F.G;
          const int next_c64 = (nx < 3072 && (nx & 15) == h) ? (nx >> 4) : -1;
          gdn_prep_item(F, in, it >> 4, h, h != prev, rq_, rk_, rv_, rgate, gpar, next_c64);
          if (next_c64 < 0 && nx < 3072) gdn_prep_request(F, nx >> 4, nx & 15, rq_, rk_, rv_, rgate);
          prev = h; } }
    { int prev = -1; u32x4 rx0[6], rx1[6], rb_[6], rc_[6]; unsigned rdt = 0u; float spar[2] = {0.f, 0.f};
      if (F.bid < 1536) ssd_prep_request(F, F.bid >> 3, F.bid & 7, rx0, rx1, rb_, rc_, rdt);
#pragma unroll 1
      for (int it = F.bid; it < 1536; it += F.G) { const int g = it & 7; const int nx = it + F.G;
          ssd_prep_item(F, in, it >> 3, g, g != prev, rx0, rx1, rb_, rc_, rdt, spar, nx < 1536 ? (nx >> 3) : -1, nx & 7); prev = g; } }
}
DI int queue_grab(const Ctx& F, unsigned* head, int n) {
    volatile LAS int* slot = (volatile LAS int*)(F.lds + 163840 - 128);
    LDSBAR();
    if (F.tid == 0) *slot = (int)__hip_atomic_fetch_add(head, (unsigned)n, __ATOMIC_RELAXED, __HIP_MEMORY_SCOPE_AGENT);
    LDSBAR();
    return *slot;
}
DI void phase_m0(const Ctx& F, const float* const* in, int only = 0) {
    const int b = F.bid;
    const int nw = F.G > 128 ? F.G - 128 : F.G, w = F.G > 128 ? b - 128 : b;
    { int it = (F.G > 128 && b < 64) ? b : (F.G > 128 ? 64 + w : b); const int step = (F.G > 128 && b < 64) ? (1 << 20) : nw;
      if (!(F.G > 128 && b >= 64 && b < 128) && only != 2)
        for (; it < 64 + 512; it += step) { int s, h, d;
            if (it < 64) { s = 16 + (it >> 5); h = (it >> 1) & 15; d = it & 1; } else { const int k = it - 64; s = k >> 5; h = (k >> 1) & 15; d = k & 1; }
            gdn_scan_item(F, in, s, h, d); } }
    { int it = (F.G > 128 && b >= 64 && b < 128) ? b - 64 : (F.G > 128 ? 64 + w : b); const int step = (F.G > 128 && b >= 64 && b < 128) ? (1 << 20) : nw;
      if (!(F.G > 128 && b < 64) && only != 1)
        for (; it < 64 + 512; it += step) { int s, g, d, hp;
            if (it < 64) { s = 16 + (it >> 5); g = (it >> 2) & 7; d = (it >> 1) & 1; hp = it & 1; } else { const int k = it - 64; s = k >> 5; g = (k >> 2) & 7; d = (k >> 1) & 1; hp = k & 1; }
            ssd_scan_item(F, in, s, g, d, hp); } }
}
DI void phase_m0c(const Ctx& F, const float* const* in) {
    const int gw = F.bid * 8 + F.wave, NGW = F.G * 8, lane = F.lane;
    const bf16* U = (const bf16*)(F.ws + WS_U); bf16* MIX = (bf16*)(F.ws + WS_MIX);
    const bf16 *OFA = (const bf16*)(F.ws + WS_OFA), *OBA = (const bf16*)(F.ws + WS_OBA), *OFB = (const bf16*)(F.ws + WS_OFB), *OBB = (const bf16*)(F.ws + WS_OBB);
    for (int row = gw; row < NROWS; row += NGW) {
        const int len = row < 4096 ? 256 : 4096, t = row < 4096 ? (row & 255) : ((row - 4096) & 4095);
        const bf16* ur = U + (size_t)row * LD_EVEN;
        { const int hsub = lane >> 4, c8 = (lane & 15) * 8;
          const f32x4 gn0 = *(const f32x4*)(in[16] + c8), gn1 = *(const f32x4*)(in[16] + c8 + 4);
          u32x4 af[4], ab[4], az[4];
#pragma unroll
          for (int hq = 0; hq < 4; ++hq) { const size_t o = (size_t)row * 2048 + (hq * 4 + hsub) * 128 + c8;
              af[hq] = *(const u32x4*)(OFA + o); ab[hq] = *(const u32x4*)(OBA + o); az[hq] = *(const u32x4*)(ur + E_ZA + (hq * 4 + hsub) * 128 + c8); }
#pragma unroll
          for (int hq = 0; hq < 4; ++hq) { float x[8], y[8], z[8]; unpack8(af[hq], x); unpack8(ab[hq], y); unpack8(az[hq], z);
              float ss = 0.f;
#pragma unroll
              for (int e = 0; e < 8; ++e) { x[e] += y[e]; ss += x[e] * x[e]; }
              ss += __shfl_xor(ss, 1); ss += __shfl_xor(ss, 2); ss += __shfl_xor(ss, 4); ss += __shfl_xor(ss, 8);
              const float rn = __builtin_amdgcn_rsqf(ss * (1.0f / 128.0f) + EPS);
              u32x4 w; w.x = pk2(x[0] * rn * gn0[0] * siluf_(z[0]), x[1] * rn * gn0[1] * siluf_(z[1])); w.y = pk2(x[2] * rn * gn0[2] * siluf_(z[2]), x[3] * rn * gn0[3] * siluf_(z[3]));
              w.z = pk2(x[4] * rn * gn1[0] * siluf_(z[4]), x[5] * rn * gn1[1] * siluf_(z[5])); w.w = pk2(x[6] * rn * gn1[2] * siluf_(z[6]), x[7] * rn * gn1[3] * siluf_(z[7]));
              *(u32x4*)(MIX + (size_t)row * DM + (hq * 4 + hsub) * 128 + c8) = w; } }
        { const int gsub = lane >> 5, c8 = (lane & 31) * 8;
#pragma unroll 2
          for (int gq = 0; gq < 4; ++gq) { const int ch = (gq * 2 + gsub) * 256 + c8; const size_t o = (size_t)row * 2048 + ch;
              const u32x4 af = *(const u32x4*)(OFB + o), ab = *(const u32x4*)(OBB + o), x0 = *(const u32x4*)(ur + E_XBC + ch), zz = *(const u32x4*)(ur + E_ZB + ch);
              u32x4 xm = {0u, 0u, 0u, 0u}, xp = {0u, 0u, 0u, 0u};
              if (t > 0) xm = *(const u32x4*)(ur - LD_EVEN + E_XBC + ch);
              if (t + 1 < len) xp = *(const u32x4*)(ur + LD_EVEN + E_XBC + ch);
              const float dsk = in[20][ch >> 6];
              float a[8], bq[8], fm[8], f0[8], fp[8], zb[8], y[8]; unpack8(af, a); unpack8(ab, bq); unpack8(xm, fm); unpack8(x0, f0); unpack8(xp, fp); unpack8(zz, zb);
              float ss = 0.f;
#pragma unroll
              for (int e4 = 0; e4 < 2; ++e4) { const f32x4 w0 = *(const f32x4*)(in[17] + ch + 4 * e4), w1 = *(const f32x4*)(in[17] + 4096 + ch + 4 * e4), w2 = *(const f32x4*)(in[17] + 8192 + ch + 4 * e4);
#pragma unroll
                  for (int e = 0; e < 4; ++e) { const int k = 4 * e4 + e; const float xs = w0[e] * fm[k] + w1[e] * f0[k] + w2[e] * fp[k];
                      y[k] = (a[k] + bq[k] + dsk * siluf_(xs)) * siluf_(zb[k]); ss += y[k] * y[k]; } }
              ss += __shfl_xor(ss, 1); ss += __shfl_xor(ss, 2); ss += __shfl_xor(ss, 4); ss += __shfl_xor(ss, 8); ss += __shfl_xor(ss, 16);
              const float rn = __builtin_amdgcn_rsqf(ss * (1.0f / 256.0f) + EPS);
              const f32x4 g0 = *(const f32x4*)(in[21] + ch), g1 = *(const f32x4*)(in[21] + ch + 4);
              u32x4 w; w.x = pk2(y[0] * rn * g0[0], y[1] * rn * g0[1]); w.y = pk2(y[2] * rn * g0[2], y[3] * rn * g0[3]); w.z = pk2(y[4] * rn * g1[0], y[5] * rn * g1[1]); w.w = pk2(y[6] * rn * g1[2], y[7] * rn * g1[3]);
              *(u32x4*)(MIX + (size_t)row * DM + 2048 + ch) = w; } }
    }
}
DI void gla_prep_all(const Ctx& F, const float* const* in) {
    LAS bf16* QS = (LAS bf16*)(F.lds + 0);
    LAS bf16* KS = (LAS bf16*)(F.lds + 17408);
    LAS bf16* KST = (LAS bf16*)(F.lds + 34816);
    LAS bf16* VT = (LAS bf16*)(F.lds + 53248);
    LAS float* GL = (LAS float*)(F.lds + 71680);
    LAS float* PART = GL + 128;
    LAS bf16* RF0 = (LAS bf16*)(F.lds + 74240);
    LAS bf16* RF1 = (LAS bf16*)(F.lds + 91648);
    LAS bf16* RQ = (LAS bf16*)(F.lds + 109056);
    LAS bf16* RV = (LAS bf16*)(F.lds + 126464);
    const bf16* U = (const bf16*)(F.ws + WS_U);
    const int lane_o = F.lane, wave = F.wave;
    const int kch = F.tid & 127, qtr = F.tid >> 7;
    const int er = F.tid >> 3, ep = F.tid & 7;
    u32x4 pr[8];
#define GLA_PRE(it_) do { const bf16* ur_ = U + (size_t)(((it_) >> 4) * 64 + er) * IN_ODD + ((it_) & 15) * 128 + ep * 16; \
        const u32x4* a_ = (const u32x4*)(ur_ + O_Q); const u32x4* b_ = (const u32x4*)(ur_ + O_I); const u32x4* c_ = (const u32x4*)(ur_ + O_F); const u32x4* d_ = (const u32x4*)(ur_ + O_F + 2048); \
        pr[0] = a_[0]; pr[1] = a_[1]; pr[2] = b_[0]; pr[3] = b_[1]; pr[4] = c_[0]; pr[5] = c_[1]; pr[6] = d_[0]; pr[7] = d_[1]; } while (0)
    float lbv[2] = {0.f, 0.f}; int lb_h = -1;
    int it = F.bid;
    if (it < 3072) GLA_PRE(it);
#pragma unroll 1
  for (; it < 3072; it += F.G) {
    const int c64 = it >> 4, h = it & 15, r0 = c64 * 64;
    if (h != lb_h) { lb_h = h;
#pragma unroll
        for (int d = 0; d < 2; ++d) lbv[d] = 1.0f / (1.0f + expf(in[31][4096 + d * 2048 + h * 128 + kch] - in[31][d * 2048 + h * 128 + kch])); }
    LDSBAR();
    *(LAS u32x4*)(RQ + er * LDQ + ep * 16) = pr[0]; *(LAS u32x4*)(RQ + er * LDQ + ep * 16 + 8) = pr[1];
    *(LAS u32x4*)(RV + er * LDQ + ep * 16) = pr[2]; *(LAS u32x4*)(RV + er * LDQ + ep * 16 + 8) = pr[3];
    *(LAS u32x4*)(RF0 + er * LDQ + ep * 16) = pr[4]; *(LAS u32x4*)(RF0 + er * LDQ + ep * 16 + 8) = pr[5];
    *(LAS u32x4*)(RF1 + er * LDQ + ep * 16) = pr[6]; *(LAS u32x4*)(RF1 + er * LDQ + ep * 16 + 8) = pr[7];
    if (it + F.G < 3072) GLA_PRE(it + F.G);
    float sq[16];
#pragma unroll 1
    for (int d = 0; d < 2; ++d) {
        const size_t item = ((size_t)c64 * 16 + h) * 2 + d;
        LAS bf16* RF = d ? RF1 : RF0;
        int lane = lane_o; asm volatile("" : "+v"(lane)); const int l15 = lane & 15, q4 = lane >> 4;
        const float lb = d ? lbv[1] : lbv[0];
        LDSBAR();
#ifndef PROBE_GE
#define PROBE_GE 1
#endif
#pragma unroll 1
        for (int rp_ = 0; rp_ < PROBE_GE; ++rp_)
        { const int sqt = d ? 3 - qtr : qtr;
          float pr_[16], kk[16]; float run = 1.f;
#pragma unroll
          for (int ii = 0; ii < 16; ++ii) { const int i = 16 * sqt + ii, tok = d ? 63 - i : i;
              const float fr = bf2f(RF[tok * LDQ + kch]);
              const float f = lb + (1.0f - lb) * sigmoidf_(fr); kk[ii] = 1.0f - f; run *= f; pr_[ii] = run; }
          PART[sqt * 128 + kch] = run;
          if (d == 0) {
#pragma unroll
              for (int ii = 0; ii < 16; ++ii) { const int i = 16 * qtr + ii; sq[ii] = siluf_(bf2f(RQ[i * LDQ + kch])) * 0.08838834764831845f; } }
          LDSBAR();
          float off = 1.f, tot = 1.f;
#pragma unroll
          for (int qq = 0; qq < 4; ++qq) { const float pq = PART[qq * 128 + kch]; if (qq < sqt) off *= pq; tot *= pq; }
          if (qtr == 0) ((float*)(F.ws + WS_LGL))[item * 128 + kch] = __logf(tot);
          unsigned kp[8], vp[8];
          float kvs[16];
          { float inv = __builtin_amdgcn_rcpf(off * pr_[15]);
#pragma unroll
            for (int ii = 15; ii >= 0; --ii) { kvs[ii] = kk[ii] * inv; inv *= 1.0f - kk[ii]; } }
#pragma unroll
          for (int ii = 0; ii < 16; ++ii) { const int i = 16 * sqt + ii, tok = d ? 63 - i : i;
              const float eg = off * pr_[ii];
              const float qv = (d ? sq[15 - ii] : sq[ii]) * eg;
              const float kv = kvs[ii];
              QS[i * LDQ + kch] = f2bf(qv); const bf16 kb = f2bf(kv); KS[i * LDQ + kch] = kb;
              if (ii & 1) kp[ii >> 1] |= (unsigned)kb << 16; else kp[ii >> 1] = kb;
              if (d == 0) { const unsigned vb = RV[tok * LDQ + kch]; if (ii & 1) vp[ii >> 1] |= vb << 16; else vp[ii >> 1] = vb; } }
          *(LAS u32x4*)(KST + kch * LDT + 16 * sqt) = (u32x4){kp[0], kp[1], kp[2], kp[3]}; *(LAS u32x4*)(KST + kch * LDT + 16 * sqt + 8) = (u32x4){kp[4], kp[5], kp[6], kp[7]};
          if (d == 0) { *(LAS u32x4*)(VT + kch * LDT + 16 * qtr) = (u32x4){vp[0], vp[1], vp[2], vp[3]}; *(LAS u32x4*)(VT + kch * LDT + 16 * qtr + 8) = (u32x4){vp[4], vp[5], vp[6], vp[7]}; } }
        LDSBAR();
#ifndef PROBE_GA
#define PROBE_GA 1
#endif
#pragma unroll 1
        for (int rq_ = 0; rq_ < PROBE_GA; ++rq_) {
#pragma unroll
        for (int tt = 0; tt < 2; ++tt) { const int id = 2 * wave + tt, ti = id >> 2, tj = id & 3;
            f32x4 a = {0.f, 0.f, 0.f, 0.f};
#pragma unroll
            for (int ks = 0; ks < 4; ++ks) a = MFMA16(frag_nat(KS, LDQ, tj * 16, ks * 32, lane), frag_nat(QS, LDQ, ti * 16, ks * 32, lane), a);
            const int i = ti * 16 + l15; float pv[4];
#pragma unroll
            for (int r = 0; r < 4; ++r) { const int j = tj * 16 + 4 * q4 + r; pv[r] = (i >= j) ? a[r] : 0.f; }
            u32x2 w2; w2.x = pk2(pv[0], pv[1]); w2.y = pk2(pv[2], pv[3]);
            *(u32x2*)((bf16*)(F.ws + WS_LAT) + (item * 64 + i) * 64 + tj * 16 + 4 * q4) = w2; }
        { bf16* qg = (bf16*)(F.ws + WS_LQS) + item * 8192; bf16* kg = (bf16*)(F.ws + WS_LKS) + item * 8192;
#pragma unroll
          for (int k = 0; k < 2; ++k) { const int e = F.tid + 512 * k;
              { const int row = e >> 4, pc = e & 15; *(u32x4*)(qg + row * 128 + pc * 8) = *(const LAS u32x4*)(QS + row * LDQ + pc * 8); }
              { const int row = e >> 3, pc = e & 7; *(u32x4*)(kg + row * 64 + pc * 8) = *(const LAS u32x4*)(KST + row * LDT + pc * 8);
                if (d == 0) *(u32x4*)((bf16*)(F.ws + WS_LVT) + ((size_t)h * 128 + row) * NROWS + r0 + pc * 8) = *(const LAS u32x4*)(VT + row * LDT + pc * 8); } } }
        }
    }
  }
#undef GLA_PRE
}

#define GLA_SETB 64000
DI void gla_scan_step(const Ctx& F, f32x4 (&S)[2][8], int set, int ci, int d, int len, int row0, int h, bf16* OUT) {
    const int wave = F.wave;
    int lane = F.lane; asm volatile("" : "+v"(lane)); const int l15 = lane & 15, q4 = lane >> 4;
    LAS unsigned char* base = F.lds + set * GLA_SETB;
    LAS bf16* QS = (LAS bf16*)base; LAS bf16* KST = (LAS bf16*)(base + 17408); LAS bf16* ATT = (LAS bf16*)(base + 35840); LAS bf16* VT = (LAS bf16*)(base + 45056); LAS float* GL = (LAS float*)(base + 63488);
#define LQ(dst, it) do { _Pragma("unroll") for (int i_ = 0; i_ < 4; ++i_) dst[i_] = frag_perm(QS, LDQ, (it) * 16, i_ * 32, lane); SCHED_FENCE(); } while (0)
#define LT(dst, M, t0) do { _Pragma("unroll") for (int i_ = 0; i_ < 4; ++i_) dst[i_] = frag_nat(M, LDT, ((t0) + (i_ >> 1)) * 16, (i_ & 1) * 32, lane); SCHED_FENCE(); } while (0)
#define CO(X, j) do { _Pragma("unroll") for (int ks = 0; ks < 4; ++ks) { o[0][j] = MFMA16(Sp[0][ks], X[ks], o[0][j]); o[1][j] = MFMA16(Sp[1][ks], X[ks], o[1][j]); } SCHED_FENCE(); } while (0)
#define CA(X, it0) do { _Pragma("unroll") for (int ks = 0; ks < 2; ++ks) _Pragma("unroll") for (int j = 0; j < 2; ++j) { o[0][j] = MFMA16(VF[0][ks], X[j * 2 + ks], o[0][j]); o[1][j] = MFMA16(VF[1][ks], X[j * 2 + ks], o[1][j]); } \
        _Pragma("unroll") for (int j = 0; j < 2; ++j) { const int i = ((it0) + j) * 16 + l15; const int tl = ci * 64 + i, t = d ? (len - 1 - tl) : tl; bf16* op = OUT + (size_t)(row0 + t) * 2048 + h * 128 + 32 * wave + 4 * q4; \
            u32x2 w2; w2.x = pk2(o[0][j][0], o[0][j][1]); w2.y = pk2(o[0][j][2], o[0][j][3]); *(u32x2*)op = w2; w2.x = pk2(o[1][j][0], o[1][j][1]); w2.y = pk2(o[1][j][2], o[1][j][3]); *(u32x2*)(op + 16) = w2; \
            o[0][j] = (f32x4){0.f, 0.f, 0.f, 0.f}; o[1][j] = (f32x4){0.f, 0.f, 0.f, 0.f}; } SCHED_FENCE(); } while (0)
#define CS(X, t0) do { _Pragma("unroll") for (int ks = 0; ks < 2; ++ks) _Pragma("unroll") for (int j = 0; j < 2; ++j) { S[0][(t0) + j] = MFMA16(X[j * 2 + ks], VF[0][ks], S[0][(t0) + j]); S[1][(t0) + j] = MFMA16(X[j * 2 + ks], VF[1][ks], S[1][(t0) + j]); } SCHED_FENCE(); } while (0)
    bf16x8 X0[4], X1[4], X2[4];
    bf16x8 VF[2][2];
#pragma unroll
    for (int x = 0; x < 2; ++x)
#pragma unroll
        for (int ks = 0; ks < 2; ++ks) VF[x][ks] = frag_nat(VT, LDT, 16 * (2 * wave + x), ks * 32, lane);
    LQ(X0, 0); LQ(X1, 1);
    bf16x8 Sp[2][4];
#pragma unroll
    for (int x = 0; x < 2; ++x)
#pragma unroll
        for (int ks = 0; ks < 4; ++ks) Sp[x][ks] = pack2(S[x][2 * ks], S[x][2 * ks + 1]);
    f32x4 o[2][2];
#pragma unroll
    for (int x = 0; x < 2; ++x)
#pragma unroll
        for (int j = 0; j < 2; ++j) o[x][j] = (f32x4){0.f, 0.f, 0.f, 0.f};
    SCHED_FENCE();
    LT(X2, ATT, 0); CO(X0, 0);
    LQ(X0, 2); CO(X1, 1);
    LQ(X1, 3); CA(X2, 0);
    LT(X2, ATT, 2); CO(X0, 0);
    LT(X0, KST, 0); CO(X1, 1);
    LT(X1, KST, 2); CA(X2, 2);
    LT(X2, KST, 4); CS(X0, 0);
    LT(X0, KST, 6); CS(X1, 2);
    CS(X2, 4); CS(X0, 6);
#pragma unroll
    for (int t = 0; t < 8; ++t) { const f32x4 gl = *(const LAS f32x4*)(GL + 16 * t + 4 * q4);
#pragma unroll
        for (int r = 0; r < 4; ++r) { const float eg = __expf(gl[r]); S[0][t][r] *= eg; S[1][t][r] *= eg; } }
#undef LQ
#undef LT
#undef CO
#undef CA
#undef CS
}
DI void gla_scan_item(const Ctx& F, const float* const* in, int s, int h, int d) {
    constexpr int SETB = GLA_SETB;
    const int row0 = seq_row0(s), len = seq_len(s), nch = len >> 6, c640 = row0 >> 6;
    const int lane_o = F.lane, wave = F.wave;
    bf16* OUT = (bf16*)(F.ws + (d ? WS_OBA : WS_OFA));
    const bf16* LQS = (const bf16*)(F.ws + WS_LQS); const bf16* LKS = (const bf16*)(F.ws + WS_LKS); const bf16* LAT = (const bf16*)(F.ws + WS_LAT);
    const bf16* LVT = (const bf16*)(F.ws + WS_LVT) + (size_t)h * 128 * NROWS; const float* LGL = (const float*)(F.ws + WS_LGL);
    LDSBAR();
    if (wave >= 4) {
        struct Pre { u32x4 q[4], k[4], a[2], v[4]; float g; };
        Pre PA, PB_;
        const int e = F.tid - 256, er = e >> 2, eq = e & 3;
#define REV8(w_) ((u32x4){((w_).w >> 16) | ((w_).w << 16), ((w_).z >> 16) | ((w_).z << 16), ((w_).y >> 16) | ((w_).y << 16), ((w_).x >> 16) | ((w_).x << 16)})
#define GLA_ISSUE(ci_, P_) do { const int cc = c640 + (d ? nch - 1 - (ci_) : (ci_)); const size_t item = ((size_t)cc * 16 + h) * 2 + d; \
        const u32x4* qsrc = (const u32x4*)(LQS + item * 8192 + er * 128 + eq * 32); _Pragma("unroll") for (int m_ = 0; m_ < 4; ++m_) P_.q[m_] = qsrc[m_]; \
        const u32x4* k0src = (const u32x4*)(LKS + item * 8192 + er * 64 + eq * 16); const u32x4* k1src = (const u32x4*)(LKS + item * 8192 + (64 + er) * 64 + eq * 16); \
        P_.k[0] = k0src[0]; P_.k[1] = k0src[1]; P_.k[2] = k1src[0]; P_.k[3] = k1src[1]; \
        const u32x4* asrc = (const u32x4*)(LAT + item * 4096 + er * 64 + eq * 16); P_.a[0] = asrc[0]; P_.a[1] = asrc[1]; \
        const u32x4* v0src = (const u32x4*)(LVT + (size_t)er * NROWS + cc * 64 + eq * 16); const u32x4* v1src = (const u32x4*)(LVT + (size_t)(64 + er) * NROWS + cc * 64 + eq * 16); \
        P_.v[0] = v0src[0]; P_.v[1] = v0src[1]; P_.v[2] = v1src[0]; P_.v[3] = v1src[1]; \
        P_.g = 0.f; if (e < 128) P_.g = LGL[item * 128 + e]; } while (0)
#define GLA_COMMIT(set_, P_) do { LAS unsigned char* base = F.lds + (set_) * SETB; \
        _Pragma("unroll") for (int m_ = 0; m_ < 4; ++m_) *(LAS u32x4*)((LAS bf16*)base + er * LDQ + eq * 32 + m_ * 8) = P_.q[m_]; \
        *(LAS u32x4*)((LAS bf16*)(base + 17408) + er * LDT + eq * 16) = P_.k[0]; *(LAS u32x4*)((LAS bf16*)(base + 17408) + er * LDT + eq * 16 + 8) = P_.k[1]; \
        *(LAS u32x4*)((LAS bf16*)(base + 17408) + (64 + er) * LDT + eq * 16) = P_.k[2]; *(LAS u32x4*)((LAS bf16*)(base + 17408) + (64 + er) * LDT + eq * 16 + 8) = P_.k[3]; \
        *(LAS u32x4*)((LAS bf16*)(base + 35840) + er * LDT + eq * 16) = P_.a[0]; *(LAS u32x4*)((LAS bf16*)(base + 35840) + er * LDT + eq * 16 + 8) = P_.a[1]; \
        if (d == 0) { *(LAS u32x4*)((LAS bf16*)(base + 45056) + er * LDT + eq * 16) = P_.v[0]; *(LAS u32x4*)((LAS bf16*)(base + 45056) + er * LDT + eq * 16 + 8) = P_.v[1]; \
            *(LAS u32x4*)((LAS bf16*)(base + 45056) + (64 + er) * LDT + eq * 16) = P_.v[2]; *(LAS u32x4*)((LAS bf16*)(base + 45056) + (64 + er) * LDT + eq * 16 + 8) = P_.v[3]; } \
        else { *(LAS u32x4*)((LAS bf16*)(base + 45056) + er * LDT + (3 - eq) * 16 + 8) = REV8(P_.v[0]); *(LAS u32x4*)((LAS bf16*)(base + 45056) + er * LDT + (3 - eq) * 16) = REV8(P_.v[1]); \
            *(LAS u32x4*)((LAS bf16*)(base + 45056) + (64 + er) * LDT + (3 - eq) * 16 + 8) = REV8(P_.v[2]); *(LAS u32x4*)((LAS bf16*)(base + 45056) + (64 + er) * LDT + (3 - eq) * 16) = REV8(P_.v[3]); } \
        if (e < 128) ((LAS float*)(base + 63488))[e] = P_.g; } while (0)
        GLA_ISSUE(0, PA); GLA_ISSUE(1, PB_);
#pragma unroll 1
        for (int ci = 0; ci < nch; ci += 2) {
            GLA_COMMIT(0, PA); LDSBAR(); if (ci + 2 < nch) GLA_ISSUE(ci + 2, PA);
            GLA_COMMIT(1, PB_); LDSBAR(); if (ci + 3 < nch) GLA_ISSUE(ci + 3, PB_); }
#undef GLA_ISSUE
#undef GLA_COMMIT
#undef REV8
    } else {
        f32x4 S[2][8];
        if (s >= 16) { int ln = lane_o; asm volatile("" : "+v"(ln)); const int l15 = ln & 15, q4 = ln >> 4; const float* sp = in[4] + ((size_t)((s - 16) * 2 + d) * 16 + h) * 16384;
#pragma unroll
            for (int x = 0; x < 2; ++x)
#pragma unroll
                for (int t = 0; t < 8; ++t)
#pragma unroll
                    for (int r = 0; r < 4; ++r) S[x][t][r] = sp[(size_t)(16 * t + 4 * q4 + r) * 128 + 32 * wave + 16 * x + l15];
        } else {
#pragma unroll
            for (int x = 0; x < 2; ++x)
#pragma unroll
                for (int t = 0; t < 8; ++t) S[x][t] = (f32x4){0.f, 0.f, 0.f, 0.f}; }
#pragma unroll 1
        for (int ci = 0; ci < nch; ci += 2) { LDSBAR(); gla_scan_step(F, S, 0, ci, d, len, row0, h, OUT); LDSBAR(); gla_scan_step(F, S, 1, ci + 1, d, len, row0, h, OUT); }
        if (s < 16) { int ln = lane_o; asm volatile("" : "+v"(ln)); const int l15 = ln & 15, q4 = ln >> 4; float* sp = F.out + OUT_SH + ((size_t)(s * 2 + d) * 16 + h) * 16384;
#pragma unroll
            for (int x = 0; x < 2; ++x)
#pragma unroll
                for (int t = 0; t < 8; ++t)
#pragma unroll
                    for (int r = 0; r < 4; ++r) sp[(size_t)(16 * t + 4 * q4 + r) * 128 + 32 * wave + 16 * x + l15] = S[x][t][r]; }
    }
}

struct M1aRaw { u32x4 a[2], b[2], m[2], p[2]; };
DI void m1a_load(const Ctx& F, int item, M1aRaw& R) {
    const int tt = item >> 5, cb = item & 31, r0 = tt * 64, c0 = cb * 256;
    const bf16* U = (const bf16*)(F.ws + WS_U);
    const int cg = F.lane & 31;
    const int len = r0 < 4096 ? 256 : 4096, tbase = r0 < 4096 ? (r0 & 255) : ((r0 - 4096) & 4095);
    const int col = c0 + cg * 8;
#pragma unroll
    for (int itk = 0; itk < 2; ++itk) { const int tp = itk * 16 + F.wave * 2 + (F.lane >> 5);
        const int tl = 2 * tp, t = tbase + tl; const bf16* ur = U + (size_t)(r0 + tl) * IN_ODD + col;
        R.a[itk] = *(const u32x4*)ur; R.b[itk] = *(const u32x4*)(ur + IN_ODD);
        R.m[itk] = (u32x4){0u, 0u, 0u, 0u}; R.p[itk] = (u32x4){0u, 0u, 0u, 0u};
        if (col < 6144) { if (t > 0) R.m[itk] = *(const u32x4*)(ur - IN_ODD); if (t + 2 < len) R.p[itk] = *(const u32x4*)(ur + 2 * IN_ODD); } }
}
DI void m1a_item(const Ctx& F, const float* const* in, int item, M1aRaw& R, int next_item) {
    LAS unsigned* T = (LAS unsigned*)F.lds;
    const int tt = item >> 5, cb = item & 31, r0 = tt * 64, c0 = cb * 256;
    bf16* TB = (bf16*)(F.ws + WS_TB);
    const int cg = F.lane & 31;
    const int col = c0 + cg * 8;
#pragma unroll
    for (int itk = 0; itk < 2; ++itk) { const int tp = itk * 16 + F.wave * 2 + (F.lane >> 5);
        float xa[8], xb[8], oa[8], ob[8]; unpack8(R.a[itk], xa); unpack8(R.b[itk], xb);
        if (col < 6144) { float xm[8], xp[8]; unpack8(R.m[itk], xm); unpack8(R.p[itk], xp);
            const float* cw = in[23] + col;
#pragma unroll
            for (int e = 0; e < 8; ++e) { oa[e] = cw[e] * xm[e] + cw[6144 + e] * xa[e] + cw[12288 + e] * xb[e]; ob[e] = cw[e] * xa[e] + cw[6144 + e] * xb[e] + cw[12288 + e] * xp[e]; }
        } else {
#pragma unroll
            for (int e = 0; e < 8; ++e) { oa[e] = siluf_(xa[e]); ob[e] = siluf_(xb[e]); } }
#pragma unroll
        for (int e = 0; e < 8; ++e) T[(e * 32 + cg) * 33 + tp] = pk2(oa[e], ob[e]); }
    if (next_item >= 0) m1a_load(F, next_item, R);
    LDSBAR();
#pragma unroll
    for (int k = 0; k < 4; ++k) { const int e = F.tid + 512 * k, part = e & 7, chi = e >> 3;
        const int ch = (chi & 31) * 8 + (chi >> 5);
        const LAS unsigned* sp = T + chi * 33 + part * 4;
        u32x4 w; w.x = sp[0]; w.y = sp[1]; w.z = sp[2]; w.w = sp[3];
        *(u32x4*)(TB + (size_t)(c0 + ch) * NROWS + r0 + part * 8) = w; }
    LDSBAR();
}

DI f32x2 w16(int k) {
    switch (k & 7) {
        case 0: return (f32x2){1.0f, 0.0f};
        case 1: return (f32x2){0.9238795325112867f, -0.3826834323650898f};
        case 2: return (f32x2){0.7071067811865476f, -0.7071067811865476f};
        case 3: return (f32x2){0.3826834323650898f, -0.9238795325112867f};
        case 4: return (f32x2){0.0f, -1.0f};
        case 5: return (f32x2){-0.3826834323650898f, -0.9238795325112867f};
        case 6: return (f32x2){-0.7071067811865476f, -0.7071067811865476f};
        default: return (f32x2){-0.9238795325112867f, -0.3826834323650898f};
    }
}
DI f32x2 cmul(f32x2 a, f32x2 b) { return (f32x2){a[0] * b[0] - a[1] * b[1], a[0] * b[1] + a[1] * b[0]}; }
DI f32x2 cmulc(f32x2 a, f32x2 b) { return (f32x2){a[0] * b[0] + a[1] * b[1], a[1] * b[0] - a[0] * b[1]}; }
template <int LOGR, bool INV, bool UNIT = false> DI void fft_bfly(f32x2 (&x)[1 << LOGR], f32x2 w0) {
    constexpr int R = 1 << LOGR;
    f32x2 wj[LOGR];
    wj[0] = w0;
#pragma unroll
    for (int s = 1; s < LOGR; ++s) wj[s] = cmul(wj[s - 1], wj[s - 1]);
#pragma unroll
    for (int ss = 0; ss < LOGR; ++ss) { const int s = INV ? (LOGR - 1 - ss) : ss; const int hm = R >> (s + 1);
#pragma unroll
        for (int m = 0; m < R; ++m) { if (m & hm) continue; const int mm = m % hm;
            const int k16 = mm * (16 >> (LOGR - s));
            if (UNIT && k16 == 0) { const f32x2 a = x[m], b = x[m + hm]; x[m] = a + b; x[m + hm] = a - b; continue; }
            if (UNIT && k16 == 4) {
                if (!INV) { const f32x2 a = x[m], b = x[m + hm], d = a - b; x[m] = a + b; x[m + hm] = (f32x2){d[1], -d[0]}; }
                else { const f32x2 a = x[m], bb = x[m + hm], b = (f32x2){-bb[1], bb[0]}; x[m] = a + b; x[m + hm] = a - b; }
                continue; }
            f32x2 w;
            if (UNIT) w = w16(k16);
            else if (k16 == 0) w = wj[s];
            else if (k16 == 4) w = (f32x2){wj[s][1], -wj[s][0]};
            else w = cmul(wj[s], w16(k16));
            if (!INV) { const f32x2 a = x[m], b = x[m + hm]; x[m] = a + b; x[m + hm] = cmul(a - b, w); }
            else { const f32x2 a = x[m], b = cmulc(x[m + hm], w); x[m] = a + b; x[m + hm] = a - b; } } }
}
template <int LOGR, bool INV, int PADSH> DI void fft_group(LAS f32x2* buf, const LAS f32x2* TW, int B, int tws, int g) {
    constexpr int R = 1 << LOGR;
    const int stride = B >> LOGR, blk = g / stride, j = g - blk * stride;
    const int base = blk * B + j;
    LAS f32x2* p = buf + base + (base >> PADSH);
    const int pstride = stride >= (1 << PADSH) ? stride + (stride >> PADSH) : stride;
    f32x2 x[R];
#pragma unroll
    for (int m = 0; m < R; ++m) x[m] = p[m * pstride];
    fft_bfly<LOGR, INV>(x, TW[j * tws]);
#pragma unroll
    for (int m = 0; m < R; ++m) p[m * pstride] = x[m];
}
template <int LOGR, bool INV, int PADSH> DI void fft_group2(LAS f32x2* buf, const LAS f32x2* TW, int B, int tws, int g0, int g1) {
    constexpr int R = 1 << LOGR;
    const int stride = B >> LOGR, pstride = stride >= (1 << PADSH) ? stride + (stride >> PADSH) : stride;
    const int blk0 = g0 / stride, j0 = g0 - blk0 * stride, base0 = blk0 * B + j0;
    const int blk1 = g1 / stride, j1 = g1 - blk1 * stride, base1 = blk1 * B + j1;
    LAS f32x2* p0 = buf + base0 + (base0 >> PADSH); LAS f32x2* p1 = buf + base1 + (base1 >> PADSH);
    f32x2 xa[R], xb[R];
#pragma unroll
    for (int m = 0; m < R; ++m) xa[m] = p0[m * pstride];
#pragma unroll
    for (int m = 0; m < R; ++m) xb[m] = p1[m * pstride];
    const f32x2 wa = TW[j0 * tws], wb = TW[j1 * tws];
    SCHED_FENCE();
    fft_bfly<LOGR, INV>(xa, wa);
#pragma unroll
    for (int m = 0; m < R; ++m) p0[m * pstride] = xa[m];
    fft_bfly<LOGR, INV>(xb, wb);
#pragma unroll
    for (int m = 0; m < R; ++m) p1[m * pstride] = xb[m];
}
template <int PADSH> DI void fft_first8(LAS f32x2* buf, f32x2 w0, int N, int j, f32x2 i0, f32x2 i1, f32x2 i2, f32x2 i3) {
    const int stride = N >> 3, pstride = stride + (stride >> PADSH);
    f32x2 x[8] = {i0, i1, i2, i3, (f32x2){0.f, 0.f}, (f32x2){0.f, 0.f}, (f32x2){0.f, 0.f}, (f32x2){0.f, 0.f}};
    fft_bfly<3, false>(x, w0);
    LAS f32x2* p = buf + j + (j >> PADSH);
#pragma unroll
    for (int m = 0; m < 8; ++m) p[m * pstride] = x[m];
}
template <int PADSH> DI void fft_last8(const LAS f32x2* buf, f32x2 w0, int N, int j, f32x2& o0, f32x2& o1, f32x2& o2, f32x2& o3) {
    const int stride = N >> 3, pstride = stride + (stride >> PADSH);
    const LAS f32x2* p = buf + j + (j >> PADSH);
    f32x2 x[8];
#pragma unroll
    for (int m = 0; m < 8; ++m) x[m] = p[m * pstride];
    fft_bfly<3, true>(x, w0);
    o0 = x[0]; o1 = x[1]; o2 = x[2]; o3 = x[3];
}
#define PD4(i_) ((i_) + ((i_) >> 4))
#define PD3(i_) ((i_) + ((i_) >> 3))
template <bool INV> DI void fft8192(LAS f32x2* buf, const LAS f32x2* TW, int tid) {
    if (!INV) {
        fft_group2<3, false, 4>(buf, TW, 8192, 1, tid, tid + 512); LDSBAR();
        fft_group2<3, false, 4>(buf, TW, 1024, 8, tid, tid + 512); LDSBAR();
        fft_group2<3, false, 4>(buf, TW, 128, 64, tid, tid + 512); LDSBAR();
        fft_group<4, false, 4>(buf, TW, 16, 0, tid); LDSBAR();
    } else {
        fft_group<4, true, 4>(buf, TW, 16, 0, tid); LDSBAR();
        fft_group2<3, true, 4>(buf, TW, 128, 64, tid, tid + 512); LDSBAR();
        fft_group2<3, true, 4>(buf, TW, 1024, 8, tid, tid + 512); LDSBAR();
        fft_group2<3, true, 4>(buf, TW, 8192, 1, tid, tid + 512); LDSBAR();
    }
}
#define WSYNC() asm volatile("s_waitcnt lgkmcnt(0)" ::: "memory")
template <bool INV> DI void fft512(LAS f32x2* buf, const LAS f32x2* TW, int lane) {
    if (!INV) { fft_group<3, false, 3>(buf, TW, 512, 16, lane); WSYNC(); fft_group<3, false, 3>(buf, TW, 64, 128, lane); WSYNC(); fft_group<3, false, 3>(buf, TW, 8, 0, lane); WSYNC(); }
    else { fft_group<3, true, 3>(buf, TW, 8, 0, lane); WSYNC(); fft_group<3, true, 3>(buf, TW, 64, 128, lane); WSYNC(); fft_group<3, true, 3>(buf, TW, 512, 16, lane); WSYNC(); }
}
constexpr int LDS_TW = 139264;
DI void fft_table_init(const Ctx& F) { LAS f32x2* TW = (LAS f32x2*)(F.lds + LDS_TW);
    for (int j = F.tid; j < 1024; j += 512) { float sn, cs; sincospif(-2.0f * (float)j / 8192.0f, &sn, &cs); TW[j] = (f32x2){cs, sn}; }
    LDSBAR(); }
DI f32x2 filt_spec(f32x2 z1, f32x2 z2, int ord) { const float sg = ord ? -0.5f : 0.5f; const float ar = 0.5f * z1[0] + sg * z2[0], ai = 0.5f * z1[1] - sg * z2[1];
    return ord ? (f32x2){ai, -ar} : (f32x2){ar, ai}; }

template <int LOGR, int PADSH, int LOGN> DI void fft_mid(LAS f32x2* D, const LAS f32x2* HZ, int ord, int g) {
    constexpr int R = 1 << LOGR, N = 1 << LOGN;
    LAS f32x2* p = D + g * R + ((g * R) >> PADSH);
    f32x2 x[R];
#pragma unroll
    for (int m = 0; m < R; ++m) x[m] = p[m];
    fft_bfly<LOGR, false, true>(x, (f32x2){1.f, 0.f});
#pragma unroll
    for (int m = 0; m < R; ++m) { const int t = g * R + m; const int fq = (int)(__brev((unsigned)t) >> (32 - LOGN)), t2 = (int)(__brev((unsigned)((N - fq) & (N - 1))) >> (32 - LOGN));
        x[m] = cmul(x[m], filt_spec(HZ[t + (t >> PADSH)], HZ[t2 + (t2 >> PADSH)], ord)) * (1.0f / (float)N); }
    fft_bfly<LOGR, true, true>(x, (f32x2){1.f, 0.f});
#pragma unroll
    for (int m = 0; m < R; ++m) p[m] = x[m];
}
DI int hyena_dec_item(const Ctx& F, const float* const* in, int c, unsigned* qhead) {
    LAS f32x2* HB = (LAS f32x2*)F.lds;
    LAS f32x2* DB = HB + 8704;
    const LAS f32x2* TW = (const LAS f32x2*)(F.lds + LDS_TW);
    const bf16* TB = (const bf16*)(F.ws + WS_TB); bf16* YT = (bf16*)(F.ws + WS_YT);
    const float* HF = (const float*)(F.ws + WS_HF4096); const float* HN = (const float*)(F.ws + WS_HNRM) + 4096;
    const int tid_o = F.tid;
    int nxt_raw = 0;
    if (tid_o == 0) nxt_raw = (int)__hip_atomic_fetch_add(qhead, 1u, __ATOMIC_RELAXED, __HIP_MEMORY_SCOPE_AGENT);
    float va[8], vb[8];
#pragma unroll
    for (int k = 0; k < 8; ++k) { const int t = tid_o + 512 * k; va[k] = bf2f(TB[(size_t)c * NROWS + 4096 + t]); vb[k] = bf2f(TB[(size_t)c * NROWS + 8192 + t]); }
    { const float n0 = HN[c], n1 = HN[2048 + c]; const float* h0 = HF + (size_t)c * 8192; const float* h1 = HF + ((size_t)2048 + c) * 8192;
#pragma unroll 8
      for (int k = 0; k < 16; ++k) { const int t = tid_o + 512 * k; HB[PD4(t)] = (f32x2){h0[t] * n0, h1[t] * n1}; } }
    LDSBAR();
    fft8192<false>(HB, TW, tid_o);
#pragma unroll 1
    for (int ord = 0; ord < 2; ++ord) {
        int tid = tid_o; asm volatile("" : "+v"(tid));
        const size_t xoff = (size_t)((ord + 1) * 2048 + c) * NROWS, zoff = (size_t)(6144 + c) * NROWS;
        const float bias = in[30][ord * 2048 + c];
        bf16 rxa[8], rxb[8], rza[8], rzb[8];
#pragma unroll
        for (int k = 0; k < 8; ++k) { const int t = tid + 512 * k; rxa[k] = TB[xoff + 4096 + t]; rxb[k] = TB[xoff + 8192 + t];
            if (ord == 1) { rza[k] = TB[zoff + 4096 + t]; rzb[k] = TB[zoff + 8192 + t]; } else { rza[k] = 0; rzb[k] = 0; } }
        fft_first8<4>(DB, TW[tid], 8192, tid, (f32x2){va[0], vb[0]}, (f32x2){va[2], vb[2]}, (f32x2){va[4], vb[4]}, (f32x2){va[6], vb[6]});
        fft_first8<4>(DB, TW[tid + 512], 8192, tid + 512, (f32x2){va[1], vb[1]}, (f32x2){va[3], vb[3]}, (f32x2){va[5], vb[5]}, (f32x2){va[7], vb[7]});
        LDSBAR();
        fft_group2<3, false, 4>(DB, TW, 1024, 8, tid, tid + 512); LDSBAR();
        fft_group2<3, false, 4>(DB, TW, 128, 64, tid, tid + 512); LDSBAR();
        fft_mid<4, 4, 13>(DB, HB, ord, tid); LDSBAR();
        fft_group2<3, true, 4>(DB, TW, 128, 64, tid, tid + 512); LDSBAR();
        fft_group2<3, true, 4>(DB, TW, 1024, 8, tid, tid + 512); LDSBAR();
        f32x2 y[8];
        fft_last8<4>(DB, TW[tid], 8192, tid, y[0], y[2], y[4], y[6]);
        fft_last8<4>(DB, TW[tid + 512], 8192, tid + 512, y[1], y[3], y[5], y[7]);
#pragma unroll
        for (int k = 0; k < 8; ++k) { const int t = tid + 512 * k;
            va[k] = bf2f(rxa[k]) * (y[k][0] + bias * va[k]); vb[k] = bf2f(rxb[k]) * (y[k][1] + bias * vb[k]);
            if (ord == 1) { YT[(size_t)c * NROWS + 4096 + t] = f2bf(va[k] * bf2f(rza[k])); YT[(size_t)c * NROWS + 8192 + t] = f2bf(vb[k] * bf2f(rzb[k])); } }
    }
    volatile LAS int* slot = (volatile LAS int*)(F.lds + 163840 - 128);
    if (tid_o == 0) *slot = nxt_raw;
    LDSBAR();
    return *slot;
}
DI void hyena_ctx_item(const Ctx& F, const float* const* in, int c, int p0) {
    LAS f32x2* HZ = (LAS f32x2*)F.lds + F.wave * 1152;
    LAS f32x2* D = HZ + 576;
    const LAS f32x2* TW = (const LAS f32x2*)(F.lds + LDS_TW);
    const bf16* TB = (const bf16*)(F.ws + WS_TB); bf16* YT = (bf16*)(F.ws + WS_YT);
    const float* HF = (const float*)(F.ws + WS_HF256); const float* HN = (const float*)(F.ws + WS_HNRM);
    const int lane = F.lane;
    { const float n0 = HN[c], n1 = HN[2048 + c]; const float* h0 = HF + (size_t)c * 512; const float* h1 = HF + ((size_t)2048 + c) * 512;
#pragma unroll
      for (int k = 0; k < 8; ++k) { const int t = lane + 64 * k; HZ[PD3(t)] = (f32x2){h0[t] * n0, h1[t] * n1}; } }
    WSYNC();
    fft512<false>(HZ, TW, lane);
#pragma unroll 1
    for (int pp = p0; pp < p0 + 4; ++pp) { const int ra = (2 * pp) * 256, rb = (2 * pp + 1) * 256;
    float va[4], vb[4];
#pragma unroll
    for (int k = 0; k < 4; ++k) { const int t = lane + 64 * k; va[k] = bf2f(TB[(size_t)c * NROWS + ra + t]); vb[k] = bf2f(TB[(size_t)c * NROWS + rb + t]); }
#pragma unroll 1
    for (int ord = 0; ord < 2; ++ord) {
        const size_t xoff = (size_t)((ord + 1) * 2048 + c) * NROWS, zoff = (size_t)(6144 + c) * NROWS;
        const float bias = in[30][ord * 2048 + c];
        bf16 rxa[4], rxb[4], rza[4], rzb[4];
#pragma unroll
        for (int k = 0; k < 4; ++k) { const int t = lane + 64 * k; rxa[k] = TB[xoff + ra + t]; rxb[k] = TB[xoff + rb + t];
            if (ord == 1) { rza[k] = TB[zoff + ra + t]; rzb[k] = TB[zoff + rb + t]; } else { rza[k] = 0; rzb[k] = 0; } }
        fft_first8<3>(D, TW[lane * 16], 512, lane, (f32x2){va[0], vb[0]}, (f32x2){va[1], vb[1]}, (f32x2){va[2], vb[2]}, (f32x2){va[3], vb[3]}); WSYNC();
        fft_group<3, false, 3>(D, TW, 64, 128, lane); WSYNC();
        fft_mid<3, 3, 9>(D, HZ, ord, lane); WSYNC();
        fft_group<3, true, 3>(D, TW, 64, 128, lane); WSYNC();
        f32x2 y[4];
        fft_last8<3>(D, TW[lane * 16], 512, lane, y[0], y[1], y[2], y[3]);
#pragma unroll
        for (int k = 0; k < 4; ++k) { const int t = lane + 64 * k;
            va[k] = bf2f(rxa[k]) * (y[k][0] + bias * va[k]); vb[k] = bf2f(rxb[k]) * (y[k][1] + bias * vb[k]);
            if (ord == 1) { YT[(size_t)c * NROWS + ra + t] = f2bf(va[k] * bf2f(rza[k])); YT[(size_t)c * NROWS + rb + t] = f2bf(vb[k] * bf2f(rzb[k])); } }
        WSYNC();
    }
    }
}
DI void phase_m1a(const Ctx& F, const float* const* in) {
    { M1aRaw R; int it = F.bid; if (it < 192 * 32) m1a_load(F, it, R);
#pragma unroll 1
      for (; it < 192 * 32; it += F.G) m1a_item(F, in, it, R, it + F.G < 192 * 32 ? it + F.G : -1); }
    gla_prep_all(F, in);
}
DI void phase_m1b(const Ctx& F, const float* const* in, int pass = 0) {
    const int b = F.bid; unsigned* ctl = (unsigned*)(F.ws + WS_CTL) + pass * 1024;
    fft_table_init(F);
#ifndef P11_ONLY
#define P11_ONLY 0
#endif
    const int only = pass ? P11_ONLY : 0;
    if (b < 64 && (only == 0 || only == 1)) gla_scan_item(F, in, 16 + (b >> 5), (b >> 1) & 15, b & 1);
    if (only == 0 || only == 2) { int it = queue_grab(F, ctl + CW_Q0, 1);
#pragma unroll 1
        while (it < 2048) it = hyena_dec_item(F, in, it, ctl + CW_Q0); }
    if (only == 0 || only == 3) for (;;) { const int it = queue_grab(F, ctl + CW_Q1, 1); if (it >= 512) break; gla_scan_item(F, in, it >> 5, (it >> 1) & 15, it & 1); }
    if (only == 0 || only == 4) for (;;) { const int g = queue_grab(F, ctl + CW_Q2, 1); if (g >= 512) break;
        hyena_ctx_item(F, in, (g >> 1) * 8 + F.wave, (g & 1) * 4); }
}
DI void phase_m1c(const Ctx& F, const float* const* in) {
    const int gw = F.bid * 8 + F.wave, NGW = F.G * 8, lane = F.lane;
    const bf16* U = (const bf16*)(F.ws + WS_U); bf16* MIX = (bf16*)(F.ws + WS_MIX);
    const bf16 *OFA = (const bf16*)(F.ws + WS_OFA), *OBA = (const bf16*)(F.ws + WS_OBA);
    const int hsub = lane >> 4, c8 = (lane & 15) * 8;
    const f32x4 gn0 = *(const f32x4*)(in[32] + c8), gn1 = *(const f32x4*)(in[32] + c8 + 4);
    for (int row = gw; row < NROWS; row += NGW) { const bf16* ur = U + (size_t)row * IN_ODD;
        u32x4 af[4], ab[4], az[4];
#pragma unroll
        for (int hq = 0; hq < 4; ++hq) { const size_t o = (size_t)row * 2048 + (hq * 4 + hsub) * 128 + c8;
            af[hq] = *(const u32x4*)(OFA + o); ab[hq] = *(const u32x4*)(OBA + o); az[hq] = *(const u32x4*)(ur + O_ZD + (hq * 4 + hsub) * 128 + c8); }
#pragma unroll
        for (int hq = 0; hq < 4; ++hq) { float x[8], y[8], z[8]; unpack8(af[hq], x); unpack8(ab[hq], y); unpack8(az[hq], z);
            float ss = 0.f;
#pragma unroll
            for (int e = 0; e < 8; ++e) { x[e] += y[e]; ss += x[e] * x[e]; }
            ss += __shfl_xor(ss, 1); ss += __shfl_xor(ss, 2); ss += __shfl_xor(ss, 4); ss += __shfl_xor(ss, 8);
            const float rn = __builtin_amdgcn_rsqf(ss * (1.0f / 128.0f) + EPS);
            u32x4 w; w.x = pk2(x[0] * rn * gn0[0] * siluf_(z[0]), x[1] * rn * gn0[1] * siluf_(z[1])); w.y = pk2(x[2] * rn * gn0[2] * siluf_(z[2]), x[3] * rn * gn0[3] * siluf_(z[3]));
            w.z = pk2(x[4] * rn * gn1[0] * siluf_(z[4]), x[5] * rn * gn1[1] * siluf_(z[5])); w.w = pk2(x[6] * rn * gn1[2] * siluf_(z[6]), x[7] * rn * gn1[3] * siluf_(z[7]));
            *(u32x4*)(MIX + (size_t)row * DM + 2048 + (hq * 4 + hsub) * 128 + c8) = w; } }
    const bf16* YT = (const bf16*)(F.ws + WS_YT);
    LAS bf16* T = (LAS bf16*)(F.lds + F.wave * 8448);
    for (int it = gw; it < 32 * 192; it += NGW) { const int cb = it & 31, rbk = it >> 5, c0 = cb * 64, r0 = rbk * 64;
#pragma unroll
        for (int k = 0; k < 8; ++k) { const int ch = 8 * k + (lane >> 3); const u32x4 w = *(const u32x4*)(YT + (size_t)(c0 + ch) * NROWS + r0 + (lane & 7) * 8);
            LAS bf16* dp = T + ch * 66 + (lane & 7) * 8;
            dp[0] = (bf16)(w.x & 0xffffu); dp[1] = (bf16)(w.x >> 16); dp[2] = (bf16)(w.y & 0xffffu); dp[3] = (bf16)(w.y >> 16); dp[4] = (bf16)(w.z & 0xffffu); dp[5] = (bf16)(w.z >> 16); dp[6] = (bf16)(w.w & 0xffffu); dp[7] = (bf16)(w.w >> 16); }
        asm volatile("s_waitcnt lgkmcnt(0)" ::: "memory");
#pragma unroll
        for (int k = 0; k < 8; ++k) { const int rr = 8 * k + (lane >> 3), cc = (lane & 7) * 8;
            u32x4 w; w.x = (unsigned)T[(cc + 0) * 66 + rr] | ((unsigned)T[(cc + 1) * 66 + rr] << 16); w.y = (unsigned)T[(cc + 2) * 66 + rr] | ((unsigned)T[(cc + 3) * 66 + rr] << 16);
            w.z = (unsigned)T[(cc + 4) * 66 + rr] | ((unsigned)T[(cc + 5) * 66 + rr] << 16); w.w = (unsigned)T[(cc + 6) * 66 + rr] | ((unsigned)T[(cc + 7) * 66 + rr] << 16);
            *(u32x4*)(MIX + (size_t)(r0 + rr) * DM + c0 + cc) = w; }
        asm volatile("s_waitcnt lgkmcnt(0)" ::: "memory"); }
}
constexpr int NWAVES = 8, NTHREADS = 512;
constexpr int LDS_BYTES = 163840;
constexpr int LDS_MISC = LDS_BYTES - 64;
constexpr int N_PHASES = 14;
struct Args { const float* in[33]; float* out; unsigned char* ws; int ph_lo, ph_hi; };

__global__ void __launch_bounds__(NTHREADS, 2) mk_fwd(Args args) {
    extern __shared__ __attribute__((aligned(16))) unsigned char lds_raw[];
    Ctx F;
    F.lds = (LAS unsigned char*)lds_raw; F.in = nullptr; F.ws = args.ws; F.out = args.out;
    F.tid = threadIdx.x; F.lane = F.tid & 63; F.wave = __builtin_amdgcn_readfirstlane(F.tid >> 6); F.bid = blockIdx.x; F.G = gridDim.x;
    const float* const* in = args.in;
    volatile LAS unsigned* xbw = (volatile LAS unsigned*)(F.lds + LDS_MISC);
    if (F.tid < 4) xbw[F.tid] = 0u;
    __syncthreads();
    unsigned* ctl = (unsigned*)(args.ws + WS_CTL);
    XcdBarrier bar = xcd_barrier_post(ctl + CW_BAR, xbw);
    const int lo = args.ph_lo, hi = args.ph_hi;
#ifndef PHASE_MASK
#define PHASE_MASK 0xffffffffu
#endif
#define IN(k) (((PHASE_MASK >> (k)) & 1u) && lo <= (k) && (k) < hi)
#define SEAM(k) do { if (IN(k) && IN((k) + 1)) xcd_barrier(bar); } while (0)
#ifndef DUP_MASK
#define DUP_MASK 0u
#endif
#define DUP(k) (((DUP_MASK >> (k)) & 1u) != 0u)
    if (IN(0)) { phase_p0(F, in); if (DUP(0)) { xcd_barrier(bar); phase_p0(F, in); } }
    SEAM(0);
    if (IN(1)) { phase_p0c(F, in); if (DUP(1)) { xcd_barrier(bar); phase_p0c(F, in); } }
    SEAM(1);
    if (IN(2)) { phase_norm<0>(F, in); if (DUP(2)) { xcd_barrier(bar); phase_norm<0>(F, in); } }
    SEAM(2);
    if (IN(3)) { pg8::Gemm g{(const pg8::bf16_t*)(F.ws + WS_H), (const pg8::bf16_t*)(F.ws + WS_WTE), NROWS, LD_EVEN, DM}; pg8::StaticOrder S; S.init(NROWS, LD_EVEN, F.G, F.bid);
        pg8::EpiStoreBf16 E{(pg8::bf16_t*)(F.ws + WS_U), LD_EVEN};
        pg8::gemm_phase<pg8::EpiStoreBf16, pg8::StaticOrder, true, true>(F.lds, g, S, E);
        if (DUP(3)) { xcd_barrier(bar); pg8::gemm_phase<pg8::EpiStoreBf16, pg8::StaticOrder, true, true>(F.lds, g, S, E); }
        { constexpr int NU = (NROWS / 256) * (LD_EVEN / 256); const int nfull = NU % F.G;
          if (nfull > 0 && F.bid >= nfull) { convert_wout(F, in, F.bid - nfull, F.G - nfull, 0); convert_wodd(F, in, F.bid - nfull, F.G - nfull); } else if (nfull == 0) { convert_wout(F, in, F.bid, F.G, 0); convert_wodd(F, in, F.bid, F.G); } } }
    SEAM(3);
    if (IN(4)) { phase_m0a(F, in); if (DUP(4)) { xcd_barrier(bar); phase_m0a(F, in); } }
    SEAM(4);
#ifndef P5_ONLY
#define P5_ONLY 0
#endif
    if (IN(5)) { phase_m0(F, in); if (DUP(5)) { xcd_barrier(bar); phase_m0(F, in, P5_ONLY); } }
    SEAM(5);
    if (IN(6)) { phase_m0c(F, in); if (DUP(6)) { xcd_barrier(bar); phase_m0c(F, in); } }
    SEAM(6);
    if (IN(7)) { pg8::Gemm g{(const pg8::bf16_t*)(F.ws + WS_MIX), (const pg8::bf16_t*)(F.ws + WS_WTOUT), NROWS, DM, DM}; pg8::StaticOrder S; S.init(NROWS, DM, F.G, F.bid);
        pg8::EpiResGateBf16 E{(pg8::bf16_t*)xr_base(F), LDX, (const float*)(F.ws + WS_MODF) + (size_t)6 * 4096};
        pg8::gemm_phase<pg8::EpiResGateBf16, pg8::StaticOrder, true, true>(F.lds, g, S, E); }
    SEAM(7);
    if (IN(8)) { phase_norm<1>(F, in); if (DUP(8)) { xcd_barrier(bar); phase_norm<1>(F, in); } }
    SEAM(8);
    if (IN(9)) { pg8::Gemm g{(const pg8::bf16_t*)(F.ws + WS_H), (const pg8::bf16_t*)(F.ws + WS_WTO), NROWS, IN_ODD, DM}; pg8::StaticOrder S; S.init(NROWS, IN_ODD, F.G, F.bid);
        pg8::EpiStoreBf16 E{(pg8::bf16_t*)(F.ws + WS_U), IN_ODD};
        pg8::gemm_phase<pg8::EpiStoreBf16, pg8::StaticOrder, true, true>(F.lds, g, S, E);
        if (DUP(9)) { xcd_barrier(bar); pg8::gemm_phase<pg8::EpiStoreBf16, pg8::StaticOrder, true, true>(F.lds, g, S, E); }
        { constexpr int NU = (NROWS / 256) * (IN_ODD / 256); const int nfull = NU % F.G;
          if (nfull > 0 && F.bid >= nfull) { phase_filters(F, in, F.bid - nfull, F.G - nfull); convert_wout(F, in, F.bid - nfull, F.G - nfull, 1); } else if (nfull == 0) { phase_filters(F, in, F.bid, F.G); convert_wout(F, in, F.bid, F.G, 1); } } }
    SEAM(9);
    if (IN(10)) { phase_m1a(F, in); if (DUP(10)) { xcd_barrier(bar); phase_m1a(F, in); } }
    SEAM(10);
    if (IN(11)) { phase_m1b(F, in); if (DUP(11)) { xcd_barrier(bar); phase_m1b(F, in, 1); } }
    SEAM(11);
    if (IN(12)) { phase_m1c(F, in); if (DUP(12)) { xcd_barrier(bar); phase_m1c(F, in); } }
    SEAM(12);
    if (IN(13)) { pg8::Gemm g{(const pg8::bf16_t*)(F.ws + WS_MIX), (const pg8::bf16_t*)(F.ws + WS_WTOUT) + (size_t)DM * DM, NROWS, DM, DM}; pg8::StaticOrder S; S.init(NROWS, DM, F.G, F.bid);
        pg8::EpiResGateBf16 E{(pg8::bf16_t*)xr_base(F), LDX, (const float*)(F.ws + WS_MODF) + (size_t)(9 + 6) * 4096};
        pg8::gemm_phase<pg8::EpiResGateBf16, pg8::StaticOrder, true, true>(F.lds, g, S, E); }
    SEAM(13);
    if (IN(14)) phase_norm<2>(F, in);
#ifdef DBG_DUMP
    xcd_barrier(bar);
#define DUMP_ONE(OOFF, ONEXT, PTR, NB, ISBF) do { const size_t no = (size_t)(ONEXT) - (size_t)(OOFF), nb = (NB); float* op = F.out + (OOFF); \
        for (size_t i = (size_t)F.bid * 512 + F.tid; i < no; i += (size_t)F.G * 512) { float acc = 0.f; \
            for (size_t j = i; j < nb; j += no) acc += (ISBF) ? bf2f(((const bf16*)(PTR))[j]) : ((const float*)(PTR))[j]; \
            op[i] = acc; } } while (0)
#if DBG_DUMP == 1
    DUMP_ONE(0, 16777216, F.ws + WS_H, (size_t)NROWS * DM, 1);
    DUMP_ONE(16777216, 50331648, F.ws + WS_U, (size_t)NROWS * LD_EVEN, 1);
    DUMP_ONE(50331648, 58720256, F.ws + WS_OFA, (size_t)2 * NROWS * 2048, 0);
    DUMP_ONE(58720256, 67108864, F.ws + WS_OFB, (size_t)2 * NROWS * 2048, 0);
    DUMP_ONE(67108864, 75497472, F.ws + WS_MIX, (size_t)NROWS * DM, 1);
#elif DBG_DUMP == 4
    DUMP_ONE(0, 16777216, F.ws + WS_OFA, (size_t)NROWS * 2048, 0);
    DUMP_ONE(16777216, 50331648, F.ws + WS_OBA, (size_t)NROWS * 2048, 0);
    DUMP_ONE(58720256, 67108864, F.ws + WS_H, (size_t)NROWS * DM, 1);
    DUMP_ONE(67108864, 75497472, F.ws + WS_H, (size_t)NROWS * DM, 1);
#elif DBG_DUMP == 7
    { unsigned fl = 0u; const float* pa = (const float*)(F.ws + WS_OFA); const float* pb = (const float*)(F.ws + WS_OBA); const float* ps = F.out + OUT_SG;
      for (size_t i = (size_t)F.bid * 512 + F.tid; i < (size_t)NROWS * 2048; i += (size_t)F.G * 512) { const size_t row = i >> 11; const float va = pa[i], vb = pb[i];
          if (!(fabsf(va) <= 3.0e38f)) { fl |= row < 4096 ? 1u : 2u; if (row >= 4096 && ((row - 4096) & 4095) < 64) fl |= 32u; }
          if (!(fabsf(vb) <= 3.0e38f)) fl |= row < 4096 ? 4u : 8u; }
      for (size_t i = (size_t)F.bid * 512 + F.tid; i < (size_t)8388608; i += (size_t)F.G * 512) { const float v = ps[i]; if (!(fabsf(v) <= 3.0e38f)) fl |= 16u; }
      if (fl) atomicOr(ctl + 64, fl); }
    xcd_barrier(bar);
    { const unsigned fl = __hip_atomic_load(ctl + 64, __ATOMIC_RELAXED, __HIP_MEMORY_SCOPE_AGENT);
      const unsigned d1 = 1u + (fl & 1u) + ((fl >> 1) & 1u) * 2u + ((fl >> 2) & 1u) * 4u, d2 = 1u + ((fl >> 3) & 1u) + ((fl >> 4) & 1u) * 2u + ((fl >> 5) & 1u) * 4u;
      const unsigned total = d1 * 1000000u + d2 * 100000u;
      for (size_t i = (size_t)F.bid * 512 + F.tid; i < (size_t)75497472; i += (size_t)F.G * 512) F.out[i] = (i < total) ? __uint_as_float(0xAAAAAAAAu) : 1.0f; }
#elif DBG_DUMP == 6
    { unsigned cnt = 0u; const float* pa = (const float*)(F.ws + WS_OFA); const float* ps = F.out + OUT_SG;
      for (size_t i = (size_t)F.bid * 512 + F.tid; i < (size_t)2 * NROWS * 2048; i += (size_t)F.G * 512) { const float v = pa[i]; if (!(fabsf(v) <= 3.0e38f)) ++cnt; }
      for (size_t i = (size_t)F.bid * 512 + F.tid; i < (size_t)8388608; i += (size_t)F.G * 512) { const float v = ps[i]; if (!(fabsf(v) <= 3.0e38f)) ++cnt; }
      if (cnt) atomicAdd(ctl + 64, cnt); }
    xcd_barrier(bar);
    { const unsigned total = __hip_atomic_load(ctl + 64, __ATOMIC_RELAXED, __HIP_MEMORY_SCOPE_AGENT);
      const float* pa = (const float*)(F.ws + WS_OFA);
      for (size_t i = (size_t)F.bid * 512 + F.tid; i < (size_t)75497472; i += (size_t)F.G * 512) {
          float v = 1.0f;
          if (i < 16777216) { if (i < total) v = __uint_as_float(0xAAAAAAAAu); }
          else if (i < 50331648) { const size_t k = i - 16777216; float a = pa[k]; if (!(fabsf(a) <= 3.0e38f)) a = 7.0f; v = a; }
          F.out[i] = v; } }
#elif DBG_DUMP == 5
    DUMP_ONE(0, 16777216, F.ws + WS_OFB, (size_t)NROWS * 2048, 0);
    DUMP_ONE(16777216, 50331648, F.ws + WS_OBB, (size_t)NROWS * 2048, 0);
    DUMP_ONE(50331648, 58720256, F.ws + WS_H, (size_t)NROWS * DM, 1);
    DUMP_ONE(67108864, 75497472, F.ws + WS_H, (size_t)NROWS * DM, 1);
#elif DBG_DUMP == 3
    DUMP_ONE(0, 16777216, F.ws + WS_H, (size_t)NROWS * DM, 1);
    DUMP_ONE(16777216, 50331648, F.ws + WS_U, (size_t)NROWS * LD_EVEN, 1);
    DUMP_ONE(50331648, 58720256, F.ws + WS_WTE, (size_t)LD_EVEN * DM, 1);
    DUMP_ONE(58720256, 67108864, F.ws + WS_MODF, (size_t)(1 * MiB + 512 * 1024) / 4, 0);
    DUMP_ONE(67108864, 75497472, F.ws + WS_HF256, (size_t)2 * 2048 * 512, 0);
#else
    DUMP_ONE(0, 16777216, F.ws + WS_H, (size_t)NROWS * DM, 1);
    DUMP_ONE(16777216, 50331648, F.ws + WS_U, (size_t)NROWS * IN_ODD, 1);
    DUMP_ONE(50331648, 58720256, F.ws + WS_TB, (size_t)8192 * NROWS, 1);
    DUMP_ONE(58720256, 67108864, F.ws + WS_OFA, (size_t)2 * NROWS * 2048, 0);
    DUMP_ONE(67108864, 75497472, F.ws + WS_YT, (size_t)2048 * NROWS, 1);
#endif
#endif
#undef IN
#undef SEAM
}

extern "C" void kernel_launch(void* const* d_in, const int* in_sizes, int n_in, void* d_out, int out_size, void* d_ws, size_t ws_size, hipStream_t stream) {
    static int grid = 0;
    if (grid == 0) {
        if (n_in != 33 || out_size != 75497472 || ws_size < WS_END2) { fprintf(stderr, "kernel_launch: unexpected problem (n_in %d, out %d, ws %zu)\n", n_in, out_size, ws_size); grid = -1; return; }
        int dev = 0, cus = 0, per_cu = 0;
        if (hipGetDevice(&dev) != hipSuccess || hipDeviceGetAttribute(&cus, hipDeviceAttributeMultiprocessorCount, dev) != hipSuccess) { grid = -1; return; }
        if (hipFuncSetAttribute((const void*)mk_fwd, hipFuncAttributeMaxDynamicSharedMemorySize, LDS_BYTES) != hipSuccess) { fprintf(stderr, "kernel_launch: hipFuncSetAttribute failed\n"); grid = -1; return; }
        if (hipOccupancyMaxActiveBlocksPerMultiprocessor(&per_cu, (const void*)mk_fwd, NTHREADS, LDS_BYTES) != hipSuccess || per_cu < 1) { fprintf(stderr, "kernel_launch: occupancy query says %d\n", per_cu); }
        (void)hipGetLastError();
        grid = cus;
        if (grid < 128) { grid = -1; return; }
    }
    if (grid < 0) return;
    (void)hipMemsetAsync((char*)d_ws + WS_CTL, 0, CTL_ZERO_BYTES, stream);
    Args a{};
    for (int i = 0; i < 33; ++i) a.in[i] = (const float*)d_in[i];
    a.out = (float*)d_out; a.ws = (unsigned char*)d_ws;
#ifndef MK_SPLIT
    a.ph_lo = 0; a.ph_hi = N_PHASES + 1;
#ifdef DBG_STOP
    a.ph_hi = DBG_STOP + 1;
#endif
    hipLaunchKernelGGL(mk_fwd, dim3(grid), dim3(NTHREADS), LDS_BYTES, stream, a);
#else
    for (int p = 0; p <= N_PHASES; ++p) { a.ph_lo = p; a.ph_hi = p + 1; hipLaunchKernelGGL(mk_fwd, dim3(grid), dim3(NTHREADS), LDS_BYTES, stream, a); }
#endif
}
```

```cpp
#include <hip/hip_runtime.h>
#include <cstdio>
#include <cstdint>
namespace pg8 {
#define PG8_LAS __attribute__((address_space(3)))
typedef unsigned short bf16_t;
typedef short bf16x8 __attribute__((ext_vector_type(8)));
typedef float f32x4 __attribute__((ext_vector_type(4)));
typedef unsigned u32x4 __attribute__((ext_vector_type(4)));
constexpr int BM = 256, BK = 64, HALF = 128, HTB = HALF * BK * 2  , STAGE_BYTES = 8 * HTB, NXCD = 8, WGM = 8;

__host__ __device__ __forceinline__ int lds_byte(int r, int c) { const int st = (r >> 4) * 2 + (c >> 5), rr = r & 15, cc = c & 31, ob = rr * 64 + cc * 2; return st * 1024 + (ob ^ (((ob >> 9) & 1) << 5)); }
__host__ __device__ __forceinline__ void stage_rc(int b, int& R, int& C) { const int st = b / 1024, sb = b % 1024, swz = sb ^ (((sb >> 9) & 1) << 5); R = (st >> 1) * 16 + swz / 64; C = (st & 1) * 32 + (swz % 64) / 2; }
__host__ __device__ __forceinline__ int perm32(int rho) { const int n = rho >> 4, i = rho & 15; return 8 * (i >> 2) + 4 * n + (i & 3); }

struct Unit { int pm, pn; };
struct Gemm { const bf16_t* A; const bf16_t* Bt; int M, N, K; };

struct StaticOrder {
    int nM, nN, nwg, G, c;
    __host__ __device__ void init(int M, int N, int G_, int c_) { nM = M / BM; nN = N / BM; nwg = nM * nN; G = G_; c = c_; }
    __host__ __device__ bool next(int i, Unit& u) const {
        const long L = (long)i * G + c; if (L >= nwg) return false;
        int wgid = (int)L; { const int q = nwg / NXCD, r = nwg % NXCD, xcd = wgid % NXCD, off = wgid / NXCD; wgid = (xcd < r ? xcd * (q + 1) : r * (q + 1) + (xcd - r) * q) + off; }
        const int nig = WGM * nN, gid = wgid / nig, fm = gid * WGM, gsz = (nM - fm) < WGM ? (nM - fm) : WGM;
        u.pm = fm + ((wgid % nig) % gsz); u.pn = (wgid % nig) / gsz; return true;
    }
    __device__ __forceinline__ void a_ready(const Unit&) const {}
    __device__ __forceinline__ void done(const Unit&) const {}
};
__device__ __forceinline__ unsigned cvt_pk_bf16(float lo, float hi) { unsigned r; asm volatile("v_cvt_pk_bf16_f32 %0, %1, %2" : "=v"(r) : "v"(lo), "v"(hi)); return r; }
typedef __bf16 bf16x2v __attribute__((ext_vector_type(2)));
typedef float f32x2v_ __attribute__((ext_vector_type(2)));
__device__ __forceinline__ unsigned pk_bf16(float lo, float hi) { f32x2v_ v = {lo, hi}; return __builtin_bit_cast(unsigned, __builtin_convertvector(v, bf16x2v)); }
struct EpiStoreBf16 {
    static constexpr bool PERM = true, AFTER_DRAIN = false;
    bf16_t* O; int ldc;
    __device__ __forceinline__ void operator()(const f32x4 (&acc)[2][2][4][2], const Unit& u, int wr, int wc, int fr, int fq) const {
        const int row0 = u.pm * BM + wr * 64 + fr, col0 = u.pn * BM + wc * 32 + 8 * fq;
#pragma unroll
        for (int ai = 0; ai < 2; ++ai)
#pragma unroll
            for (int m = 0; m < 4; ++m) { bf16_t* rowp = O + (size_t)(row0 + ai * HALF + m * 16) * ldc + col0;
#pragma unroll
                for (int bj = 0; bj < 2; ++bj) { const f32x4 v0 = acc[ai][bj][m][0], v1 = acc[ai][bj][m][1];
                    u32x4 w; w.x = pk_bf16(v0[0], v0[1]); w.y = pk_bf16(v0[2], v0[3]); w.z = pk_bf16(v1[0], v1[1]); w.w = pk_bf16(v1[2], v1[3]);
                    *(u32x4*)(rowp + bj * HALF) = w; } }
    }
};
struct EpiResGate {
    static constexpr bool PERM = false, AFTER_DRAIN = false;
    float* io; int ldc; const float* gate;
    __device__ __forceinline__ void operator()(const f32x4 (&acc)[2][2][4][2], const Unit& u, int wr, int wc, int fr, int fq) const {
        const int row0 = u.pm * BM + wr * 64 + fr, col0 = u.pn * BM + wc * 32 + 4 * fq;
        const int rb = u.pm * BM; const int r = rb < 4096 ? 0 : 1 + ((rb - 4096) >> 12);
        const float* g = gate + r * 4096 + col0;
        f32x4 gv[2][2];
#pragma unroll
        for (int bj = 0; bj < 2; ++bj)
#pragma unroll
            for (int n = 0; n < 2; ++n) gv[bj][n] = *(const f32x4*)(g + bj * HALF + n * 16);
#pragma unroll
        for (int ai = 0; ai < 2; ++ai)
#pragma unroll
            for (int m = 0; m < 4; ++m) { float* rowp = io + (size_t)(row0 + ai * HALF + m * 16) * ldc + col0;
#pragma unroll
                for (int bj = 0; bj < 2; ++bj)
#pragma unroll
                    for (int n = 0; n < 2; ++n) { f32x4* p = (f32x4*)(rowp + bj * HALF + n * 16); const f32x4 b = *p; *p = b + gv[bj][n] * acc[ai][bj][m][n]; }
                if (m == 3) asm volatile("" ::: "memory"); }
    }
};

struct EpiResGateBf16 {
    static constexpr bool PERM = true, AFTER_DRAIN = false;
    bf16_t* io; int ldc; const float* gate;
    __device__ __forceinline__ void operator()(const f32x4 (&acc)[2][2][4][2], const Unit& u, int wr, int wc, int fr, int fq) const {
        const int row0 = u.pm * BM + wr * 64 + fr, col0 = u.pn * BM + wc * 32 + 8 * fq;
        const int rb = u.pm * BM; const int r = rb < 4096 ? 0 : 1 + ((rb - 4096) >> 12);
        const float* g = gate + r * 4096 + col0;
        f32x4 gv[2][2];
#pragma unroll
        for (int bj = 0; bj < 2; ++bj)
#pragma unroll
            for (int n = 0; n < 2; ++n) gv[bj][n] = *(const f32x4*)(g + bj * HALF + 4 * n);
#pragma unroll
        for (int ai = 0; ai < 2; ++ai)
#pragma unroll
            for (int m = 0; m < 4; ++m) { bf16_t* rowp = io + (size_t)(row0 + ai * HALF + m * 16) * ldc + col0;
#pragma unroll
                for (int bj = 0; bj < 2; ++bj) { u32x4* p = (u32x4*)(rowp + bj * HALF); const u32x4 b = *p;
                    const f32x4 a0 = acc[ai][bj][m][0] * gv[bj][0], a1 = acc[ai][bj][m][1] * gv[bj][1];
                    u32x4 w;
                    w.x = pk_bf16(__uint_as_float(b.x << 16) + a0[0], __uint_as_float(b.x & 0xffff0000u) + a0[1]); w.y = pk_bf16(__uint_as_float(b.y << 16) + a0[2], __uint_as_float(b.y & 0xffff0000u) + a0[3]);
                    w.z = pk_bf16(__uint_as_float(b.z << 16) + a1[0], __uint_as_float(b.z & 0xffff0000u) + a1[1]); w.w = pk_bf16(__uint_as_float(b.w << 16) + a1[2], __uint_as_float(b.w & 0xffff0000u) + a1[3]);
                    *p = w; }
                if (m == 3) asm volatile("" ::: "memory"); }
    }
};
template <class Epi, class Sched, bool ALIGN_EPI = false, bool SP2 = false>
__device__ __forceinline__ void gemm_phase(PG8_LAS unsigned char* lds, const Gemm g, const Sched& S, const Epi& E) {
    const int tid = threadIdx.x, wid = __builtin_amdgcn_readfirstlane(tid >> 6), lane = tid & 63, wr = wid >> 2, wc = wid & 3, fr = lane & 15, fq = lane >> 4;
    const int K = g.K, nt = K / BK;
    unsigned voffA[2], voffB[2];
#pragma unroll
    for (int i = 0; i < 2; ++i) { int R, C; stage_rc(tid * 16 + i * 8192, R, C); const int Rb = Epi::PERM ? ((R & ~31) + perm32(R & 31)) : R;
        voffA[i] = (unsigned)(R * K + C) * 2u; voffB[i] = (unsigned)(Rb * K + C) * 2u; }
    const size_t kstep = (size_t)(BK * 2);
    const size_t hstep = (size_t)HALF * K * 2;
    const size_t tstep = 2 * hstep;
    const unsigned ldsw = (unsigned)wid * 1024u;
    const int aoff = lds_byte(wr * 64 + fr, fq * 8), boff = lds_byte(wc * 32 + fr, fq * 8);
#define PG8_SA(b, h) (((b) * 2 + (h)) * HTB)
#define PG8_SB(b, h) ((4 + (b) * 2 + (h)) * HTB)
#define PG8_STAGE(bufoff, gbase, voff) do { _Pragma("unroll") for (int _i = 0; _i < 2; ++_i) \
        __builtin_amdgcn_global_load_lds((const unsigned*)((const char*)(gbase) + (voff)[_i]), (PG8_LAS unsigned*)(lds + (bufoff) + ldsw + _i * 8192), 16, 0, 0); } while (0)
#define PG8_LDA(dst, b, h) do { _Pragma("unroll") for (int m = 0; m < 4; ++m) _Pragma("unroll") for (int k = 0; k < 2; ++k) dst[m][k] = *(const PG8_LAS bf16x8*)(lds + PG8_SA(b, h) + aoff + m * 2048 + k * 1024); } while (0)
#define PG8_LDB(dst, b, h) do { _Pragma("unroll") for (int n = 0; n < 2; ++n) _Pragma("unroll") for (int k = 0; k < 2; ++k) dst[n][k] = *(const PG8_LAS bf16x8*)(lds + PG8_SB(b, h) + boff + n * 2048 + k * 1024); } while (0)
#define PG8_MMA(ai, bj, At, Bt) do { __builtin_amdgcn_s_setprio(1); _Pragma("unroll") for (int m = 0; m < 4; ++m) _Pragma("unroll") for (int n = 0; n < 2; ++n) _Pragma("unroll") for (int k = 0; k < 2; ++k) \
        acc[ai][bj][m][n] = __builtin_amdgcn_mfma_f32_16x16x32_bf16(Bt[n][k], At[m][k], acc[ai][bj][m][n], 0, 0, 0); __builtin_amdgcn_s_setprio(0); } while (0)
#define PG8_WAIT_V(n) asm volatile("s_waitcnt vmcnt(" #n ")" ::: "memory")
#define PG8_WAIT_L(n) asm volatile("s_waitcnt lgkmcnt(" #n ")" ::: "memory")
#define PG8_BAR __builtin_amdgcn_s_barrier()
#define PG8_SCHED __builtin_amdgcn_sched_barrier(0)
    Unit cur, nxt; int ui = 0;
    if (!S.next(0, cur)) return;
    f32x4 acc[2][2][4][2];
#pragma unroll
    for (int a = 0; a < 2; ++a)
#pragma unroll
        for (int b = 0; b < 2; ++b)
#pragma unroll
            for (int m = 0; m < 4; ++m)
#pragma unroll
                for (int n = 0; n < 2; ++n) acc[a][b][m][n] = (f32x4){0.f, 0.f, 0.f, 0.f};
    bf16x8 At[4][2], B0[2][2], B1[2][2];
    const char* cA = (const char*)g.A + (size_t)cur.pm * tstep; const char* cB = (const char*)g.Bt + (size_t)cur.pn * tstep;
    S.a_ready(cur);
    if constexpr (SP2) {
        PG8_STAGE(PG8_SB(0, 0), cB, voffB); PG8_STAGE(PG8_SB(0, 1), cB + hstep, voffB); PG8_STAGE(PG8_SA(0, 0), cA, voffA); PG8_STAGE(PG8_SA(0, 1), cA + hstep, voffA);
        if (wr == 1) PG8_BAR;
        PG8_WAIT_V(2); PG8_BAR;
        PG8_STAGE(PG8_SB(1, 0), cB + kstep, voffB); PG8_STAGE(PG8_SA(1, 0), cA + kstep, voffA); PG8_STAGE(PG8_SB(1, 1), cB + hstep + kstep, voffB);
        PG8_WAIT_V(6); PG8_BAR;
    } else {
        PG8_STAGE(PG8_SB(0, 0), cB, voffB); PG8_STAGE(PG8_SA(0, 0), cA, voffA); PG8_STAGE(PG8_SB(0, 1), cB + hstep, voffB); PG8_STAGE(PG8_SA(0, 1), cA + hstep, voffA);
        if (wr == 1) PG8_BAR;
        PG8_WAIT_V(4); PG8_BAR;
        PG8_STAGE(PG8_SB(1, 0), cB + kstep, voffB); PG8_STAGE(PG8_SA(1, 0), cA + kstep, voffA); PG8_STAGE(PG8_SB(1, 1), cB + hstep + kstep, voffB);
        PG8_WAIT_V(6); PG8_BAR;
    }
    for (;;) {
        const bool has_next = S.next(ui + 1, nxt);
        const char* nA = has_next ? (const char*)g.A + (size_t)nxt.pm * tstep : cA; const char* nB = has_next ? (const char*)g.Bt + (size_t)nxt.pn * tstep : cB;
        for (int t = 0; t < nt; t += 2) {
            const bool last = (t == nt - 2);
            const char* a1 = cA + (size_t)(t + 1) * kstep;
            const char* a2 = last ? nA : cA + (size_t)(t + 2) * kstep; const char* b2 = last ? nB : cB + (size_t)(t + 2) * kstep;
            const char* a3 = a2 + kstep; const char* b3 = b2 + kstep;
            if (last && has_next) S.a_ready(nxt);
            if constexpr (SP2) {
            PG8_LDB(B0, 0, 0); PG8_LDB(B1, 0, 1); PG8_SCHED; PG8_LDA(At, 0, 0); PG8_STAGE(PG8_SA(1, 1), a1 + hstep, voffA);
            PG8_WAIT_V(8); PG8_WAIT_L(0); PG8_BAR; PG8_MMA(0, 0, At, B0); PG8_MMA(0, 1, At, B1); PG8_BAR; PG8_SCHED;
            PG8_LDA(At, 0, 1); PG8_STAGE(PG8_SB(0, 0), b2, voffB); PG8_STAGE(PG8_SB(0, 1), b2 + hstep, voffB); PG8_STAGE(PG8_SA(0, 0), a2, voffA);
            PG8_WAIT_V(8); PG8_WAIT_L(0); PG8_BAR; PG8_MMA(1, 0, At, B0); PG8_MMA(1, 1, At, B1); PG8_BAR; PG8_SCHED;
            PG8_LDB(B0, 1, 0); PG8_LDB(B1, 1, 1); PG8_SCHED; PG8_LDA(At, 1, 0); PG8_STAGE(PG8_SA(0, 1), a2 + hstep, voffA);
            PG8_WAIT_V(8); PG8_WAIT_L(0); PG8_BAR; PG8_MMA(0, 0, At, B0); PG8_MMA(0, 1, At, B1); PG8_BAR; PG8_SCHED;
            PG8_LDA(At, 1, 1); PG8_STAGE(PG8_SB(1, 0), b3, voffB); PG8_STAGE(PG8_SB(1, 1), b3 + hstep, voffB); PG8_STAGE(PG8_SA(1, 0), a3, voffA);
            PG8_WAIT_V(8); PG8_WAIT_L(0); PG8_BAR; PG8_MMA(1, 0, At, B0); PG8_MMA(1, 1, At, B1); PG8_BAR; PG8_SCHED;
            } else {
            PG8_LDB(B0, 0, 0); PG8_SCHED; PG8_LDA(At, 0, 0); PG8_STAGE(PG8_SA(1, 1), a1 + hstep, voffA);
            PG8_WAIT_L(8); PG8_BAR; PG8_WAIT_L(0); PG8_MMA(0, 0, At, B0); PG8_BAR; PG8_SCHED;
            PG8_LDB(B1, 0, 1); PG8_STAGE(PG8_SB(0, 0), b2, voffB);
            PG8_BAR; PG8_WAIT_L(0); PG8_MMA(0, 1, At, B1); PG8_BAR;
            PG8_LDA(At, 0, 1); PG8_STAGE(PG8_SA(0, 0), a2, voffA);
            PG8_BAR; PG8_WAIT_L(0); PG8_MMA(1, 0, At, B0); PG8_BAR; PG8_SCHED;
            PG8_STAGE(PG8_SB(0, 1), b2 + hstep, voffB);
            PG8_WAIT_V(6); PG8_BAR; PG8_MMA(1, 1, At, B1); PG8_BAR;
            PG8_LDB(B0, 1, 0); PG8_SCHED; PG8_LDA(At, 1, 0); PG8_STAGE(PG8_SA(0, 1), a2 + hstep, voffA);
            PG8_WAIT_L(8); PG8_BAR; PG8_WAIT_L(0); PG8_MMA(0, 0, At, B0); PG8_BAR; PG8_SCHED;
            PG8_LDB(B1, 1, 1); PG8_STAGE(PG8_SB(1, 0), b3, voffB);
            PG8_BAR; PG8_WAIT_L(0); PG8_MMA(0, 1, At, B1); PG8_BAR;
            PG8_LDA(At, 1, 1); PG8_STAGE(PG8_SA(1, 0), a3, voffA);
            PG8_BAR; PG8_WAIT_L(0); PG8_MMA(1, 0, At, B0); PG8_BAR; PG8_SCHED;
            PG8_STAGE(PG8_SB(1, 1), b3 + hstep, voffB);
            PG8_WAIT_V(6); PG8_BAR; PG8_MMA(1, 1, At, B1); PG8_BAR;
            }
        }
        if constexpr (ALIGN_EPI) { if (wr == 0) PG8_BAR; }
        if constexpr (!Epi::AFTER_DRAIN) { E(acc, cur, wr, wc, fr, fq); S.done(cur); }
        if (!has_next) break;
#pragma unroll
        for (int a = 0; a < 2; ++a)
#pragma unroll
            for (int b = 0; b < 2; ++b)
#pragma unroll
                for (int m = 0; m < 4; ++m)
#pragma unroll
                    for (int n = 0; n < 2; ++n) acc[a][b][m][n] = (f32x4){0.f, 0.f, 0.f, 0.f};
        cur = nxt; cA = nA; cB = nB; ++ui;
        if constexpr (ALIGN_EPI) { if (wr == 1) PG8_BAR; }
    }
    PG8_WAIT_V(0);
    if constexpr (!ALIGN_EPI) { if (wr == 0) PG8_BAR; }
    PG8_BAR;
    if constexpr (Epi::AFTER_DRAIN) { E.fused(acc, cur, wr, wc, fr, fq, lds, wid, lane); S.done(cur); }
#undef PG8_SA
#undef PG8_SB
#undef PG8_STAGE
#undef PG8_LDA
#undef PG8_LDB
#undef PG8_MMA
#undef PG8_WAIT_V
#undef PG8_WAIT_L
#undef PG8_BAR
#undef PG8_SCHED
}
}
#define XB_TMO      128
#define XB_XCNT(j)  (256  + 64 * (j))
#define XB_XSUB(j)  (1280 + 64 * (j))
#define XB_XGEN(j)  (2304 + 64 * (j))
#define XB_TOP      3328
#define XB_TOPGEN   3392
#define XCD_BAR_WORDS 3456
#define XB_SPIN_CAP (1u << 18)
#define LAS __attribute__((address_space(3)))

__device__ __forceinline__ unsigned xb_ld(unsigned* p)              { return __hip_atomic_load(p, __ATOMIC_RELAXED, __HIP_MEMORY_SCOPE_AGENT); }
__device__ __forceinline__ unsigned xb_add(unsigned* p, unsigned v) { return __hip_atomic_fetch_add(p, v, __ATOMIC_RELAXED, __HIP_MEMORY_SCOPE_AGENT); }
__device__ __forceinline__ unsigned xb_xcc_id() { return (unsigned)__builtin_amdgcn_s_getreg((3 << 11) | 20) & 0xFu; }
#define XB_SPIN(cond, bar) do { unsigned _sp = 0; while (cond) { __builtin_amdgcn_s_sleep(1); \
    if ((++_sp & 255u) == 0u) { if (xb_ld(&(bar)[XB_TMO])) break; if (_sp > XB_SPIN_CAP) { atomicAdd(&(bar)[XB_TMO], 1u); break; } } } } while (0)

struct XcdBarrier {
    unsigned* bar; unsigned x;
    volatile LAS unsigned* st;
};

__device__ __forceinline__ XcdBarrier xcd_barrier_post(unsigned* bar, volatile LAS unsigned* st) {
    XcdBarrier b; b.bar = bar; b.x = xb_xcc_id(); b.st = st;
    if (threadIdx.x == 0) (void)xb_add(&bar[XB_XCNT(b.x)], 1u);
    return b;
}
__device__ __forceinline__ void xcd_barrier_complete(unsigned* bar, unsigned x, unsigned& nloc, unsigned& nx) {
    const unsigned G = gridDim.x * gridDim.y * gridDim.z;
    unsigned sum, cnt, mine, sp = 0u;
    for (;;) {
        sum = 0u; cnt = 0u; mine = 0u;
#pragma unroll
        for (unsigned j = 0; j < 16; ++j) { const unsigned c = xb_ld(&bar[XB_XCNT(j)]); sum += c; cnt += (c > 0u) ? 1u : 0u; mine = (j == x) ? c : mine; }
        if (sum == G) break;
        __builtin_amdgcn_s_sleep(1);
        if ((++sp & 255u) == 0u) { if (xb_ld(&bar[XB_TMO])) break; if (sp > XB_SPIN_CAP) { atomicAdd(&bar[XB_TMO], 1u); break; } }
    }
    nloc = mine > 0u ? mine : 1u; nx = cnt > 0u ? cnt : 1u;
}

__device__ __forceinline__ void xcd_barrier(const XcdBarrier& b) {
    asm volatile("s_waitcnt vmcnt(0)" ::: "memory");
    __syncthreads();
    if (threadIdx.x == 0) {
        unsigned* bar = b.bar;
        __builtin_amdgcn_s_waitcnt(0);
        unsigned nloc = b.st[0], nx = b.st[1];
        if (nloc == 0u) { xcd_barrier_complete(bar, b.x, nloc, nx); b.st[0] = nloc; b.st[1] = nx; }
        const unsigned old = xb_add(&bar[XB_XSUB(b.x)], 1u);
        const unsigned gen = old / nloc;
        if (old + 1u == (gen + 1u) * nloc) {
            __builtin_amdgcn_fence(__ATOMIC_RELEASE, "agent");
            asm volatile("s_waitcnt vmcnt(0)" ::: "memory");
            const unsigned og = xb_add(&bar[XB_TOP], 1u);
            const unsigned tg = og / nx;
            if (og + 1u == (tg + 1u) * nx) xb_add(&bar[XB_TOPGEN], 1u);
            else XB_SPIN(xb_ld(&bar[XB_TOPGEN]) == tg, bar);
            __builtin_amdgcn_fence(__ATOMIC_ACQUIRE, "agent");
            xb_add(&bar[XB_XGEN(b.x)], 1u);
            asm volatile("s_waitcnt vmcnt(0)" ::: "memory");
        } else {
            XB_SPIN(xb_ld(&bar[XB_XGEN(b.x)]) == gen, bar);
            __builtin_amdgcn_fence(__ATOMIC_ACQUIRE, "agent");
            asm volatile("s_waitcnt vmcnt(0)" ::: "memory");
        }
    }
    __syncthreads();
}
#define DI __device__ __forceinline__
typedef unsigned short bf16;
typedef short bf16x8 __attribute__((ext_vector_type(8)));
typedef short bf16x4 __attribute__((ext_vector_type(4)));
typedef float f32x4 __attribute__((ext_vector_type(4)));
typedef float f32x2 __attribute__((ext_vector_type(2)));
typedef unsigned u32x4 __attribute__((ext_vector_type(4)));
typedef unsigned u32x2 __attribute__((ext_vector_type(2)));
typedef __bf16 bf16x2n __attribute__((ext_vector_type(2)));
#define MFMA16(a, b, c) __builtin_amdgcn_mfma_f32_16x16x32_bf16((a), (b), (c), 0, 0, 0)

constexpr int DM = 4096, NROWS = 12288;
constexpr int IN_EVEN = 14464, LD_EVEN = 14592, IN_ODD = 18432;
constexpr int E_QKV = 0, E_BETA = 6144, E_A = 6176, E_ZA = 6208, E_XBC = 8256, E_DT = 12352, E_ZB = 12416;
constexpr int O_VX = 0, O_ZC = 6144, O_Q = 8192, O_F = 10240, O_I = 14336, O_ZD = 16384;
constexpr float EPS = 1e-6f;
constexpr int NSEQ = 18;
DI int seq_row0(int s) { return s < 16 ? s * 256 : 4096 + (s - 16) * 4096; }
DI int seq_len(int s) { return s < 16 ? 256 : 4096; }
constexpr size_t OUT_SG = 50331648, OUT_SS = 58720256, OUT_SH = 67108864;

constexpr size_t MiB = 1u << 20;
constexpr size_t WS_CTL = 0, CTL_ZERO_BYTES = 1 * MiB;
constexpr size_t WS_MODP = 1 * MiB;
constexpr size_t WS_MODF = 4 * MiB;
constexpr size_t WS_PE = 5 * MiB;
constexpr size_t WS_HDN = 6 * MiB;
constexpr size_t WS_HNRM = 8 * MiB;
constexpr size_t WS_HF256 = 16 * MiB;
constexpr size_t WS_HF4096 = 32 * MiB;
constexpr size_t WS_WTE = 160 * MiB;
constexpr size_t WS_WTO = 274 * MiB;
constexpr size_t WS_WTOUT = 418 * MiB;
constexpr size_t WS_H = 482 * MiB;
constexpr size_t WS_U = 578 * MiB;
constexpr size_t WS_MIX = 1010 * MiB;
constexpr size_t WS_OFA = 1106 * MiB;
constexpr size_t WS_OBA = 1154 * MiB;
constexpr size_t WS_OFB = 1202 * MiB;
constexpr size_t WS_OBB = 1250 * MiB;
constexpr size_t WS_TB = 1298 * MiB;
constexpr size_t WS_END = 1490 * MiB;
constexpr size_t WS_YT = WS_WTE;
constexpr size_t WS_GWN = 1298 * MiB;
constexpr size_t WS_GUF = 1394 * MiB;
constexpr size_t WS_GPP = 920 * MiB;
constexpr size_t WS_GGC = 968 * MiB;
constexpr size_t WS_GQN = WS_WTE;
constexpr size_t WS_GKT = WS_WTE + 48 * MiB;
constexpr size_t WS_SSP = 32 * MiB;
constexpr size_t WS_SCN = 128 * MiB;
constexpr size_t WS_SSG = 152 * MiB;
constexpr size_t WS_SBT = 1490 * MiB;
constexpr size_t WS_SVT = WS_H;
constexpr size_t WS_END2 = 1514 * MiB;
constexpr size_t WS_LQS = WS_H;
constexpr size_t WS_LKS = WS_WTO;
constexpr size_t WS_LAT = WS_WTO + 96 * MiB;
constexpr size_t WS_LVT = WS_OFB;
constexpr size_t WS_LGL = WS_OBB;
constexpr int CW_Q0 = 8192, CW_Q1 = 8256, CW_Q2 = 8320, CW_Q3 = 8384, CW_Q4 = 8448;
constexpr int CW_BAR = 4096;

DI float bf2f(bf16 b) { return __uint_as_float(((unsigned)b) << 16); }
DI unsigned pk2(float lo, float hi) { f32x2 v = {lo, hi}; return __builtin_bit_cast(unsigned, __builtin_convertvector(v, bf16x2n)); }
DI bf16 f2bf(float f) { return (bf16)(pk2(f, 0.f) & 0xffffu); }
DI float wave_sum(float v) {
#pragma unroll
    for (int o = 1; o < 64; o <<= 1) v += __shfl_xor(v, o);
    return v;
}
DI float sigmoidf_(float x) { return __builtin_amdgcn_rcpf(1.0f + __expf(-x)); }
DI float siluf_(float x) { return x * __builtin_amdgcn_rcpf(1.0f + __expf(-x)); }
DI float softplusf_(float x) { return x > 20.f ? x : log1pf(__expf(x)); }
DI void unpack8(const u32x4 w, float* o) {
    o[0] = __uint_as_float(w.x << 16); o[1] = __uint_as_float(w.x & 0xffff0000u); o[2] = __uint_as_float(w.y << 16); o[3] = __uint_as_float(w.y & 0xffff0000u);
    o[4] = __uint_as_float(w.z << 16); o[5] = __uint_as_float(w.z & 0xffff0000u); o[6] = __uint_as_float(w.w << 16); o[7] = __uint_as_float(w.w & 0xffff0000u);
}
DI bf16x8 frag_nat(const LAS bf16* M, int ld, int r0, int k0, int lane) { return *(const LAS bf16x8*)(M + (r0 + (lane & 15)) * ld + k0 + 8 * (lane >> 4)); }
DI bf16x8 frag_perm(const LAS bf16* M, int ld, int r0, int k0, int lane) {
    const LAS bf16* p = M + (r0 + (lane & 15)) * ld + k0 + 4 * (lane >> 4);
    const bf16x4 lo = *(const LAS bf16x4*)p, hi = *(const LAS bf16x4*)(p + 16);
    return __builtin_shufflevector(lo, hi, 0, 1, 2, 3, 4, 5, 6, 7);
}
DI bf16x8 pack2(const f32x4 a, const f32x4 b) {
    u32x4 w; w.x = pk2(a[0], a[1]); w.y = pk2(a[2], a[3]); w.z = pk2(b[0], b[1]); w.w = pk2(b[2], b[3]);
    return __builtin_bit_cast(bf16x8, w);
}
DI void st_bf16x4(LAS bf16* p, float a, float b, float c, float d) { u32x2 w; w.x = pk2(a, b); w.y = pk2(c, d); *(LAS u32x2*)p = w; }
constexpr int LDQ = 136, LDT = 72;
DI int swz_idx(int row, int col) { return row * LDT + (((((col >> 3) ^ (row >> 4)) & 7) << 3) | (col & 7)); }
DI bf16x8 frag_nat_sw(const LAS bf16* M, int r0, int k0, int lane) { const int q = lane >> 4; return *(const LAS bf16x8*)(M + (r0 + (lane & 15)) * LDT + ((((k0 >> 3) + q) ^ (r0 >> 4)) & 7) * 8); }
DI bf16x8 frag_perm_sw(const LAS bf16* M, int r0, int k0, int lane) { const int q = lane >> 4, sw = r0 >> 4; const LAS bf16* p = M + (r0 + (lane & 15)) * LDT + 4 * (q & 1);
    const bf16x4 lo = *(const LAS bf16x4*)(p + ((((k0 >> 3) + (q >> 1)) ^ sw) & 7) * 8), hi = *(const LAS bf16x4*)(p + ((((k0 >> 3) + 2 + (q >> 1)) ^ sw) & 7) * 8);
    return __builtin_shufflevector(lo, hi, 0, 1, 2, 3, 4, 5, 6, 7); }
#define LDSBAR() do { asm volatile("s_waitcnt lgkmcnt(0)" ::: "memory"); __builtin_amdgcn_s_barrier(); asm volatile("" ::: "memory"); } while (0)
#ifndef WODD_KEEP
#define WODD_KEEP 288
#endif
constexpr int WODD_P0 = 64 * WODD_KEEP;
struct Ctx {
    LAS unsigned char* lds;
    const float* const* in;
    unsigned char* ws;
    float* out;
    int tid, lane, wave, bid, G;
};
DI void p0_transpose_pair(const float* W, int K, int N, bf16* WT, LAS float* scr, int item0, int item1, int lane) {
    const int nblk = N / 32;
    float va[32], vb[32];
    { const int kb = item0 / nblk, nb = item0 % nblk; const float* src = W + (size_t)(64 * kb + (lane >> 5)) * N + 32 * nb + (lane & 31);
#pragma unroll
      for (int i = 0; i < 32; ++i) va[i] = __builtin_nontemporal_load(src + (size_t)(2 * i) * N); }
    if (item1 >= 0) { const int kb = item1 / nblk, nb = item1 % nblk; const float* src = W + (size_t)(64 * kb + (lane >> 5)) * N + 32 * nb + (lane & 31);
#pragma unroll
      for (int i = 0; i < 32; ++i) vb[i] = __builtin_nontemporal_load(src + (size_t)(2 * i) * N); }
#pragma unroll
    for (int half = 0; half < 2; ++half) { const int item = half ? item1 : item0; if (item < 0) break;
        const int kb = item / nblk, nb = item % nblk, k0 = 64 * kb, n0 = 32 * nb;
#pragma unroll
        for (int i = 0; i < 32; ++i) scr[(2 * i + (lane >> 5)) * 33 + (lane & 31)] = half ? vb[i] : va[i];
        asm volatile("s_waitcnt lgkmcnt(0)" ::: "memory");
        const int c = lane & 7;
#pragma unroll
        for (int j = 0; j < 4; ++j) { const int n = (lane >> 3) + 8 * j; const LAS float* s = scr + (8 * c) * 33 + n;
            u32x4 o; o.x = pk2(s[0 * 33], s[1 * 33]); o.y = pk2(s[2 * 33], s[3 * 33]); o.z = pk2(s[4 * 33], s[5 * 33]); o.w = pk2(s[6 * 33], s[7 * 33]);
            *(u32x4*)(WT + (size_t)(n0 + n) * K + k0 + 8 * c) = o; }
        asm volatile("s_waitcnt lgkmcnt(0)" ::: "memory"); }
}
DI void p0_transpose_range(const float* W, int K, int N, bf16* WT, LAS float* scr, int first, int stride, int total, int lane) {
    for (int it = first; it < total; it += 2 * stride) p0_transpose_pair(W, K, N, WT, scr, it, it + stride < total ? it + stride : -1, lane);
}
DI void p0_adaln_item(const Ctx& F, const float* w_ada, const float* c, const float* c_ctx, int item) {
    const int li = item / 384, rem = item % 384, strip = rem >> 3, kseg = rem & 7;
    const float* W = w_ada + (size_t)li * 4096 * 12288 + strip * 256 + F.lane * 4;
    const int k0 = kseg * 512 + F.wave * 64;
    f32x4 a0 = {0.f, 0.f, 0.f, 0.f}, a1 = a0, a2 = a0;
#pragma unroll 8
    for (int kk = 0; kk < 64; ++kk) { const int k = k0 + kk;
        const float s0 = siluf_(c_ctx[k]), s1 = siluf_(c[k]), s2 = siluf_(c[4096 + k]);
        const f32x4 w = __builtin_nontemporal_load((const f32x4*)(W + (size_t)k * 12288));
        a0 += s0 * w; a1 += s1 * w; a2 += s2 * w; }
    LAS float* scr = (LAS float*)F.lds;
    *(LAS f32x4*)(scr + F.wave * 768 + 0 * 256 + F.lane * 4) = a0;
    *(LAS f32x4*)(scr + F.wave * 768 + 1 * 256 + F.lane * 4) = a1;
    *(LAS f32x4*)(scr + F.wave * 768 + 2 * 256 + F.lane * 4) = a2;
    __syncthreads();
    float* modp = (float*)(F.ws + WS_MODP);
    for (int o = F.tid; o < 768; o += 512) { float s = 0.f;
#pragma unroll
        for (int w = 0; w < 8; ++w) s += scr[w * 768 + o];
        const int r = o >> 8, ci = o & 255;
        modp[((size_t)(kseg * 2 + li) * 3 + r) * 12288 + strip * 256 + ci] = s; }
    __syncthreads();
}
DI void p0_hdn_item(const float* w1, const float* b1, const float* freq, const float* w2, const float* b2, int L, int p, float* out, int lane) {
    const float t = (float)p / (float)(L - 1);
    float zk = 0.f;
    if (lane == 0) zk = t;
    else if (lane <= 32) { const int b = (lane - 1) & 15; const float band = 1e-4f + (float)b * ((15.0f - 1e-4f) / 15.0f);
        const float ang = (6.283185307179586f / (float)L) * (float)p * band; zk = (lane <= 16) ? cosf(ang) : -sinf(ang); }
    float a = b1[lane];
#pragma unroll
    for (int k = 0; k < 33; ++k) a += __shfl(zk, k) * w1[k * 64 + lane];
    const float h1 = sinf(freq[lane] * a);
    float a2 = b2[lane];
#pragma unroll 16
    for (int k = 0; k < 64; ++k) a2 += __shfl(h1, k) * w2[k * 64 + lane];
    out[lane] = sinf(freq[64 + lane] * a2);
}
DI void p0_filter_item(const Ctx& F, const float* hdn, const float* w3, float* HF, float* HNRM, int L, int cg) {
    LAS float* wl = (LAS float*)F.lds;
    LAS float* red = wl + 2048;
    for (int e = F.tid; e < 2048; e += 512) { const int k = e >> 5, x = e & 31, dir = x >> 4, ord = (x >> 3) & 1, cc = x & 7;
        wl[e] = w3[(size_t)k * 8192 + dir * 4096 + ord * 2048 + cg * 8 + cc]; }
    __syncthreads();
    float asum[16];
#pragma unroll
    for (int i = 0; i < 16; ++i) asum[i] = 0.f;
    const float tinv = 1.0f / (float)(L - 1);
    float dl2[8];
#pragma unroll
    for (int cc = 0; cc < 8; ++cc) dl2[cc] = 1.4426950408889634f * fabsf(-3.0701134573253945f + (-15.350567286626972f + 3.0701134573253945f) * ((float)(cg * 8 + cc) * (1.0f / 2047.0f)));
    const int half = L > 512 ? L / 2 : L;
    for (int p = F.tid; p < half; p += 512) { const bool two = (L > 512); const int p1 = two ? p + half : p;
        float acc0[32], acc1[32];
#pragma unroll
        for (int i = 0; i < 32; ++i) { acc0[i] = 0.f; acc1[i] = 0.f; }
        const f32x4* hp0 = (const f32x4*)(hdn + (size_t)p * 64); const f32x4* hp1 = (const f32x4*)(hdn + (size_t)p1 * 64);
#pragma unroll 2
        for (int k4 = 0; k4 < 16; ++k4) { const f32x4 hv0 = hp0[k4], hv1 = hp1[k4];
#pragma unroll
            for (int kk = 0; kk < 4; ++kk) { const float h0 = hv0[kk], h1 = hv1[kk]; const LAS f32x4* wr = (const LAS f32x4*)(wl + (k4 * 4 + kk) * 32);
#pragma unroll
                for (int x4 = 0; x4 < 8; ++x4) { const f32x4 w = wr[x4];
                    acc0[x4 * 4 + 0] += h0 * w[0]; acc0[x4 * 4 + 1] += h0 * w[1]; acc0[x4 * 4 + 2] += h0 * w[2]; acc0[x4 * 4 + 3] += h0 * w[3];
                    acc1[x4 * 4 + 0] += h1 * w[0]; acc1[x4 * 4 + 1] += h1 * w[1]; acc1[x4 * 4 + 2] += h1 * w[2]; acc1[x4 * 4 + 3] += h1 * w[3]; } } }
#pragma unroll
        for (int pp = 0; pp < 2; ++pp) { if (pp == 1 && !two) break; const int q = pp ? p1 : p; const float t = (float)q * tinv;
            float win[8];
#pragma unroll
            for (int cc = 0; cc < 8; ++cc) win[cc] = __builtin_amdgcn_exp2f(-t * dl2[cc]);
#pragma unroll
            for (int x = 0; x < 32; ++x) { const int dir = x >> 4, ord = (x >> 3) & 1, cc = x & 7, c = cg * 8 + cc;
                const float val = (pp ? acc1[x] : acc0[x]) * win[cc];
                float* row = HF + ((size_t)ord * 2048 + c) * (size_t)(2 * L);
                if (dir == 0) { row[q] = val; asum[ord * 8 + cc] += fabsf(val); if (q == 0) row[L] = 0.f; }
                else if (q >= 1) { row[2 * L - q] = val; asum[ord * 8 + cc] += fabsf(val); } } }
    }
#pragma unroll
    for (int i = 0; i < 16; ++i) { const float s = wave_sum(asum[i]); if (F.lane == 0) red[F.wave * 16 + i] = s; }
    __syncthreads();
    if (F.tid < 16) { float s = 0.f;
#pragma unroll
        for (int w = 0; w < 8; ++w) s += red[w * 16 + F.tid];
        const int ord = F.tid >> 3, cc = F.tid & 7; HNRM[ord * 2048 + cg * 8 + cc] = 1.0f / s; }
    __syncthreads();
}
DI void phase_p0(const Ctx& F, const float* const* in) {
    const int gw = F.bid * 8 + F.wave, NGW = F.G * 8;
    for (int it = F.bid; it < 768; it += F.G) p0_adaln_item(F, in[8], in[5], in[6], it);
    LAS float* scr = (LAS float*)(F.lds + F.wave * 16384);
    constexpr int I_E = 64 * (IN_EVEN / 32);
    p0_transpose_range(in[12], 4096, IN_EVEN, (bf16*)(F.ws + WS_WTE), scr, gw, NGW, I_E, F.lane);
    p0_transpose_range(in[22], 4096, IN_ODD, (bf16*)(F.ws + WS_WTO), scr, gw, NGW, WODD_P0, F.lane);
    { u32x4* z = (u32x4*)((bf16*)(F.ws + WS_WTE) + (size_t)IN_EVEN * 4096); const u32x4 zero = {0u, 0u, 0u, 0u};
      for (int i = F.bid * 512 + F.tid; i < (LD_EVEN - IN_EVEN) * 4096 / 8; i += F.G * 512) z[i] = zero; }
    { float* pe = (float*)(F.ws + WS_PE);
      for (int i = F.bid * 512 + F.tid; i < 65536; i += F.G * 512) { const int v = i >> 10, j = i & 1023;
          const float omega = 1.0f / powf(10000.0f, (float)j / 1024.0f); const float ang = (float)v * omega;
          pe[2 * i] = sinf(ang); pe[2 * i + 1] = cosf(ang); } }
    { float* hdn = (float*)(F.ws + WS_HDN);
      for (int it = gw; it < 256 + 4096; it += NGW) { const int L = it < 256 ? 256 : 4096, p = it < 256 ? it : it - 256;
          p0_hdn_item(in[24], in[25], in[26], in[27], in[28], L, p, hdn + (size_t)it * 64, F.lane); } }
}
DI void phase_p0c(const Ctx& F, const float* const* in) {
    { const float* modp = (const float*)(F.ws + WS_MODP); float* modf = (float*)(F.ws + WS_MODF);
      for (int i = F.bid * 512 + F.tid; i < 2 * 3 * 4096; i += F.G * 512) { const int li = i / 12288, r = (i / 4096) % 3, cc = i & 4095;
          float sh = in[9][li * 12288 + cc], sc = in[9][li * 12288 + 4096 + cc], gt = in[9][li * 12288 + 8192 + cc];
#pragma unroll
          for (int ks = 0; ks < 8; ++ks) { const float* m = modp + ((size_t)(ks * 2 + li) * 3 + r) * 12288; sh += m[cc]; sc += m[4096 + cc]; gt += m[8192 + cc]; }
          float* o = modf + (size_t)(li * 9 + r) * 4096;
          o[cc] = in[7][li * 4096 + cc] * (1.0f + sc); o[3 * 4096 + cc] = sh; o[6 * 4096 + cc] = gt; } }
}
DI void phase_filters(const Ctx& F, const float* const* in, int w, int nw) {
    __syncthreads();
    for (int it = w; it < 512; it += nw) { const int cg = it & 255, li = it >> 8;
        const float* hdn = (const float*)(F.ws + WS_HDN) + (li ? (size_t)256 * 64 : 0);
        p0_filter_item(F, hdn, in[29], (float*)(F.ws + (li ? WS_HF4096 : WS_HF256)), (float*)(F.ws + WS_HNRM) + li * 4096, li ? 4096 : 256, cg); }
}
DI void convert_wout(const Ctx& F, const float* const* in, int w, int nw, int li) {
    __syncthreads();
    LAS float* scr = (LAS float*)(F.lds + F.wave * 16384);
    p0_transpose_range(in[10] + (size_t)li * 4096 * 4096, 4096, 4096, (bf16*)(F.ws + WS_WTOUT) + (size_t)li * 4096 * 4096, scr, w * 8 + F.wave, nw * 8, 8192, F.lane);
}
DI void convert_wodd(const Ctx& F, const float* const* in, int w, int nw) {
    __syncthreads();
    LAS float* scr = (LAS float*)(F.lds + F.wave * 16384);
    p0_transpose_range(in[22], 4096, IN_ODD, (bf16*)(F.ws + WS_WTO), scr, WODD_P0 + w * 8 + F.wave, nw * 8, 64 * (IN_ODD / 32), F.lane);
}
constexpr int LDX = 8192;
DI bf16* xr_base(const Ctx& F) { return (bf16*)F.out + 4096; }
template <int MODE> DI void phase_norm(const Ctx& F, const float* const* in) {
    const int gw = F.bid * 8 + F.wave, NGW = F.G * 8;
    bf16* H = (bf16*)(F.ws + WS_H); const float* pe = (const float*)(F.ws + WS_PE); bf16* XR = xr_base(F);
    f32x4 ra[MODE == 0 ? 8 : 1], rb[MODE == 0 ? 8 : 1]; u32x4 rw[MODE == 0 ? 1 : 8];
#define NORM_LOAD(row_) do { if (MODE == 0) { const float* src_ = (row_) < 4096 ? in[0] + (size_t)(row_) * DM : in[1] + (size_t)((row_) - 4096) * DM; \
            _Pragma("unroll") for (int j_ = 0; j_ < 8; ++j_) { ra[MODE == 0 ? j_ : 0] = __builtin_nontemporal_load((const f32x4*)(src_ + j_ * 512 + F.lane * 8)); rb[MODE == 0 ? j_ : 0] = __builtin_nontemporal_load((const f32x4*)(src_ + j_ * 512 + F.lane * 8 + 4)); } } \
        else { _Pragma("unroll") for (int j_ = 0; j_ < 8; ++j_) rw[MODE == 0 ? 0 : j_] = *(const u32x4*)(XR + (size_t)(row_) * LDX + j_ * 512 + F.lane * 8); } } while (0)
    if (gw < NROWS) NORM_LOAD(gw);
#pragma unroll 1
    for (int row = gw; row < NROWS; row += NGW) {
        const int r = row < 4096 ? 0 : 1 + ((row - 4096) >> 12);
        const int t = (row - 4096) & 4095, gr = t >> 6, gc = t & 63;
        float v[8][8]; float ss = 0.f;
        if (MODE == 0) {
#pragma unroll
            for (int j = 0; j < 8; ++j) { const int col = j * 512 + F.lane * 8; const f32x4 a = ra[MODE == 0 ? j : 0], b = rb[MODE == 0 ? j : 0];
                v[j][0] = a[0]; v[j][1] = a[1]; v[j][2] = a[2]; v[j][3] = a[3]; v[j][4] = b[0]; v[j][5] = b[1]; v[j][6] = b[2]; v[j][7] = b[3];
                if (row >= 4096) { const int q4 = j >> 1, jj = col & 1023, vv = (q4 < 2) ? gr : gc, comp = q4 & 1;
                    const f32x4* pp = (const f32x4*)(pe + ((size_t)vv * 1024 + jj) * 2);
#pragma unroll
                    for (int e2 = 0; e2 < 4; ++e2) { const f32x4 p = pp[e2]; v[j][2 * e2] += comp ? p[1] : p[0]; v[j][2 * e2 + 1] += comp ? p[3] : p[2]; } } }
        } else {
#pragma unroll
            for (int j = 0; j < 8; ++j) unpack8(rw[MODE == 0 ? 0 : j], v[j]); }
        if (row + NGW < NROWS) NORM_LOAD(row + NGW);
#pragma unroll
        for (int j = 0; j < 8; ++j)
#pragma unroll
            for (int e = 0; e < 8; ++e) ss += v[j][e] * v[j][e];
        const float rstd = __builtin_amdgcn_rsqf(wave_sum(ss) * (1.0f / DM) + EPS);
        if (MODE == 2) { float* yo = F.out + (size_t)row * DM;
#pragma unroll
            for (int j = 0; j < 8; ++j) { const int col = j * 512 + F.lane * 8; const f32x4 g0 = *(const f32x4*)(in[11] + col), g1 = *(const f32x4*)(in[11] + col + 4);
                __builtin_nontemporal_store((f32x4){v[j][0] * rstd * g0[0], v[j][1] * rstd * g0[1], v[j][2] * rstd * g0[2], v[j][3] * rstd * g0[3]}, (f32x4*)(yo + col));
                __builtin_nontemporal_store((f32x4){v[j][4] * rstd * g1[0], v[j][5] * rstd * g1[1], v[j][6] * rstd * g1[2], v[j][7] * rstd * g1[3]}, (f32x4*)(yo + col + 4)); }
        } else {
            const float* A = (const float*)(F.ws + WS_MODF) + (size_t)((MODE == 1 ? 9 : 0) + r) * 4096;
#pragma unroll
            for (int j = 0; j < 8; ++j) { const int col = j * 512 + F.lane * 8;
                const f32x4 a0 = *(const f32x4*)(A + col), a1 = *(const f32x4*)(A + col + 4), b0 = *(const f32x4*)(A + 3 * 4096 + col), b1 = *(const f32x4*)(A + 3 * 4096 + col + 4);
                u32x4 w; w.x = pk2(v[j][0] * rstd * a0[0] + b0[0], v[j][1] * rstd * a0[1] + b0[1]); w.y = pk2(v[j][2] * rstd * a0[2] + b0[2], v[j][3] * rstd * a0[3] + b0[3]);
                w.z = pk2(v[j][4] * rstd * a1[0] + b1[0], v[j][5] * rstd * a1[1] + b1[1]); w.w = pk2(v[j][6] * rstd * a1[2] + b1[2], v[j][7] * rstd * a1[3] + b1[3]);
                *(u32x4*)(H + (size_t)row * DM + col) = w;
                if (MODE == 0) { u32x4 x; x.x = pk2(v[j][0], v[j][1]); x.y = pk2(v[j][2], v[j][3]); x.z = pk2(v[j][4], v[j][5]); x.w = pk2(v[j][6], v[j][7]);
                    *(u32x4*)(XR + (size_t)row * LDX + col) = x; } }
        }
    }
}
#undef NORM_LOAD

DI void conv3_load(const bf16* Urow, size_t ld, int t, int len, u32x4* r) {
    const u32x4 z = {0u, 0u, 0u, 0u};
    const u32x4* p0 = (const u32x4*)Urow; r[2] = p0[0]; r[3] = p0[1];
    if (t > 0) { const u32x4* p = (const u32x4*)(Urow - ld); r[0] = p[0]; r[1] = p[1]; } else { r[0] = z; r[1] = z; }
    if (t + 1 < len) { const u32x4* p = (const u32x4*)(Urow + ld); r[4] = p[0]; r[5] = p[1]; } else { r[4] = z; r[5] = z; }
}
DI void conv3_calc(const u32x4* r, const LAS float* cw, int cstride, float* o) {
#pragma unroll
    for (int hf = 0; hf < 2; ++hf) { float xm[8], x0[8], xp[8]; unpack8(r[hf], xm); unpack8(r[2 + hf], x0); unpack8(r[4 + hf], xp);
#pragma unroll
        for (int e4 = 0; e4 < 2; ++e4) { const int c = hf * 8 + e4 * 4; const f32x4 w0 = *(const LAS f32x4*)(cw + c), w1 = *(const LAS f32x4*)(cw + cstride + c), w2 = *(const LAS f32x4*)(cw + 2 * cstride + c);
#pragma unroll
            for (int e = 0; e < 4; ++e) o[c + e] = w0[e] * xm[e4 * 4 + e] + w1[e] * x0[e4 * 4 + e] + w2[e] * xp[e4 * 4 + e]; } }
}
#define SCHED_FENCE() __builtin_amdgcn_sched_barrier(0)
DI float wave_scan_incl(float v, int lane) {
#pragma unroll
    for (int o = 1; o < 64; o <<= 1) { const float u = __shfl_up(v, o); if (lane >= o) v += u; }
    return v;
}

DI void gdn_prep_request(const Ctx& F, int c64, int h, u32x4 (&rq_)[6], u32x4 (&rk_)[6], u32x4 (&rv_)[6], unsigned& rgate) {
    const bf16* U = (const bf16*)(F.ws + WS_U);
    const int r0 = c64 * 64, len = r0 < 4096 ? 256 : 4096, t0 = r0 < 4096 ? (r0 & 255) : ((r0 - 4096) & 4095);
    const int i = F.tid >> 3, sub = F.tid & 7, t = t0 + i;
    const bf16* ur = U + (size_t)(r0 + i) * LD_EVEN;
    conv3_load(ur + E_QKV + h * 128 + sub * 16, LD_EVEN, t, len, rq_);
    conv3_load(ur + E_QKV + 2048 + h * 128 + sub * 16, LD_EVEN, t, len, rk_);
    conv3_load(ur + E_QKV + 4096 + h * 128 + sub * 16, LD_EVEN, t, len, rv_);
    rgate = (unsigned)ur[E_BETA + (sub & 1) * 16 + h] | ((unsigned)ur[E_A + (sub & 1) * 16 + h] << 16);
}
DI void gdn_prep_item(const Ctx& F, const float* const* in, int c64, int h, bool stage_cw, u32x4 (&rq_)[6], u32x4 (&rk_)[6], u32x4 (&rv_)[6], unsigned& rgate, float (&gpar)[2], int next_c64) {
    LAS bf16* Q = (LAS bf16*)(F.lds + 0);
    LAS bf16* K = (LAS bf16*)(F.lds + 17408);
    LAS bf16* KT = (LAS bf16*)(F.lds + 34816);
    LAS bf16* VT = (LAS bf16*)(F.lds + 53248);
    LAS float* KKR = (LAS float*)(F.lds + 71680);
    LAS float* QKR = (LAS float*)(F.lds + 89088);
    LAS bf16* NN = (LAS bf16*)(F.lds + 106496);
    LAS float* NDG = (LAS float*)(F.lds + 115712);
    LAS bf16* DBK = (LAS bf16*)(F.lds + 119808);
    LAS bf16* W = (LAS bf16*)(F.lds + 124928);
    LAS float* TBL = (LAS float*)(F.lds + 142336);
    LAS float* CW = TBL + 384;
    constexpr int LDD = 40, LDR = 68;
    const bf16* U = (const bf16*)(F.ws + WS_U);
    const int r0 = c64 * 64, len = r0 < 4096 ? 256 : 4096, t0 = r0 < 4096 ? (r0 & 255) : ((r0 - 4096) & 4095);
    const int lane_o = F.lane, wave = F.wave;
    LDSBAR();
    if (stage_cw) { const int sd = (F.tid & 1); gpar[0] = -expf(in[14][sd * 16 + h]); gpar[1] = in[15][sd * 16 + h]; }
    if (stage_cw) {
        for (int e = F.tid; e < 3 * 384; e += 512) { const int tap = e / 384, c = e % 384; CW[e] = in[13][tap * 6144 + (c >> 7) * 2048 + h * 128 + (c & 127)]; }
        for (int e = F.tid; e < 4 * 16 * LDD / 2; e += 512) ((LAS unsigned*)DBK)[e] = 0u;
        LDSBAR(); }
    int lane = lane_o; asm volatile("" : "+v"(lane)); const int l15 = lane & 15, q4 = lane >> 4;
    { const int i = F.tid >> 3, sub = F.tid & 7;
      const bf16* ur = U + (size_t)(r0 + i) * LD_EVEN;
      SCHED_FENCE();
      { float qv[16]; conv3_calc(rq_, CW + sub * 16, 384, qv); float sq = 0.f;
#pragma unroll
        for (int e = 0; e < 16; ++e) { qv[e] = siluf_(qv[e]); sq += qv[e] * qv[e]; }
        sq += __shfl_xor(sq, 1); sq += __shfl_xor(sq, 2); sq += __shfl_xor(sq, 4);
        const float rq = 0.08838834764831845f * __builtin_amdgcn_rsqf(sq + EPS);
        u32x4 g0, g1; g0.x = pk2(qv[0] * rq, qv[1] * rq); g0.y = pk2(qv[2] * rq, qv[3] * rq); g0.z = pk2(qv[4] * rq, qv[5] * rq); g0.w = pk2(qv[6] * rq, qv[7] * rq);
        g1.x = pk2(qv[8] * rq, qv[9] * rq); g1.y = pk2(qv[10] * rq, qv[11] * rq); g1.z = pk2(qv[12] * rq, qv[13] * rq); g1.w = pk2(qv[14] * rq, qv[15] * rq);
        *(LAS u32x4*)(Q + i * LDQ + sub * 16) = g0; *(LAS u32x4*)(Q + i * LDQ + sub * 16 + 8) = g1;
        u32x4* gq = (u32x4*)((bf16*)(F.ws + WS_GQN) + (size_t)(r0 + i) * 2048 + h * 128 + sub * 16); gq[0] = g0; gq[1] = g1; }
      SCHED_FENCE();
      { float kv[16]; conv3_calc(rk_, CW + 128 + sub * 16, 384, kv); float sk = 0.f;
#pragma unroll
        for (int e = 0; e < 16; ++e) { kv[e] = siluf_(kv[e]); sk += kv[e] * kv[e]; }
        sk += __shfl_xor(sk, 1); sk += __shfl_xor(sk, 2); sk += __shfl_xor(sk, 4);
        const float rk = __builtin_amdgcn_rsqf(sk + EPS);
#pragma unroll
        for (int e = 0; e < 16; ++e) kv[e] *= rk;
#pragma unroll
        for (int e = 0; e < 16; e += 4) st_bf16x4(K + i * LDQ + sub * 16 + e, kv[e], kv[e + 1], kv[e + 2], kv[e + 3]);
#pragma unroll
        for (int e = 0; e < 16; ++e) KT[swz_idx(sub * 16 + e, i)] = f2bf(kv[e]); }
      SCHED_FENCE();
      { float vv[16]; conv3_calc(rv_, CW + 256 + sub * 16, 384, vv);
#pragma unroll
        for (int e = 0; e < 16; ++e) VT[swz_idx(sub * 16 + e, i)] = f2bf(siluf_(vv[e])); }
      SCHED_FENCE();
      if (sub < 2) { const int d = sub; const float braw = bf2f((bf16)(rgate & 0xffffu)), araw = bf2f((bf16)(rgate >> 16));
          const int ii = d ? 63 - i : i;
          TBL[d * 192 + ii] = gpar[0] * softplusf_(araw + gpar[1]); TBL[d * 192 + 64 + ii] = sigmoidf_(braw); } }
    LDSBAR();
    if (wave < 2) TBL[wave * 192 + 128 + lane] = wave_scan_incl(TBL[wave * 192 + lane], lane);
    { bf16* ktg = (bf16*)(F.ws + WS_GKT) + (size_t)h * 128 * NROWS + r0;
#pragma unroll
      for (int k = 0; k < 2; ++k) { const int e = F.tid + 512 * k, row = e >> 3, pc = e & 7;
          *(u32x4*)(ktg + (size_t)row * NROWS + pc * 8) = *(const LAS u32x4*)(KT + row * LDT + ((pc ^ (row >> 4)) & 7) * 8); } }
#pragma unroll
    for (int tt = 0; tt < 2; ++tt) { const int id = 2 * wave + tt, ti = id >> 2, tj = id & 3;
        f32x4 akk = {0.f, 0.f, 0.f, 0.f}, aqk = akk;
#pragma unroll
        for (int ks = 0; ks < 4; ++ks) { const bf16x8 bk = frag_nat(K, LDQ, tj * 16, ks * 32, lane);
            akk = MFMA16(bk, frag_nat(K, LDQ, ti * 16, ks * 32, lane), akk);
            aqk = MFMA16(bk, frag_nat(Q, LDQ, ti * 16, ks * 32, lane), aqk); }
        *(LAS f32x4*)(KKR + (ti * 16 + l15) * LDR + tj * 16 + 4 * q4) = akk; *(LAS f32x4*)(QKR + (ti * 16 + l15) * LDR + tj * 16 + 4 * q4) = aqk; }
    LDSBAR();
#pragma unroll
    for (int d = 0; d < 2; ++d) {
        const size_t item = ((size_t)c64 * 16 + h) * 2 + d;
        const LAS float* TB_ = TBL + d * 192;
        if (d == 1 && next_c64 >= 0) { gdn_prep_request(F, next_c64, h, rq_, rk_, rv_, rgate); }
#pragma unroll
        for (int tt = 0; tt < 2; ++tt) { const int id = 2 * wave + tt, ti = id >> 2, tj = id & 3;
            const int i = ti * 16 + l15, j0 = tj * 16 + 4 * q4;
            f32x4 kk, qk;
            if (d == 0) { kk = *(const LAS f32x4*)(KKR + i * LDR + j0); qk = *(const LAS f32x4*)(QKR + i * LDR + j0); }
            else { const f32x4 a = *(const LAS f32x4*)(KKR + (63 - i) * LDR + 60 - j0), b = *(const LAS f32x4*)(QKR + (63 - i) * LDR + 60 - j0);
                kk = (f32x4){a[3], a[2], a[1], a[0]}; qk = (f32x4){b[3], b[2], b[1], b[0]}; }
            const float gi = TB_[128 + i], bi = TB_[64 + i];
            float nv[4], pv[4];
#pragma unroll
            for (int r = 0; r < 4; ++r) { const int j = j0 + r; const float dec = (i >= j) ? __expf(gi - TB_[128 + j]) : 0.f;
                nv[r] = (i > j) ? bi * kk[r] * dec : 0.f; pv[r] = qk[r] * dec; }
            st_bf16x4(NN + i * LDT + j0, -nv[0], -nv[1], -nv[2], -nv[3]);
            { u32x2 w2; w2.x = pk2(pv[0], pv[1]); w2.y = pk2(pv[2], pv[3]); *(u32x2*)((bf16*)(F.ws + WS_GPP) + (item * 64 + i) * 64 + j0) = w2; }
            if (ti == tj) *(LAS f32x4*)(NDG + (ti * 16 + l15) * 16 + 4 * q4) = (f32x4){nv[0], nv[1], nv[2], nv[3]}; }
        if (wave == 1) ((float*)(F.ws + WS_GGC))[item * 64 + lane] = TB_[128 + lane];
        LDSBAR();
        if (wave == 0) { float x[16];
#pragma unroll
            for (int i = 0; i < 16; ++i) { float sa[4] = {0.f, 0.f, 0.f, 0.f};
                const LAS f32x4* nr = (const LAS f32x4*)(NDG + (q4 * 16 + i) * 16);
#pragma unroll
                for (int k4 = 0; k4 < 4; ++k4) { if (4 * k4 < i) { const f32x4 nvv = nr[k4];
#pragma unroll
                        for (int e = 0; e < 4; ++e) if (4 * k4 + e < i) sa[e] += nvv[e] * x[4 * k4 + e]; } }
                const float a = ((i == l15) ? 1.f : 0.f) - ((sa[0] + sa[1]) + (sa[2] + sa[3]));
                x[i] = a; DBK[(q4 * 16 + i) * LDD + l15] = f2bf(a); } }
        LDSBAR();
        { f32x4 u[4], xw[4]; const f32x4 z4 = {0.f, 0.f, 0.f, 0.f};
#pragma unroll
          for (int b = 0; b < 4; ++b) {
              const f32x4 be = *(const LAS f32x4*)(TB_ + 64 + 16 * b + 4 * q4), gcv = *(const LAS f32x4*)(TB_ + 128 + 16 * b + 4 * q4);
              const int c0 = d ? 60 - 16 * b - 4 * q4 : 16 * b + 4 * q4;
              const bf16x4 vraw = *(const LAS bf16x4*)(VT + swz_idx(16 * wave + l15, c0)), kraw = *(const LAS bf16x4*)(KT + swz_idx(16 * wave + l15, c0));
              f32x4 au, aw;
#pragma unroll
              for (int r = 0; r < 4; ++r) { const int rr = d ? 3 - r : r; au[r] = be[r] * bf2f((bf16)vraw[rr]); aw[r] = be[r] * __expf(gcv[r]) * bf2f((bf16)kraw[rr]); }
              if (b >= 1) { const bf16x8 nf = frag_perm(NN, LDT, 16 * b, 0, lane);
                  au = MFMA16(nf, pack2(u[0], b >= 2 ? u[1] : z4), au); aw = MFMA16(nf, pack2(xw[0], b >= 2 ? xw[1] : z4), aw); }
              if (b == 3) { const bf16x8 nf = frag_perm(NN, LDT, 48, 32, lane);
                  au = MFMA16(nf, pack2(u[2], z4), au); aw = MFMA16(nf, pack2(xw[2], z4), aw); }
              const bf16x8 df = frag_perm(DBK + b * 16 * LDD, LDD, 0, 0, lane);
              u[b] = MFMA16(df, pack2(au, z4), z4); xw[b] = MFMA16(df, pack2(aw, z4), z4);
              { u32x2 w2; w2.x = pk2(u[b][0], u[b][1]); w2.y = pk2(u[b][2], u[b][3]);
                *(u32x2*)((bf16*)(F.ws + WS_GUF) + (((item * 8 + wave) * 4 + b) * 64 + lane) * 4) = w2; }
#pragma unroll
              for (int r = 0; r < 4; ++r) W[(16 * b + 4 * q4 + r) * LDQ + 16 * wave + l15] = f2bf(-xw[b][r]); } }
        LDSBAR();
        { bf16* wg = (bf16*)(F.ws + WS_GWN) + item * 8192;
#pragma unroll
          for (int k = 0; k < 2; ++k) { const int e = F.tid + 512 * k, row = e >> 4, pc = e & 15;
              *(u32x4*)(wg + row * 128 + pc * 8) = *(const LAS u32x4*)(W + row * LDQ + pc * 8); } }
    }
}

#define GDN_SETB 79872
DI void gdn_scan_step(const Ctx& F, f32x4 (&S)[2][8], int set, int ci, int d, int len, int row0, int h, bf16* OUT) {
    const int wave = F.wave;
    int lane = F.lane; asm volatile("" : "+v"(lane)); const int l15 = lane & 15, q4 = lane >> 4;
    LAS bf16* W = (LAS bf16*)(F.lds + set * GDN_SETB); LAS bf16* Q = (LAS bf16*)(F.lds + set * GDN_SETB + 17408); LAS bf16* PB = (LAS bf16*)(F.lds + set * GDN_SETB + 34816);
    LAS bf16* KT = (LAS bf16*)(F.lds + set * GDN_SETB + 44032); LAS float* GC = (LAS float*)(F.lds + set * GDN_SETB + 62464); const LAS bf16* UL = (const LAS bf16*)(F.lds + set * GDN_SETB + 63488);
#define LQ(dst, M, it) do { _Pragma("unroll") for (int i_ = 0; i_ < 4; ++i_) dst[i_] = frag_perm(M, LDQ, (it) * 16, i_ * 32, lane); SCHED_FENCE(); } while (0)
#define LT(dst, M, t0) do { _Pragma("unroll") for (int i_ = 0; i_ < 4; ++i_) dst[i_] = frag_perm(M, LDT, ((t0) + (i_ >> 1)) * 16, (i_ & 1) * 32, lane); SCHED_FENCE(); } while (0)
#define CVN(X, it) do { _Pragma("unroll") for (int ks = 0; ks < 4; ++ks) { vn[0][it] = MFMA16(X[ks], Sp[0][ks], vn[0][it]); vn[1][it] = MFMA16(X[ks], Sp[1][ks], vn[1][it]); } SCHED_FENCE(); } while (0)
#define CO(X, j) do { _Pragma("unroll") for (int ks = 0; ks < 4; ++ks) { o[0][j] = MFMA16(Sp[0][ks], X[ks], o[0][j]); o[1][j] = MFMA16(Sp[1][ks], X[ks], o[1][j]); } SCHED_FENCE(); } while (0)
#define CS(X, t0) do { _Pragma("unroll") for (int ks = 0; ks < 2; ++ks) _Pragma("unroll") for (int j = 0; j < 2; ++j) { S[0][(t0) + j] = MFMA16(X[j * 2 + ks], V2p[0][ks], S[0][(t0) + j]); S[1][(t0) + j] = MFMA16(X[j * 2 + ks], V2p[1][ks], S[1][(t0) + j]); } SCHED_FENCE(); } while (0)
#define CPV(X, it0) do { _Pragma("unroll") for (int j = 0; j < 2; ++j) { const float eg = __expf(GC[((it0) + j) * 16 + l15]); o[0][j] = o[0][j] * eg; o[1][j] = o[1][j] * eg; } \
        _Pragma("unroll") for (int ks = 0; ks < 2; ++ks) _Pragma("unroll") for (int j = 0; j < 2; ++j) { o[0][j] = MFMA16(Vp[0][ks], X[j * 2 + ks], o[0][j]); o[1][j] = MFMA16(Vp[1][ks], X[j * 2 + ks], o[1][j]); } \
        _Pragma("unroll") for (int j = 0; j < 2; ++j) { const int i = ((it0) + j) * 16 + l15; const int tl = ci * 64 + i, t = d ? (len - 1 - tl) : tl; bf16* op = OUT + (size_t)(row0 + t) * 2048 + h * 128 + 32 * wave + 4 * q4; \
            u32x2 w2; w2.x = pk2(o[0][j][0], o[0][j][1]); w2.y = pk2(o[0][j][2], o[0][j][3]); *(u32x2*)op = w2; w2.x = pk2(o[1][j][0], o[1][j][1]); w2.y = pk2(o[1][j][2], o[1][j][3]); *(u32x2*)(op + 16) = w2; \
            o[0][j] = (f32x4){0.f, 0.f, 0.f, 0.f}; o[1][j] = (f32x4){0.f, 0.f, 0.f, 0.f}; } SCHED_FENCE(); } while (0)
    bf16x8 X0[4], X1[4], X2[4];
    f32x4 vn[2][4];
#pragma unroll
    for (int x = 0; x < 2; ++x)
#pragma unroll
        for (int b = 0; b < 4; ++b) { const u32x2 ur = *(const LAS u32x2*)(UL + (((2 * wave + x) * 4 + b) * 64 + lane) * 4);
            vn[x][b][0] = __uint_as_float(ur.x << 16); vn[x][b][1] = __uint_as_float(ur.x & 0xffff0000u); vn[x][b][2] = __uint_as_float(ur.y << 16); vn[x][b][3] = __uint_as_float(ur.y & 0xffff0000u); }
    const float gl = GC[63];
    LQ(X0, W, 0); LQ(X1, W, 1);
    bf16x8 Sp[2][4];
#pragma unroll
    for (int x = 0; x < 2; ++x)
#pragma unroll
        for (int ks = 0; ks < 4; ++ks) Sp[x][ks] = pack2(S[x][2 * ks], S[x][2 * ks + 1]);
    SCHED_FENCE();
    LQ(X2, W, 2); CVN(X0, 0);
    LQ(X0, W, 3); CVN(X1, 1);
    LQ(X1, Q, 0); CVN(X2, 2);
    LQ(X2, Q, 1); CVN(X0, 3);
    bf16x8 Vp[2][2], V2p[2][2];
#pragma unroll
    for (int ks = 0; ks < 2; ++ks) { float e0[4], e1[4];
#pragma unroll
        for (int r = 0; r < 4; ++r) { e0[r] = __expf(gl - GC[(2 * ks) * 16 + 4 * q4 + r]); e1[r] = __expf(gl - GC[(2 * ks + 1) * 16 + 4 * q4 + r]); }
#pragma unroll
        for (int x = 0; x < 2; ++x) { Vp[x][ks] = pack2(vn[x][2 * ks], vn[x][2 * ks + 1]);
            f32x4 a, b;
#pragma unroll
            for (int r = 0; r < 4; ++r) { a[r] = vn[x][2 * ks][r] * e0[r]; b[r] = vn[x][2 * ks + 1][r] * e1[r]; }
            V2p[x][ks] = pack2(a, b); } }
    const float egl = __expf(gl);
    SCHED_FENCE();
    f32x4 o[2][2];
#pragma unroll
    for (int x = 0; x < 2; ++x)
#pragma unroll
        for (int j = 0; j < 2; ++j) o[x][j] = (f32x4){0.f, 0.f, 0.f, 0.f};
    LT(X0, PB, 0); CO(X1, 0);
    LQ(X1, Q, 2); CO(X2, 1);
    LQ(X2, Q, 3); CPV(X0, 0);
    LT(X0, PB, 2); CO(X1, 0);
    LT(X1, KT, 0); CO(X2, 1);
    LT(X2, KT, 2); CPV(X0, 2);
#pragma unroll
    for (int x = 0; x < 2; ++x)
#pragma unroll
        for (int t = 0; t < 8; ++t) S[x][t] = S[x][t] * egl;
    SCHED_FENCE();
    LT(X0, KT, 4); CS(X1, 0);
    LT(X1, KT, 6); CS(X2, 2);
    CS(X0, 4); CS(X1, 6);
#undef LQ
#undef LT
#undef CVN
#undef CO
#undef CS
#undef CPV
}
DI void gdn_scan_item(const Ctx& F, const float* const* in, int s, int h, int d) {
    constexpr int SETB = GDN_SETB;
    const int row0 = seq_row0(s), len = seq_len(s), nch = len >> 6, c640 = row0 >> 6;
    const int lane_o = F.lane, wave = F.wave;
    bf16* OUT = (bf16*)(F.ws + (d ? WS_OBA : WS_OFA));
    const bf16* GWN = (const bf16*)(F.ws + WS_GWN); const bf16* GUF = (const bf16*)(F.ws + WS_GUF); const bf16* GPP = (const bf16*)(F.ws + WS_GPP);
    const float* GGC = (const float*)(F.ws + WS_GGC); const bf16* GQN = (const bf16*)(F.ws + WS_GQN); const bf16* GKT = (const bf16*)(F.ws + WS_GKT) + (size_t)h * 128 * NROWS;
    LDSBAR();
    if (wave >= 4) {
        struct Pre { u32x4 w[4], q[4], p[2], k[4], u[4]; float g; };
        Pre PA, PB_;
        const int e = F.tid - 256, er = e >> 2, eq = e & 3;
#define GDN_ISSUE(ci_, P_) do { const int cc = c640 + (d ? nch - 1 - (ci_) : (ci_)); const size_t item = ((size_t)cc * 16 + h) * 2 + d; \
        const u32x4* wsrc = (const u32x4*)(GWN + item * 8192 + er * 128 + eq * 32); \
        const int qrow = cc * 64 + (d ? 63 - er : er); const u32x4* qsrc = (const u32x4*)(GQN + (size_t)qrow * 2048 + h * 128 + eq * 32); \
        _Pragma("unroll") for (int m_ = 0; m_ < 4; ++m_) { P_.w[m_] = wsrc[m_]; P_.q[m_] = qsrc[m_]; } \
        const u32x4* psrc = (const u32x4*)(GPP + item * 4096 + er * 64 + eq * 16); P_.p[0] = psrc[0]; P_.p[1] = psrc[1]; \
        const u32x4* k0src = (const u32x4*)(GKT + (size_t)er * NROWS + cc * 64 + eq * 16); const u32x4* k1src = (const u32x4*)(GKT + (size_t)(64 + er) * NROWS + cc * 64 + eq * 16); \
        P_.k[0] = k0src[0]; P_.k[1] = k0src[1]; P_.k[2] = k1src[0]; P_.k[3] = k1src[1]; \
        const u32x4* usrc = (const u32x4*)(GUF + item * 8192) + e; _Pragma("unroll") for (int m_ = 0; m_ < 4; ++m_) P_.u[m_] = usrc[m_ * 256]; \
        P_.g = (e < 64) ? GGC[item * 64 + e] : 0.f; } while (0)
#define REV8(w_) ((u32x4){((w_).w >> 16) | ((w_).w << 16), ((w_).z >> 16) | ((w_).z << 16), ((w_).y >> 16) | ((w_).y << 16), ((w_).x >> 16) | ((w_).x << 16)})
#define GDN_COMMIT(set_, P_) do { LAS unsigned char* base = F.lds + (set_) * SETB; \
        _Pragma("unroll") for (int m_ = 0; m_ < 4; ++m_) { *(LAS u32x4*)((LAS bf16*)base + er * LDQ + eq * 32 + m_ * 8) = P_.w[m_]; *(LAS u32x4*)((LAS bf16*)(base + 17408) + er * LDQ + eq * 32 + m_ * 8) = P_.q[m_]; } \
        *(LAS u32x4*)((LAS bf16*)(base + 34816) + er * LDT + eq * 16) = P_.p[0]; *(LAS u32x4*)((LAS bf16*)(base + 34816) + er * LDT + eq * 16 + 8) = P_.p[1]; \
        if (d == 0) { *(LAS u32x4*)((LAS bf16*)(base + 44032) + er * LDT + eq * 16) = P_.k[0]; *(LAS u32x4*)((LAS bf16*)(base + 44032) + er * LDT + eq * 16 + 8) = P_.k[1]; \
            *(LAS u32x4*)((LAS bf16*)(base + 44032) + (64 + er) * LDT + eq * 16) = P_.k[2]; *(LAS u32x4*)((LAS bf16*)(base + 44032) + (64 + er) * LDT + eq * 16 + 8) = P_.k[3]; } \
        else { *(LAS u32x4*)((LAS bf16*)(base + 44032) + er * LDT + (3 - eq) * 16 + 8) = REV8(P_.k[0]); *(LAS u32x4*)((LAS bf16*)(base + 44032) + er * LDT + (3 - eq) * 16) = REV8(P_.k[1]); \
            *(LAS u32x4*)((LAS bf16*)(base + 44032) + (64 + er) * LDT + (3 - eq) * 16 + 8) = REV8(P_.k[2]); *(LAS u32x4*)((LAS bf16*)(base + 44032) + (64 + er) * LDT + (3 - eq) * 16) = REV8(P_.k[3]); } \
        _Pragma("unroll") for (int m_ = 0; m_ < 4; ++m_) *((LAS u32x4*)(base + 63488) + e + m_ * 256) = P_.u[m_]; \
        if (e < 64) ((LAS float*)(base + 62464))[e] = P_.g; } while (0)
        GDN_ISSUE(0, PA); GDN_ISSUE(1, PB_);
#pragma unroll 1
        for (int ci = 0; ci < nch; ci += 2) {
            GDN_COMMIT(0, PA); LDSBAR(); if (ci + 2 < nch) GDN_ISSUE(ci + 2, PA);
            GDN_COMMIT(1, PB_); LDSBAR(); if (ci + 3 < nch) GDN_ISSUE(ci + 3, PB_); }
#undef GDN_ISSUE
#undef GDN_COMMIT
#undef REV8
    } else {
        f32x4 S[2][8];
        if (s >= 16) { int ln = lane_o; asm volatile("" : "+v"(ln)); const int l15 = ln & 15, q4 = ln >> 4; const float* sp = in[2] + ((size_t)((s - 16) * 2 + d) * 16 + h) * 16384;
#pragma unroll
            for (int x = 0; x < 2; ++x)
#pragma unroll
                for (int t = 0; t < 8; ++t)
#pragma unroll
                    for (int r = 0; r < 4; ++r) S[x][t][r] = sp[(size_t)(16 * t + 4 * q4 + r) * 128 + 32 * wave + 16 * x + l15];
        } else {
#pragma unroll
            for (int x = 0; x < 2; ++x)
#pragma unroll
                for (int t = 0; t < 8; ++t) S[x][t] = (f32x4){0.f, 0.f, 0.f, 0.f}; }
#pragma unroll 1
        for (int ci = 0; ci < nch; ci += 2) { LDSBAR(); gdn_scan_step(F, S, 0, ci, d, len, row0, h, OUT); LDSBAR(); gdn_scan_step(F, S, 1, ci + 1, d, len, row0, h, OUT); }
        if (s < 16) { int ln = lane_o; asm volatile("" : "+v"(ln)); const int l15 = ln & 15, q4 = ln >> 4; float* sp = F.out + OUT_SG + ((size_t)(s * 2 + d) * 16 + h) * 16384;
#pragma unroll
            for (int x = 0; x < 2; ++x)
#pragma unroll
                for (int t = 0; t < 8; ++t)
#pragma unroll
                    for (int r = 0; r < 4; ++r) sp[(size_t)(16 * t + 4 * q4 + r) * 128 + 32 * wave + 16 * x + l15] = S[x][t][r]; }
    }
}

DI void ssd_prep_request(const Ctx& F, int c64, int g, u32x4 (&rx0)[6], u32x4 (&rx1)[6], u32x4 (&rb_)[6], u32x4 (&rc_)[6], unsigned& rdt) {
    const bf16* U = (const bf16*)(F.ws + WS_U);
    const int r0 = c64 * 64, len = r0 < 4096 ? 256 : 4096, t0 = r0 < 4096 ? (r0 & 255) : ((r0 - 4096) & 4095);
    const int i = F.tid >> 3, sub = F.tid & 7, t = t0 + i;
    const bf16* ur = U + (size_t)(r0 + i) * LD_EVEN;
    conv3_load(ur + E_XBC + g * 256 + sub * 32, LD_EVEN, t, len, rx0);
    conv3_load(ur + E_XBC + g * 256 + sub * 32 + 16, LD_EVEN, t, len, rx1);
    conv3_load(ur + E_XBC + 2048 + g * 128 + sub * 16, LD_EVEN, t, len, rb_);
    conv3_load(ur + E_XBC + 3072 + g * 128 + sub * 16, LD_EVEN, t, len, rc_);
    rdt = (unsigned)ur[E_DT + (sub >> 2) * 32 + g * 4 + (sub & 3)];
}
DI void ssd_prep_item(const Ctx& F, const float* const* in, int c64, int g, bool stage_cw, u32x4 (&rx0)[6], u32x4 (&rx1)[6], u32x4 (&rb_)[6], u32x4 (&rc_)[6], unsigned& rdt, float (&spar)[2], int next_c64, int next_g) {
    LAS bf16* C = (LAS bf16*)(F.lds + 0);
    LAS bf16* B = (LAS bf16*)(F.lds + 17408);
    LAS bf16* BT = (LAS bf16*)(F.lds + 34816);
    LAS bf16* XT = (LAS bf16*)(F.lds + 53248);
    LAS float* CBR = (LAS float*)(F.lds + 90112);
    LAS float* TBL = (LAS float*)(F.lds + 107520);
    LAS float* CW = TBL + 8 * 192;
    constexpr int LDR = 68;
    const bf16* U = (const bf16*)(F.ws + WS_U);
    const int r0 = c64 * 64, len = r0 < 4096 ? 256 : 4096, t0 = r0 < 4096 ? (r0 & 255) : ((r0 - 4096) & 4095);
    const int lane_o = F.lane, wave = F.wave;
    LDSBAR();
    if (stage_cw) { const int sd = (F.tid & 7) >> 2, shd = g * 4 + (F.tid & 3); spar[0] = -expf(in[18][sd * 32 + shd]); spar[1] = in[19][sd * 32 + shd]; }
    if (stage_cw) {
        for (int e = F.tid; e < 3 * 512; e += 512) { const int tap = e >> 9, c = e & 511; const int col = c < 256 ? g * 256 + c : (c < 384 ? 2048 + g * 128 + (c - 256) : 3072 + g * 128 + (c - 384)); CW[e] = in[17][tap * 4096 + col]; }
        LDSBAR(); }
    int lane = lane_o; asm volatile("" : "+v"(lane)); const int l15 = lane & 15, q4 = lane >> 4;
    { const int i = F.tid >> 3, sub = F.tid & 7; const int t = t0 + i;
      const bf16* ur = U + (size_t)(r0 + i) * LD_EVEN;
      SCHED_FENCE();
      { float xv[16]; conv3_calc(rx0, CW + sub * 32, 512, xv);
#pragma unroll
        for (int e = 0; e < 16; ++e) XT[swz_idx((sub >> 1) * 64 + (sub & 1) * 32 + e, i)] = f2bf(siluf_(xv[e])); }
      SCHED_FENCE();
      { float xv[16]; conv3_calc(rx1, CW + sub * 32 + 16, 512, xv);
#pragma unroll
        for (int e = 0; e < 16; ++e) XT[swz_idx((sub >> 1) * 64 + (sub & 1) * 32 + 16 + e, i)] = f2bf(siluf_(xv[e])); }
      SCHED_FENCE();
      { float bv[16]; conv3_calc(rb_, CW + 256 + sub * 16, 512, bv);
#pragma unroll
        for (int e = 0; e < 16; ++e) bv[e] = siluf_(bv[e]);
#pragma unroll
        for (int e = 0; e < 16; e += 4) st_bf16x4(B + i * LDQ + sub * 16 + e, bv[e], bv[e + 1], bv[e + 2], bv[e + 3]);
#pragma unroll
        for (int e = 0; e < 16; ++e) BT[swz_idx(sub * 16 + e, i)] = f2bf(bv[e]); }
      SCHED_FENCE();
      { float cv[16]; conv3_calc(rc_, CW + 384 + sub * 16, 512, cv);
        u32x4 g0, g1; g0.x = pk2(siluf_(cv[0]), siluf_(cv[1])); g0.y = pk2(siluf_(cv[2]), siluf_(cv[3])); g0.z = pk2(siluf_(cv[4]), siluf_(cv[5])); g0.w = pk2(siluf_(cv[6]), siluf_(cv[7]));
        g1.x = pk2(siluf_(cv[8]), siluf_(cv[9])); g1.y = pk2(siluf_(cv[10]), siluf_(cv[11])); g1.z = pk2(siluf_(cv[12]), siluf_(cv[13])); g1.w = pk2(siluf_(cv[14]), siluf_(cv[15]));
        *(LAS u32x4*)(C + i * LDQ + sub * 16) = g0; *(LAS u32x4*)(C + i * LDQ + sub * 16 + 8) = g1;
        u32x4* gc_ = (u32x4*)((bf16*)(F.ws + WS_SCN) + (size_t)(r0 + i) * 1024 + g * 128 + sub * 16); gc_[0] = g0; gc_[1] = g1; }
      SCHED_FENCE();
      { const int d = sub >> 2, hx = sub & 3, hd = g * 4 + hx, ii = d ? 63 - i : i;
        const float dt = softplusf_(bf2f((bf16)(rdt & 0xffffu)) + spar[1]);
        TBL[sub * 192 + ii] = spar[0] * dt; TBL[sub * 192 + 128 + ii] = dt; } }
    if (next_c64 >= 0) ssd_prep_request(F, next_c64, next_g, rx0, rx1, rb_, rc_, rdt);
    LDSBAR();
    TBL[wave * 192 + 64 + lane] = wave_scan_incl(TBL[wave * 192 + lane], lane);
    { bf16* btg = (bf16*)(F.ws + WS_SBT) + (size_t)g * 128 * NROWS + r0;
#pragma unroll
      for (int k = 0; k < 2; ++k) { const int e = F.tid + 512 * k, row = e >> 3, pc = e & 7;
          *(u32x4*)(btg + (size_t)row * NROWS + pc * 8) = *(const LAS u32x4*)(BT + row * LDT + ((pc ^ (row >> 4)) & 7) * 8); } }
#pragma unroll
    for (int k = 0; k < 8; ++k) { const int e = F.tid + 512 * k, pc = e & 7, row = (e >> 3) & 63, hx = (e >> 9) & 3, d = e >> 11;
        const u32x4 raw = *(const LAS u32x4*)(XT + (hx * 64 + row) * LDT + ((pc ^ ((hx * 64 + row) >> 4)) & 7) * 8); float f[8]; unpack8(raw, f);
        const LAS float* dtp = TBL + (d * 4 + hx) * 192 + 128;
        u32x4 o;
        if (d == 0) { const f32x4 d0 = *(const LAS f32x4*)(dtp + pc * 8), d1 = *(const LAS f32x4*)(dtp + pc * 8 + 4);
            o.x = pk2(f[0] * d0[0], f[1] * d0[1]); o.y = pk2(f[2] * d0[2], f[3] * d0[3]); o.z = pk2(f[4] * d1[0], f[5] * d1[1]); o.w = pk2(f[6] * d1[2], f[7] * d1[3]); }
        else { const f32x4 d0 = *(const LAS f32x4*)(dtp + 56 - pc * 8), d1 = *(const LAS f32x4*)(dtp + 60 - pc * 8);
            o.x = pk2(f[0] * d1[3], f[1] * d1[2]); o.y = pk2(f[2] * d1[1], f[3] * d1[0]); o.z = pk2(f[4] * d0[3], f[5] * d0[2]); o.w = pk2(f[6] * d0[1], f[7] * d0[0]); }
        *(u32x4*)((bf16*)(F.ws + WS_SVT) + ((size_t)((g * 4 + hx) * 2 + d) * 64 + row) * NROWS + r0 + pc * 8) = o; }
#pragma unroll
    for (int tt = 0; tt < 2; ++tt) { const int id = 2 * wave + tt, ti = id >> 2, tj = id & 3;
        f32x4 cb = {0.f, 0.f, 0.f, 0.f};
#pragma unroll
        for (int ks = 0; ks < 4; ++ks) cb = MFMA16(frag_nat(B, LDQ, tj * 16, ks * 32, lane), frag_nat(C, LDQ, ti * 16, ks * 32, lane), cb);
        *(LAS f32x4*)(CBR + (ti * 16 + l15) * LDR + tj * 16 + 4 * q4) = cb; }
    LDSBAR();
    { const int d = wave >> 2, hx = wave & 3; const size_t item = ((size_t)c64 * 32 + g * 4 + hx) * 2 + d;
      const LAS float* gcp = TBL + wave * 192 + 64; const float gi = gcp[lane];
      ((float*)(F.ws + WS_SSG))[item * 64 + lane] = gi;
      const LAS float* crow = CBR + (d ? 63 - lane : lane) * LDR;
      bf16* pg = (bf16*)(F.ws + WS_SSP) + (item * 64 + lane) * 64;
#pragma unroll
      for (int j8 = 0; j8 < 8; ++j8) { float pv[8];
          f32x4 c0, c1;
          if (d == 0) { c0 = *(const LAS f32x4*)(crow + j8 * 8); c1 = *(const LAS f32x4*)(crow + j8 * 8 + 4); }
          else { const f32x4 a0 = *(const LAS f32x4*)(crow + 60 - j8 * 8), a1 = *(const LAS f32x4*)(crow + 56 - j8 * 8); c0 = (f32x4){a0[3], a0[2], a0[1], a0[0]}; c1 = (f32x4){a1[3], a1[2], a1[1], a1[0]}; }
          const f32x4 g0 = *(const LAS f32x4*)(gcp + j8 * 8), g1 = *(const LAS f32x4*)(gcp + j8 * 8 + 4);
#pragma unroll
          for (int e = 0; e < 4; ++e) { const int j = j8 * 8 + e; pv[e] = (lane >= j) ? c0[e] * __expf(gi - g0[e]) : 0.f; pv[4 + e] = (lane >= j + 4) ? c1[e] * __expf(gi - g1[e]) : 0.f; }
          u32x4 o; o.x = pk2(pv[0], pv[1]); o.y = pk2(pv[2], pv[3]); o.z = pk2(pv[4], pv[5]); o.w = pk2(pv[6], pv[7]);
          *(u32x4*)(pg + j8 * 8) = o; } }
}

#define SSD_SETB 73728
DI void ssd_scan_step(const Ctx& F, f32x4 (&S)[2][8], int set, int ci, int d, int len, int row0, int head0, bf16* OUT) {
    const int pq = F.wave;
    int lane = F.lane; asm volatile("" : "+v"(lane)); const int l15 = lane & 15, q4 = lane >> 4;
    LAS unsigned char* base = F.lds + set * SSD_SETB;
    LAS bf16* C = (LAS bf16*)base; LAS bf16* BT = (LAS bf16*)(base + 17408); LAS bf16* PH = (LAS bf16*)(base + 35840); LAS bf16* VT = (LAS bf16*)(base + 54272);
    LAS float* GC = (LAS float*)(base + 72704);
#define LC(dst, it) do { _Pragma("unroll") for (int i_ = 0; i_ < 4; ++i_) dst[i_] = frag_perm(C, LDQ, (it) * 16, i_ * 32, lane); SCHED_FENCE(); } while (0)
#define LP(dst, it) do { _Pragma("unroll") for (int i_ = 0; i_ < 4; ++i_) dst[i_] = frag_nat(PH + (i_ >> 1) * 4608, LDT, (it) * 16, (i_ & 1) * 32, lane); SCHED_FENCE(); } while (0)
#define LB(dst, t0) do { _Pragma("unroll") for (int i_ = 0; i_ < 4; ++i_) dst[i_] = frag_nat(BT, LDT, ((t0) + (i_ >> 1)) * 16, (i_ & 1) * 32, lane); SCHED_FENCE(); } while (0)
#define CY(X, it) do { y[0] = (f32x4){0.f, 0.f, 0.f, 0.f}; y[1] = y[0]; _Pragma("unroll") for (int ks = 0; ks < 4; ++ks) { y[0] = MFMA16(Sp[0][ks], X[ks], y[0]); y[1] = MFMA16(Sp[1][ks], X[ks], y[1]); } \
        y[0] = y[0] * __expf(GC[(it) * 16 + l15]); y[1] = y[1] * __expf(GC[64 + (it) * 16 + l15]); SCHED_FENCE(); } while (0)
#define CP(X, it) do { _Pragma("unroll") for (int ks = 0; ks < 2; ++ks) { y[0] = MFMA16(VF[0][ks], X[ks], y[0]); y[1] = MFMA16(VF[1][ks], X[2 + ks], y[1]); } \
        { const int i = (it) * 16 + l15; const int tl = ci * 64 + i, t = d ? (len - 1 - tl) : tl; bf16* op = OUT + (size_t)(row0 + t) * 2048 + head0 * 64 + 16 * pq + 4 * q4; \
          u32x2 w2; w2.x = pk2(y[0][0], y[0][1]); w2.y = pk2(y[0][2], y[0][3]); *(u32x2*)op = w2; w2.x = pk2(y[1][0], y[1][1]); w2.y = pk2(y[1][2], y[1][3]); *(u32x2*)(op + 64) = w2; } SCHED_FENCE(); } while (0)
#define CS(X, t0) do { _Pragma("unroll") for (int ks = 0; ks < 2; ++ks) _Pragma("unroll") for (int j = 0; j < 2; ++j) { S[0][(t0) + j] = MFMA16(X[j * 2 + ks], V2[0][ks], S[0][(t0) + j]); S[1][(t0) + j] = MFMA16(X[j * 2 + ks], V2[1][ks], S[1][(t0) + j]); } SCHED_FENCE(); } while (0)
    bf16x8 X0[4], X1[4], X2[4];
    bf16x8 VF[2][2];
#pragma unroll
    for (int x = 0; x < 2; ++x)
#pragma unroll
        for (int ks = 0; ks < 2; ++ks) VF[x][ks] = frag_nat(VT + x * 4608, LDT, 16 * pq, ks * 32, lane);
    const float gl0 = GC[63], gl1 = GC[127];
    LC(X0, 0); LP(X1, 0);
    bf16x8 Sp[2][4];
#pragma unroll
    for (int x = 0; x < 2; ++x)
#pragma unroll
        for (int ks = 0; ks < 4; ++ks) Sp[x][ks] = pack2(S[x][2 * ks], S[x][2 * ks + 1]);
    bf16x8 V2[2][2];
#pragma unroll
    for (int x = 0; x < 2; ++x) { const float gl = x ? gl1 : gl0;
#pragma unroll
        for (int ks = 0; ks < 2; ++ks) { float f[8]; unpack8(__builtin_bit_cast(u32x4, VF[x][ks]), f);
            const f32x4 g0 = *(const LAS f32x4*)(GC + x * 64 + ks * 32 + 8 * q4), g1 = *(const LAS f32x4*)(GC + x * 64 + ks * 32 + 8 * q4 + 4);
            u32x4 w; w.x = pk2(f[0] * __expf(gl - g0[0]), f[1] * __expf(gl - g0[1])); w.y = pk2(f[2] * __expf(gl - g0[2]), f[3] * __expf(gl - g0[3]));
            w.z = pk2(f[4] * __expf(gl - g1[0]), f[5] * __expf(gl - g1[1])); w.w = pk2(f[6] * __expf(gl - g1[2]), f[7] * __expf(gl - g1[3]));
            V2[x][ks] = __builtin_bit_cast(bf16x8, w); } }
    const float egl0 = __expf(gl0), egl1 = __expf(gl1);
    SCHED_FENCE();
    f32x4 y[2];
    LC(X2, 1); CY(X0, 0);
    LP(X0, 1); CP(X1, 0);
    LC(X1, 2); CY(X2, 1);
    LP(X2, 2); CP(X0, 1);
    LC(X0, 3); CY(X1, 2);
    LP(X1, 3); CP(X2, 2);
    LB(X2, 0); CY(X0, 3);
    LB(X0, 2); CP(X1, 3);
#pragma unroll
    for (int t = 0; t < 8; ++t) { S[0][t] = S[0][t] * egl0; S[1][t] = S[1][t] * egl1; }
    SCHED_FENCE();
    LB(X1, 4); CS(X2, 0);
    LB(X2, 6); CS(X0, 2);
    CS(X1, 4); CS(X2, 6);
#undef LC
#undef LP
#undef LB
#undef CY
#undef CP
#undef CS
}
DI void ssd_scan_item(const Ctx& F, const float* const* in, int s, int g, int d, int hp) {
    constexpr int SETB = SSD_SETB;
    const int row0 = seq_row0(s), len = seq_len(s), nch = len >> 6, c640 = row0 >> 6;
    const int lane_o = F.lane, wave = F.wave;
    const int head0 = g * 4 + hp * 2;
    bf16* OUT = (bf16*)(F.ws + (d ? WS_OBB : WS_OFB));
    const bf16* SCN = (const bf16*)(F.ws + WS_SCN); const bf16* SBT = (const bf16*)(F.ws + WS_SBT) + (size_t)g * 128 * NROWS;
    const bf16* SVT = (const bf16*)(F.ws + WS_SVT); const bf16* SSP = (const bf16*)(F.ws + WS_SSP); const float* SSG = (const float*)(F.ws + WS_SSG);
    LDSBAR();
    if (wave >= 4) {
        struct Pre { u32x4 c[4], b[4], p[4], v[4]; float g; };
        Pre PA, PB_;
        const int e = F.tid - 256, er = e >> 2, eq = e & 3;
#define REV8(w_) ((u32x4){((w_).w >> 16) | ((w_).w << 16), ((w_).z >> 16) | ((w_).z << 16), ((w_).y >> 16) | ((w_).y << 16), ((w_).x >> 16) | ((w_).x << 16)})
#define SSD_ISSUE(ci_, P_) do { const int cc = c640 + (d ? nch - 1 - (ci_) : (ci_)); \
        const int crow = cc * 64 + (d ? 63 - er : er); const u32x4* csrc = (const u32x4*)(SCN + (size_t)crow * 1024 + g * 128 + eq * 32); \
        _Pragma("unroll") for (int m_ = 0; m_ < 4; ++m_) P_.c[m_] = csrc[m_]; \
        const u32x4* b0src = (const u32x4*)(SBT + (size_t)er * NROWS + cc * 64 + eq * 16); const u32x4* b1src = (const u32x4*)(SBT + (size_t)(64 + er) * NROWS + cc * 64 + eq * 16); \
        P_.b[0] = b0src[0]; P_.b[1] = b0src[1]; P_.b[2] = b1src[0]; P_.b[3] = b1src[1]; \
        const size_t it0 = ((size_t)cc * 32 + head0) * 2 + d, it1 = it0 + 2; \
        const u32x4* p0src = (const u32x4*)(SSP + (it0 * 64 + er) * 64 + eq * 16); const u32x4* p1src = (const u32x4*)(SSP + (it1 * 64 + er) * 64 + eq * 16); \
        P_.p[0] = p0src[0]; P_.p[1] = p0src[1]; P_.p[2] = p1src[0]; P_.p[3] = p1src[1]; \
        const u32x4* v0src = (const u32x4*)(SVT + ((size_t)(head0 * 2 + d) * 64 + er) * NROWS + cc * 64 + eq * 16); const u32x4* v1src = (const u32x4*)(SVT + ((size_t)((head0 + 1) * 2 + d) * 64 + er) * NROWS + cc * 64 + eq * 16); \
        P_.v[0] = v0src[0]; P_.v[1] = v0src[1]; P_.v[2] = v1src[0]; P_.v[3] = v1src[1]; \
        P_.g = 0.f; if (e < 128) P_.g = SSG[((e < 64) ? it0 : it1) * 64 + (e & 63)]; } while (0)
#define SSD_COMMIT(set_, P_) do { LAS unsigned char* base = F.lds + (set_) * SETB; \
        _Pragma("unroll") for (int m_ = 0; m_ < 4; ++m_) *(LAS u32x4*)((LAS bf16*)base + er * LDQ + eq * 32 + m_ * 8) = P_.c[m_]; \
        *(LAS u32x4*)((LAS bf16*)(base + 35840) + er * LDT + eq * 16) = P_.p[0]; *(LAS u32x4*)((LAS bf16*)(base + 35840) + er * LDT + eq * 16 + 8) = P_.p[1]; \
        *(LAS u32x4*)((LAS bf16*)(base + 45056) + er * LDT + eq * 16) = P_.p[2]; *(LAS u32x4*)((LAS bf16*)(base + 45056) + er * LDT + eq * 16 + 8) = P_.p[3]; \
        if (d == 0) { *(LAS u32x4*)((LAS bf16*)(base + 17408) + er * LDT + eq * 16) = P_.b[0]; *(LAS u32x4*)((LAS bf16*)(base + 17408) + er * LDT + eq * 16 + 8) = P_.b[1]; \
            *(LAS u32x4*)((LAS bf16*)(base + 17408) + (64 + er) * LDT + eq * 16) = P_.b[2]; *(LAS u32x4*)((LAS bf16*)(base + 17408) + (64 + er) * LDT + eq * 16 + 8) = P_.b[3]; \
            *(LAS u32x4*)((LAS bf16*)(base + 54272) + er * LDT + eq * 16) = P_.v[0]; *(LAS u32x4*)((LAS bf16*)(base + 54272) + er * LDT + eq * 16 + 8) = P_.v[1]; \
            *(LAS u32x4*)((LAS bf16*)(base + 63488) + er * LDT + eq * 16) = P_.v[2]; *(LAS u32x4*)((LAS bf16*)(base + 63488) + er * LDT + eq * 16 + 8) = P_.v[3]; } \
        else { *(LAS u32x4*)((LAS bf16*)(base + 17408) + er * LDT + (3 - eq) * 16 + 8) = REV8(P_.b[0]); *(LAS u32x4*)((LAS bf16*)(base + 17408) + er * LDT + (3 - eq) * 16) = REV8(P_.b[1]); \
            *(LAS u32x4*)((LAS bf16*)(base + 17408) + (64 + er) * LDT + (3 - eq) * 16 + 8) = REV8(P_.b[2]); *(LAS u32x4*)((LAS bf16*)(base + 17408) + (64 + er) * LDT + (3 - eq) * 16) = REV8(P_.b[3]); \
            *(LAS u32x4*)((LAS bf16*)(base + 54272) + er * LDT + (3 - eq) * 16 + 8) = REV8(P_.v[0]); *(LAS u32x4*)((LAS bf16*)(base + 54272) + er * LDT + (3 - eq) * 16) = REV8(P_.v[1]); \
            *(LAS u32x4*)((LAS bf16*)(base + 63488) + er * LDT + (3 - eq) * 16 + 8) = REV8(P_.v[2]); *(LAS u32x4*)((LAS bf16*)(base + 63488) + er * LDT + (3 - eq) * 16) = REV8(P_.v[3]); } \
        if (e < 128) ((LAS float*)(base + 72704))[e] = P_.g; } while (0)
        SSD_ISSUE(0, PA); SSD_ISSUE(1, PB_);
#pragma unroll 1
        for (int ci = 0; ci < nch; ci += 2) {
            SSD_COMMIT(0, PA); LDSBAR(); if (ci + 2 < nch) SSD_ISSUE(ci + 2, PA);
            SSD_COMMIT(1, PB_); LDSBAR(); if (ci + 3 < nch) SSD_ISSUE(ci + 3, PB_); }
#undef SSD_ISSUE
#undef SSD_COMMIT
#undef REV8
    } else {
        const int pq = wave;
        f32x4 S[2][8];
        if (s >= 16) { int ln = lane_o; asm volatile("" : "+v"(ln)); const int l15 = ln & 15, q4 = ln >> 4;
#pragma unroll
            for (int x = 0; x < 2; ++x) { const float* sp = in[3] + ((size_t)((s - 16) * 2 + d) * 32 + head0 + x) * 8192;
#pragma unroll
                for (int t = 0; t < 8; ++t) S[x][t] = *(const f32x4*)(sp + (size_t)(16 * pq + l15) * 128 + 16 * t + 4 * q4); }
        } else {
#pragma unroll
            for (int x = 0; x < 2; ++x)
#pragma unroll
                for (int t = 0; t < 8; ++t) S[x][t] = (f32x4){0.f, 0.f, 0.f, 0.f}; }
#pragma unroll 1
        for (int ci = 0; ci < nch; ci += 2) { LDSBAR(); ssd_scan_step(F, S, 0, ci, d, len, row0, head0, OUT); LDSBAR(); ssd_scan_step(F, S, 1, ci + 1, d, len, row0, head0, OUT); }
        if (s < 16) { int ln = lane_o; asm volatile("" : "+v"(ln)); const int l15 = ln & 15, q4 = ln >> 4;
#pragma unroll
            for (int x = 0; x < 2; ++x) { float* sp = F.out + OUT_SS + ((size_t)(s * 2 + d) * 32 + head0 + x) * 8192;
#pragma unroll
                for (int t = 0; t < 8; ++t) *(f32x4*)(sp + (size_t)(16 * pq + l15) * 128 + 16 * t + 4 * q4) = S[x][t]; } }
    }
}

DI void phase_m0a(const Ctx& F, const float* const* in) {
    { int prev = -1; u32x4 rq_[6], rk_[6], rv_[6]; unsigned rgate = 0u; float gpar[2] = {0.f, 0.f};
      if (F.bid < 3072) gdn_prep_request(F, F.bid >> 4, F.bid & 15, rq_, rk_, rv_, rgate);
      for (int it = F.bid; it < 3072; it += F.G) { const int h = it & 15; const int nx = it + F.G;
          const int next_c64 = (nx < 3072 && (nx & 15) == h) ? (nx >> 4) : -1;
          gdn_prep_item(F, in, it >> 4, h, h != prev, rq_, rk_, rv_, rgate, gpar, next_c64);
          if (next_c64 < 0 && nx < 3072) gdn_prep_request(F, nx >> 4, nx & 15, rq_, rk_, rv_, rgate);
          prev = h; } }
    { int prev = -1; u32x4 rx0[6], rx1[6], rb_[6], rc_[6]; unsigned rdt = 0u; float spar[2] = {0.f, 0.f};
      if (F.bid < 1536) ssd_prep_request(F, F.bid >> 3, F.bid & 7, rx0, rx1, rb_, rc_, rdt);
#pragma unroll 1
      for (int it = F.bid; it < 1536; it += F.G) { const int g = it & 7; const int nx = it + F.G;
          ssd_prep_item(F, in, it >> 3, g, g != prev, rx0, rx1, rb_, rc_, rdt, spar, nx < 1536 ? (nx >> 3) : -1, nx & 7); prev = g; } }
}
DI int queue_grab(const Ctx& F, unsigned* head, int n) {
    volatile LAS int* slot = (volatile LAS int*)(F.lds + 163840 - 128);
    LDSBAR();
    if (F.tid == 0) *slot = (int)__hip_atomic_fetch_add(head, (unsigned)n, __ATOMIC_RELAXED, __HIP_MEMORY_SCOPE_AGENT);
    LDSBAR();
    return *slot;
}
DI void phase_m0(const Ctx& F, const float* const* in, int only = 0) {
    const int b = F.bid;
    const int nw = F.G > 128 ? F.G - 128 : F.G, w = F.G > 128 ? b - 128 : b;
    { int it = (F.G > 128 && b < 64) ? b : (F.G > 128 ? 64 + w : b); const int step = (F.G > 128 && b < 64) ? (1 << 20) : nw;
      if (!(F.G > 128 && b >= 64 && b < 128) && only != 2)
        for (; it < 64 + 512; it += step) { int s, h, d;
            if (it < 64) { s = 16 + (it >> 5); h = (it >> 1) & 15; d = it & 1; } else { const int k = it - 64; s = k >> 5; h = (k >> 1) & 15; d = k & 1; }
            gdn_scan_item(F, in, s, h, d); } }
    { int it = (F.G > 128 && b >= 64 && b < 128) ? b - 64 : (F.G > 128 ? 64 + w : b); const int step = (F.G > 128 && b >= 64 && b < 128) ? (1 << 20) : nw;
      if (!(F.G > 128 && b < 64) && only != 1)
        for (; it < 64 + 512; it += step) { int s, g, d, hp;
            if (it < 64) { s = 16 + (it >> 5); g = (it >> 2) & 7; d = (it >> 1) & 1; hp = it & 1; } else { const int k = it - 64; s = k >> 5; g = (k >> 2) & 7; d = (k >> 1) & 1; hp = k & 1; }
            ssd_scan_item(F, in, s, g, d, hp); } }
}
DI void phase_m0c(const Ctx& F, const float* const* in) {
    const int gw = F.bid * 8 + F.wave, NGW = F.G * 8, lane = F.lane;
    const bf16* U = (const bf16*)(F.ws + WS_U); bf16* MIX = (bf16*)(F.ws + WS_MIX);
    const bf16 *OFA = (const bf16*)(F.ws + WS_OFA), *OBA = (const bf16*)(F.ws + WS_OBA), *OFB = (const bf16*)(F.ws + WS_OFB), *OBB = (const bf16*)(F.ws + WS_OBB);
    for (int row = gw; row < NROWS; row += NGW) {
        const int len = row < 4096 ? 256 : 4096, t = row < 4096 ? (row & 255) : ((row - 4096) & 4095);
        const bf16* ur = U + (size_t)row * LD_EVEN;
        { const int hsub = lane >> 4, c8 = (lane & 15) * 8;
          const f32x4 gn0 = *(const f32x4*)(in[16] + c8), gn1 = *(const f32x4*)(in[16] + c8 + 4);
          u32x4 af[4], ab[4], az[4];
#pragma unroll
          for (int hq = 0; hq < 4; ++hq) { const size_t o = (size_t)row * 2048 + (hq * 4 + hsub) * 128 + c8;
              af[hq] = *(const u32x4*)(OFA + o); ab[hq] = *(const u32x4*)(OBA + o); az[hq] = *(const u32x4*)(ur + E_ZA + (hq * 4 + hsub) * 128 + c8); }
#pragma unroll
          for (int hq = 0; hq < 4; ++hq) { float x[8], y[8], z[8]; unpack8(af[hq], x); unpack8(ab[hq], y); unpack8(az[hq], z);
              float ss = 0.f;
#pragma unroll
              for (int e = 0; e < 8; ++e) { x[e] += y[e]; ss += x[e] * x[e]; }
              ss += __shfl_xor(ss, 1); ss += __shfl_xor(ss, 2); ss += __shfl_xor(ss, 4); ss += __shfl_xor(ss, 8);
              const float rn = __builtin_amdgcn_rsqf(ss * (1.0f / 128.0f) + EPS);
              u32x4 w; w.x = pk2(x[0] * rn * gn0[0] * siluf_(z[0]), x[1] * rn * gn0[1] * siluf_(z[1])); w.y = pk2(x[2] * rn * gn0[2] * siluf_(z[2]), x[3] * rn * gn0[3] * siluf_(z[3]));
              w.z = pk2(x[4] * rn * gn1[0] * siluf_(z[4]), x[5] * rn * gn1[1] * siluf_(z[5])); w.w = pk2(x[6] * rn * gn1[2] * siluf_(z[6]), x[7] * rn * gn1[3] * siluf_(z[7]));
              *(u32x4*)(MIX + (size_t)row * DM + (hq * 4 + hsub) * 128 + c8) = w; } }
        { const int gsub = lane >> 5, c8 = (lane & 31) * 8;
#pragma unroll 2
          for (int gq = 0; gq < 4; ++gq) { const int ch = (gq * 2 + gsub) * 256 + c8; const size_t o = (size_t)row * 2048 + ch;
              const u32x4 af = *(const u32x4*)(OFB + o), ab = *(const u32x4*)(OBB + o), x0 = *(const u32x4*)(ur + E_XBC + ch), zz = *(const u32x4*)(ur + E_ZB + ch);
              u32x4 xm = {0u, 0u, 0u, 0u}, xp = {0u, 0u, 0u, 0u};
              if (t > 0) xm = *(const u32x4*)(ur - LD_EVEN + E_XBC + ch);
              if (t + 1 < len) xp = *(const u32x4*)(ur + LD_EVEN + E_XBC + ch);
              const float dsk = in[20][ch >> 6];
              float a[8], bq[8], fm[8], f0[8], fp[8], zb[8], y[8]; unpack8(af, a); unpack8(ab, bq); unpack8(xm, fm); unpack8(x0, f0); unpack8(xp, fp); unpack8(zz, zb);
              float ss = 0.f;
#pragma unroll
              for (int e4 = 0; e4 < 2; ++e4) { const f32x4 w0 = *(const f32x4*)(in[17] + ch + 4 * e4), w1 = *(const f32x4*)(in[17] + 4096 + ch + 4 * e4), w2 = *(const f32x4*)(in[17] + 8192 + ch + 4 * e4);
#pragma unroll
                  for (int e = 0; e < 4; ++e) { const int k = 4 * e4 + e; const float xs = w0[e] * fm[k] + w1[e] * f0[k] + w2[e] * fp[k];
                      y[k] = (a[k] + bq[k] + dsk * siluf_(xs)) * siluf_(zb[k]); ss += y[k] * y[k]; } }
              ss += __shfl_xor(ss, 1); ss += __shfl_xor(ss, 2); ss += __shfl_xor(ss, 4); ss += __shfl_xor(ss, 8); ss += __shfl_xor(ss, 16);
              const float rn = __builtin_amdgcn_rsqf(ss * (1.0f / 256.0f) + EPS);
              const f32x4 g0 = *(const f32x4*)(in[21] + ch), g1 = *(const f32x4*)(in[21] + ch + 4);
              u32x4 w; w.x = pk2(y[0] * rn * g0[0], y[1] * rn * g0[1]); w.y = pk2(y[2] * rn * g0[2], y[3] * rn * g0[3]); w.z = pk2(y[4] * rn * g1[0], y[5] * rn * g1[1]); w.w = pk2(y[6] * rn * g1[2], y[7] * rn * g1[3]);
              *(u32x4*)(MIX + (size_t)row * DM + 2048 + ch) = w; } }
    }
}
DI void gla_prep_all(const Ctx& F, const float* const* in) {
    LAS bf16* QS = (LAS bf16*)(F.lds + 0);
    LAS bf16* KS = (LAS bf16*)(F.lds + 17408);
    LAS bf16* KST = (LAS bf16*)(F.lds + 34816);
    LAS bf16* VT = (LAS bf16*)(F.lds + 53248);
    LAS float* GL = (LAS float*)(F.lds + 71680);
    LAS float* PART = GL + 128;
    LAS bf16* RF0 = (LAS bf16*)(F.lds + 74240);
    LAS bf16* RF1 = (LAS bf16*)(F.lds + 91648);
    LAS bf16* RQ = (LAS bf16*)(F.lds + 109056);
    LAS bf16* RV = (LAS bf16*)(F.lds + 126464);
    const bf16* U = (const bf16*)(F.ws + WS_U);
    const int lane_o = F.lane, wave = F.wave;
    const int kch = F.tid & 127, qtr = F.tid >> 7;
    const int er = F.tid >> 3, ep = F.tid & 7;
    u32x4 pr[8];
#define GLA_PRE(it_) do { const bf16* ur_ = U + (size_t)(((it_) >> 4) * 64 + er) * IN_ODD + ((it_) & 15) * 128 + ep * 16; \
        const u32x4* a_ = (const u32x4*)(ur_ + O_Q); const u32x4* b_ = (const u32x4*)(ur_ + O_I); const u32x4* c_ = (const u32x4*)(ur_ + O_F); const u32x4* d_ = (const u32x4*)(ur_ + O_F + 2048); \
        pr[0] = a_[0]; pr[1] = a_[1]; pr[2] = b_[0]; pr[3] = b_[1]; pr[4] = c_[0]; pr[5] = c_[1]; pr[6] = d_[0]; pr[7] = d_[1]; } while (0)
    float lbv[2] = {0.f, 0.f}; int lb_h = -1;
    int it = F.bid;
    if (it < 3072) GLA_PRE(it);
#pragma unroll 1
  for (; it < 3072; it += F.G) {
    const int c64 = it >> 4, h = it & 15, r0 = c64 * 64;
    if (h != lb_h) { lb_h = h;
#pragma unroll
        for (int d = 0; d < 2; ++d) lbv[d] = 1.0f / (1.0f + expf(in[31][4096 + d * 2048 + h * 128 + kch] - in[31][d * 2048 + h * 128 + kch])); }
    LDSBAR();
    *(LAS u32x4*)(RQ + er * LDQ + ep * 16) = pr[0]; *(LAS u32x4*)(RQ + er * LDQ + ep * 16 + 8) = pr[1];
    *(LAS u32x4*)(RV + er * LDQ + ep * 16) = pr[2]; *(LAS u32x4*)(RV + er * LDQ + ep * 16 + 8) = pr[3];
    *(LAS u32x4*)(RF0 + er * LDQ + ep * 16) = pr[4]; *(LAS u32x4*)(RF0 + er * LDQ + ep * 16 + 8) = pr[5];
    *(LAS u32x4*)(RF1 + er * LDQ + ep * 16) = pr[6]; *(LAS u32x4*)(RF1 + er * LDQ + ep * 16 + 8) = pr[7];
    if (it + F.G < 3072) GLA_PRE(it + F.G);
    float sq[16];
#pragma unroll 1
    for (int d = 0; d < 2; ++d) {
        const size_t item = ((size_t)c64 * 16 + h) * 2 + d;
        LAS bf16* RF = d ? RF1 : RF0;
        int lane = lane_o; asm volatile("" : "+v"(lane)); const int l15 = lane & 15, q4 = lane >> 4;
        const float lb = d ? lbv[1] : lbv[0];
        LDSBAR();
#ifndef PROBE_GE
#define PROBE_GE 1
#endif
#pragma unroll 1
        for (int rp_ = 0; rp_ < PROBE_GE; ++rp_)
        { const int sqt = d ? 3 - qtr : qtr;
          float pr_[16], kk[16]; float run = 1.f;
#pragma unroll
          for (int ii = 0; ii < 16; ++ii) { const int i = 16 * sqt + ii, tok = d ? 63 - i : i;
              const float fr = bf2f(RF[tok * LDQ + kch]);
              const float f = lb + (1.0f - lb) * sigmoidf_(fr); kk[ii] = 1.0f - f; run *= f; pr_[ii] = run; }
          PART[sqt * 128 + kch] = run;
          if (d == 0) {
#pragma unroll
              for (int ii = 0; ii < 16; ++ii) { const int i = 16 * qtr + ii; sq[ii] = siluf_(bf2f(RQ[i * LDQ + kch])) * 0.08838834764831845f; } }
          LDSBAR();
          float off = 1.f, tot = 1.f;
#pragma unroll
          for (int qq = 0; qq < 4; ++qq) { const float pq = PART[qq * 128 + kch]; if (qq < sqt) off *= pq; tot *= pq; }
          if (qtr == 0) ((float*)(F.ws + WS_LGL))[item * 128 + kch] = __logf(tot);
          unsigned kp[8], vp[8];
          float kvs[16];
          { float inv = __builtin_amdgcn_rcpf(off * pr_[15]);
#pragma unroll
            for (int ii = 15; ii >= 0; --ii) { kvs[ii] = kk[ii] * inv; inv *= 1.0f - kk[ii]; } }
#pragma unroll
          for (int ii = 0; ii < 16; ++ii) { const int i = 16 * sqt + ii, tok = d ? 63 - i : i;
              const float eg = off * pr_[ii];
              const float qv = (d ? sq[15 - ii] : sq[ii]) * eg;
              const float kv = kvs[ii];
              QS[i * LDQ + kch] = f2bf(qv); const bf16 kb = f2bf(kv); KS[i * LDQ + kch] = kb;
              if (ii & 1) kp[ii >> 1] |= (unsigned)kb << 16; else kp[ii >> 1] = kb;
              if (d == 0) { const unsigned vb = RV[tok * LDQ + kch]; if (ii & 1) vp[ii >> 1] |= vb << 16; else vp[ii >> 1] = vb; } }
          *(LAS u32x4*)(KST + kch * LDT + 16 * sqt) = (u32x4){kp[0], kp[1], kp[2], kp[3]}; *(LAS u32x4*)(KST + kch * LDT + 16 * sqt + 8) = (u32x4){kp[4], kp[5], kp[6], kp[7]};
          if (d == 0) { *(LAS u32x4*)(VT + kch * LDT + 16 * qtr) = (u32x4){vp[0], vp[1], vp[2], vp[3]}; *(LAS u32x4*)(VT + kch * LDT + 16 * qtr + 8) = (u32x4){vp[4], vp[5], vp[6], vp[7]}; } }
        LDSBAR();
#ifndef PROBE_GA
#define PROBE_GA 1
#endif
#pragma unroll 1
        for (int rq_ = 0; rq_ < PROBE_GA; ++rq_) {
#pragma unroll
        for (int tt = 0; tt < 2; ++tt) { const int id = 2 * wave + tt, ti = id >> 2, tj = id & 3;
            f32x4 a = {0.f, 0.f, 0.f, 0.f};
#pragma unroll
            for (int ks = 0; ks < 4; ++ks) a = MFMA16(frag_nat(KS, LDQ, tj * 16, ks * 32, lane), frag_nat(QS, LDQ, ti * 16, ks * 32, lane), a);
            const int i = ti * 16 + l15; float pv[4];
#pragma unroll
            for (int r = 0; r < 4; ++r) { const int j = tj * 16 + 4 * q4 + r; pv[r] = (i >= j) ? a[r] : 0.f; }
            u32x2 w2; w2.x = pk2(pv[0], pv[1]); w2.y = pk2(pv[2], pv[3]);
            *(u32x2*)((bf16*)(F.ws + WS_LAT) + (item * 64 + i) * 64 + tj * 16 + 4 * q4) = w2; }
        { bf16* qg = (bf16*)(F.ws + WS_LQS) + item * 8192; bf16* kg = (bf16*)(F.ws + WS_LKS) + item * 8192;
#pragma unroll
          for (int k = 0; k < 2; ++k) { const int e = F.tid + 512 * k;
              { const int row = e >> 4, pc = e & 15; *(u32x4*)(qg + row * 128 + pc * 8) = *(const LAS u32x4*)(QS + row * LDQ + pc * 8); }
              { const int row = e >> 3, pc = e & 7; *(u32x4*)(kg + row * 64 + pc * 8) = *(const LAS u32x4*)(KST + row * LDT + pc * 8);
                if (d == 0) *(u32x4*)((bf16*)(F.ws + WS_LVT) + ((size_t)h * 128 + row) * NROWS + r0 + pc * 8) = *(const LAS u32x4*)(VT + row * LDT + pc * 8); } } }
        }
    }
  }
#undef GLA_PRE
}

#define GLA_SETB 64000
DI void gla_scan_step(const Ctx& F, f32x4 (&S)[2][8], int set, int ci, int d, int len, int row0, int h, bf16* OUT) {
    const int wave = F.wave;
    int lane = F.lane; asm volatile("" : "+v"(lane)); const int l15 = lane & 15, q4 = lane >> 4;
    LAS unsigned char* base = F.lds + set * GLA_SETB;
    LAS bf16* QS = (LAS bf16*)base; LAS bf16* KST = (LAS bf16*)(base + 17408); LAS bf16* ATT = (LAS bf16*)(base + 35840); LAS bf16* VT = (LAS bf16*)(base + 45056); LAS float* GL = (LAS float*)(base + 63488);
#define LQ(dst, it) do { _Pragma("unroll") for (int i_ = 0; i_ < 4; ++i_) dst[i_] = frag_perm(QS, LDQ, (it) * 16, i_ * 32, lane); SCHED_FENCE(); } while (0)
#define LT(dst, M, t0) do { _Pragma("unroll") for (int i_ = 0; i_ < 4; ++i_) dst[i_] = frag_nat(M, LDT, ((t0) + (i_ >> 1)) * 16, (i_ & 1) * 32, lane); SCHED_FENCE(); } while (0)
#define CO(X, j) do { _Pragma("unroll") for (int ks = 0; ks < 4; ++ks) { o[0][j] = MFMA16(Sp[0][ks], X[ks], o[0][j]); o[1][j] = MFMA16(Sp[1][ks], X[ks], o[1][j]); } SCHED_FENCE(); } while (0)
#define CA(X, it0) do { _Pragma("unroll") for (int ks = 0; ks < 2; ++ks) _Pragma("unroll") for (int j = 0; j < 2; ++j) { o[0][j] = MFMA16(VF[0][ks], X[j * 2 + ks], o[0][j]); o[1][j] = MFMA16(VF[1][ks], X[j * 2 + ks], o[1][j]); } \
        _Pragma("unroll") for (int j = 0; j < 2; ++j) { const int i = ((it0) + j) * 16 + l15; const int tl = ci * 64 + i, t = d ? (len - 1 - tl) : tl; bf16* op = OUT + (size_t)(row0 + t) * 2048 + h * 128 + 32 * wave + 4 * q4; \
            u32x2 w2; w2.x = pk2(o[0][j][0], o[0][j][1]); w2.y = pk2(o[0][j][2], o[0][j][3]); *(u32x2*)op = w2; w2.x = pk2(o[1][j][0], o[1][j][1]); w2.y = pk2(o[1][j][2], o[1][j][3]); *(u32x2*)(op + 16) = w2; \
            o[0][j] = (f32x4){0.f, 0.f, 0.f, 0.f}; o[1][j] = (f32x4){0.f, 0.f, 0.f, 0.f}; } SCHED_FENCE(); } while (0)
#define CS(X, t0) do { _Pragma("unroll") for (int ks = 0; ks < 2; ++ks) _Pragma("unroll") for (int j = 0; j < 2; ++j) { S[0][(t0) + j] = MFMA16(X[j * 2 + ks], VF[0][ks], S[0][(t0) + j]); S[1][(t0) + j] = MFMA16(X[j * 2 + ks], VF[1][ks], S[1][(t0) + j]); } SCHED_FENCE(); } while (0)
    bf16x8 X0[4], X1[4], X2[4];
    bf16x8 VF[2][2];
#pragma unroll
    for (int x = 0; x < 2; ++x)
#pragma unroll
        for (int ks = 0; ks < 2; ++ks) VF[x][ks] = frag_nat(VT, LDT, 16 * (2 * wave + x), ks * 32, lane);
    LQ(X0, 0); LQ(X1, 1);
    bf16x8 Sp[2][4];
#pragma unroll
    for (int x = 0; x < 2; ++x)
#pragma unroll
        for (int ks = 0; ks < 4; ++ks) Sp[x][ks] = pack2(S[x][2 * ks], S[x][2 * ks + 1]);
    f32x4 o[2][2];
#pragma unroll
    for (int x = 0; x < 2; ++x)
#pragma unroll
        for (int j = 0; j < 2; ++j) o[x][j] = (f32x4){0.f, 0.f, 0.f, 0.f};
    SCHED_FENCE();
    LT(X2, ATT, 0); CO(X0, 0);
    LQ(X0, 2); CO(X1, 1);
    LQ(X1, 3); CA(X2, 0);
    LT(X2, ATT, 2); CO(X0, 0);
    LT(X0, KST, 0); CO(X1, 1);
    LT(X1, KST, 2); CA(X2, 2);
    LT(X2, KST, 4); CS(X0, 0);
    LT(X0, KST, 6); CS(X1, 2);
    CS(X2, 4); CS(X0, 6);
#pragma unroll
    for (int t = 0; t < 8; ++t) { const f32x4 gl = *(const LAS f32x4*)(GL + 16 * t + 4 * q4);
#pragma unroll
        for (int r = 0; r < 4; ++r) { const float eg = __expf(gl[r]); S[0][t][r] *= eg; S[1][t][r] *= eg; } }
#undef LQ
#undef LT
#undef CO
#undef CA
#undef CS
}
DI void gla_scan_item(const Ctx& F, const float* const* in, int s, int h, int d) {
    constexpr int SETB = GLA_SETB;
    const int row0 = seq_row0(s), len = seq_len(s), nch = len >> 6, c640 = row0 >> 6;
    const int lane_o = F.lane, wave = F.wave;
    bf16* OUT = (bf16*)(F.ws + (d ? WS_OBA : WS_OFA));
    const bf16* LQS = (const bf16*)(F.ws + WS_LQS); const bf16* LKS = (const bf16*)(F.ws + WS_LKS); const bf16* LAT = (const bf16*)(F.ws + WS_LAT);
    const bf16* LVT = (const bf16*)(F.ws + WS_LVT) + (size_t)h * 128 * NROWS; const float* LGL = (const float*)(F.ws + WS_LGL);
    LDSBAR();
    if (wave >= 4) {
        struct Pre { u32x4 q[4], k[4], a[2], v[4]; float g; };
        Pre PA, PB_;
        const int e = F.tid - 256, er = e >> 2, eq = e & 3;
#define REV8(w_) ((u32x4){((w_).w >> 16) | ((w_).w << 16), ((w_).z >> 16) | ((w_).z << 16), ((w_).y >> 16) | ((w_).y << 16), ((w_).x >> 16) | ((w_).x << 16)})
#define GLA_ISSUE(ci_, P_) do { const int cc = c640 + (d ? nch - 1 - (ci_) : (ci_)); const size_t item = ((size_t)cc * 16 + h) * 2 + d; \
        const u32x4* qsrc = (const u32x4*)(LQS + item * 8192 + er * 128 + eq * 32); _Pragma("unroll") for (int m_ = 0; m_ < 4; ++m_) P_.q[m_] = qsrc[m_]; \
        const u32x4* k0src = (const u32x4*)(LKS + item * 8192 + er * 64 + eq * 16); const u32x4* k1src = (const u32x4*)(LKS + item * 8192 + (64 + er) * 64 + eq * 16); \
        P_.k[0] = k0src[0]; P_.k[1] = k0src[1]; P_.k[2] = k1src[0]; P_.k[3] = k1src[1]; \
        const u32x4* asrc = (const u32x4*)(LAT + item * 4096 + er * 64 + eq * 16); P_.a[0] = asrc[0]; P_.a[1] = asrc[1]; \
        const u32x4* v0src = (const u32x4*)(LVT + (size_t)er * NROWS + cc * 64 + eq * 16); const u32x4* v1src = (const u32x4*)(LVT + (size_t)(64 + er) * NROWS + cc * 64 + eq * 16); \
        P_.v[0] = v0src[0]; P_.v[1] = v0src[1]; P_.v[2] = v1src[0]; P_.v[3] = v1src[1]; \
        P_.g = 0.f; if (e < 128) P_.g = LGL[item * 128 + e]; } while (0)
#define GLA_COMMIT(set_, P_) do { LAS unsigned char* base = F.lds + (set_) * SETB; \
        _Pragma("unroll") for (int m_ = 0; m_ < 4; ++m_) *(LAS u32x4*)((LAS bf16*)base + er * LDQ + eq * 32 + m_ * 8) = P_.q[m_]; \
        *(LAS u32x4*)((LAS bf16*)(base + 17408) + er * LDT + eq * 16) = P_.k[0]; *(LAS u32x4*)((LAS bf16*)(base + 17408) + er * LDT + eq * 16 + 8) = P_.k[1]; \
        *(LAS u32x4*)((LAS bf16*)(base + 17408) + (64 + er) * LDT + eq * 16) = P_.k[2]; *(LAS u32x4*)((LAS bf16*)(base + 17408) + (64 + er) * LDT + eq * 16 + 8) = P_.k[3]; \
        *(LAS u32x4*)((LAS bf16*)(base + 35840) + er * LDT + eq * 16) = P_.a[0]; *(LAS u32x4*)((LAS bf16*)(base + 35840) + er * LDT + eq * 16 + 8) = P_.a[1]; \
        if (d == 0) { *(LAS u32x4*)((LAS bf16*)(base + 45056) + er * LDT + eq * 16) = P_.v[0]; *(LAS u32x4*)((LAS bf16*)(base + 45056) + er * LDT + eq * 16 + 8) = P_.v[1]; \
            *(LAS u32x4*)((LAS bf16*)(base + 45056) + (64 + er) * LDT + eq * 16) = P_.v[2]; *(LAS u32x4*)((LAS bf16*)(base + 45056) + (64 + er) * LDT + eq * 16 + 8) = P_.v[3]; } \
        else { *(LAS u32x4*)((LAS bf16*)(base + 45056) + er * LDT + (3 - eq) * 16 + 8) = REV8(P_.v[0]); *(LAS u32x4*)((LAS bf16*)(base + 45056) + er * LDT + (3 - eq) * 16) = REV8(P_.v[1]); \
            *(LAS u32x4*)((LAS bf16*)(base + 45056) + (64 + er) * LDT + (3 - eq) * 16 + 8) = REV8(P_.v[2]); *(LAS u32x4*)((LAS bf16*)(base + 45056) + (64 + er) * LDT + (3 - eq) * 16) = REV8(P_.v[3]); } \
        if (e < 128) ((LAS float*)(base + 63488))[e] = P_.g; } while (0)
        GLA_ISSUE(0, PA); GLA_ISSUE(1, PB_);
#pragma unroll 1
        for (int ci = 0; ci < nch; ci += 2) {
            GLA_COMMIT(0, PA); LDSBAR(); if (ci + 2 < nch) GLA_ISSUE(ci + 2, PA);
            GLA_COMMIT(1, PB_); LDSBAR(); if (ci + 3 < nch) GLA_ISSUE(ci + 3, PB_); }
#undef GLA_ISSUE
#undef GLA_COMMIT
#undef REV8
    } else {
        f32x4 S[2][8];
        if (s >= 16) { int ln = lane_o; asm volatile("" : "+v"(ln)); const int l15 = ln & 15, q4 = ln >> 4; const float* sp = in[4] + ((size_t)((s - 16) * 2 + d) * 16 + h) * 16384;
#pragma unroll
            for (int x = 0; x < 2; ++x)
#pragma unroll
                for (int t = 0; t < 8; ++t)
#pragma unroll
                    for (int r = 0; r < 4; ++r) S[x][t][r] = sp[(size_t)(16 * t + 4 * q4 + r) * 128 + 32 * wave + 16 * x + l15];
        } else {
#pragma unroll
            for (int x = 0; x < 2; ++x)
#pragma unroll
                for (int t = 0; t < 8; ++t) S[x][t] = (f32x4){0.f, 0.f, 0.f, 0.f}; }
#pragma unroll 1
        for (int ci = 0; ci < nch; ci += 2) { LDSBAR(); gla_scan_step(F, S, 0, ci, d, len, row0, h, OUT); LDSBAR(); gla_scan_step(F, S, 1, ci + 1, d, len, row0, h, OUT); }
        if (s < 16) { int ln = lane_o; asm volatile("" : "+v"(ln)); const int l15 = ln & 15, q4 = ln >> 4; float* sp = F.out + OUT_SH + ((size_t)(s * 2 + d) * 16 + h) * 16384;
#pragma unroll
            for (int x = 0; x < 2; ++x)
#pragma unroll
                for (int t = 0; t < 8; ++t)
#pragma unroll
                    for (int r = 0; r < 4; ++r) sp[(size_t)(16 * t + 4 * q4 + r) * 128 + 32 * wave + 16 * x + l15] = S[x][t][r]; }
    }
}

struct M1aRaw { u32x4 a[2], b[2], m[2], p[2]; };
DI void m1a_load(const Ctx& F, int item, M1aRaw& R) {
    const int tt = item >> 5, cb = item & 31, r0 = tt * 64, c0 = cb * 256;
    const bf16* U = (const bf16*)(F.ws + WS_U);
    const int cg = F.lane & 31;
    const int len = r0 < 4096 ? 256 : 4096, tbase = r0 < 4096 ? (r0 & 255) : ((r0 - 4096) & 4095);
    const int col = c0 + cg * 8;
#pragma unroll
    for (int itk = 0; itk < 2; ++itk) { const int tp = itk * 16 + F.wave * 2 + (F.lane >> 5);
        const int tl = 2 * tp, t = tbase + tl; const bf16* ur = U + (size_t)(r0 + tl) * IN_ODD + col;
        R.a[itk] = *(const u32x4*)ur; R.b[itk] = *(const u32x4*)(ur + IN_ODD);
        R.m[itk] = (u32x4){0u, 0u, 0u, 0u}; R.p[itk] = (u32x4){0u, 0u, 0u, 0u};
        if (col < 6144) { if (t > 0) R.m[itk] = *(const u32x4*)(ur - IN_ODD); if (t + 2 < len) R.p[itk] = *(const u32x4*)(ur + 2 * IN_ODD); } }
}
DI void m1a_item(const Ctx& F, const float* const* in, int item, M1aRaw& R, int next_item) {
    LAS unsigned* T = (LAS unsigned*)F.lds;
    const int tt = item >> 5, cb = item & 31, r0 = tt * 64, c0 = cb * 256;
    bf16* TB = (bf16*)(F.ws + WS_TB);
    const int cg = F.lane & 31;
    const int col = c0 + cg * 8;
#pragma unroll
    for (int itk = 0; itk < 2; ++itk) { const int tp = itk * 16 + F.wave * 2 + (F.lane >> 5);
        float xa[8], xb[8], oa[8], ob[8]; unpack8(R.a[itk], xa); unpack8(R.b[itk], xb);
        if (col < 6144) { float xm[8], xp[8]; unpack8(R.m[itk], xm); unpack8(R.p[itk], xp);
            const float* cw = in[23] + col;
#pragma unroll
            for (int e = 0; e < 8; ++e) { oa[e] = cw[e] * xm[e] + cw[6144 + e] * xa[e] + cw[12288 + e] * xb[e]; ob[e] = cw[e] * xa[e] + cw[6144 + e] * xb[e] + cw[12288 + e] * xp[e]; }
        } else {
#pragma unroll
            for (int e = 0; e < 8; ++e) { oa[e] = siluf_(xa[e]); ob[e] = siluf_(xb[e]); } }
#pragma unroll
        for (int e = 0; e < 8; ++e) T[(e * 32 + cg) * 33 + tp] = pk2(oa[e], ob[e]); }
    if (next_item >= 0) m1a_load(F, next_item, R);
    LDSBAR();
#pragma unroll
    for (int k = 0; k < 4; ++k) { const int e = F.tid + 512 * k, part = e & 7, chi = e >> 3;
        const int ch = (chi & 31) * 8 + (chi >> 5);
        const LAS unsigned* sp = T + chi * 33 + part * 4;
        u32x4 w; w.x = sp[0]; w.y = sp[1]; w.z = sp[2]; w.w = sp[3];
        *(u32x4*)(TB + (size_t)(c0 + ch) * NROWS + r0 + part * 8) = w; }
    LDSBAR();
}

DI f32x2 w16(int k) {
    switch (k & 7) {
        case 0: return (f32x2){1.0f, 0.0f};
        case 1: return (f32x2){0.9238795325112867f, -0.3826834323650898f};
        case 2: return (f32x2){0.7071067811865476f, -0.7071067811865476f};
        case 3: return (f32x2){0.3826834323650898f, -0.9238795325112867f};
        case 4: return (f32x2){0.0f, -1.0f};
        case 5: return (f32x2){-0.3826834323650898f, -0.9238795325112867f};
        case 6: return (f32x2){-0.7071067811865476f, -0.7071067811865476f};
        default: return (f32x2){-0.9238795325112867f, -0.3826834323650898f};
    }
}
DI f32x2 cmul(f32x2 a, f32x2 b) { return (f32x2){a[0] * b[0] - a[1] * b[1], a[0] * b[1] + a[1] * b[0]}; }
DI f32x2 cmulc(f32x2 a, f32x2 b) { return (f32x2){a[0] * b[0] + a[1] * b[1], a[1] * b[0] - a[0] * b[1]}; }
template <int LOGR, bool INV, bool UNIT = false> DI void fft_bfly(f32x2 (&x)[1 << LOGR], f32x2 w0) {
    constexpr int R = 1 << LOGR;
    f32x2 wj[LOGR];
    wj[0] = w0;
#pragma unroll
    for (int s = 1; s < LOGR; ++s) wj[s] = cmul(wj[s - 1], wj[s - 1]);
#pragma unroll
    for (int ss = 0; ss < LOGR; ++ss) { const int s = INV ? (LOGR - 1 - ss) : ss; const int hm = R >> (s + 1);
#pragma unroll
        for (int m = 0; m < R; ++m) { if (m & hm) continue; const int mm = m % hm;
            const int k16 = mm * (16 >> (LOGR - s));
            if (UNIT && k16 == 0) { const f32x2 a = x[m], b = x[m + hm]; x[m] = a + b; x[m + hm] = a - b; continue; }
            if (UNIT && k16 == 4) {
                if (!INV) { const f32x2 a = x[m], b = x[m + hm], d = a - b; x[m] = a + b; x[m + hm] = (f32x2){d[1], -d[0]}; }
                else { const f32x2 a = x[m], bb = x[m + hm], b = (f32x2){-bb[1], bb[0]}; x[m] = a + b; x[m + hm] = a - b; }
                continue; }
            f32x2 w;
            if (UNIT) w = w16(k16);
            else if (k16 == 0) w = wj[s];
            else if (k16 == 4) w = (f32x2){wj[s][1], -wj[s][0]};
            else w = cmul(wj[s], w16(k16));
            if (!INV) { const f32x2 a = x[m], b = x[m + hm]; x[m] = a + b; x[m + hm] = cmul(a - b, w); }
            else { const f32x2 a = x[m], b = cmulc(x[m + hm], w); x[m] = a + b; x[m + hm] = a - b; } } }
}
template <int LOGR, bool INV, int PADSH> DI void fft_group(LAS f32x2* buf, const LAS f32x2* TW, int B, int tws, int g) {
    constexpr int R = 1 << LOGR;
    const int stride = B >> LOGR, blk = g / stride, j = g - blk * stride;
    const int base = blk * B + j;
    LAS f32x2* p = buf + base + (base >> PADSH);
    const int pstride = stride >= (1 << PADSH) ? stride + (stride >> PADSH) : stride;
    f32x2 x[R];
#pragma unroll
    for (int m = 0; m < R; ++m) x[m] = p[m * pstride];
    fft_bfly<LOGR, INV>(x, TW[j * tws]);
#pragma unroll
    for (int m = 0; m < R; ++m) p[m * pstride] = x[m];
}
template <int LOGR, bool INV, int PADSH> DI void fft_group2(LAS f32x2* buf, const LAS f32x2* TW, int B, int tws, int g0, int g1) {
    constexpr int R = 1 << LOGR;
    const int stride = B >> LOGR, pstride = stride >= (1 << PADSH) ? stride + (stride >> PADSH) : stride;
    const int blk0 = g0 / stride, j0 = g0 - blk0 * stride, base0 = blk0 * B + j0;
    const int blk1 = g1 / stride, j1 = g1 - blk1 * stride, base1 = blk1 * B + j1;
    LAS f32x2* p0 = buf + base0 + (base0 >> PADSH); LAS f32x2* p1 = buf + base1 + (base1 >> PADSH);
    f32x2 xa[R], xb[R];
#pragma unroll
    for (int m = 0; m < R; ++m) xa[m] = p0[m * pstride];
#pragma unroll
    for (int m = 0; m < R; ++m) xb[m] = p1[m * pstride];
    const f32x2 wa = TW[j0 * tws], wb = TW[j1 * tws];
    SCHED_FENCE();
    fft_bfly<LOGR, INV>(xa, wa);
#pragma unroll
    for (int m = 0; m < R; ++m) p0[m * pstride] = xa[m];
    fft_bfly<LOGR, INV>(xb, wb);
#pragma unroll
    for (int m = 0; m < R; ++m) p1[m * pstride] = xb[m];
}
template <int PADSH> DI void fft_first8(LAS f32x2* buf, f32x2 w0, int N, int j, f32x2 i0, f32x2 i1, f32x2 i2, f32x2 i3) {
    const int stride = N >> 3, pstride = stride + (stride >> PADSH);
    f32x2 x[8] = {i0, i1, i2, i3, (f32x2){0.f, 0.f}, (f32x2){0.f, 0.f}, (f32x2){0.f, 0.f}, (f32x2){0.f, 0.f}};
    fft_bfly<3, false>(x, w0);
    LAS f32x2* p = buf + j + (j >> PADSH);
#pragma unroll
    for (int m = 0; m < 8; ++m) p[m * pstride] = x[m];
}
template <int PADSH> DI void fft_last8(const LAS f32x2* buf, f32x2 w0, int N, int j, f32x2& o0, f32x2& o1, f32x2& o2, f32x2& o3) {
    const int stride = N >> 3, pstride = stride + (stride >> PADSH);
    const LAS f32x2* p = buf + j + (j >> PADSH);
    f32x2 x[8];
#pragma unroll
    for (int m = 0; m < 8; ++m) x[m] = p[m * pstride];
    fft_bfly<3, true>(x, w0);
    o0 = x[0]; o1 = x[1]; o2 = x[2]; o3 = x[3];
}
#define PD4(i_) ((i_) + ((i_) >> 4))
#define PD3(i_) ((i_) + ((i_) >> 3))
template <bool INV> DI void fft8192(LAS f32x2* buf, const LAS f32x2* TW, int tid) {
    if (!INV) {
        fft_group2<3, false, 4>(buf, TW, 8192, 1, tid, tid + 512); LDSBAR();
        fft_group2<3, false, 4>(buf, TW, 1024, 8, tid, tid + 512); LDSBAR();
        fft_group2<3, false, 4>(buf, TW, 128, 64, tid, tid + 512); LDSBAR();
        fft_group<4, false, 4>(buf, TW, 16, 0, tid); LDSBAR();
    } else {
        fft_group<4, true, 4>(buf, TW, 16, 0, tid); LDSBAR();
        fft_group2<3, true, 4>(buf, TW, 128, 64, tid, tid + 512); LDSBAR();
        fft_group2<3, true, 4>(buf, TW, 1024, 8, tid, tid + 512); LDSBAR();
        fft_group2<3, true, 4>(buf, TW, 8192, 1, tid, tid + 512); LDSBAR();
    }
}
#define WSYNC() asm volatile("s_waitcnt lgkmcnt(0)" ::: "memory")
template <bool INV> DI void fft512(LAS f32x2* buf, const LAS f32x2* TW, int lane) {
    if (!INV) { fft_group<3, false, 3>(buf, TW, 512, 16, lane); WSYNC(); fft_group<3, false, 3>(buf, TW, 64, 128, lane); WSYNC(); fft_group<3, false, 3>(buf, TW, 8, 0, lane); WSYNC(); }
    else { fft_group<3, true, 3>(buf, TW, 8, 0, lane); WSYNC(); fft_group<3, true, 3>(buf, TW, 64, 128, lane); WSYNC(); fft_group<3, true, 3>(buf, TW, 512, 16, lane); WSYNC(); }
}
constexpr int LDS_TW = 139264;
DI void fft_table_init(const Ctx& F) { LAS f32x2* TW = (LAS f32x2*)(F.lds + LDS_TW);
    for (int j = F.tid; j < 1024; j += 512) { float sn, cs; sincospif(-2.0f * (float)j / 8192.0f, &sn, &cs); TW[j] = (f32x2){cs, sn}; }
    LDSBAR(); }
DI f32x2 filt_spec(f32x2 z1, f32x2 z2, int ord) { const float sg = ord ? -0.5f : 0.5f; const float ar = 0.5f * z1[0] + sg * z2[0], ai = 0.5f * z1[1] - sg * z2[1];
    return ord ? (f32x2){ai, -ar} : (f32x2){ar, ai}; }

template <int LOGR, int PADSH, int LOGN> DI void fft_mid(LAS f32x2* D, const LAS f32x2* HZ, int ord, int g) {
    constexpr int R = 1 << LOGR, N = 1 << LOGN;
    LAS f32x2* p = D + g * R + ((g * R) >> PADSH);
    f32x2 x[R];
#pragma unroll
    for (int m = 0; m < R; ++m) x[m] = p[m];
    fft_bfly<LOGR, false, true>(x, (f32x2){1.f, 0.f});
#pragma unroll
    for (int m = 0; m < R; ++m) { const int t = g * R + m; const int fq = (int)(__brev((unsigned)t) >> (32 - LOGN)), t2 = (int)(__brev((unsigned)((N - fq) & (N - 1))) >> (32 - LOGN));
        x[m] = cmul(x[m], filt_spec(HZ[t + (t >> PADSH)], HZ[t2 + (t2 >> PADSH)], ord)) * (1.0f / (float)N); }
    fft_bfly<LOGR, true, true>(x, (f32x2){1.f, 0.f});
#pragma unroll
    for (int m = 0; m < R; ++m) p[m] = x[m];
}
DI int hyena_dec_item(const Ctx& F, const float* const* in, int c, unsigned* qhead) {
    LAS f32x2* HB = (LAS f32x2*)F.lds;
    LAS f32x2* DB = HB + 8704;
    const LAS f32x2* TW = (const LAS f32x2*)(F.lds + LDS_TW);
    const bf16* TB = (const bf16*)(F.ws + WS_TB); bf16* YT = (bf16*)(F.ws + WS_YT);
    const float* HF = (const float*)(F.ws + WS_HF4096); const float* HN = (const float*)(F.ws + WS_HNRM) + 4096;
    const int tid_o = F.tid;
    int nxt_raw = 0;
    if (tid_o == 0) nxt_raw = (int)__hip_atomic_fetch_add(qhead, 1u, __ATOMIC_RELAXED, __HIP_MEMORY_SCOPE_AGENT);
    float va[8], vb[8];
#pragma unroll
    for (int k = 0; k < 8; ++k) { const int t = tid_o + 512 * k; va[k] = bf2f(TB[(size_t)c * NROWS + 4096 + t]); vb[k] = bf2f(TB[(size_t)c * NROWS + 8192 + t]); }
    { const float n0 = HN[c], n1 = HN[2048 + c]; const float* h0 = HF + (size_t)c * 8192; const float* h1 = HF + ((size_t)2048 + c) * 8192;
#pragma unroll 8
      for (int k = 0; k < 16; ++k) { const int t = tid_o + 512 * k; HB[PD4(t)] = (f32x2){h0[t] * n0, h1[t] * n1}; } }
    LDSBAR();
    fft8192<false>(HB, TW, tid_o);
#pragma unroll 1
    for (int ord = 0; ord < 2; ++ord) {
        int tid = tid_o; asm volatile("" : "+v"(tid));
        const size_t xoff = (size_t)((ord + 1) * 2048 + c) * NROWS, zoff = (size_t)(6144 + c) * NROWS;
        const float bias = in[30][ord * 2048 + c];
        bf16 rxa[8], rxb[8], rza[8], rzb[8];
#pragma unroll
        for (int k = 0; k < 8; ++k) { const int t = tid + 512 * k; rxa[k] = TB[xoff + 4096 + t]; rxb[k] = TB[xoff + 8192 + t];
            if (ord == 1) { rza[k] = TB[zoff + 4096 + t]; rzb[k] = TB[zoff + 8192 + t]; } else { rza[k] = 0; rzb[k] = 0; } }
        fft_first8<4>(DB, TW[tid], 8192, tid, (f32x2){va[0], vb[0]}, (f32x2){va[2], vb[2]}, (f32x2){va[4], vb[4]}, (f32x2){va[6], vb[6]});
        fft_first8<4>(DB, TW[tid + 512], 8192, tid + 512, (f32x2){va[1], vb[1]}, (f32x2){va[3], vb[3]}, (f32x2){va[5], vb[5]}, (f32x2){va[7], vb[7]});
        LDSBAR();
        fft_group2<3, false, 4>(DB, TW, 1024, 8, tid, tid + 512); LDSBAR();
        fft_group2<3, false, 4>(DB, TW, 128, 64, tid, tid + 512); LDSBAR();
        fft_mid<4, 4, 13>(DB, HB, ord, tid); LDSBAR();
        fft_group2<3, true, 4>(DB, TW, 128, 64, tid, tid + 512); LDSBAR();
        fft_group2<3, true, 4>(DB, TW, 1024, 8, tid, tid + 512); LDSBAR();
        f32x2 y[8];
        fft_last8<4>(DB, TW[tid], 8192, tid, y[0], y[2], y[4], y[6]);
        fft_last8<4>(DB, TW[tid + 512], 8192, tid + 512, y[1], y[3], y[5], y[7]);
#pragma unroll
        for (int k = 0; k < 8; ++k) { const int t = tid + 512 * k;
            va[k] = bf2f(rxa[k]) * (y[k][0] + bias * va[k]); vb[k] = bf2f(rxb[k]) * (y[k][1] + bias * vb[k]);
            if (ord == 1) { YT[(size_t)c * NROWS + 4096 + t] = f2bf(va[k] * bf2f(rza[k])); YT[(size_t)c * NROWS + 8192 + t] = f2bf(vb[k] * bf2f(rzb[k])); } }
    }
    volatile LAS int* slot = (volatile LAS int*)(F.lds + 163840 - 128);
    if (tid_o == 0) *slot = nxt_raw;
    LDSBAR();
    return *slot;
}
DI void hyena_ctx_item(const Ctx& F, const float* const* in, int c, int p0) {
    LAS f32x2* HZ = (LAS f32x2*)F.lds + F.wave * 1152;
    LAS f32x2* D = HZ + 576;
    const LAS f32x2* TW = (const LAS f32x2*)(F.lds + LDS_TW);
    const bf16* TB = (const bf16*)(F.ws + WS_TB); bf16* YT = (bf16*)(F.ws + WS_YT);
    const float* HF = (const float*)(F.ws + WS_HF256); const float* HN = (const float*)(F.ws + WS_HNRM);
    const int lane = F.lane;
    { const float n0 = HN[c], n1 = HN[2048 + c]; const float* h0 = HF + (size_t)c * 512; const float* h1 = HF + ((size_t)2048 + c) * 512;
#pragma unroll
      for (int k = 0; k < 8; ++k) { const int t = lane + 64 * k; HZ[PD3(t)] = (f32x2){h0[t] * n0, h1[t] * n1}; } }
    WSYNC();
    fft512<false>(HZ, TW, lane);
#pragma unroll 1
    for (int pp = p0; pp < p0 + 4; ++pp) { const int ra = (2 * pp) * 256, rb = (2 * pp + 1) * 256;
    float va[4], vb[4];
#pragma unroll
    for (int k = 0; k < 4; ++k) { const int t = lane + 64 * k; va[k] = bf2f(TB[(size_t)c * NROWS + ra + t]); vb[k] = bf2f(TB[(size_t)c * NROWS + rb + t]); }
#pragma unroll 1
    for (int ord = 0; ord < 2; ++ord) {
        const size_t xoff = (size_t)((ord + 1) * 2048 + c) * NROWS, zoff = (size_t)(6144 + c) * NROWS;
        const float bias = in[30][ord * 2048 + c];
        bf16 rxa[4], rxb[4], rza[4], rzb[4];
#pragma unroll
        for (int k = 0; k < 4; ++k) { const int t = lane + 64 * k; rxa[k] = TB[xoff + ra + t]; rxb[k] = TB[xoff + rb + t];
            if (ord == 1) { rza[k] = TB[zoff + ra + t]; rzb[k] = TB[zoff + rb + t]; } else { rza[k] = 0; rzb[k] = 0; } }
        fft_first8<3>(D, TW[lane * 16], 512, lane, (f32x2){va[0], vb[0]}, (f32x2){va[1], vb[1]}, (f32x2){va[2], vb[2]}, (f32x2){va[3], vb[3]}); WSYNC();
        fft_group<3, false, 3>(D, TW, 64, 128, lane); WSYNC();
        fft_mid<3, 3, 9>(D, HZ, ord, lane); WSYNC();
        fft_group<3, true, 3>(D, TW, 64, 128, lane); WSYNC();
        f32x2 y[4];
        fft_last8<3>(D, TW[lane * 16], 512, lane, y[0], y[1], y[2], y[3]);
#pragma unroll
        for (int k = 0; k < 4; ++k) { const int t = lane + 64 * k;
            va[k] = bf2f(rxa[k]) * (y[k][0] + bias * va[k]); vb[k] = bf2f(rxb[k]) * (y[k][1] + bias * vb[k]);
            if (ord == 1) { YT[(size_t)c * NROWS + ra + t] = f2bf(va[k] * bf2f(rza[k])); YT[(size_t)c * NROWS + rb + t] = f2bf(vb[k] * bf2f(rzb[k])); } }
        WSYNC();
    }
    }
}
DI void phase_m1a(const Ctx& F, const float* const* in) {
    { M1aRaw R; int it = F.bid; if (it < 192 * 32) m1a_load(F, it, R);
#pragma unroll 1
      for (; it < 192 * 32; it += F.G) m1a_item(F, in, it, R, it + F.G < 192 * 32 ? it + F.G : -1); }
    gla_prep_all(F, in);
}
DI void phase_m1b(const Ctx& F, const float* const* in, int pass = 0) {
    const int b = F.bid; unsigned* ctl = (unsigned*)(F.ws + WS_CTL) + pass * 1024;
    fft_table_init(F);
#ifndef P11_ONLY
#define P11_ONLY 0
#endif
    const int only = pass ? P11_ONLY : 0;
    if (b < 64 && (only == 0 || only == 1)) gla_scan_item(F, in, 16 + (b >> 5), (b >> 1) & 15, b & 1);
    if (only == 0 || only == 2) { int it = queue_grab(F, ctl + CW_Q0, 1);
#pragma unroll 1
        while (it < 2048) it = hyena_dec_item(F, in, it, ctl + CW_Q0); }
    if (only == 0 || only == 3) { int it = queue_grab(F, ctl + CW_Q1, 1);
#pragma unroll 1
        while (it < 512) { int nx = 0; if (F.tid == 0) nx = (int)__hip_atomic_fetch_add(ctl + CW_Q1, 1u, __ATOMIC_RELAXED, __HIP_MEMORY_SCOPE_AGENT);
            gla_scan_item(F, in, it >> 5, (it >> 1) & 15, it & 1);
            volatile LAS int* slot = (volatile LAS int*)(F.lds + 163840 - 128); LDSBAR(); if (F.tid == 0) *slot = nx; LDSBAR(); it = *slot; } }
    if (only == 0 || only == 4) { int g = queue_grab(F, ctl + CW_Q2, 1);
#pragma unroll 1
        while (g < 512) { int nx = 0; if (F.tid == 0) nx = (int)__hip_atomic_fetch_add(ctl + CW_Q2, 1u, __ATOMIC_RELAXED, __HIP_MEMORY_SCOPE_AGENT);
            hyena_ctx_item(F, in, (g >> 1) * 8 + F.wave, (g & 1) * 4);
            volatile LAS int* slot = (volatile LAS int*)(F.lds + 163840 - 128); LDSBAR(); if (F.tid == 0) *slot = nx; LDSBAR(); g = *slot; } }
}
DI void phase_m1c(const Ctx& F, const float* const* in) {
    const int gw = F.bid * 8 + F.wave, NGW = F.G * 8, lane = F.lane;
    const bf16* U = (const bf16*)(F.ws + WS_U); bf16* MIX = (bf16*)(F.ws + WS_MIX);
    const bf16 *OFA = (const bf16*)(F.ws + WS_OFA), *OBA = (const bf16*)(F.ws + WS_OBA);
    const int hsub = lane >> 4, c8 = (lane & 15) * 8;
    const f32x4 gn0 = *(const f32x4*)(in[32] + c8), gn1 = *(const f32x4*)(in[32] + c8 + 4);
    for (int row = gw; row < NROWS; row += NGW) { const bf16* ur = U + (size_t)row * IN_ODD;
        u32x4 af[4], ab[4], az[4];
#pragma unroll
        for (int hq = 0; hq < 4; ++hq) { const size_t o = (size_t)row * 2048 + (hq * 4 + hsub) * 128 + c8;
            af[hq] = *(const u32x4*)(OFA + o); ab[hq] = *(const u32x4*)(OBA + o); az[hq] = *(const u32x4*)(ur + O_ZD + (hq * 4 + hsub) * 128 + c8); }
#pragma unroll
        for (int hq = 0; hq < 4; ++hq) { float x[8], y[8], z[8]; unpack8(af[hq], x); unpack8(ab[hq], y); unpack8(az[hq], z);
            float ss = 0.f;
#pragma unroll
            for (int e = 0; e < 8; ++e) { x[e] += y[e]; ss += x[e] * x[e]; }
            ss += __shfl_xor(ss, 1); ss += __shfl_xor(ss, 2); ss += __shfl_xor(ss, 4); ss += __shfl_xor(ss, 8);
            const float rn = __builtin_amdgcn_rsqf(ss * (1.0f / 128.0f) + EPS);
            u32x4 w; w.x = pk2(x[0] * rn * gn0[0] * siluf_(z[0]), x[1] * rn * gn0[1] * siluf_(z[1])); w.y = pk2(x[2] * rn * gn0[2] * siluf_(z[2]), x[3] * rn * gn0[3] * siluf_(z[3]));
            w.z = pk2(x[4] * rn * gn1[0] * siluf_(z[4]), x[5] * rn * gn1[1] * siluf_(z[5])); w.w = pk2(x[6] * rn * gn1[2] * siluf_(z[6]), x[7] * rn * gn1[3] * siluf_(z[7]));
            *(u32x4*)(MIX + (size_t)row * DM + 2048 + (hq * 4 + hsub) * 128 + c8) = w; } }
    const bf16* YT = (const bf16*)(F.ws + WS_YT);
    LAS bf16* T = (LAS bf16*)(F.lds + F.wave * 8448);
    for (int it = gw; it < 32 * 192; it += NGW) { const int cb = it & 31, rbk = it >> 5, c0 = cb * 64, r0 = rbk * 64;
#pragma unroll
        for (int k = 0; k < 8; ++k) { const int ch = 8 * k + (lane >> 3); const u32x4 w = *(const u32x4*)(YT + (size_t)(c0 + ch) * NROWS + r0 + (lane & 7) * 8);
            LAS bf16* dp = T + ch * 66 + (lane & 7) * 8;
            dp[0] = (bf16)(w.x & 0xffffu); dp[1] = (bf16)(w.x >> 16); dp[2] = (bf16)(w.y & 0xffffu); dp[3] = (bf16)(w.y >> 16); dp[4] = (bf16)(w.z & 0xffffu); dp[5] = (bf16)(w.z >> 16); dp[6] = (bf16)(w.w & 0xffffu); dp[7] = (bf16)(w.w >> 16); }
        asm volatile("s_waitcnt lgkmcnt(0)" ::: "memory");
#pragma unroll
        for (int k = 0; k < 8; ++k) { const int rr = 8 * k + (lane >> 3), cc = (lane & 7) * 8;
            u32x4 w; w.x = (unsigned)T[(cc + 0) * 66 + rr] | ((unsigned)T[(cc + 1) * 66 + rr] << 16); w.y = (unsigned)T[(cc + 2) * 66 + rr] | ((unsigned)T[(cc + 3) * 66 + rr] << 16);
            w.z = (unsigned)T[(cc + 4) * 66 + rr] | ((unsigned)T[(cc + 5) * 66 + rr] << 16); w.w = (unsigned)T[(cc + 6) * 66 + rr] | ((unsigned)T[(cc + 7) * 66 + rr] << 16);
            *(u32x4*)(MIX + (size_t)(r0 + rr) * DM + c0 + cc) = w; }
        asm volatile("s_waitcnt lgkmcnt(0)" ::: "memory"); }
}
constexpr int NWAVES = 8, NTHREADS = 512;
constexpr int LDS_BYTES = 163840;
constexpr int LDS_MISC = LDS_BYTES - 64;
constexpr int N_PHASES = 14;
struct Args { const float* in[33]; float* out; unsigned char* ws; int ph_lo, ph_hi; };

__global__ void __launch_bounds__(NTHREADS, 2) mk_fwd(Args args) {
    extern __shared__ __attribute__((aligned(16))) unsigned char lds_raw[];
    Ctx F;
    F.lds = (LAS unsigned char*)lds_raw; F.in = nullptr; F.ws = args.ws; F.out = args.out;
    F.tid = threadIdx.x; F.lane = F.tid & 63; F.wave = __builtin_amdgcn_readfirstlane(F.tid >> 6); F.bid = blockIdx.x; F.G = gridDim.x;
    const float* const* in = args.in;
    volatile LAS unsigned* xbw = (volatile LAS unsigned*)(F.lds + LDS_MISC);
    if (F.tid < 4) xbw[F.tid] = 0u;
    __syncthreads();
    unsigned* ctl = (unsigned*)(args.ws + WS_CTL);
    XcdBarrier bar = xcd_barrier_post(ctl + CW_BAR, xbw);
    const int lo = args.ph_lo, hi = args.ph_hi;
#ifndef PHASE_MASK
#define PHASE_MASK 0xffffffffu
#endif
#define IN(k) (((PHASE_MASK >> (k)) & 1u) && lo <= (k) && (k) < hi)
#define SEAM(k) do { if (IN(k) && IN((k) + 1)) xcd_barrier(bar); } while (0)
#ifndef DUP_MASK
#define DUP_MASK 0u
#endif
#define DUP(k) (((DUP_MASK >> (k)) & 1u) != 0u)
    if (IN(0)) { phase_p0(F, in); if (DUP(0)) { xcd_barrier(bar); phase_p0(F, in); } }
    SEAM(0);
    if (IN(1)) { phase_p0c(F, in); if (DUP(1)) { xcd_barrier(bar); phase_p0c(F, in); } }
    SEAM(1);
    if (IN(2)) { phase_norm<0>(F, in); if (DUP(2)) { xcd_barrier(bar); phase_norm<0>(F, in); } }
    SEAM(2);
    if (IN(3)) { pg8::Gemm g{(const pg8::bf16_t*)(F.ws + WS_H), (const pg8::bf16_t*)(F.ws + WS_WTE), NROWS, LD_EVEN, DM}; pg8::StaticOrder S; S.init(NROWS, LD_EVEN, F.G, F.bid);
        pg8::EpiStoreBf16 E{(pg8::bf16_t*)(F.ws + WS_U), LD_EVEN};
        pg8::gemm_phase<pg8::EpiStoreBf16, pg8::StaticOrder, true, true>(F.lds, g, S, E);
        if (DUP(3)) { xcd_barrier(bar); pg8::gemm_phase<pg8::EpiStoreBf16, pg8::StaticOrder, true, true>(F.lds, g, S, E); }
        { constexpr int NU = (NROWS / 256) * (LD_EVEN / 256); const int nfull = NU % F.G;
          if (nfull > 0 && F.bid >= nfull) { convert_wout(F, in, F.bid - nfull, F.G - nfull, 0); convert_wodd(F, in, F.bid - nfull, F.G - nfull); } else if (nfull == 0) { convert_wout(F, in, F.bid, F.G, 0); convert_wodd(F, in, F.bid, F.G); } } }
    SEAM(3);
    if (IN(4)) { phase_m0a(F, in); if (DUP(4)) { xcd_barrier(bar); phase_m0a(F, in); } }
    SEAM(4);
#ifndef P5_ONLY
#define P5_ONLY 0
#endif
    if (IN(5)) { phase_m0(F, in); if (DUP(5)) { xcd_barrier(bar); phase_m0(F, in, P5_ONLY); } }
    SEAM(5);
    if (IN(6)) { phase_m0c(F, in); if (DUP(6)) { xcd_barrier(bar); phase_m0c(F, in); } }
    SEAM(6);
    if (IN(7)) { pg8::Gemm g{(const pg8::bf16_t*)(F.ws + WS_MIX), (const pg8::bf16_t*)(F.ws + WS_WTOUT), NROWS, DM, DM}; pg8::StaticOrder S; S.init(NROWS, DM, F.G, F.bid);
        pg8::EpiResGateBf16 E{(pg8::bf16_t*)xr_base(F), LDX, (const float*)(F.ws + WS_MODF) + (size_t)6 * 4096};
        pg8::gemm_phase<pg8::EpiResGateBf16, pg8::StaticOrder, true, true>(F.lds, g, S, E); }
    SEAM(7);
    if (IN(8)) { phase_norm<1>(F, in); if (DUP(8)) { xcd_barrier(bar); phase_norm<1>(F, in); } }
    SEAM(8);
    if (IN(9)) { pg8::Gemm g{(const pg8::bf16_t*)(F.ws + WS_H), (const pg8::bf16_t*)(F.ws + WS_WTO), NROWS, IN_ODD, DM}; pg8::StaticOrder S; S.init(NROWS, IN_ODD, F.G, F.bid);
        pg8::EpiStoreBf16 E{(pg8::bf16_t*)(F.ws + WS_U), IN_ODD};
        pg8::gemm_phase<pg8::EpiStoreBf16, pg8::StaticOrder, true, true>(F.lds, g, S, E);
        if (DUP(9)) { xcd_barrier(bar); pg8::gemm_phase<pg8::EpiStoreBf16, pg8::StaticOrder, true, true>(F.lds, g, S, E); }
        { constexpr int NU = (NROWS / 256) * (IN_ODD / 256); const int nfull = NU % F.G;
          if (nfull > 0 && F.bid >= nfull) { phase_filters(F, in, F.bid - nfull, F.G - nfull); convert_wout(F, in, F.bid - nfull, F.G - nfull, 1); } else if (nfull == 0) { phase_filters(F, in, F.bid, F.G); convert_wout(F, in, F.bid, F.G, 1); } } }
    SEAM(9);
    if (IN(10)) { phase_m1a(F, in); if (DUP(10)) { xcd_barrier(bar); phase_m1a(F, in); } }
    SEAM(10);
    if (IN(11)) { phase_m1b(F, in); if (DUP(11)) { xcd_barrier(bar); phase_m1b(F, in, 1); } }
    SEAM(11);
    if (IN(12)) { phase_m1c(F, in); if (DUP(12)) { xcd_barrier(bar); phase_m1c(F, in); } }
    SEAM(12);
    if (IN(13)) { pg8::Gemm g{(const pg8::bf16_t*)(F.ws + WS_MIX), (const pg8::bf16_t*)(F.ws + WS_WTOUT) + (size_t)DM * DM, NROWS, DM, DM}; pg8::StaticOrder S; S.init(NROWS, DM, F.G, F.bid);
        pg8::EpiResGateBf16 E{(pg8::bf16_t*)xr_base(F), LDX, (const float*)(F.ws + WS_MODF) + (size_t)(9 + 6) * 4096};
        pg8::gemm_phase<pg8::EpiResGateBf16, pg8::StaticOrder, true, true>(F.lds, g, S, E); }
    SEAM(13);
    if (IN(14)) phase_norm<2>(F, in);
#ifdef DBG_DUMP
    xcd_barrier(bar);
#define DUMP_ONE(OOFF, ONEXT, PTR, NB, ISBF) do { const size_t no = (size_t)(ONEXT) - (size_t)(OOFF), nb = (NB); float* op = F.out + (OOFF); \
        for (size_t i = (size_t)F.bid * 512 + F.tid; i < no; i += (size_t)F.G * 512) { float acc = 0.f; \
            for (size_t j = i; j < nb; j += no) acc += (ISBF) ? bf2f(((const bf16*)(PTR))[j]) : ((const float*)(PTR))[j]; \
            op[i] = acc; } } while (0)
#if DBG_DUMP == 1
    DUMP_ONE(0, 16777216, F.ws + WS_H, (size_t)NROWS * DM, 1);
    DUMP_ONE(16777216, 50331648, F.ws + WS_U, (size_t)NROWS * LD_EVEN, 1);
    DUMP_ONE(50331648, 58720256, F.ws + WS_OFA, (size_t)2 * NROWS * 2048, 0);
    DUMP_ONE(58720256, 67108864, F.ws + WS_OFB, (size_t)2 * NROWS * 2048, 0);
    DUMP_ONE(67108864, 75497472, F.ws + WS_MIX, (size_t)NROWS * DM, 1);
#elif DBG_DUMP == 4
    DUMP_ONE(0, 16777216, F.ws + WS_OFA, (size_t)NROWS * 2048, 0);
    DUMP_ONE(16777216, 50331648, F.ws + WS_OBA, (size_t)NROWS * 2048, 0);
    DUMP_ONE(58720256, 67108864, F.ws + WS_H, (size_t)NROWS * DM, 1);
    DUMP_ONE(67108864, 75497472, F.ws + WS_H, (size_t)NROWS * DM, 1);
#elif DBG_DUMP == 7
    { unsigned fl = 0u; const float* pa = (const float*)(F.ws + WS_OFA); const float* pb = (const float*)(F.ws + WS_OBA); const float* ps = F.out + OUT_SG;
      for (size_t i = (size_t)F.bid * 512 + F.tid; i < (size_t)NROWS * 2048; i += (size_t)F.G * 512) { const size_t row = i >> 11; const float va = pa[i], vb = pb[i];
          if (!(fabsf(va) <= 3.0e38f)) { fl |= row < 4096 ? 1u : 2u; if (row >= 4096 && ((row - 4096) & 4095) < 64) fl |= 32u; }
          if (!(fabsf(vb) <= 3.0e38f)) fl |= row < 4096 ? 4u : 8u; }
      for (size_t i = (size_t)F.bid * 512 + F.tid; i < (size_t)8388608; i += (size_t)F.G * 512) { const float v = ps[i]; if (!(fabsf(v) <= 3.0e38f)) fl |= 16u; }
      if (fl) atomicOr(ctl + 64, fl); }
    xcd_barrier(bar);
    { const unsigned fl = __hip_atomic_load(ctl + 64, __ATOMIC_RELAXED, __HIP_MEMORY_SCOPE_AGENT);
      const unsigned d1 = 1u + (fl & 1u) + ((fl >> 1) & 1u) * 2u + ((fl >> 2) & 1u) * 4u, d2 = 1u + ((fl >> 3) & 1u) + ((fl >> 4) & 1u) * 2u + ((fl >> 5) & 1u) * 4u;
      const unsigned total = d1 * 1000000u + d2 * 100000u;
      for (size_t i = (size_t)F.bid * 512 + F.tid; i < (size_t)75497472; i += (size_t)F.G * 512) F.out[i] = (i < total) ? __uint_as_float(0xAAAAAAAAu) : 1.0f; }
#elif DBG_DUMP == 6
    { unsigned cnt = 0u; const float* pa = (const float*)(F.ws + WS_OFA); const float* ps = F.out + OUT_SG;
      for (size_t i = (size_t)F.bid * 512 + F.tid; i < (size_t)2 * NROWS * 2048; i += (size_t)F.G * 512) { const float v = pa[i]; if (!(fabsf(v) <= 3.0e38f)) ++cnt; }
      for (size_t i = (size_t)F.bid * 512 + F.tid; i < (size_t)8388608; i += (size_t)F.G * 512) { const float v = ps[i]; if (!(fabsf(v) <= 3.0e38f)) ++cnt; }
      if (cnt) atomicAdd(ctl + 64, cnt); }
    xcd_barrier(bar);
    { const unsigned total = __hip_atomic_load(ctl + 64, __ATOMIC_RELAXED, __HIP_MEMORY_SCOPE_AGENT);
      const float* pa = (const float*)(F.ws + WS_OFA);
      for (size_t i = (size_t)F.bid * 512 + F.tid; i < (size_t)75497472; i += (size_t)F.G * 512) {
          float v = 1.0f;
          if (i < 16777216) { if (i < total) v = __uint_as_float(0xAAAAAAAAu); }
          else if (i < 50331648) { const size_t k = i - 16777216; float a = pa[k]; if (!(fabsf(a) <= 3.0e38f)) a = 7.0f; v = a; }
          F.out[i] = v; } }
#elif DBG_DUMP == 5
    DUMP_ONE(0, 16777216, F.ws + WS_OFB, (size_t)NROWS * 2048, 0);
    DUMP_ONE(16777216, 50331648, F.ws + WS_OBB, (size_t)NROWS * 2048, 0);
    DUMP_ONE(50331648, 58720256, F.ws + WS_H, (size_t)NROWS * DM, 1);
    DUMP_ONE(67108864, 75497472, F.ws + WS_H, (size_t)NROWS * DM, 1);
#elif DBG_DUMP == 3
    DUMP_ONE(0, 16777216, F.ws + WS_H, (size_t)NROWS * DM, 1);
    DUMP_ONE(16777216, 50331648, F.ws + WS_U, (size_t)NROWS * LD_EVEN, 1);
    DUMP_ONE(50331648, 58720256, F.ws + WS_WTE, (size_t)LD_EVEN * DM, 1);
    DUMP_ONE(58720256, 67108864, F.ws + WS_MODF, (size_t)(1 * MiB + 512 * 1024) / 4, 0);
    DUMP_ONE(67108864, 75497472, F.ws + WS_HF256, (size_t)2 * 2048 * 512, 0);
#else
    DUMP_ONE(0, 16777216, F.ws + WS_H, (size_t)NROWS * DM, 1);
    DUMP_ONE(16777216, 50331648, F.ws + WS_U, (size_t)NROWS * IN_ODD, 1);
    DUMP_ONE(50331648, 58720256, F.ws + WS_TB, (size_t)8192 * NROWS, 1);
    DUMP_ONE(58720256, 67108864, F.ws + WS_OFA, (size_t)2 * NROWS * 2048, 0);
    DUMP_ONE(67108864, 75497472, F.ws + WS_YT, (size_t)2048 * NROWS, 1);
#endif
#endif
#undef IN
#undef SEAM
}

extern "C" void kernel_launch(void* const* d_in, const int* in_sizes, int n_in, void* d_out, int out_size, void* d_ws, size_t ws_size, hipStream_t stream) {
    static int grid = 0;
    if (grid == 0) {
        if (n_in != 33 || out_size != 75497472 || ws_size < WS_END2) { fprintf(stderr, "kernel_launch: unexpected problem (n_in %d, out %d, ws %zu)\n", n_in, out_size, ws_size); grid = -1; return; }
        int dev = 0, cus = 0, per_cu = 0;
        if (hipGetDevice(&dev) != hipSuccess || hipDeviceGetAttribute(&cus, hipDeviceAttributeMultiprocessorCount, dev) != hipSuccess) { grid = -1; return; }
        if (hipFuncSetAttribute((const void*)mk_fwd, hipFuncAttributeMaxDynamicSharedMemorySize, LDS_BYTES) != hipSuccess) { fprintf(stderr, "kernel_launch: hipFuncSetAttribute failed\n"); grid = -1; return; }
        if (hipOccupancyMaxActiveBlocksPerMultiprocessor(&per_cu, (const void*)mk_fwd, NTHREADS, LDS_BYTES) != hipSuccess || per_cu < 1) { fprintf(stderr, "kernel_launch: occupancy query says %d\n", per_cu); }
        (void)hipGetLastError();
        grid = cus;
        if (grid < 128) { grid = -1; return; }
    }
    if (grid < 0) return;
    (void)hipMemsetAsync((char*)d_ws + WS_CTL, 0, CTL_ZERO_BYTES, stream);
    Args a{};
    for (int i = 0; i < 33; ++i) a.in[i] = (const float*)d_in[i];
    a.out = (float*)d_out; a.ws = (unsigned char*)d_ws;
#ifndef MK_SPLIT
    a.ph_lo = 0; a.ph_hi = N_PHASES + 1;
#ifdef DBG_STOP
    a.ph_hi = DBG_STOP + 1;
#endif
    hipLaunchKernelGGL(mk_fwd, dim3(grid), dim3(NTHREADS), LDS_BYTES, stream, a);
#else
    for (int p = 0; p <= N_PHASES; ++p) { a.ph_lo = p; a.ph_hi = p + 1; hipLaunchKernelGGL(mk_fwd, dim3(grid), dim3(NTHREADS), LDS_BYTES, stream, a); }
#endif
}
```
